# Optimizing an MI355X kernel written in HIP

```python
import math
import jax, jax.numpy as jnp
from jax import lax
import numpy as np

D_MODEL = 1024
BATCH = 2
SEQ = 8192
DEPTH = 1

D_MIX = D_MODEL
HG_HEADS = 4
HG_DK = 128
HG_DV = 128
HG_WIDTH = HG_HEADS * HG_DV
HG_CHUNK = 64
SG_GROUPS = 4
SG_CH = 128
SG_WIDTH = SG_GROUPS * SG_CH
SG_CHUNK = 128
IN_COLS = 3 * HG_HEADS * HG_DK + HG_WIDTH + 2 * SG_WIDTH
SPLIT_POINTS = (HG_HEADS * HG_DK, 2 * HG_HEADS * HG_DK, 2 * HG_HEADS * HG_DK + HG_WIDTH,
                2 * HG_HEADS * HG_DK + 2 * HG_WIDTH)
MOE_GROUPS = 4
MOE_EXPERTS_PER_GROUP = 8
MOE_EXPERTS = MOE_GROUPS * MOE_EXPERTS_PER_GROUP
MOE_TOP_K = 2
MOE_HIDDEN = 512
MOE_BLOCK = 128
ALPHA = (2.0 * DEPTH) ** 0.25
BETA = (8.0 * DEPTH) ** -0.25
LN_EPS = 1e-5
RMS_EPS = 1e-6

kernel_name = "hymba_hgrn2_gmlp_hiermoe_deepnorm_adaln"


def _layernorm(x, g, b):
    xf = x.astype(jnp.float32)
    mu = jnp.mean(xf, axis=-1, keepdims=True)
    var = jnp.mean(jnp.square(xf - mu), axis=-1, keepdims=True)
    y = (xf - mu) * lax.rsqrt(var + LN_EPS) * g.astype(jnp.float32) + b.astype(jnp.float32)
    return y.astype(x.dtype)


def _modulate(x, shift, scale):
    return x * (1.0 + scale[:, None, :]) + shift[:, None, :]


def _to_chunks(t, c):
    b, s, h, d = t.shape
    return t.reshape(b, s // c, c, h, d).transpose(1, 0, 3, 2, 4)


def _hgrn2_mixer(q, fz, iv, og, lb, gn_w):
    b, s, _ = q.shape
    dt = q.dtype
    q = jax.nn.silu(q.astype(jnp.float32)).reshape(b, s, HG_HEADS, HG_DK)
    lbh = lb.reshape(HG_HEADS, HG_DK)
    f = lbh + (1.0 - lbh) * jax.nn.sigmoid(fz.astype(jnp.float32).reshape(b, s, HG_HEADS, HG_DK))
    logf = jnp.log(f)
    k = 1.0 - f
    v = iv.astype(jnp.float32).reshape(b, s, HG_HEADS, HG_DV)
    qc, kc, vc, lfc = (_to_chunks(t, HG_CHUNK) for t in (q, k, v, logf))
    causal = jnp.tril(jnp.ones((HG_CHUNK, HG_CHUNK), dtype=bool))

    def step(state, inp):
        qq, kk, vv, lf = inp
        cum = jnp.cumsum(lf, axis=2)
        diff = cum[:, :, :, None, :] - cum[:, :, None, :, :]
        decay = jnp.exp(jnp.where(causal[None, None, :, :, None], diff, -jnp.inf))
        scores = jnp.einsum('bhtd,bhsd,bhtsd->bhts', qq, kk, decay)
        o_intra = jnp.einsum('bhts,bhsv->bhtv', scores, vv)
        o_inter = jnp.einsum('bhtd,bhdv->bhtv', qq * jnp.exp(cum), state)
        last = cum[:, :, -1:, :]
        new_state = jnp.exp(last[:, :, 0, :])[..., None] * state + \
            jnp.einsum('bhsd,bhsv->bhdv', kk * jnp.exp(last - cum), vv)
        return new_state, o_intra + o_inter

    s0 = jnp.zeros((b, HG_HEADS, HG_DK, HG_DV), jnp.float32)
    _, oc = lax.scan(step, s0, (qc, kc, vc, lfc))
    o = oc.transpose(1, 0, 3, 2, 4).reshape(b, s, HG_HEADS, HG_DV)
    o = o * lax.rsqrt(jnp.mean(jnp.square(o), axis=-1, keepdims=True) + RMS_EPS) * gn_w.astype(jnp.float32)
    o = o * jax.nn.silu(og.astype(jnp.float32).reshape(b, s, HG_HEADS, HG_DV))
    return o.reshape(b, s, HG_WIDTH).astype(dt)


def _spatial_gating_mixer(z, ln_g, ln_b, w_s, b_s):
    b, s, _ = z.shape
    z = jax.nn.gelu(z, approximate=False)
    u, v = z[..., :SG_WIDTH], z[..., SG_WIDTH:]
    v = _layernorm(v, ln_g, ln_b)
    v = v.reshape(b, s // SG_CHUNK, SG_CHUNK, SG_GROUPS, SG_CH)
    w_causal = w_s * jnp.tril(jnp.ones((SG_CHUNK, SG_CHUNK), dtype=w_s.dtype))
    mixed = jnp.einsum('gts,bnsgc->bntgc', w_causal, v) + b_s.T[None, None, :, :, None]
    return u * mixed.reshape(b, s, SG_WIDTH)


def _hier_moe(h, rg_w, rg_b, re_w, re_b, w_up, w_down):
    b, s, d = h.shape
    t = b * s
    xf = h.reshape(t, d)
    x32 = xf.astype(jnp.float32)
    g_logits = x32 @ rg_w.astype(jnp.float32) + rg_b.astype(jnp.float32)
    g_prob = jax.nn.softmax(g_logits, axis=-1)
    p_group, g_idx = lax.top_k(g_prob, 1)
    e_logits_all = jnp.einsum('td,gde->tge', x32, re_w.astype(jnp.float32)) + re_b.astype(jnp.float32)
    e_logits = jnp.take_along_axis(e_logits_all, g_idx[:, :, None], axis=1)[:, 0]
    e_prob = jax.nn.softmax(e_logits, axis=-1)
    top_p, top_j = lax.top_k(e_prob, MOE_TOP_K)
    weights = p_group * top_p / jnp.sum(top_p, axis=-1, keepdims=True)
    expert = g_idx * MOE_EXPERTS_PER_GROUP + top_j

    n_assign = t * MOE_TOP_K
    e_flat = expert.reshape(n_assign)
    tok_flat = jnp.repeat(jnp.arange(t, dtype=jnp.int32), MOE_TOP_K)
    w_flat = weights.reshape(n_assign)
    order = jnp.argsort(e_flat)
    e_sorted, tok_sorted, w_sorted = e_flat[order], tok_flat[order], w_flat[order]
    counts = jax.ops.segment_sum(jnp.ones((n_assign,), jnp.int32), e_flat, num_segments=MOE_EXPERTS)
    start = jnp.cumsum(counts) - counts
    padded = (counts + MOE_BLOCK - 1) // MOE_BLOCK * MOE_BLOCK
    pend = jnp.cumsum(padded)
    pstart = pend - padded
    dest = pstart[e_sorted] + (jnp.arange(n_assign, dtype=jnp.int32) - start[e_sorted])
    n_blocks = -(-n_assign // MOE_BLOCK) + MOE_EXPERTS
    n_rows = n_blocks * MOE_BLOCK
    pad_tok = jnp.zeros((n_rows,), jnp.int32).at[dest].set(tok_sorted)
    pad_w = jnp.zeros((n_rows,), jnp.float32).at[dest].set(w_sorted)
    block_e = jnp.minimum(jnp.searchsorted(pend, jnp.arange(n_blocks, dtype=jnp.int32) * MOE_BLOCK,
                                           side='right'), MOE_EXPERTS - 1).astype(jnp.int32)
    xb = xf[pad_tok].reshape(n_blocks, MOE_BLOCK, d)

    def expert_block(args):
        xblk, e = args
        gu = xblk @ w_up[e]
        return (jax.nn.silu(gu[:, :MOE_HIDDEN]) * gu[:, MOE_HIDDEN:]) @ w_down[e]

    yb = lax.map(expert_block, (xb, block_e)).reshape(n_rows, d)
    y = (yb.astype(jnp.float32) * pad_w[:, None]).astype(h.dtype)
    out = jnp.zeros((t, d), h.dtype).at[pad_tok].add(y)
    return out.reshape(b, s, d)


def setup_inputs(seed: int = 0) -> dict:
    key = jax.random.key(seed)
    ks = jax.random.split(key, 24)
    f32 = jnp.float32
    L, D = DEPTH, D_MODEL

    def nrm(k, shape, scale):
        return jax.random.normal(k, shape, f32) * scale

    return {
        "x": nrm(ks[0], (BATCH, SEQ, D), 1.0),
        "c": nrm(ks[1], (BATCH, D), 1.0),
        "w_ada": nrm(ks[2], (L, D, 6 * D), 0.1 * D ** -0.5),
        "b_ada": nrm(ks[3], (L, 6 * D), 0.01),
        "w_in": nrm(ks[4], (L, D, IN_COLS), D ** -0.5),
        "lb_logits": nrm(ks[5], (L + 1, HG_HEADS * HG_DK), 1.0),
        "hg_norm_w": 1.0 + nrm(ks[6], (L, HG_DV), 0.02),
        "sg_ln_g": 1.0 + nrm(ks[7], (L, SG_WIDTH), 0.02),
        "sg_ln_b": nrm(ks[8], (L, SG_WIDTH), 0.02),
        "sg_w": nrm(ks[9], (L, SG_GROUPS, SG_CHUNK, SG_CHUNK), SG_CHUNK ** -0.5),
        "sg_b": 1.0 + nrm(ks[10], (L, SG_GROUPS, SG_CHUNK), 0.02),
        "w_out": nrm(ks[11], (L, D_MIX, D), BETA * D_MIX ** -0.5),
        "ln1_g": 1.0 + nrm(ks[12], (L, D), 0.02),
        "ln1_b": nrm(ks[13], (L, D), 0.02),
        "router_group_w": nrm(ks[14], (L, D, MOE_GROUPS), D ** -0.5),
        "router_group_b": nrm(ks[15], (L, MOE_GROUPS), 0.01),
        "router_expert_w": nrm(ks[16], (L, MOE_GROUPS, D, MOE_EXPERTS_PER_GROUP), D ** -0.5),
        "router_expert_b": nrm(ks[17], (L, MOE_GROUPS, MOE_EXPERTS_PER_GROUP), 0.01),
        "w_up": nrm(ks[18], (L, MOE_EXPERTS, D, 2 * MOE_HIDDEN), D ** -0.5),
        "w_down": nrm(ks[19], (L, MOE_EXPERTS, MOE_HIDDEN, D), BETA * MOE_HIDDEN ** -0.5),
        "ln2_g": 1.0 + nrm(ks[20], (L, D), 0.02),
        "ln2_b": nrm(ks[21], (L, D), 0.02),
    }


def reference(x, c, w_ada, b_ada, w_in, lb_logits, hg_norm_w, sg_ln_g, sg_ln_b, sg_w, sg_b,
              w_out, ln1_g, ln1_b, router_group_w, router_group_b, router_expert_w,
              router_expert_b, w_up, w_down, ln2_g, ln2_b):
    lower_bounds = jnp.cumsum(jax.nn.softmax(lb_logits.astype(jnp.float32), axis=0), axis=0)
    c_act = jax.nn.silu(c)
    for l in range(DEPTH):
        ada = c_act @ w_ada[l] + b_ada[l]
        sh1, sc1, g1, sh2, sc2, g2 = jnp.split(ada, 6, axis=-1)
        h = _modulate(x, sh1, sc1)
        proj = h @ w_in[l]
        q, fz, iv, og, z = jnp.split(proj, SPLIT_POINTS, axis=-1)
        y_a = _hgrn2_mixer(q, fz, iv, og, lower_bounds[l], hg_norm_w[l])
        y_b = _spatial_gating_mixer(z, sg_ln_g[l], sg_ln_b[l], sg_w[l], sg_b[l])
        y = jnp.concatenate([y_a, y_b], axis=-1) @ w_out[l]
        x = _layernorm(ALPHA * x + (1.0 + g1[:, None, :]) * y, ln1_g[l], ln1_b[l])
        h2 = _modulate(x, sh2, sc2)
        m = _hier_moe(h2, router_group_w[l], router_group_b[l], router_expert_w[l],
                      router_expert_b[l], w_up[l], w_down[l])
        x = _layernorm(ALPHA * x + (1.0 + g2[:, None, :]) * m, ln2_g[l], ln2_b[l])
    return x
```

```cpp
#include <hip/hip_runtime.h>
#include <cstdio>
#include <cstdint>

typedef unsigned short bf16;
typedef float f32x4 __attribute__((ext_vector_type(4)));

constexpr int NB = 2, SEQ = 8192, D = 1024, T = NB * SEQ;
constexpr int NIN = 3072;
constexpr int NE = 32, HID = 512;
constexpr float ALPHA = 1.189207115002721f;
constexpr float LN_EPS = 1e-5f, RMS_EPS = 1e-6f;
constexpr int ROWS_PAD = 40960;

constexpr size_t MiB = 1u << 20;
constexpr size_t WS_CTL = 0;
constexpr size_t WS_SMALL = 1 * MiB;
constexpr size_t WS_LIST = 2 * MiB, WS_WLIST = 4 * MiB;
constexpr size_t WS_WINT = 6 * MiB, WS_WOUTT = 12 * MiB, WS_WUPT = 14 * MiB, WS_WDNT = 78 * MiB;
constexpr size_t WS_B = 110 * MiB;
constexpr size_t WS_QS = 142 * MiB, WS_LOGF = 158 * MiB, WS_V = 190 * MiB, WS_OG = 206 * MiB, WS_ZG = 222 * MiB;
constexpr size_t WS_Y = 142 * MiB, WS_ACT = 206 * MiB;
constexpr size_t WS_SLOC = 254 * MiB, WS_SSTART = 270 * MiB;
constexpr size_t WS_X1 = 286 * MiB, WS_Y2 = 350 * MiB, WS_END = 430 * MiB;
constexpr size_t SM_ADA = 0, SM_LB = 64 * 1024, SM_ROWBASE = 128 * 1024, SM_SGSTAT = 256 * 1024, SM_TOKE = 512 * 1024, SM_TOKS = 640 * 1024, SM_DTOT = 768 * 1024;
constexpr int CW_CNT = 1024;

struct P {
    const float *x, *c, *w_ada, *b_ada, *w_in, *lb_logits, *hg_norm_w, *sg_ln_g, *sg_ln_b, *sg_w, *sg_b, *w_out, *ln1_g, *ln1_b,
        *rg_w, *rg_b, *re_w, *re_b, *w_up, *w_down, *ln2_g, *ln2_b;
    float* out; unsigned char* ws;
};

__device__ __forceinline__ float bf2f(bf16 b) { return __uint_as_float(((unsigned)b) << 16); }
__device__ __forceinline__ bf16 f2bf(float f) { unsigned u = __float_as_uint(f); return (bf16)((u + 0x7fffu + ((u >> 16) & 1u)) >> 16); }
__device__ __forceinline__ float silu_f(float x) { return x / (1.f + __expf(-x)); }
__device__ __forceinline__ float gelu_f(float x) { return 0.5f * x * (1.f + erff(x * 0.70710678118654752f)); }
__device__ __forceinline__ float wave_sum(float v) {
#pragma unroll
    for (int o = 1; o < 64; o <<= 1) v += __shfl_xor(v, o);
    return v;
}
#define WSP(type, off) ((type*)(p.ws + (off)))

__global__ void k_ada(P p) {
    const int idx = blockIdx.x * 256 + threadIdx.x; if (idx >= 2 * 6144) return;
    const int b = idx / 6144, j = idx % 6144;
    float acc = 0.f;
    for (int k = 0; k < D; ++k) { const float cv = p.c[b * D + k]; acc += silu_f(cv) * p.w_ada[(size_t)k * 6144 + j]; }
    WSP(float, WS_SMALL + SM_ADA)[idx] = acc + p.b_ada[j];
    if (idx < 512) { const float l0 = p.lb_logits[idx], l1 = p.lb_logits[512 + idx]; const float m = fmaxf(l0, l1); const float e0 = expf(l0 - m), e1 = expf(l1 - m);
        WSP(float, WS_SMALL + SM_LB)[idx] = e0 / (e0 + e1); }
}
__device__ __forceinline__ int updst(int n) { const int part = n >> 9, q = n & 511; return 256 * (q >> 7) + 128 * part + (q & 127); }
__global__ void k_convT(const float* W, bf16* WT, int K, int N, int upmode) {
    __shared__ float t[32][33];
    const float* Wb = W + (size_t)blockIdx.z * K * N; bf16* WTb = WT + (size_t)blockIdx.z * K * N;
    const int n0 = blockIdx.x * 32, k0 = blockIdx.y * 32;
    for (int i = threadIdx.y; i < 32; i += 8) t[i][threadIdx.x] = Wb[(size_t)(k0 + i) * N + n0 + threadIdx.x];
    __syncthreads();
    for (int i = threadIdx.y; i < 32; i += 8) { const int n = n0 + i; const int dn = upmode ? updst(n) : n; WTb[(size_t)dn * K + k0 + threadIdx.x] = f2bf(t[threadIdx.x][i]); }
}
__global__ void k_xmod(P p) {
    const size_t i4 = (size_t)blockIdx.x * 256 + threadIdx.x; if (i4 >= (size_t)T * D / 4) return;
    const size_t row = i4 / (D / 4); const int col = (int)(i4 % (D / 4)) * 4; const int b = (int)(row >> 13);
    const float* ada = WSP(float, WS_SMALL + SM_ADA) + b * 6144;
    const f32x4 xv = *(const f32x4*)(p.x + row * D + col), sh = *(const f32x4*)(ada + col), sc = *(const f32x4*)(ada + 1024 + col);
    bf16* h = WSP(bf16, WS_B) + row * D + col;
#pragma unroll
    for (int j = 0; j < 4; ++j) h[j] = f2bf(xv[j] * (1.f + sc[j]) + sh[j]);
}

template <class G> __global__ void __launch_bounds__(256) k_gemm_naive(G g) {
    __shared__ float As[16][65], Bs[16][65], Bs2[16][65];
    const int tn = blockIdx.x, tm = blockIdx.y, grp = blockIdx.z;
    const int mrows = g.rows(grp); if (tm * 64 >= mrows) return;
    const int tx = threadIdx.x & 15, ty = threadIdx.x >> 4, K = g.K;
    float acc[4][4], acc2[4][4];
#pragma unroll
    for (int i = 0; i < 4; ++i)
#pragma unroll
        for (int j = 0; j < 4; ++j) { acc[i][j] = 0.f; acc2[i][j] = 0.f; }
    for (int k0 = 0; k0 < K; k0 += 16) {
#pragma unroll
        for (int i = 0; i < 4; ++i) { const int e = threadIdx.x + 256 * i, r = e >> 4, kk = e & 15; const bf16* ar = g.arow(grp, tm * 64 + r); As[kk][r] = ar ? bf2f(ar[k0 + kk]) : 0.f;
            Bs[kk][r] = bf2f(g.brow(grp, tn * 64 + r, 0)[k0 + kk]); if (G::DUAL) Bs2[kk][r] = bf2f(g.brow(grp, tn * 64 + r, 1)[k0 + kk]); }
        __syncthreads();
#pragma unroll
        for (int kk = 0; kk < 16; ++kk) {
            float a[4], b[4], b2[4];
#pragma unroll
            for (int i = 0; i < 4; ++i) { a[i] = As[kk][ty * 4 + i]; b[i] = Bs[kk][tx * 4 + i]; b2[i] = G::DUAL ? Bs2[kk][tx * 4 + i] : 0.f; }
#pragma unroll
            for (int i = 0; i < 4; ++i)
#pragma unroll
                for (int j = 0; j < 4; ++j) { acc[i][j] += a[i] * b[j]; if (G::DUAL) acc2[i][j] += a[i] * b2[j]; }
        }
        __syncthreads();
    }
#pragma unroll
    for (int i = 0; i < 4; ++i)
#pragma unroll
        for (int j = 0; j < 4; ++j) { const int r = tm * 64 + ty * 4 + i; if (r < mrows) g.epi(grp, r, tn * 64 + tx * 4 + j, acc[i][j], acc2[i][j]); }
}
struct GInproj {
    static constexpr bool DUAL = false; P p; int K, pad;
    __device__ int rows(int) const { return T; }
    __device__ const bf16* arow(int, int r) const { return WSP(bf16, WS_B) + (size_t)r * D; }
    __device__ const bf16* brow(int, int n, int) const { return WSP(bf16, WS_WINT) + (size_t)n * D; }
    __device__ void epi(int, int r, int c, float v, float) const {
        if (c < 512) WSP(bf16, WS_QS)[(size_t)r * 512 + c] = f2bf(silu_f(v));
        else if (c < 1024) { const int cc = c - 512; const float lb = WSP(float, WS_SMALL + SM_LB)[cc]; const float f = lb + (1.f - lb) / (1.f + expf(-v)); WSP(float, WS_LOGF)[(size_t)r * 512 + cc] = logf(f); }
        else if (c < 1536) WSP(bf16, WS_V)[(size_t)r * 512 + c - 1024] = f2bf(v);
        else if (c < 2048) WSP(bf16, WS_OG)[(size_t)r * 512 + c - 1536] = f2bf(silu_f(v));
        else WSP(bf16, WS_ZG)[(size_t)r * 1024 + c - 2048] = f2bf(gelu_f(v));
    }
};
struct GOutproj {
    static constexpr bool DUAL = false; P p; int K, pad;
    __device__ int rows(int) const { return T; }
    __device__ const bf16* arow(int, int r) const { return WSP(bf16, WS_B) + (size_t)r * D; }
    __device__ const bf16* brow(int, int n, int) const { return WSP(bf16, WS_WOUTT) + (size_t)n * D; }
    __device__ void epi(int, int r, int c, float v, float) const { WSP(float, WS_Y)[(size_t)r * D + c] = v; }
};
struct GUp {
    static constexpr bool DUAL = true; P p; int K, pad;
    __device__ int rows(int e) const { return (int)WSP(unsigned, WS_CTL)[CW_CNT + e]; }
    __device__ const bf16* arow(int e, int r) const { if (r >= rows(e)) return nullptr; return WSP(bf16, WS_B) + (size_t)WSP(int, WS_LIST)[e * T + r] * D; }
    __device__ const bf16* brow(int e, int n, int which) const { return WSP(bf16, WS_WUPT) + ((size_t)e * 1024 + 256 * (n >> 7) + 128 * which + (n & 127)) * D; }
    __device__ void epi(int e, int r, int c, float g, float u) const { const int rb = WSP(int, WS_SMALL + SM_ROWBASE)[e]; WSP(bf16, WS_ACT)[(size_t)(rb + r) * HID + c] = f2bf(silu_f(g) * u); }
};
struct GDown {
    static constexpr bool DUAL = false; P p; int K, pad;
    __device__ int rows(int e) const { return (int)WSP(unsigned, WS_CTL)[CW_CNT + e]; }
    __device__ const bf16* arow(int e, int r) const { if (r >= rows(e)) return nullptr; const int rb = WSP(int, WS_SMALL + SM_ROWBASE)[e]; return WSP(bf16, WS_ACT) + (size_t)(rb + r) * HID; }
    __device__ const bf16* brow(int e, int n, int) const { return WSP(bf16, WS_WDNT) + ((size_t)e * 1024 + n) * HID; }
    __device__ void epi(int e, int r, int c, float v, float) const { const int rb = WSP(int, WS_SMALL + SM_ROWBASE)[e]; WSP(bf16, WS_Y2)[(size_t)(rb + r) * D + c] = f2bf(v * WSP(float, WS_WLIST)[e * T + r]); }
};

__global__ void __launch_bounds__(128) k_hgrn_naive(P p) {
    const int b = blockIdx.x >> 2, h = blockIdx.x & 3, v = threadIdx.x;
    __shared__ float sf[16][128], sk[16][128], sq[16][128]; __shared__ float red[16][2];
    float S[128];
#pragma unroll
    for (int d = 0; d < 128; ++d) S[d] = 0.f;
    const float gw = p.hg_norm_w[v];
    const bf16* QS = WSP(bf16, WS_QS); const float* LF = WSP(float, WS_LOGF); const bf16* VV = WSP(bf16, WS_V); const bf16* OG = WSP(bf16, WS_OG); bf16* YC = WSP(bf16, WS_B);
    for (int t0 = 0; t0 < SEQ; t0 += 16) {
        for (int i = 0; i < 16; ++i) { const size_t row = (size_t)b * SEQ + t0 + i; const float lf = LF[row * 512 + h * 128 + v]; sf[i][v] = expf(lf); sk[i][v] = -expm1f(lf); sq[i][v] = bf2f(QS[row * 512 + h * 128 + v]); }
        __syncthreads();
        float o[16];
#pragma unroll
        for (int i = 0; i < 16; ++i) {
            const size_t row = (size_t)b * SEQ + t0 + i; const float vv = bf2f(VV[row * 512 + h * 128 + v]);
            float acc = 0.f;
#pragma unroll
            for (int d = 0; d < 128; ++d) { S[d] = sf[i][d] * S[d] + sk[i][d] * vv; acc += S[d] * sq[i][d]; }
            o[i] = acc;
            const float ss = wave_sum(acc * acc);
            if ((v & 63) == 0) red[i][v >> 6] = ss;
        }
        __syncthreads();
#pragma unroll
        for (int i = 0; i < 16; ++i) {
            const size_t row = (size_t)b * SEQ + t0 + i;
            const float r = rsqrtf((red[i][0] + red[i][1]) * (1.f / 128.f) + RMS_EPS);
            YC[row * D + h * 128 + v] = f2bf(o[i] * r * gw * bf2f(OG[row * 512 + h * 128 + v]));
        }
        __syncthreads();
    }
}
__global__ void __launch_bounds__(256) k_sg_stats(P p) {
    const int row = (blockIdx.x * 256 + threadIdx.x) >> 6, lane = threadIdx.x & 63;
    const bf16* z = WSP(bf16, WS_ZG) + (size_t)row * 1024 + 512;
    float v[8], s = 0.f;
#pragma unroll
    for (int j = 0; j < 8; ++j) { v[j] = bf2f(z[lane * 8 + j]); s += v[j]; }
    const float mean = wave_sum(s) * (1.f / 512.f); float q = 0.f;
#pragma unroll
    for (int j = 0; j < 8; ++j) { const float d = v[j] - mean; q += d * d; }
    const float rstd = rsqrtf(wave_sum(q) * (1.f / 512.f) + LN_EPS);
    if (lane == 0) { WSP(float, WS_SMALL + SM_SGSTAT)[row * 2] = mean; WSP(float, WS_SMALL + SM_SGSTAT)[row * 2 + 1] = rstd; }
}
__global__ void __launch_bounds__(256) k_sg_naive(P p) {
    const size_t idx = (size_t)blockIdx.x * 256 + threadIdx.x; const int row = (int)(idx >> 9), ch = (int)(idx & 511), g = ch >> 7;
    const int tin = row & 127, row0 = row - tin;
    const bf16* ZG = WSP(bf16, WS_ZG); const float* st = WSP(float, WS_SMALL + SM_SGSTAT);
    const float lg = p.sg_ln_g[ch], lb = p.sg_ln_b[ch];
    float acc = 0.f;
    for (int s = 0; s <= tin; ++s) { const float vn = (bf2f(ZG[(size_t)(row0 + s) * 1024 + 512 + ch]) - st[(row0 + s) * 2]) * st[(row0 + s) * 2 + 1] * lg + lb; acc += p.sg_w[(g * 128 + tin) * 128 + s] * vn; }
    acc += p.sg_b[g * 128 + tin];
    WSP(bf16, WS_B)[(size_t)row * D + 512 + ch] = f2bf(bf2f(ZG[(size_t)row * 1024 + ch]) * acc);
}
__global__ void __launch_bounds__(256) k_ln1_route(P p) {
    const int row = (blockIdx.x * 256 + threadIdx.x) >> 6, lane = threadIdx.x & 63, b = row >> 13;
    const float* ada = WSP(float, WS_SMALL + SM_ADA) + b * 6144;
    const float* Y = WSP(float, WS_Y) + (size_t)row * D; const float* xr = p.x + (size_t)row * D;
    float v[16]; float s = 0.f;
#pragma unroll
    for (int j = 0; j < 4; ++j) { const int col = 256 * j + lane * 4; const f32x4 xv = *(const f32x4*)(xr + col), yv = *(const f32x4*)(Y + col), g1 = *(const f32x4*)(ada + 2048 + col);
#pragma unroll
        for (int i = 0; i < 4; ++i) { v[4 * j + i] = ALPHA * xv[i] + (1.f + g1[i]) * yv[i]; s += v[4 * j + i]; } }
    const float mean = wave_sum(s) * (1.f / D); float q = 0.f;
#pragma unroll
    for (int i = 0; i < 16; ++i) { v[i] -= mean; q += v[i] * v[i]; }
    const float rstd = rsqrtf(wave_sum(q) * (1.f / D) + LN_EPS);
    float lg[4], le[32];
#pragma unroll
    for (int i = 0; i < 4; ++i) lg[i] = 0.f;
#pragma unroll
    for (int i = 0; i < 32; ++i) le[i] = 0.f;
    float* X1 = WSP(float, WS_X1) + (size_t)row * D; bf16* H2 = WSP(bf16, WS_B) + (size_t)row * D;
#pragma unroll
    for (int j = 0; j < 4; ++j) { const int col = 256 * j + lane * 4; const f32x4 gg = *(const f32x4*)(p.ln1_g + col), bb = *(const f32x4*)(p.ln1_b + col), sh = *(const f32x4*)(ada + 3072 + col), sc = *(const f32x4*)(ada + 4096 + col);
        f32x4 x1;
#pragma unroll
        for (int i = 0; i < 4; ++i) { x1[i] = v[4 * j + i] * rstd * gg[i] + bb[i]; const float h2 = x1[i] * (1.f + sc[i]) + sh[i]; H2[col + i] = f2bf(h2);
            const f32x4 wg = *(const f32x4*)(p.rg_w + (size_t)(col + i) * 4);
#pragma unroll
            for (int g = 0; g < 4; ++g) { lg[g] += h2 * wg[g];
                const f32x4 w0 = *(const f32x4*)(p.re_w + ((size_t)g * D + col + i) * 8), w1 = *(const f32x4*)(p.re_w + ((size_t)g * D + col + i) * 8 + 4);
#pragma unroll
                for (int e = 0; e < 4; ++e) { le[g * 8 + e] += h2 * w0[e]; le[g * 8 + 4 + e] += h2 * w1[e]; } } }
        *(f32x4*)(X1 + col) = x1; }
#pragma unroll
    for (int g = 0; g < 4; ++g) lg[g] = wave_sum(lg[g]) + p.rg_b[g];
#pragma unroll
    for (int i = 0; i < 32; ++i) le[i] = wave_sum(le[i]) + p.re_b[i];
    int gi = 0; float gm = lg[0];
#pragma unroll
    for (int g = 1; g < 4; ++g) if (lg[g] > gm) { gm = lg[g]; gi = g; }
    float gs = 0.f;
#pragma unroll
    for (int g = 0; g < 4; ++g) gs += expf(lg[g] - gm);
    const float pgroup = 1.f / gs;
    float el[8];
#pragma unroll
    for (int e = 0; e < 8; ++e) el[e] = gi == 0 ? le[e] : gi == 1 ? le[8 + e] : gi == 2 ? le[16 + e] : le[24 + e];
    int j0 = 0; float m0 = el[0];
#pragma unroll
    for (int e = 1; e < 8; ++e) if (el[e] > m0) { m0 = el[e]; j0 = e; }
    int j1 = -1; float m1 = -3.0e38f;
#pragma unroll
    for (int e = 0; e < 8; ++e) if (e != j0 && el[e] > m1) { m1 = el[e]; j1 = e; }
    const float r1 = expf(m1 - m0); const float w0 = pgroup / (1.f + r1), w1 = pgroup * r1 / (1.f + r1);
    if (lane == 0) {
        unsigned* cnt = WSP(unsigned, WS_CTL) + CW_CNT; int* LIST = WSP(int, WS_LIST); float* WL = WSP(float, WS_WLIST); int* TE = WSP(int, WS_SMALL + SM_TOKE); int* TS = WSP(int, WS_SMALL + SM_TOKS);
        const int e0 = gi * 8 + j0, e1 = gi * 8 + j1;
        const int s0 = (int)atomicAdd(cnt + e0, 1u), s1 = (int)atomicAdd(cnt + e1, 1u);
        LIST[e0 * T + s0] = row; WL[e0 * T + s0] = w0; LIST[e1 * T + s1] = row; WL[e1 * T + s1] = w1;
        TE[row * 2] = e0; TE[row * 2 + 1] = e1; TS[row * 2] = s0; TS[row * 2 + 1] = s1;
    }
}
__global__ void k_rowbase(P p) {
    if (threadIdx.x == 0) { const unsigned* cnt = WSP(unsigned, WS_CTL) + CW_CNT; int* rb = WSP(int, WS_SMALL + SM_ROWBASE); int acc = 0;
        for (int e = 0; e < NE; ++e) { rb[e] = acc; acc += (int)((cnt[e] + 255u) / 256u) * 256; } rb[NE] = acc; }
}
__global__ void __launch_bounds__(256) k_final(P p) {
    const int row = (blockIdx.x * 256 + threadIdx.x) >> 6, lane = threadIdx.x & 63, b = row >> 13;
    const float* ada = WSP(float, WS_SMALL + SM_ADA) + b * 6144;
    const int* TE = WSP(int, WS_SMALL + SM_TOKE); const int* TS = WSP(int, WS_SMALL + SM_TOKS); const int* rb = WSP(int, WS_SMALL + SM_ROWBASE);
    const size_t rA = (size_t)(rb[TE[row * 2]] + TS[row * 2]), rB = (size_t)(rb[TE[row * 2 + 1]] + TS[row * 2 + 1]);
    const bf16* ya = WSP(bf16, WS_Y2) + rA * D; const bf16* yb = WSP(bf16, WS_Y2) + rB * D; const float* X1 = WSP(float, WS_X1) + (size_t)row * D;
    float v[16]; float s = 0.f;
#pragma unroll
    for (int j = 0; j < 4; ++j) { const int col = 256 * j + lane * 4; const f32x4 xv = *(const f32x4*)(X1 + col), g2 = *(const f32x4*)(ada + 5120 + col);
#pragma unroll
        for (int i = 0; i < 4; ++i) { const float m = bf2f(ya[col + i]) + bf2f(yb[col + i]); v[4 * j + i] = ALPHA * xv[i] + (1.f + g2[i]) * m; s += v[4 * j + i]; } }
    const float mean = wave_sum(s) * (1.f / D); float q = 0.f;
#pragma unroll
    for (int i = 0; i < 16; ++i) { v[i] -= mean; q += v[i] * v[i]; }
    const float rstd = rsqrtf(wave_sum(q) * (1.f / D) + LN_EPS);
#pragma unroll
    for (int j = 0; j < 4; ++j) { const int col = 256 * j + lane * 4; const f32x4 gg = *(const f32x4*)(p.ln2_g + col), bb = *(const f32x4*)(p.ln2_b + col); f32x4 o;
#pragma unroll
        for (int i = 0; i < 4; ++i) o[i] = v[4 * j + i] * rstd * gg[i] + bb[i];
        *(f32x4*)(p.out + (size_t)row * D + col) = o; }
}

extern "C" void kernel_launch(void* const* d_in, const int* in_sizes, int n_in, void* d_out, int out_size, void* d_ws, size_t ws_size, hipStream_t stream) {
    if (n_in != 22 || ws_size < WS_END) { fprintf(stderr, "kernel_launch: unexpected n_in %d / ws %zu\n", n_in, ws_size); return; }
    P p{};
    const float** f = (const float**)&p;
    for (int i = 0; i < 22; ++i) f[i] = (const float*)d_in[i];
    p.out = (float*)d_out; p.ws = (unsigned char*)d_ws;
    (void)hipMemsetAsync((char*)d_ws + WS_CTL, 0, 1 * MiB, stream);
    k_ada<<<48, 256, 0, stream>>>(p);
    k_convT<<<dim3(NIN / 32, D / 32, 1), dim3(32, 8), 0, stream>>>(p.w_in, WSP(bf16, WS_WINT), D, NIN, 0);
    k_convT<<<dim3(D / 32, D / 32, 1), dim3(32, 8), 0, stream>>>(p.w_out, WSP(bf16, WS_WOUTT), D, D, 0);
    k_convT<<<dim3(1024 / 32, D / 32, NE), dim3(32, 8), 0, stream>>>(p.w_up, WSP(bf16, WS_WUPT), D, 1024, 1);
    k_convT<<<dim3(D / 32, HID / 32, NE), dim3(32, 8), 0, stream>>>(p.w_down, WSP(bf16, WS_WDNT), HID, D, 0);
    k_xmod<<<T * D / 4 / 256, 256, 0, stream>>>(p);
    k_gemm_naive<GInproj><<<dim3(NIN / 64, T / 64, 1), 256, 0, stream>>>(GInproj{p, D, 0});
    k_hgrn_naive<<<8, 128, 0, stream>>>(p);
    k_sg_stats<<<T / 4, 256, 0, stream>>>(p);
    k_sg_naive<<<T * 512 / 256, 256, 0, stream>>>(p);
    k_gemm_naive<GOutproj><<<dim3(D / 64, T / 64, 1), 256, 0, stream>>>(GOutproj{p, D, 0});
    k_ln1_route<<<T / 4, 256, 0, stream>>>(p);
    k_rowbase<<<1, 64, 0, stream>>>(p);
    k_gemm_naive<GUp><<<dim3(HID / 64, T / 64, NE), 256, 0, stream>>>(GUp{p, D, 0});
    k_gemm_naive<GDown><<<dim3(D / 64, T / 64, NE), 256, 0, stream>>>(GDown{p, HID, 0});
    k_final<<<T / 4, 256, 0, stream>>>(p);
}
```

```cpp
#include <hip/hip_runtime.h>
#include <cstdio>
#include <cstdint>

typedef unsigned short bf16;
typedef float f32x4 __attribute__((ext_vector_type(4)));

constexpr int NB = 2, SEQ = 8192, D = 1024, T = NB * SEQ;
constexpr int NIN = 3072;
constexpr int NE = 32, HID = 512;
constexpr float ALPHA = 1.189207115002721f;
constexpr float LN_EPS = 1e-5f, RMS_EPS = 1e-6f;
constexpr int ROWS_PAD = 40960;

constexpr size_t MiB = 1u << 20;
constexpr size_t WS_CTL = 0;
constexpr size_t WS_SMALL = 1 * MiB;
constexpr size_t WS_LIST = 2 * MiB, WS_WLIST = 4 * MiB;
constexpr size_t WS_WINT = 6 * MiB, WS_WOUTT = 12 * MiB, WS_WUPT = 14 * MiB, WS_WDNT = 78 * MiB;
constexpr size_t WS_B = 110 * MiB;
constexpr size_t WS_QS = 142 * MiB, WS_V = 158 * MiB, WS_OG = 174 * MiB, WS_LOGF = 190 * MiB, WS_ZG = 222 * MiB;
constexpr size_t WS_Y = 142 * MiB, WS_ACT = 206 * MiB;
constexpr size_t WS_SLOC = 254 * MiB, WS_SSTART = 270 * MiB;
constexpr size_t WS_X1 = 286 * MiB, WS_Y2 = 350 * MiB, WS_END = 430 * MiB;
constexpr size_t SM_ADA = 0, SM_LB = 64 * 1024, SM_ROWBASE = 128 * 1024, SM_SGSTAT = 256 * 1024, SM_TOKE = 512 * 1024, SM_TOKS = 640 * 1024, SM_DTOT = 768 * 1024;
constexpr int CW_CNT = 1024;

struct P {
    const float *x, *c, *w_ada, *b_ada, *w_in, *lb_logits, *hg_norm_w, *sg_ln_g, *sg_ln_b, *sg_w, *sg_b, *w_out, *ln1_g, *ln1_b,
        *rg_w, *rg_b, *re_w, *re_b, *w_up, *w_down, *ln2_g, *ln2_b;
    float* out; unsigned char* ws;
};

__device__ __forceinline__ float bf2f(bf16 b) { return __uint_as_float(((unsigned)b) << 16); }
__device__ __forceinline__ bf16 f2bf(float f) { unsigned u = __float_as_uint(f); return (bf16)((u + 0x7fffu + ((u >> 16) & 1u)) >> 16); }
__device__ __forceinline__ float silu_f(float x) { return x / (1.f + __expf(-x)); }
__device__ __forceinline__ float gelu_f(float x) { return 0.5f * x * (1.f + erff(x * 0.70710678118654752f)); }
__device__ __forceinline__ float wave_sum(float v) {
#pragma unroll
    for (int o = 1; o < 64; o <<= 1) v += __shfl_xor(v, o);
    return v;
}
#define WSP(type, off) ((type*)(p.ws + (off)))

__global__ void k_ada(P p) {
    const int idx = blockIdx.x * 256 + threadIdx.x; if (idx >= 2 * 6144) return;
    const int b = idx / 6144, j = idx % 6144;
    float acc = 0.f;
    for (int k = 0; k < D; ++k) { const float cv = p.c[b * D + k]; acc += silu_f(cv) * p.w_ada[(size_t)k * 6144 + j]; }
    WSP(float, WS_SMALL + SM_ADA)[idx] = acc + p.b_ada[j];
    if (idx < 512) { const float l0 = p.lb_logits[idx], l1 = p.lb_logits[512 + idx]; const float m = fmaxf(l0, l1); const float e0 = expf(l0 - m), e1 = expf(l1 - m);
        WSP(float, WS_SMALL + SM_LB)[idx] = e0 / (e0 + e1); }
}
__device__ __forceinline__ int updst(int n) { const int part = n >> 9, q = n & 511; return 256 * (q >> 7) + 128 * part + (q & 127); }
__global__ void k_convT(const float* W, bf16* WT, int K, int N, int upmode) {
    __shared__ float t[32][33];
    const float* Wb = W + (size_t)blockIdx.z * K * N; bf16* WTb = WT + (size_t)blockIdx.z * K * N;
    const int n0 = blockIdx.x * 32, k0 = blockIdx.y * 32;
    for (int i = threadIdx.y; i < 32; i += 8) t[i][threadIdx.x] = Wb[(size_t)(k0 + i) * N + n0 + threadIdx.x];
    __syncthreads();
    for (int i = threadIdx.y; i < 32; i += 8) { const int n = n0 + i; const int dn = upmode ? updst(n) : n; WTb[(size_t)dn * K + k0 + threadIdx.x] = f2bf(t[threadIdx.x][i]); }
}
__global__ void k_xmod(P p) {
    const size_t i4 = (size_t)blockIdx.x * 256 + threadIdx.x; if (i4 >= (size_t)T * D / 4) return;
    const size_t row = i4 / (D / 4); const int col = (int)(i4 % (D / 4)) * 4; const int b = (int)(row >> 13);
    const float* ada = WSP(float, WS_SMALL + SM_ADA) + b * 6144;
    const f32x4 xv = *(const f32x4*)(p.x + row * D + col), sh = *(const f32x4*)(ada + col), sc = *(const f32x4*)(ada + 1024 + col);
    bf16* h = WSP(bf16, WS_B) + row * D + col;
#pragma unroll
    for (int j = 0; j < 4; ++j) h[j] = f2bf(xv[j] * (1.f + sc[j]) + sh[j]);
}

template <class G> __global__ void __launch_bounds__(256) k_gemm_naive(G g) {
    __shared__ float As[16][65], Bs[16][65], Bs2[16][65];
    const int tn = blockIdx.x, tm = blockIdx.y, grp = blockIdx.z;
    const int mrows = g.rows(grp); if (tm * 64 >= mrows) return;
    const int tx = threadIdx.x & 15, ty = threadIdx.x >> 4, K = g.K;
    float acc[4][4], acc2[4][4];
#pragma unroll
    for (int i = 0; i < 4; ++i)
#pragma unroll
        for (int j = 0; j < 4; ++j) { acc[i][j] = 0.f; acc2[i][j] = 0.f; }
    for (int k0 = 0; k0 < K; k0 += 16) {
#pragma unroll
        for (int i = 0; i < 4; ++i) { const int e = threadIdx.x + 256 * i, r = e >> 4, kk = e & 15; const bf16* ar = g.arow(grp, tm * 64 + r); As[kk][r] = ar ? bf2f(ar[k0 + kk]) : 0.f;
            Bs[kk][r] = bf2f(g.brow(grp, tn * 64 + r, 0)[k0 + kk]); if (G::DUAL) Bs2[kk][r] = bf2f(g.brow(grp, tn * 64 + r, 1)[k0 + kk]); }
        __syncthreads();
#pragma unroll
        for (int kk = 0; kk < 16; ++kk) {
            float a[4], b[4], b2[4];
#pragma unroll
            for (int i = 0; i < 4; ++i) { a[i] = As[kk][ty * 4 + i]; b[i] = Bs[kk][tx * 4 + i]; b2[i] = G::DUAL ? Bs2[kk][tx * 4 + i] : 0.f; }
#pragma unroll
            for (int i = 0; i < 4; ++i)
#pragma unroll
                for (int j = 0; j < 4; ++j) { acc[i][j] += a[i] * b[j]; if (G::DUAL) acc2[i][j] += a[i] * b2[j]; }
        }
        __syncthreads();
    }
#pragma unroll
    for (int i = 0; i < 4; ++i)
#pragma unroll
        for (int j = 0; j < 4; ++j) { const int r = tm * 64 + ty * 4 + i; if (r < mrows) g.epi(grp, r, tn * 64 + tx * 4 + j, acc[i][j], acc2[i][j]); }
}
struct GInproj {
    static constexpr bool DUAL = false; P p; int K, pad;
    __device__ int rows(int) const { return T; }
    __device__ const bf16* arow(int, int r) const { return WSP(bf16, WS_B) + (size_t)r * D; }
    __device__ const bf16* brow(int, int n, int) const { return WSP(bf16, WS_WINT) + (size_t)n * D; }
    __device__ void epi(int, int r, int c, float v, float) const {
        if (c < 512) WSP(bf16, WS_QS)[(size_t)r * 512 + c] = f2bf(silu_f(v));
        else if (c < 1024) { const int cc = c - 512; const float lb = WSP(float, WS_SMALL + SM_LB)[cc]; const float f = lb + (1.f - lb) / (1.f + expf(-v)); WSP(float, WS_LOGF)[(size_t)r * 512 + cc] = logf(f); }
        else if (c < 1536) WSP(bf16, WS_V)[(size_t)r * 512 + c - 1024] = f2bf(v);
        else if (c < 2048) WSP(bf16, WS_OG)[(size_t)r * 512 + c - 1536] = f2bf(silu_f(v));
        else WSP(bf16, WS_ZG)[(size_t)r * 1024 + c - 2048] = f2bf(gelu_f(v));
    }
};
struct GOutproj {
    static constexpr bool DUAL = false; P p; int K, pad;
    __device__ int rows(int) const { return T; }
    __device__ const bf16* arow(int, int r) const { return WSP(bf16, WS_B) + (size_t)r * D; }
    __device__ const bf16* brow(int, int n, int) const { return WSP(bf16, WS_WOUTT) + (size_t)n * D; }
    __device__ void epi(int, int r, int c, float v, float) const { WSP(float, WS_Y)[(size_t)r * D + c] = v; }
};
struct GUp {
    static constexpr bool DUAL = true; P p; int K, pad;
    __device__ int rows(int e) const { return (int)WSP(unsigned, WS_CTL)[CW_CNT + e]; }
    __device__ const bf16* arow(int e, int r) const { if (r >= rows(e)) return nullptr; return WSP(bf16, WS_B) + (size_t)WSP(int, WS_LIST)[e * T + r] * D; }
    __device__ const bf16* brow(int e, int n, int which) const { return WSP(bf16, WS_WUPT) + ((size_t)e * 1024 + 256 * (n >> 7) + 128 * which + (n & 127)) * D; }
    __device__ void epi(int e, int r, int c, float g, float u) const { const int rb = WSP(int, WS_SMALL + SM_ROWBASE)[e]; WSP(bf16, WS_ACT)[(size_t)(rb + r) * HID + c] = f2bf(silu_f(g) * u); }
};
struct GDown {
    static constexpr bool DUAL = false; P p; int K, pad;
    __device__ int rows(int e) const { return (int)WSP(unsigned, WS_CTL)[CW_CNT + e]; }
    __device__ const bf16* arow(int e, int r) const { if (r >= rows(e)) return nullptr; const int rb = WSP(int, WS_SMALL + SM_ROWBASE)[e]; return WSP(bf16, WS_ACT) + (size_t)(rb + r) * HID; }
    __device__ const bf16* brow(int e, int n, int) const { return WSP(bf16, WS_WDNT) + ((size_t)e * 1024 + n) * HID; }
    __device__ void epi(int e, int r, int c, float v, float) const { const int rb = WSP(int, WS_SMALL + SM_ROWBASE)[e]; WSP(bf16, WS_Y2)[(size_t)(rb + r) * D + c] = f2bf(v * WSP(float, WS_WLIST)[e * T + r]); }
};

__global__ void __launch_bounds__(128) k_hgrn_naive(P p) {
    const int b = blockIdx.x >> 2, h = blockIdx.x & 3, v = threadIdx.x;
    __shared__ float sf[16][128], sk[16][128], sq[16][128]; __shared__ float red[16][2];
    float S[128];
#pragma unroll
    for (int d = 0; d < 128; ++d) S[d] = 0.f;
    const float gw = p.hg_norm_w[v];
    const bf16* QS = WSP(bf16, WS_QS); const float* LF = WSP(float, WS_LOGF); const bf16* VV = WSP(bf16, WS_V); const bf16* OG = WSP(bf16, WS_OG); bf16* YC = WSP(bf16, WS_B);
    for (int t0 = 0; t0 < SEQ; t0 += 16) {
        for (int i = 0; i < 16; ++i) { const size_t row = (size_t)b * SEQ + t0 + i; const float lf = LF[row * 512 + h * 128 + v]; sf[i][v] = expf(lf); sk[i][v] = -expm1f(lf); sq[i][v] = bf2f(QS[row * 512 + h * 128 + v]); }
        __syncthreads();
        float o[16];
#pragma unroll
        for (int i = 0; i < 16; ++i) {
            const size_t row = (size_t)b * SEQ + t0 + i; const float vv = bf2f(VV[row * 512 + h * 128 + v]);
            float acc = 0.f;
#pragma unroll
            for (int d = 0; d < 128; ++d) { S[d] = sf[i][d] * S[d] + sk[i][d] * vv; acc += S[d] * sq[i][d]; }
            o[i] = acc;
            const float ss = wave_sum(acc * acc);
            if ((v & 63) == 0) red[i][v >> 6] = ss;
        }
        __syncthreads();
#pragma unroll
        for (int i = 0; i < 16; ++i) {
            const size_t row = (size_t)b * SEQ + t0 + i;
            const float r = rsqrtf((red[i][0] + red[i][1]) * (1.f / 128.f) + RMS_EPS);
            YC[row * D + h * 128 + v] = f2bf(o[i] * r * gw * bf2f(OG[row * 512 + h * 128 + v]));
        }
        __syncthreads();
    }
}
__global__ void __launch_bounds__(256) k_sg_stats(P p) {
    const int row = (blockIdx.x * 256 + threadIdx.x) >> 6, lane = threadIdx.x & 63;
    const bf16* z = WSP(bf16, WS_ZG) + (size_t)row * 1024 + 512;
    float v[8], s = 0.f;
#pragma unroll
    for (int j = 0; j < 8; ++j) { v[j] = bf2f(z[lane * 8 + j]); s += v[j]; }
    const float mean = wave_sum(s) * (1.f / 512.f); float q = 0.f;
#pragma unroll
    for (int j = 0; j < 8; ++j) { const float d = v[j] - mean; q += d * d; }
    const float rstd = rsqrtf(wave_sum(q) * (1.f / 512.f) + LN_EPS);
    if (lane == 0) { WSP(float, WS_SMALL + SM_SGSTAT)[row * 2] = mean; WSP(float, WS_SMALL + SM_SGSTAT)[row * 2 + 1] = rstd; }
}
__global__ void __launch_bounds__(256) k_sg_naive(P p) {
    const size_t idx = (size_t)blockIdx.x * 256 + threadIdx.x; const int row = (int)(idx >> 9), ch = (int)(idx & 511), g = ch >> 7;
    const int tin = row & 127, row0 = row - tin;
    const bf16* ZG = WSP(bf16, WS_ZG); const float* st = WSP(float, WS_SMALL + SM_SGSTAT);
    const float lg = p.sg_ln_g[ch], lb = p.sg_ln_b[ch];
    float acc = 0.f;
    for (int s = 0; s <= tin; ++s) { const float vn = (bf2f(ZG[(size_t)(row0 + s) * 1024 + 512 + ch]) - st[(row0 + s) * 2]) * st[(row0 + s) * 2 + 1] * lg + lb; acc += p.sg_w[(g * 128 + tin) * 128 + s] * vn; }
    acc += p.sg_b[g * 128 + tin];
    WSP(bf16, WS_B)[(size_t)row * D + 512 + ch] = f2bf(bf2f(ZG[(size_t)row * 1024 + ch]) * acc);
}
__global__ void __launch_bounds__(256) k_ln1_route(P p) {
    const int row = (blockIdx.x * 256 + threadIdx.x) >> 6, lane = threadIdx.x & 63, b = row >> 13;
    const float* ada = WSP(float, WS_SMALL + SM_ADA) + b * 6144;
    const float* Y = WSP(float, WS_Y) + (size_t)row * D; const float* xr = p.x + (size_t)row * D;
    float v[16]; float s = 0.f;
#pragma unroll
    for (int j = 0; j < 4; ++j) { const int col = 256 * j + lane * 4; const f32x4 xv = *(const f32x4*)(xr + col), yv = *(const f32x4*)(Y + col), g1 = *(const f32x4*)(ada + 2048 + col);
#pragma unroll
        for (int i = 0; i < 4; ++i) { v[4 * j + i] = ALPHA * xv[i] + (1.f + g1[i]) * yv[i]; s += v[4 * j + i]; } }
    const float mean = wave_sum(s) * (1.f / D); float q = 0.f;
#pragma unroll
    for (int i = 0; i < 16; ++i) { v[i] -= mean; q += v[i] * v[i]; }
    const float rstd = rsqrtf(wave_sum(q) * (1.f / D) + LN_EPS);
    float lg[4], le[32];
#pragma unroll
    for (int i = 0; i < 4; ++i) lg[i] = 0.f;
#pragma unroll
    for (int i = 0; i < 32; ++i) le[i] = 0.f;
    float* X1 = WSP(float, WS_X1) + (size_t)row * D; bf16* H2 = WSP(bf16, WS_B) + (size_t)row * D;
#pragma unroll
    for (int j = 0; j < 4; ++j) { const int col = 256 * j + lane * 4; const f32x4 gg = *(const f32x4*)(p.ln1_g + col), bb = *(const f32x4*)(p.ln1_b + col), sh = *(const f32x4*)(ada + 3072 + col), sc = *(const f32x4*)(ada + 4096 + col);
        f32x4 x1;
#pragma unroll
        for (int i = 0; i < 4; ++i) { x1[i] = v[4 * j + i] * rstd * gg[i] + bb[i]; const float h2 = x1[i] * (1.f + sc[i]) + sh[i]; H2[col + i] = f2bf(h2);
            const f32x4 wg = *(const f32x4*)(p.rg_w + (size_t)(col + i) * 4);
#pragma unroll
            for (int g = 0; g < 4; ++g) { lg[g] += h2 * wg[g];
                const f32x4 w0 = *(const f32x4*)(p.re_w + ((size_t)g * D + col + i) * 8), w1 = *(const f32x4*)(p.re_w + ((size_t)g * D + col + i) * 8 + 4);
#pragma unroll
                for (int e = 0; e < 4; ++e) { le[g * 8 + e] += h2 * w0[e]; le[g * 8 + 4 + e] += h2 * w1[e]; } } }
        *(f32x4*)(X1 + col) = x1; }
#pragma unroll
    for (int g = 0; g < 4; ++g) lg[g] = wave_sum(lg[g]) + p.rg_b[g];
#pragma unroll
    for (int i = 0; i < 32; ++i) le[i] = wave_sum(le[i]) + p.re_b[i];
    int gi = 0; float gm = lg[0];
#pragma unroll
    for (int g = 1; g < 4; ++g) if (lg[g] > gm) { gm = lg[g]; gi = g; }
    float gs = 0.f;
#pragma unroll
    for (int g = 0; g < 4; ++g) gs += expf(lg[g] - gm);
    const float pgroup = 1.f / gs;
    float el[8];
#pragma unroll
    for (int e = 0; e < 8; ++e) el[e] = gi == 0 ? le[e] : gi == 1 ? le[8 + e] : gi == 2 ? le[16 + e] : le[24 + e];
    int j0 = 0; float m0 = el[0];
#pragma unroll
    for (int e = 1; e < 8; ++e) if (el[e] > m0) { m0 = el[e]; j0 = e; }
    int j1 = -1; float m1 = -3.0e38f;
#pragma unroll
    for (int e = 0; e < 8; ++e) if (e != j0 && el[e] > m1) { m1 = el[e]; j1 = e; }
    const float r1 = expf(m1 - m0); const float w0 = pgroup / (1.f + r1), w1 = pgroup * r1 / (1.f + r1);
    if (lane == 0) {
        unsigned* cnt = WSP(unsigned, WS_CTL) + CW_CNT; int* LIST = WSP(int, WS_LIST); float* WL = WSP(float, WS_WLIST); int* TE = WSP(int, WS_SMALL + SM_TOKE); int* TS = WSP(int, WS_SMALL + SM_TOKS);
        const int e0 = gi * 8 + j0, e1 = gi * 8 + j1;
        const int s0 = (int)atomicAdd(cnt + e0, 1u), s1 = (int)atomicAdd(cnt + e1, 1u);
        LIST[e0 * T + s0] = row; WL[e0 * T + s0] = w0; LIST[e1 * T + s1] = row; WL[e1 * T + s1] = w1;
        TE[row * 2] = e0; TE[row * 2 + 1] = e1; TS[row * 2] = s0; TS[row * 2 + 1] = s1;
    }
}
__global__ void k_rowbase(P p) {
    if (threadIdx.x == 0) { const unsigned* cnt = WSP(unsigned, WS_CTL) + CW_CNT; int* rb = WSP(int, WS_SMALL + SM_ROWBASE); int acc = 0;
        for (int e = 0; e < NE; ++e) { rb[e] = acc; acc += (int)((cnt[e] + 255u) / 256u) * 256; } rb[NE] = acc; }
}
__global__ void __launch_bounds__(256) k_final(P p) {
    const int row = (blockIdx.x * 256 + threadIdx.x) >> 6, lane = threadIdx.x & 63, b = row >> 13;
    const float* ada = WSP(float, WS_SMALL + SM_ADA) + b * 6144;
    const int* TE = WSP(int, WS_SMALL + SM_TOKE); const int* TS = WSP(int, WS_SMALL + SM_TOKS); const int* rb = WSP(int, WS_SMALL + SM_ROWBASE);
    const size_t rA = (size_t)(rb[TE[row * 2]] + TS[row * 2]), rB = (size_t)(rb[TE[row * 2 + 1]] + TS[row * 2 + 1]);
    const bf16* ya = WSP(bf16, WS_Y2) + rA * D; const bf16* yb = WSP(bf16, WS_Y2) + rB * D; const float* X1 = WSP(float, WS_X1) + (size_t)row * D;
    float v[16]; float s = 0.f;
#pragma unroll
    for (int j = 0; j < 4; ++j) { const int col = 256 * j + lane * 4; const f32x4 xv = *(const f32x4*)(X1 + col), g2 = *(const f32x4*)(ada + 5120 + col);
#pragma unroll
        for (int i = 0; i < 4; ++i) { const float m = bf2f(ya[col + i]) + bf2f(yb[col + i]); v[4 * j + i] = ALPHA * xv[i] + (1.f + g2[i]) * m; s += v[4 * j + i]; } }
    const float mean = wave_sum(s) * (1.f / D); float q = 0.f;
#pragma unroll
    for (int i = 0; i < 16; ++i) { v[i] -= mean; q += v[i] * v[i]; }
    const float rstd = rsqrtf(wave_sum(q) * (1.f / D) + LN_EPS);
#pragma unroll
    for (int j = 0; j < 4; ++j) { const int col = 256 * j + lane * 4; const f32x4 gg = *(const f32x4*)(p.ln2_g + col), bb = *(const f32x4*)(p.ln2_b + col); f32x4 o;
#pragma unroll
        for (int i = 0; i < 4; ++i) o[i] = v[4 * j + i] * rstd * gg[i] + bb[i];
        *(f32x4*)(p.out + (size_t)row * D + col) = o; }
}


#define LAS __attribute__((address_space(3)))
#define GAS __attribute__((address_space(1)))
typedef short bf16x8 __attribute__((ext_vector_type(8)));
typedef unsigned u32x4 __attribute__((ext_vector_type(4)));
typedef unsigned u32x2 __attribute__((ext_vector_type(2)));
typedef float f32x2 __attribute__((ext_vector_type(2)));
constexpr int NWAVES = 8, NTHR = 512;
__device__ __forceinline__ int otid(int swave) { int l; asm volatile("v_mbcnt_lo_u32_b32 %0, -1, 0\n\tv_mbcnt_hi_u32_b32 %0, -1, %0" : "=v"(l)); return (swave << 6) | l; }
constexpr int RING_BYTES = 131072, LDSCTL_OFF = 147456, LDS_BYTES = 151552;
constexpr int LC_BAR = 0, LC_TSTART = 64  , LC_CNT = 128  , LC_RT = 256  ;

__device__ __forceinline__ unsigned cvt_pk_bf16(float lo, float hi) { unsigned r; asm volatile("v_cvt_pk_bf16_f32 %0, %1, %2" : "=v"(r) : "v"(lo), "v"(hi)); return r; }
__device__ __forceinline__ float fast_sigmoid(float x) { return __builtin_amdgcn_rcpf(1.f + __expf(-x)); }
__device__ __forceinline__ f32x2 gelu_pk(f32x2 v) {
    const f32x2 av = __builtin_elementwise_abs(v), d = av * 0.2316418882f + 1.0f;
    f32x2 t; t.x = __builtin_amdgcn_rcpf(d.x); t.y = __builtin_amdgcn_rcpf(d.y);
    f32x2 q = t * 0.5307027145f + (-0.7265760135f); q = q * t + 0.7107068705f; q = q * t + (-0.142248368f); q = q * t + 0.127414796f; q = q * t;
    const f32x2 s = (v * v) * (-0.72134752044f);
    f32x2 e; e.x = __builtin_amdgcn_exp2f(s.x); e.y = __builtin_amdgcn_exp2f(s.y);
    const f32x2 m = v * (q * e), r = v - m;
    f32x2 o; o.x = v.x < 0.f ? m.x : r.x; o.y = v.y < 0.f ? m.y : r.y; return o;
}

namespace pg8 {
constexpr int BM = 256, BK = 64, HALF = 128, HTB = HALF * BK * 2, STAGE_BYTES = 8 * HTB, NXCD = 8, WGM = 8;
__host__ __device__ __forceinline__ int lds_byte(int r, int c) { const int st = (r >> 4) * 2 + (c >> 5), rr = r & 15, cc = c & 31, ob = rr * 64 + cc * 2; return st * 1024 + (ob ^ (((ob >> 9) & 1) << 5)); }
__host__ __device__ __forceinline__ void stage_rc(int b, int& R, int& C) { const int st = b / 1024, sb = b % 1024, swz = sb ^ (((sb >> 9) & 1) << 5); R = (st >> 1) * 16 + swz / 64; C = (st & 1) * 32 + (swz % 64) / 2; }
__host__ __device__ __forceinline__ int perm32(int rho) { const int n = rho >> 4, i = rho & 15; return 8 * (i >> 2) + 4 * n + (i & 3); }

struct Unit { int pm, pn, e, nvalid, r0, pad; };
struct Gemm { const bf16* A; const bf16* Bt; int K, pad; size_t bstride; const int* list; };

struct StaticOrder {
    int nM, nN, nwg, G, c;
    __device__ void init(int M, int N, int G_, int c_) { nM = M / BM; nN = N / BM; nwg = nM * nN; G = G_; c = c_; }
    __device__ bool next(int i, Unit& u) const {
        const long L = (long)i * G + c; if (L >= nwg) return false;
        int wgid = (int)L; { const int q = nwg / NXCD, r = nwg % NXCD, xcd = wgid % NXCD, off = wgid / NXCD; wgid = (xcd < r ? xcd * (q + 1) : r * (q + 1) + (xcd - r) * q) + off; }
        const int nig = WGM * nN, gid = wgid / nig, fm = gid * WGM, gsz = (nM - fm) < WGM ? (nM - fm) : WGM;
        u.pm = fm + ((wgid % nig) % gsz); u.pn = (wgid % nig) / gsz; u.e = 0; u.nvalid = 256; u.r0 = 0; u.pad = 0; return true;
    }
};
struct MoeOrder {
    const LAS int* tstart; const LAS int* cnt; int G, c, nN;
    __device__ bool next(int i, Unit& u) const {
        const int L = i * G + c, ntile = tstart[NE]; if (L >= ntile * nN) return false;
        const int tile = L / nN; u.pn = L % nN; u.pm = tile;
        int e = 0;
#pragma unroll 1
        for (int k = 1; k < NE; ++k) e = (tile >= tstart[k]) ? k : e;
        u.e = e; u.r0 = (tile - tstart[e]) * 256; const int left = cnt[e] - u.r0; u.nvalid = left < 256 ? left : 256; u.pad = 0; return true;
    }
};

#define PG8_LAS LAS
template <class Epi, class Sched, bool ALIGN_EPI, bool SP2, bool GATHER>
__device__ __forceinline__ void gemm_phase(const int swave, PG8_LAS unsigned char* lds, const Gemm g, const Sched& S, const Epi& E) {
    const int tid = otid(swave), wid = __builtin_amdgcn_readfirstlane(tid >> 6), lane = tid & 63, wr = wid >> 2, wc = wid & 3, fr = lane & 15, fq = lane >> 4;
    const int K = g.K, nt = K / BK;
    unsigned voffB[2], vA[2][2], vAn[2][2]; int RA[2], CA[2];
#pragma unroll
    for (int i = 0; i < 2; ++i) { int R, C; stage_rc(tid * 16 + i * 8192, R, C); const int Rb = Epi::PERM ? ((R & ~31) + perm32(R & 31)) : R; RA[i] = R; CA[i] = C;
        voffB[i] = (unsigned)(Rb * K + C) * 2u;
#pragma unroll
        for (int h = 0; h < 2; ++h) { vA[h][i] = (unsigned)((h * HALF + R) * K + C) * 2u; vAn[h][i] = vA[h][i]; } }
    const size_t kstep = (size_t)(BK * 2);
    const size_t hstep = (size_t)HALF * K * 2;
    const size_t tstep = 2 * hstep;
    const unsigned ldsw = (unsigned)wid * 1024u;
    const int aoff = lds_byte(wr * 64 + fr, fq * 8), boff = lds_byte(wc * 32 + fr, fq * 8);
#define PG8_SA(b, h) (((b) * 2 + (h)) * HTB)
#define PG8_SB(b, h) ((4 + (b) * 2 + (h)) * HTB)
#define PG8_STAGE(bufoff, gbase, voff) do { _Pragma("unroll") for (int _i = 0; _i < 2; ++_i) \
        __builtin_amdgcn_global_load_lds((const unsigned*)((const char*)(gbase) + (voff)[_i]), (PG8_LAS unsigned*)(lds + (bufoff) + ldsw + _i * 8192), 16, 0, 0); } while (0)
#define PG8_LDA(dst, b, h) do { _Pragma("unroll") for (int m = 0; m < 4; ++m) _Pragma("unroll") for (int k = 0; k < 2; ++k) dst[m][k] = *(const PG8_LAS bf16x8*)(lds + PG8_SA(b, h) + aoff + m * 2048 + k * 1024); } while (0)
#define PG8_LDB(dst, b, h) do { _Pragma("unroll") for (int n = 0; n < 2; ++n) _Pragma("unroll") for (int k = 0; k < 2; ++k) dst[n][k] = *(const PG8_LAS bf16x8*)(lds + PG8_SB(b, h) + boff + n * 2048 + k * 1024); } while (0)
#define PG8_MMA(ai, bj, At, Bt) do { __builtin_amdgcn_s_setprio(1); _Pragma("unroll") for (int m = 0; m < 4; ++m) _Pragma("unroll") for (int n = 0; n < 2; ++n) _Pragma("unroll") for (int k = 0; k < 2; ++k) \
        acc[ai][bj][m][n] = __builtin_amdgcn_mfma_f32_16x16x32_bf16(Bt[n][k], At[m][k], acc[ai][bj][m][n], 0, 0, 0); __builtin_amdgcn_s_setprio(0); } while (0)
#define PG8_WAIT_V(n) asm volatile("s_waitcnt vmcnt(" #n ")" ::: "memory")
#define PG8_WAIT_L(n) asm volatile("s_waitcnt lgkmcnt(" #n ")" ::: "memory")
#define PG8_BAR __builtin_amdgcn_s_barrier()
#define PG8_SCHED __builtin_amdgcn_sched_barrier(0)
#define PG8_SETV(V, U) do { if constexpr (GATHER) { _Pragma("unroll") for (int _h = 0; _h < 2; ++_h) _Pragma("unroll") for (int _i = 0; _i < 2; ++_i) { const int _r = _h * HALF + RA[_i]; \
        const int _tok = _r < (U).nvalid ? g.list[(size_t)(U).e * T + (U).r0 + _r] : 0; V[_h][_i] = (unsigned)(_tok * K + CA[_i]) * 2u; } } } while (0)
    Unit cur, nxt; int ui = 0;
    if (!S.next(0, cur)) return;
    f32x4 acc[2][2][4][2];
#pragma unroll
    for (int a = 0; a < 2; ++a)
#pragma unroll
        for (int b = 0; b < 2; ++b)
#pragma unroll
            for (int m = 0; m < 4; ++m)
#pragma unroll
                for (int n = 0; n < 2; ++n) acc[a][b][m][n] = (f32x4){0.f, 0.f, 0.f, 0.f};
    bf16x8 At[4][2], B0[2][2], B1[2][2];
    PG8_SETV(vA, cur);
    const char* cA = (const char*)g.A + (GATHER ? (size_t)0 : (size_t)cur.pm * tstep); const char* cB = (const char*)g.Bt + (size_t)cur.e * g.bstride + (size_t)cur.pn * tstep;
    if constexpr (SP2) {
        PG8_STAGE(PG8_SB(0, 0), cB, voffB); PG8_STAGE(PG8_SB(0, 1), cB + hstep, voffB); PG8_STAGE(PG8_SA(0, 0), cA, vA[0]); PG8_STAGE(PG8_SA(0, 1), cA, vA[1]);
        if (wr == 1) PG8_BAR;
        PG8_WAIT_V(2); PG8_BAR;
        PG8_STAGE(PG8_SB(1, 0), cB + kstep, voffB); PG8_STAGE(PG8_SA(1, 0), cA + kstep, vA[0]); PG8_STAGE(PG8_SB(1, 1), cB + hstep + kstep, voffB);
        PG8_WAIT_V(6); PG8_BAR;
    } else {
        PG8_STAGE(PG8_SB(0, 0), cB, voffB); PG8_STAGE(PG8_SA(0, 0), cA, vA[0]); PG8_STAGE(PG8_SB(0, 1), cB + hstep, voffB); PG8_STAGE(PG8_SA(0, 1), cA, vA[1]);
        if (wr == 1) PG8_BAR;
        PG8_WAIT_V(4); PG8_BAR;
        PG8_STAGE(PG8_SB(1, 0), cB + kstep, voffB); PG8_STAGE(PG8_SA(1, 0), cA + kstep, vA[0]); PG8_STAGE(PG8_SB(1, 1), cB + hstep + kstep, voffB);
        PG8_WAIT_V(6); PG8_BAR;
    }
    for (;;) {
        const bool has_next = S.next(ui + 1, nxt);
        if (has_next) PG8_SETV(vAn, nxt);
        const char* nA = has_next ? (const char*)g.A + (GATHER ? (size_t)0 : (size_t)nxt.pm * tstep) : cA; const char* nB = has_next ? (const char*)g.Bt + (size_t)nxt.e * g.bstride + (size_t)nxt.pn * tstep : cB;
        for (int t = 0; t < nt; t += 2) {
            const bool last = (t == nt - 2);
            const char* a1 = cA + (size_t)(t + 1) * kstep;
            const char* a2 = last ? nA : cA + (size_t)(t + 2) * kstep; const char* b2 = last ? nB : cB + (size_t)(t + 2) * kstep;
            const char* a3 = a2 + kstep; const char* b3 = b2 + kstep;
            unsigned v2[2][2];
#pragma unroll
            for (int h = 0; h < 2; ++h)
#pragma unroll
                for (int i = 0; i < 2; ++i) v2[h][i] = (GATHER && last && has_next) ? vAn[h][i] : vA[h][i];
            if constexpr (SP2) {
            PG8_LDB(B0, 0, 0); PG8_LDB(B1, 0, 1); PG8_SCHED; PG8_LDA(At, 0, 0); PG8_STAGE(PG8_SA(1, 1), a1, vA[1]);
            PG8_WAIT_V(8); PG8_WAIT_L(0); PG8_BAR; PG8_MMA(0, 0, At, B0); PG8_MMA(0, 1, At, B1); PG8_BAR; PG8_SCHED;
            PG8_LDA(At, 0, 1); PG8_STAGE(PG8_SB(0, 0), b2, voffB); PG8_STAGE(PG8_SB(0, 1), b2 + hstep, voffB); PG8_STAGE(PG8_SA(0, 0), a2, v2[0]);
            PG8_WAIT_V(8); PG8_WAIT_L(0); PG8_BAR; PG8_MMA(1, 0, At, B0); PG8_MMA(1, 1, At, B1); PG8_BAR; PG8_SCHED;
            PG8_LDB(B0, 1, 0); PG8_LDB(B1, 1, 1); PG8_SCHED; PG8_LDA(At, 1, 0); PG8_STAGE(PG8_SA(0, 1), a2, v2[1]);
            PG8_WAIT_V(8); PG8_WAIT_L(0); PG8_BAR; PG8_MMA(0, 0, At, B0); PG8_MMA(0, 1, At, B1); PG8_BAR; PG8_SCHED;
            PG8_LDA(At, 1, 1); PG8_STAGE(PG8_SB(1, 0), b3, voffB); PG8_STAGE(PG8_SB(1, 1), b3 + hstep, voffB); PG8_STAGE(PG8_SA(1, 0), a3, v2[0]);
            PG8_WAIT_V(8); PG8_WAIT_L(0); PG8_BAR; PG8_MMA(1, 0, At, B0); PG8_MMA(1, 1, At, B1); PG8_BAR; PG8_SCHED;
            } else {
            PG8_LDB(B0, 0, 0); PG8_SCHED; PG8_LDA(At, 0, 0); PG8_STAGE(PG8_SA(1, 1), a1, vA[1]);
            PG8_WAIT_L(8); PG8_BAR; PG8_WAIT_L(0); PG8_MMA(0, 0, At, B0); PG8_BAR; PG8_SCHED;
            PG8_LDB(B1, 0, 1); PG8_STAGE(PG8_SB(0, 0), b2, voffB);
            PG8_BAR; PG8_WAIT_L(0); PG8_MMA(0, 1, At, B1); PG8_BAR;
            PG8_LDA(At, 0, 1); PG8_STAGE(PG8_SA(0, 0), a2, v2[0]);
            PG8_BAR; PG8_WAIT_L(0); PG8_MMA(1, 0, At, B0); PG8_BAR; PG8_SCHED;
            PG8_STAGE(PG8_SB(0, 1), b2 + hstep, voffB);
            PG8_WAIT_V(6); PG8_BAR; PG8_MMA(1, 1, At, B1); PG8_BAR;
            PG8_LDB(B0, 1, 0); PG8_SCHED; PG8_LDA(At, 1, 0); PG8_STAGE(PG8_SA(0, 1), a2, v2[1]);
            PG8_WAIT_L(8); PG8_BAR; PG8_WAIT_L(0); PG8_MMA(0, 0, At, B0); PG8_BAR; PG8_SCHED;
            PG8_LDB(B1, 1, 1); PG8_STAGE(PG8_SB(1, 0), b3, voffB);
            PG8_BAR; PG8_WAIT_L(0); PG8_MMA(0, 1, At, B1); PG8_BAR;
            PG8_LDA(At, 1, 1); PG8_STAGE(PG8_SA(1, 0), a3, v2[0]);
            PG8_BAR; PG8_WAIT_L(0); PG8_MMA(1, 0, At, B0); PG8_BAR; PG8_SCHED;
            PG8_STAGE(PG8_SB(1, 1), b3 + hstep, voffB);
            PG8_WAIT_V(6); PG8_BAR; PG8_MMA(1, 1, At, B1); PG8_BAR;
            }
        }
        if constexpr (ALIGN_EPI) { if (wr == 0) PG8_BAR; }
        E(acc, cur, wr, wc, fr, fq);
        if (!has_next) break;
#pragma unroll
        for (int a = 0; a < 2; ++a)
#pragma unroll
            for (int b = 0; b < 2; ++b)
#pragma unroll
                for (int m = 0; m < 4; ++m)
#pragma unroll
                    for (int n = 0; n < 2; ++n) acc[a][b][m][n] = (f32x4){0.f, 0.f, 0.f, 0.f};
        cur = nxt; cA = nA; cB = nB; ++ui;
        if constexpr (GATHER) {
#pragma unroll
            for (int h = 0; h < 2; ++h)
#pragma unroll
                for (int i = 0; i < 2; ++i) vA[h][i] = vAn[h][i]; }
        if constexpr (ALIGN_EPI) { if (wr == 1) PG8_BAR; }
    }
    PG8_WAIT_V(0);
    if constexpr (!ALIGN_EPI) { if (wr == 0) PG8_BAR; }
    PG8_BAR;
#undef PG8_SA
#undef PG8_SB
#undef PG8_STAGE
#undef PG8_LDA
#undef PG8_LDB
#undef PG8_MMA
#undef PG8_WAIT_V
#undef PG8_WAIT_L
#undef PG8_BAR
#undef PG8_SCHED
#undef PG8_SETV
}

struct EpiInproj {
    static constexpr bool PERM = true;
    unsigned char* ws;
    __device__ __forceinline__ void operator()(const f32x4 (&acc)[2][2][4][2], const Unit& u, int wr, int wc, int fr, int fq) const {
        unsigned char* wsb = ws; asm volatile("" : "+v"(wsb));
        bf16* QVO = (bf16*)(wsb + WS_QS); bf16* ZG = (bf16*)(wsb + WS_ZG); float* LOGF = (float*)(wsb + WS_LOGF); const float* LB = (const float*)(wsb + WS_SMALL + SM_LB);
        const int row0 = u.pm * BM + wr * 64 + fr, seg = u.pn >> 1, cin = (u.pn & 1) * 256 + wc * 32 + 8 * fq;
        if (seg == 1) {
            f32x4 lb[2][2];
#pragma unroll
            for (int bj = 0; bj < 2; ++bj)
#pragma unroll
                for (int n = 0; n < 2; ++n) lb[bj][n] = *(const f32x4*)(LB + cin + bj * HALF + 4 * n);
#pragma unroll
            for (int ai = 0; ai < 2; ++ai)
#pragma unroll
                for (int m = 0; m < 4; ++m) { float* rowp = LOGF + (size_t)(row0 + ai * HALF + m * 16) * 512 + cin;
#pragma unroll
                    for (int bj = 0; bj < 2; ++bj)
#pragma unroll
                        for (int n = 0; n < 2; ++n) { f32x4 o;
#pragma unroll
                            for (int j = 0; j < 4; ++j) { const float l = lb[bj][n][j]; o[j] = __logf(l + (1.f - l) * fast_sigmoid(acc[ai][bj][m][n][j])); }
                            *(f32x4*)(rowp + bj * HALF + 4 * n) = o; } }
            return;
        }
        if (seg >= 4) {
            const int cz = (u.pn - 8) * 256 + wc * 32 + 8 * fq;
#pragma unroll
            for (int ai = 0; ai < 2; ++ai)
#pragma unroll
                for (int m = 0; m < 4; ++m) { bf16* rowp = ZG + (size_t)(row0 + ai * HALF + m * 16) * 1024 + cz;
#pragma unroll
                    for (int bj = 0; bj < 2; ++bj) { const f32x4 v0 = acc[ai][bj][m][0], v1 = acc[ai][bj][m][1];
                        const f32x2 a = gelu_pk((f32x2){v0[0], v0[1]}), b = gelu_pk((f32x2){v0[2], v0[3]}), c = gelu_pk((f32x2){v1[0], v1[1]}), d = gelu_pk((f32x2){v1[2], v1[3]});
                        u32x4 w; w.x = cvt_pk_bf16(a.x, a.y); w.y = cvt_pk_bf16(b.x, b.y); w.z = cvt_pk_bf16(c.x, c.y); w.w = cvt_pk_bf16(d.x, d.y);
                        *(u32x4*)(rowp + bj * HALF) = w; } }
            return;
        }
        bf16* base = QVO + (size_t)(seg == 0 ? 0 : seg - 1) * (8u << 20); const bool act = seg != 2;
#pragma unroll
        for (int ai = 0; ai < 2; ++ai)
#pragma unroll
            for (int m = 0; m < 4; ++m) { bf16* rowp = base + (size_t)(row0 + ai * HALF + m * 16) * 512 + cin;
#pragma unroll
                for (int bj = 0; bj < 2; ++bj) { f32x4 v0 = acc[ai][bj][m][0], v1 = acc[ai][bj][m][1];
                    if (act) {
#pragma unroll
                        for (int j = 0; j < 4; ++j) { v0[j] = v0[j] * fast_sigmoid(v0[j]); v1[j] = v1[j] * fast_sigmoid(v1[j]); } }
                    u32x4 w; w.x = cvt_pk_bf16(v0[0], v0[1]); w.y = cvt_pk_bf16(v0[2], v0[3]); w.z = cvt_pk_bf16(v1[0], v1[1]); w.w = cvt_pk_bf16(v1[2], v1[3]);
                    *(u32x4*)(rowp + bj * HALF) = w; } }
    }
};
struct EpiF32 {
    static constexpr bool PERM = false;
    unsigned char* ws; size_t off; int ldc;
    __device__ __forceinline__ void operator()(const f32x4 (&acc)[2][2][4][2], const Unit& u, int wr, int wc, int fr, int fq) const {
        unsigned char* wsb = ws; asm volatile("" : "+v"(wsb)); float* C = (float*)(wsb + off);
        const int row0 = u.pm * BM + wr * 64 + fr, col0 = u.pn * BM + wc * 32 + 4 * fq;
#pragma unroll
        for (int ai = 0; ai < 2; ++ai)
#pragma unroll
            for (int m = 0; m < 4; ++m) { float* rowp = C + (size_t)(row0 + ai * HALF + m * 16) * ldc + col0;
#pragma unroll
                for (int bj = 0; bj < 2; ++bj)
#pragma unroll
                    for (int n = 0; n < 2; ++n) *(f32x4*)(rowp + bj * HALF + n * 16) = acc[ai][bj][m][n]; }
    }
};
struct EpiUp {
    static constexpr bool PERM = true;
    unsigned char* ws;
    __device__ __forceinline__ void operator()(const f32x4 (&acc)[2][2][4][2], const Unit& u, int wr, int wc, int fr, int fq) const {
        unsigned char* wsb = ws; asm volatile("" : "+v"(wsb)); bf16* ACT = (bf16*)(wsb + WS_ACT);
        const int row0 = u.pm * BM + wr * 64 + fr, col0 = u.pn * HALF + wc * 32 + 8 * fq;
#pragma unroll
        for (int ai = 0; ai < 2; ++ai)
#pragma unroll
            for (int m = 0; m < 4; ++m) { bf16* rowp = ACT + (size_t)(row0 + ai * HALF + m * 16) * HID + col0;
                f32x4 o0, o1;
#pragma unroll
                for (int j = 0; j < 4; ++j) { const float g0 = acc[ai][0][m][0][j], g1 = acc[ai][0][m][1][j]; o0[j] = g0 * fast_sigmoid(g0) * acc[ai][1][m][0][j]; o1[j] = g1 * fast_sigmoid(g1) * acc[ai][1][m][1][j]; }
                u32x4 w; w.x = cvt_pk_bf16(o0[0], o0[1]); w.y = cvt_pk_bf16(o0[2], o0[3]); w.z = cvt_pk_bf16(o1[0], o1[1]); w.w = cvt_pk_bf16(o1[2], o1[3]);
                *(u32x4*)rowp = w; }
    }
};
struct EpiDown {
    static constexpr bool PERM = true;
    unsigned char* ws;
    __device__ __forceinline__ void operator()(const f32x4 (&acc)[2][2][4][2], const Unit& u, int wr, int wc, int fr, int fq) const {
        unsigned char* wsb = ws; asm volatile("" : "+v"(wsb)); bf16* Y2 = (bf16*)(wsb + WS_Y2); const float* WL = (const float*)(wsb + WS_WLIST);
        const int rt0 = wr * 64 + fr, col0 = u.pn * BM + wc * 32 + 8 * fq;
#pragma unroll
        for (int ai = 0; ai < 2; ++ai)
#pragma unroll
            for (int m = 0; m < 4; ++m) { const int rt = rt0 + ai * HALF + m * 16; const float w8 = rt < u.nvalid ? WL[(size_t)u.e * T + u.r0 + rt] : 0.f;
                bf16* rowp = Y2 + (size_t)(u.pm * BM + rt) * D + col0;
#pragma unroll
                for (int bj = 0; bj < 2; ++bj) { const f32x4 v0 = acc[ai][bj][m][0] * w8, v1 = acc[ai][bj][m][1] * w8;
                    u32x4 w; w.x = cvt_pk_bf16(v0[0], v0[1]); w.y = cvt_pk_bf16(v0[2], v0[3]); w.z = cvt_pk_bf16(v1[0], v1[1]); w.w = cvt_pk_bf16(v1[2], v1[3]);
                    *(u32x4*)(rowp + bj * HALF) = w; } }
    }
};
}


__device__ __forceinline__ f32x4 mma16(bf16x8 a, bf16x8 b, f32x4 c) { return __builtin_amdgcn_mfma_f32_16x16x32_bf16(a, b, c, 0, 0, 0); }
__device__ __forceinline__ bf16x8 frag(const LAS bf16* X, int stride, int rb, int ks, int lane) { return *(const LAS bf16x8*)(X + (rb * 16 + (lane & 15)) * stride + ks * 32 + 8 * (lane >> 4)); }
constexpr int MX_QD = 0, MX_KD = 17408, MX_KDT = 34816, MX_VT = 53248, MX_PT = 71680, MX_STT = 80896, MX_SMALL = 115712;
constexpr int SD = 136, SS = 72, SO = 132;
template <int MODE> __device__ __forceinline__ void hgrn_item(const int swave, const P& p, LAS unsigned char* lds, int item) {
    const int tid = otid(swave), lane = tid & 63, w = __builtin_amdgcn_readfirstlane(tid >> 6), q4 = lane >> 4, r16 = lane & 15;
    const int bh = item >> 5, sc = item & 31, b = bh >> 2, h = bh & 3;
    const size_t row0 = (size_t)b * SEQ + (size_t)sc * 256;
    LAS bf16* QD = (LAS bf16*)(lds + MX_QD); LAS bf16* KD = (LAS bf16*)(lds + MX_KD); LAS bf16* KDT = (LAS bf16*)(lds + MX_KDT); LAS bf16* VT = (LAS bf16*)(lds + MX_VT);
    LAS bf16* PT = (LAS bf16*)(lds + MX_PT); LAS bf16* STT = (LAS bf16*)(lds + MX_STT); LAS float* O = (LAS float*)(lds + MX_QD);
    LAS float* tot = (LAS float*)(lds + MX_SMALL); LAS float* ecm = tot + 512; LAS float* elast = ecm + 128; LAS float* efac = elast + 128;
    const bf16* QS = WSP(bf16, WS_QS); const float* LF = WSP(float, WS_LOGF); const bf16* VV = WSP(bf16, WS_V); const bf16* OG = WSP(bf16, WS_OG); bf16* YC = WSP(bf16, WS_B);
    const int col = tid & 127, g = tid >> 7;
    f32x4 S[8];
#pragma unroll
    for (int db = 0; db < 8; ++db) {
        if (MODE == 1) {
#pragma unroll
            for (int r = 0; r < 4; ++r) S[db][r] = WSP(float, WS_SSTART)[(size_t)item * 16384 + (16 * w + 4 * q4 + r) * 128 + 16 * db + r16];
        } else S[db] = (f32x4){0.f, 0.f, 0.f, 0.f}; }
    float lastsum = 0.f;
#pragma unroll 1
    for (int c = 0; c < 4; ++c) {
        const size_t rowc = row0 + 64 * c + 16 * g;
        float lf[16]; bf16 qv[16], vv[16];
#pragma unroll
        for (int i = 0; i < 16; ++i) { const size_t o = (rowc + i) * 512 + h * 128 + col; lf[i] = LF[o]; vv[i] = VV[o]; qv[i] = MODE == 1 ? QS[o] : (bf16)0; }
        float run = 0.f;
#pragma unroll
        for (int i = 0; i < 16; ++i) { run += lf[i]; }
        tot[g * 128 + col] = run;
        __syncthreads();
        const float t0 = tot[col], t1 = tot[128 + col], t2 = tot[256 + col], t3 = tot[384 + col];
        const float cstart = g == 0 ? 0.f : (g == 1 ? t0 : (g == 2 ? t0 + t1 : t0 + t1 + t2));
        const float cmid = t0 + t1, last = (t0 + t1) + (t2 + t3);
        if (g == 0) { ecm[col] = __expf(cmid); elast[col] = __expf(last); efac[col] = __expf(last - cmid); lastsum += last; }
        {
            float cum = cstart; unsigned kt[8], vt[8];
#pragma unroll
            for (int i = 0; i < 16; i += 2) {
                float kd2[2];
#pragma unroll
                for (int j = 0; j < 2; ++j) { cum += lf[i + j]; const float kk = 1.f - __expf(lf[i + j]); const float ek = __expf(fminf(cmid - cum, 80.f)); kd2[j] = kk * ek;
                    const bf16 kb = f2bf(kd2[j]);
                    if (MODE == 1) { const float eq = __expf(fminf(cum - cmid, 80.f)); QD[(16 * g + i + j) * SD + col] = f2bf(bf2f(qv[i + j]) * eq); KD[(16 * g + i + j) * SD + col] = kb; } }
                kt[i >> 1] = cvt_pk_bf16(kd2[0], kd2[1]); vt[i >> 1] = (unsigned)vv[i] | ((unsigned)vv[i + 1] << 16);
            }
            *(LAS u32x4*)(KDT + col * SS + 16 * g) = (u32x4){kt[0], kt[1], kt[2], kt[3]}; *(LAS u32x4*)(KDT + col * SS + 16 * g + 8) = (u32x4){kt[4], kt[5], kt[6], kt[7]};
            *(LAS u32x4*)(VT + col * SS + 16 * g) = (u32x4){vt[0], vt[1], vt[2], vt[3]}; *(LAS u32x4*)(VT + col * SS + 16 * g + 8) = (u32x4){vt[4], vt[5], vt[6], vt[7]};
        }
        __syncthreads();
        f32x4 o[4]; const int tb = w & 3, vb0 = (w >> 2) * 4;
        if (MODE == 1) {
#pragma unroll
            for (int db = 0; db < 8; ++db) { const float e = ecm[16 * db + r16];
#pragma unroll
                for (int r = 0; r < 4; ++r) STT[(16 * w + 4 * q4 + r) * SD + 16 * db + r16] = f2bf(S[db][r] * e); }
#pragma unroll
            for (int k = 0; k < 2; ++k) { const int tile = w + 8 * k, stb = tile >> 2, ssb = tile & 3; f32x4 a = (f32x4){0.f, 0.f, 0.f, 0.f};
                if (ssb <= stb) {
#pragma unroll
                    for (int ks = 0; ks < 4; ++ks) a = mma16(frag(QD, SD, stb, ks, lane), frag(KD, SD, ssb, ks, lane), a); }
#pragma unroll
                for (int r = 0; r < 4; ++r) { const int t = stb * 16 + 4 * q4 + r, s_ = ssb * 16 + r16; PT[t * SS + s_] = (s_ <= t) ? f2bf(a[r]) : (bf16)0; } }
            __syncthreads();
            bf16x8 ap[2], aq[4];
#pragma unroll
            for (int ks = 0; ks < 2; ++ks) ap[ks] = frag(PT, SS, tb, ks, lane);
#pragma unroll
            for (int ks = 0; ks < 4; ++ks) aq[ks] = frag(QD, SD, tb, ks, lane);
#pragma unroll
            for (int j = 0; j < 4; ++j) { f32x4 a = (f32x4){0.f, 0.f, 0.f, 0.f};
#pragma unroll
                for (int ks = 0; ks < 2; ++ks) a = mma16(ap[ks], frag(VT, SS, vb0 + j, ks, lane), a);
#pragma unroll
                for (int ks = 0; ks < 4; ++ks) a = mma16(aq[ks], frag(STT, SD, vb0 + j, ks, lane), a);
                o[j] = a; }
        }
        {
            bf16x8 av[2];
#pragma unroll
            for (int ks = 0; ks < 2; ++ks) av[ks] = frag(VT, SS, w, ks, lane);
#pragma unroll
            for (int db = 0; db < 8; ++db) { f32x4 u = (f32x4){0.f, 0.f, 0.f, 0.f};
#pragma unroll
                for (int ks = 0; ks < 2; ++ks) u = mma16(av[ks], frag(KDT, SS, db, ks, lane), u);
                const float el = elast[16 * db + r16], ef = efac[16 * db + r16];
                S[db] = S[db] * el + u * ef; }
        }
        if (MODE == 1) {
            __syncthreads();
#pragma unroll
            for (int j = 0; j < 4; ++j)
#pragma unroll
                for (int r = 0; r < 4; ++r) O[(tb * 16 + 4 * q4 + r) * SO + (vb0 + j) * 16 + r16] = o[j][r];
            __syncthreads();
            const f32x2 gw = *(const f32x2*)(p.hg_norm_w + 2 * lane);
#pragma unroll
            for (int rr = 0; rr < 8; ++rr) { const int t = 8 * w + rr; const size_t row = row0 + 64 * c + t;
                const f32x2 ov = *(const LAS f32x2*)(O + t * SO + 2 * lane);
                const float ss = wave_sum(ov.x * ov.x + ov.y * ov.y); const float rs = rsqrtf(ss * (1.f / 128.f) + RMS_EPS);
                const unsigned ogp = *(const unsigned*)(OG + row * 512 + h * 128 + 2 * lane);
                const float y0 = ov.x * rs * gw.x * __uint_as_float(ogp << 16), y1 = ov.y * rs * gw.y * __uint_as_float(ogp & 0xffff0000u);
                *(unsigned*)(YC + row * D + h * 128 + 2 * lane) = cvt_pk_bf16(y0, y1); }
        }
    }
    if (MODE == 0) {
#pragma unroll
        for (int db = 0; db < 8; ++db)
#pragma unroll
            for (int r = 0; r < 4; ++r) WSP(float, WS_SLOC)[(size_t)item * 16384 + (16 * w + 4 * q4 + r) * 128 + 16 * db + r16] = S[db][r];
        if (g == 0) WSP(float, WS_SMALL + SM_DTOT)[item * 128 + col] = __expf(lastsum);
    }
    __syncthreads();
}
__device__ __forceinline__ void hgrn_scan(const P& p, int gid) {
    const int bh = gid >> 14, idx = gid & 16383, d = idx & 127;
    const float* SL = WSP(float, WS_SLOC) + (size_t)bh * 32 * 16384 + idx; float* ST = WSP(float, WS_SSTART) + (size_t)bh * 32 * 16384 + idx; const float* DT = WSP(float, WS_SMALL + SM_DTOT) + bh * 32 * 128 + d;
    float s = 0.f;
#pragma unroll 8
    for (int sc = 0; sc < 32; ++sc) { ST[(size_t)sc * 16384] = s; s = s * DT[sc * 128] + SL[(size_t)sc * 16384]; }
}
__device__ __forceinline__ void sg_item(const int swave, const P& p, LAS unsigned char* lds, int item) {
    const int tid = otid(swave), lane = tid & 63, w = __builtin_amdgcn_readfirstlane(tid >> 6), q4 = lane >> 4, r16 = lane & 15;
    const int b = item >> 8, n = (item >> 2) & 63, g = item & 3; const size_t row0 = (size_t)b * SEQ + (size_t)n * 128;
    LAS bf16* VNT = (LAS bf16*)lds; LAS bf16* WT = (LAS bf16*)(lds + 34816); LAS float* mean = (LAS float*)(lds + 69632); LAS float* rstd = mean + 128;
    const bf16* ZG = WSP(bf16, WS_ZG); bf16* YC = WSP(bf16, WS_B);
#pragma unroll 4
    for (int rr = 0; rr < 16; ++rr) { const int t = 16 * w + rr; const bf16x8 z = *(const bf16x8*)(ZG + (row0 + t) * 1024 + 512 + 8 * lane);
        float v[8], s = 0.f;
#pragma unroll
        for (int j = 0; j < 8; ++j) { v[j] = bf2f((bf16)z[j]); s += v[j]; }
        const float m = wave_sum(s) * (1.f / 512.f); float qq = 0.f;
#pragma unroll
        for (int j = 0; j < 8; ++j) { const float d = v[j] - m; qq += d * d; }
        const float rs = rsqrtf(wave_sum(qq) * (1.f / 512.f) + LN_EPS);
        if (lane == 0) { mean[t] = m; rstd[t] = rs; } }
    {
        const int t = tid >> 2, seg = tid & 3; const float* wr = p.sg_w + ((size_t)(g * 128 + t)) * 128 + seg * 32;
#pragma unroll
        for (int j = 0; j < 4; ++j) { const f32x4 a = *(const f32x4*)(wr + 8 * j), c = *(const f32x4*)(wr + 8 * j + 4); const int s0 = seg * 32 + 8 * j; u32x4 o;
            o.x = cvt_pk_bf16(s0 + 0 <= t ? a[0] : 0.f, s0 + 1 <= t ? a[1] : 0.f); o.y = cvt_pk_bf16(s0 + 2 <= t ? a[2] : 0.f, s0 + 3 <= t ? a[3] : 0.f);
            o.z = cvt_pk_bf16(s0 + 4 <= t ? c[0] : 0.f, s0 + 5 <= t ? c[1] : 0.f); o.w = cvt_pk_bf16(s0 + 6 <= t ? c[2] : 0.f, s0 + 7 <= t ? c[3] : 0.f);
            *(LAS u32x4*)(WT + t * SD + s0) = o; }
    }
    __syncthreads();
    {
        const int c = tid & 127, sgp = tid >> 7; const float lg = p.sg_ln_g[g * 128 + c], lb = p.sg_ln_b[g * 128 + c];
#pragma unroll
        for (int i8 = 0; i8 < 4; ++i8) { float vn[8];
#pragma unroll
            for (int j = 0; j < 8; ++j) { const int s_ = 32 * sgp + 8 * i8 + j; vn[j] = (bf2f(ZG[(row0 + s_) * 1024 + 512 + g * 128 + c]) - mean[s_]) * rstd[s_] * lg + lb; }
            *(LAS u32x4*)(VNT + c * SD + 32 * sgp + 8 * i8) = (u32x4){cvt_pk_bf16(vn[0], vn[1]), cvt_pk_bf16(vn[2], vn[3]), cvt_pk_bf16(vn[4], vn[5]), cvt_pk_bf16(vn[6], vn[7])}; }
    }
    __syncthreads();
    bf16x8 aw[4];
#pragma unroll
    for (int ks = 0; ks < 4; ++ks) aw[ks] = frag(WT, SD, w, ks, lane);
#pragma unroll
    for (int cb = 0; cb < 8; ++cb) { f32x4 a = (f32x4){0.f, 0.f, 0.f, 0.f};
#pragma unroll
        for (int ks = 0; ks < 4; ++ks) a = mma16(aw[ks], frag(VNT, SD, cb, ks, lane), a);
#pragma unroll
        for (int r = 0; r < 4; ++r) { const int t = 16 * w + 4 * q4 + r, c = 16 * cb + r16; const float u = bf2f(ZG[(row0 + t) * 1024 + g * 128 + c]);
            YC[(row0 + t) * D + 512 + g * 128 + c] = f2bf(u * (a[r] + p.sg_b[g * 128 + t])); } }
    __syncthreads();
}


typedef GAS unsigned gu32;
#define XB_TMO      128
#define XB_XCNT(j)  (256  + 64 * (j))
#define XB_XSUB(j)  (1280 + 64 * (j))
#define XB_XGEN(j)  (2304 + 64 * (j))
#define XB_TOP      3328
#define XB_TOPGEN   3392
#define XCD_BAR_WORDS 3456
#define XB_SPIN_CAP (1u << 18)
__device__ __forceinline__ unsigned xb_ld(unsigned* p)              { return __hip_atomic_load(p, __ATOMIC_RELAXED, __HIP_MEMORY_SCOPE_AGENT); }
__device__ __forceinline__ unsigned xb_add(unsigned* p, unsigned v) { return __hip_atomic_fetch_add(p, v, __ATOMIC_RELAXED, __HIP_MEMORY_SCOPE_AGENT); }
__device__ __forceinline__ unsigned xb_xcc_id() { return (unsigned)__builtin_amdgcn_s_getreg((3 << 11) | 20) & 0xFu; }
#define XB_SPIN(cond, bar) do { unsigned _sp = 0; while (cond) { __builtin_amdgcn_s_sleep(1); \
    if ((++_sp & 255u) == 0u) { if (xb_ld(&(bar)[XB_TMO])) break; if (_sp > XB_SPIN_CAP) { atomicAdd(&(bar)[XB_TMO], 1u); break; } } } } while (0)
struct XcdBarrier { unsigned* bar; unsigned x; volatile LAS unsigned* st; };
__device__ __forceinline__ XcdBarrier xcd_barrier_post(const int swave, unsigned* bar, volatile LAS unsigned* st) {
    XcdBarrier b; b.bar = bar; b.x = xb_xcc_id(); b.st = st;
    if (otid(swave) == 0) (void)xb_add(&bar[XB_XCNT(b.x)], 1u);
    return b;
}
__device__ __forceinline__ void xcd_barrier_complete(unsigned* bar, unsigned x, unsigned& nloc, unsigned& nx) {
    const unsigned G = gridDim.x * gridDim.y * gridDim.z;
    unsigned sum, cnt, mine, sp = 0u;
    for (;;) {
        sum = 0u; cnt = 0u; mine = 0u;
#pragma unroll
        for (unsigned j = 0; j < 16; ++j) { const unsigned c = xb_ld(&bar[XB_XCNT(j)]); sum += c; cnt += (c > 0u) ? 1u : 0u; mine = (j == x) ? c : mine; }
        if (sum == G) break;
        __builtin_amdgcn_s_sleep(1);
        if ((++sp & 255u) == 0u) { if (xb_ld(&bar[XB_TMO])) break; if (sp > XB_SPIN_CAP) { atomicAdd(&bar[XB_TMO], 1u); break; } }
    }
    nloc = mine > 0u ? mine : 1u; nx = cnt > 0u ? cnt : 1u;
}
__device__ __forceinline__ void xcd_barrier(const int swave, const XcdBarrier& b) {
    asm volatile("s_waitcnt vmcnt(0)" ::: "memory");
    __syncthreads();
    if (otid(swave) == 0) {
        unsigned* bar = b.bar;
        __builtin_amdgcn_s_waitcnt(0);
        unsigned nloc = b.st[0], nx = b.st[1];
        if (nloc == 0u) { xcd_barrier_complete(bar, b.x, nloc, nx); b.st[0] = nloc; b.st[1] = nx; }
        const unsigned old = xb_add(&bar[XB_XSUB(b.x)], 1u);
        const unsigned gen = old / nloc;
        if (old + 1u == (gen + 1u) * nloc) {
            __builtin_amdgcn_fence(__ATOMIC_RELEASE, "agent");
            asm volatile("s_waitcnt vmcnt(0)" ::: "memory");
            const unsigned og = xb_add(&bar[XB_TOP], 1u);
            const unsigned tg = og / nx;
            if (og + 1u == (tg + 1u) * nx) xb_add(&bar[XB_TOPGEN], 1u);
            else XB_SPIN(xb_ld(&bar[XB_TOPGEN]) == tg, bar);
            __builtin_amdgcn_fence(__ATOMIC_ACQUIRE, "agent");
            xb_add(&bar[XB_XGEN(b.x)], 1u);
            asm volatile("s_waitcnt vmcnt(0)" ::: "memory");
        } else {
            XB_SPIN(xb_ld(&bar[XB_XGEN(b.x)]) == gen, bar);
            __builtin_amdgcn_fence(__ATOMIC_ACQUIRE, "agent");
            asm volatile("s_waitcnt vmcnt(0)" ::: "memory");
        }
    }
    __syncthreads();
}
constexpr int CW_BAR = 4096;

__device__ __forceinline__ unsigned pk2(float lo, float hi) { return (unsigned)f2bf(lo) | ((unsigned)f2bf(hi) << 16); }
__device__ __forceinline__ void transpose_item(const float* W, int K, int N, bf16* WT, int upmode, LAS float* scr, int item, int lane) {
    const int nblk = N / 32, kb = item / nblk, nb = item % nblk, k0 = 64 * kb, n0 = 32 * nb;
#pragma unroll 8
    for (int i = 0; i < 32; ++i) { const int kk = 2 * i + (lane >> 5); scr[kk * 33 + (lane & 31)] = W[(size_t)(k0 + kk) * N + n0 + (lane & 31)]; }
    asm volatile("s_waitcnt lgkmcnt(0)" ::: "memory");
    const int c = lane & 7;
#pragma unroll
    for (int j = 0; j < 4; ++j) { const int n = (lane >> 3) + 8 * j; const LAS float* sp = scr + (8 * c) * 33 + n;
        u32x4 o; o.x = pk2(sp[0 * 33], sp[1 * 33]); o.y = pk2(sp[2 * 33], sp[3 * 33]); o.z = pk2(sp[4 * 33], sp[5 * 33]); o.w = pk2(sp[6 * 33], sp[7 * 33]);
        const int dn = upmode ? updst(n0 + n) : n0 + n;
        *(u32x4*)(WT + (size_t)dn * K + k0 + 8 * c) = o; }
    asm volatile("s_waitcnt lgkmcnt(0)" ::: "memory");
}
__device__ __forceinline__ void phase_prep(const int swave, const P& p, LAS unsigned char* lds, int bx, int G) {
    const int tid = otid(swave), lane = tid & 63, w = __builtin_amdgcn_readfirstlane(tid >> 6);
    if (bx < 192) {
        LAS float* sc = (LAS float*)lds; LAS float* red = sc + 2048;
        for (int i = tid; i < 2048; i += NTHR) sc[i] = silu_f(p.c[i]);
        __syncthreads();
        for (int cb = bx; cb < 192; cb += G) {
            const int kg = tid >> 5, cl = tid & 31, colj = cb * 32 + cl; float a0 = 0.f, a1 = 0.f;
#pragma unroll 8
            for (int i = 0; i < 64; ++i) { const int k = kg + 16 * i; const float wv = p.w_ada[(size_t)k * 6144 + colj]; a0 += sc[k] * wv; a1 += sc[1024 + k] * wv; }
            red[(kg * 32 + cl) * 2] = a0; red[(kg * 32 + cl) * 2 + 1] = a1;
            __syncthreads();
            if (tid < 64) { const int c2 = tid & 31, bb = tid >> 5; float t = 0.f;
#pragma unroll
                for (int k2 = 0; k2 < 16; ++k2) t += red[(k2 * 32 + c2) * 2 + bb];
                WSP(float, WS_SMALL + SM_ADA)[bb * 6144 + cb * 32 + c2] = t + p.b_ada[cb * 32 + c2]; }
            __syncthreads();
        }
    }
    if (bx == G - 1) { const float l0 = p.lb_logits[tid], l1 = p.lb_logits[512 + tid]; const float m = fmaxf(l0, l1); const float e0 = expf(l0 - m), e1 = expf(l1 - m);
        WSP(float, WS_SMALL + SM_LB)[tid] = e0 / (e0 + e1); }
    LAS float* scr = (LAS float*)(lds + 16384 + w * 8704);
    const int gw = bx * NWAVES + w, NGW = G * NWAVES;
    constexpr int I_IN = (D / 64) * (NIN / 32), I_OUT = (D / 64) * (D / 32), I_UP1 = (D / 64) * (1024 / 32), I_DN1 = (HID / 64) * (D / 32);
    constexpr int NITEMS = I_IN + I_OUT + NE * I_UP1 + NE * I_DN1;
    for (int it = gw; it < NITEMS; it += NGW) {
        int r = it;
        if (r < I_IN) { transpose_item(p.w_in, D, NIN, WSP(bf16, WS_WINT), 0, scr, r, lane); continue; } r -= I_IN;
        if (r < I_OUT) { transpose_item(p.w_out, D, D, WSP(bf16, WS_WOUTT), 0, scr, r, lane); continue; } r -= I_OUT;
        if (r < NE * I_UP1) { const int e = r / I_UP1; transpose_item(p.w_up + (size_t)e * D * 1024, D, 1024, WSP(bf16, WS_WUPT) + (size_t)e * D * 1024, 1, scr, r % I_UP1, lane); continue; } r -= NE * I_UP1;
        { const int e = r / I_DN1; transpose_item(p.w_down + (size_t)e * HID * D, HID, D, WSP(bf16, WS_WDNT) + (size_t)e * HID * D, 0, scr, r % I_DN1, lane); }
    }
}
__device__ __forceinline__ void phase_xmod(const int swave, const P& p, int bx, int G) {
    const int lane = otid(swave) & 63, gw = bx * NWAVES + (otid(swave) >> 6), NGW = G * NWAVES;
    for (int row = gw; row < T; row += NGW) { const float* ada = WSP(float, WS_SMALL + SM_ADA) + (row >> 13) * 6144;
#pragma unroll
        for (int j = 0; j < 4; ++j) { const int col = 256 * j + lane * 4; const f32x4 xv = *(const f32x4*)(p.x + (size_t)row * D + col), sh = *(const f32x4*)(ada + col), sc = *(const f32x4*)(ada + 1024 + col);
            u32x2 o; o.x = cvt_pk_bf16(xv[0] * (1.f + sc[0]) + sh[0], xv[1] * (1.f + sc[1]) + sh[1]); o.y = cvt_pk_bf16(xv[2] * (1.f + sc[2]) + sh[2], xv[3] * (1.f + sc[3]) + sh[3]);
            *(u32x2*)(WSP(bf16, WS_B) + (size_t)row * D + col) = o; } }
}
__device__ __forceinline__ void route_load_weights(const int swave, const P& p, LAS float* WR) {
    for (int c = otid(swave); c < D; c += NTHR) { const f32x4 wg = *(const f32x4*)(p.rg_w + (size_t)c * 4);
#pragma unroll
        for (int g = 0; g < 4; ++g) { WR[g * D + c] = wg[g];
            const f32x4 w0 = *(const f32x4*)(p.re_w + ((size_t)g * D + c) * 8), w1 = *(const f32x4*)(p.re_w + ((size_t)g * D + c) * 8 + 4);
#pragma unroll
            for (int e = 0; e < 4; ++e) { WR[(4 + g * 8 + e) * D + c] = w0[e]; WR[(4 + g * 8 + 4 + e) * D + c] = w1[e]; } } }
}
__device__ __forceinline__ void ln1_route_row(const P& p, const LAS float* WR, LAS int* rt_e, LAS float* rt_w, int row, int rl, int lane) {
    const int b = row >> 13;
    const float* ada = WSP(float, WS_SMALL + SM_ADA) + b * 6144;
    const float* Y = WSP(float, WS_Y) + (size_t)row * D; const float* xr = p.x + (size_t)row * D;
    float v[16]; float s = 0.f;
#pragma unroll
    for (int j = 0; j < 4; ++j) { const int col = 256 * j + lane * 4; const f32x4 xv = *(const f32x4*)(xr + col), yv = *(const f32x4*)(Y + col), g1 = *(const f32x4*)(ada + 2048 + col);
#pragma unroll
        for (int i = 0; i < 4; ++i) { v[4 * j + i] = ALPHA * xv[i] + (1.f + g1[i]) * yv[i]; s += v[4 * j + i]; } }
    const float mean = wave_sum(s) * (1.f / D); float q = 0.f;
#pragma unroll
    for (int i = 0; i < 16; ++i) { v[i] -= mean; q += v[i] * v[i]; }
    const float rstd = rsqrtf(wave_sum(q) * (1.f / D) + LN_EPS);
    float* X1 = WSP(float, WS_X1) + (size_t)row * D; bf16* H2 = WSP(bf16, WS_B) + (size_t)row * D;
#pragma unroll
    for (int j = 0; j < 4; ++j) { const int col = 256 * j + lane * 4; const f32x4 gg = *(const f32x4*)(p.ln1_g + col), bb = *(const f32x4*)(p.ln1_b + col), sh = *(const f32x4*)(ada + 3072 + col), sc = *(const f32x4*)(ada + 4096 + col);
        f32x4 x1;
#pragma unroll
        for (int i = 0; i < 4; ++i) { x1[i] = v[4 * j + i] * rstd * gg[i] + bb[i]; v[4 * j + i] = x1[i] * (1.f + sc[i]) + sh[i]; }
        *(f32x4*)(X1 + col) = x1; u32x2 o; o.x = cvt_pk_bf16(v[4 * j], v[4 * j + 1]); o.y = cvt_pk_bf16(v[4 * j + 2], v[4 * j + 3]); *(u32x2*)(H2 + col) = o; }
    __builtin_amdgcn_sched_barrier(0);
    float lg[36];
#pragma unroll
    for (int o = 0; o < 36; ++o) { float a = 0.f;
#pragma unroll
        for (int j = 0; j < 4; ++j) { const f32x4 wv = *(const LAS f32x4*)(WR + o * D + 256 * j + lane * 4); a += (v[4 * j] * wv[0] + v[4 * j + 1] * wv[1]) + (v[4 * j + 2] * wv[2] + v[4 * j + 3] * wv[3]); }
        lg[o] = a; if ((o % 6) == 5) __builtin_amdgcn_sched_barrier(0); }
#pragma unroll
    for (int o = 0; o < 4; ++o) lg[o] = wave_sum(lg[o]) + p.rg_b[o];
#pragma unroll
    for (int o = 0; o < 32; ++o) lg[4 + o] = wave_sum(lg[4 + o]) + p.re_b[o];
    int gi = 0; float gm = lg[0];
#pragma unroll
    for (int g = 1; g < 4; ++g) if (lg[g] > gm) { gm = lg[g]; gi = g; }
    float gs = 0.f;
#pragma unroll
    for (int g = 0; g < 4; ++g) gs += expf(lg[g] - gm);
    const float pgroup = 1.f / gs;
    float el[8];
#pragma unroll
    for (int e = 0; e < 8; ++e) el[e] = gi == 0 ? lg[4 + e] : gi == 1 ? lg[12 + e] : gi == 2 ? lg[20 + e] : lg[28 + e];
    int j0 = 0; float m0 = el[0];
#pragma unroll
    for (int e = 1; e < 8; ++e) if (el[e] > m0) { m0 = el[e]; j0 = e; }
    int j1 = -1; float m1 = -3.0e38f;
#pragma unroll
    for (int e = 0; e < 8; ++e) if (e != j0 && el[e] > m1) { m1 = el[e]; j1 = e; }
    const float r1 = expf(m1 - m0);
    if (lane == 0) { rt_e[2 * rl] = gi * 8 + j0; rt_e[2 * rl + 1] = gi * 8 + j1; rt_w[2 * rl] = pgroup / (1.f + r1); rt_w[2 * rl + 1] = pgroup * r1 / (1.f + r1); }
}
__device__ __forceinline__ void route_assign(const int swave, const P& p, const LAS int* rt_e, const LAS float* rt_w, LAS int* rt_base, int rowbase) {
    const int lane = otid(swave);
    if (lane < 32) { int c = 0; for (int a = 0; a < 128; ++a) c += (rt_e[a] == lane) ? 1 : 0;
        rt_base[lane] = c ? (int)atomicAdd(WSP(unsigned, WS_CTL) + CW_CNT + lane, (unsigned)c) : 0; }
    asm volatile("s_waitcnt vmcnt(0) lgkmcnt(0)" ::: "memory");
    int* LIST = WSP(int, WS_LIST); float* WL = WSP(float, WS_WLIST); int* TE = WSP(int, WS_SMALL + SM_TOKE); int* TS = WSP(int, WS_SMALL + SM_TOKS);
#pragma unroll
    for (int k = 0; k < 2; ++k) { const int a = lane + 64 * k, e = rt_e[a]; int rank = 0; for (int a2 = 0; a2 < a; ++a2) rank += (rt_e[a2] == e) ? 1 : 0;
        const int slot = rt_base[e] + rank, row = rowbase + (a >> 1);
        LIST[e * T + slot] = row; WL[e * T + slot] = rt_w[a]; TE[row * 2 + (a & 1)] = e; TS[row * 2 + (a & 1)] = slot; }
}
__device__ __forceinline__ void final_row(const P& p, const LAS int* tstart, int row, int lane) {
    const int b = row >> 13;
    const float* ada = WSP(float, WS_SMALL + SM_ADA) + b * 6144;
    const int* TE = WSP(int, WS_SMALL + SM_TOKE); const int* TS = WSP(int, WS_SMALL + SM_TOKS);
    const size_t rA = (size_t)(tstart[TE[row * 2]] * 256 + TS[row * 2]), rB = (size_t)(tstart[TE[row * 2 + 1]] * 256 + TS[row * 2 + 1]);
    const bf16* ya = WSP(bf16, WS_Y2) + rA * D; const bf16* yb = WSP(bf16, WS_Y2) + rB * D; const float* X1 = WSP(float, WS_X1) + (size_t)row * D;
    float v[16]; float s = 0.f;
#pragma unroll
    for (int j = 0; j < 4; ++j) { const int col = 256 * j + lane * 4; const f32x4 xv = *(const f32x4*)(X1 + col), g2 = *(const f32x4*)(ada + 5120 + col);
        const u32x2 pa = *(const u32x2*)(ya + col), pb = *(const u32x2*)(yb + col);
        const float m0 = __uint_as_float(pa.x << 16) + __uint_as_float(pb.x << 16), m1 = __uint_as_float(pa.x & 0xffff0000u) + __uint_as_float(pb.x & 0xffff0000u);
        const float m2 = __uint_as_float(pa.y << 16) + __uint_as_float(pb.y << 16), m3 = __uint_as_float(pa.y & 0xffff0000u) + __uint_as_float(pb.y & 0xffff0000u);
        v[4 * j + 0] = ALPHA * xv[0] + (1.f + g2[0]) * m0; v[4 * j + 1] = ALPHA * xv[1] + (1.f + g2[1]) * m1; v[4 * j + 2] = ALPHA * xv[2] + (1.f + g2[2]) * m2; v[4 * j + 3] = ALPHA * xv[3] + (1.f + g2[3]) * m3;
        s += (v[4 * j] + v[4 * j + 1]) + (v[4 * j + 2] + v[4 * j + 3]); }
    const float mean = wave_sum(s) * (1.f / D); float q = 0.f;
#pragma unroll
    for (int i = 0; i < 16; ++i) { v[i] -= mean; q += v[i] * v[i]; }
    const float rstd = rsqrtf(wave_sum(q) * (1.f / D) + LN_EPS);
#pragma unroll
    for (int j = 0; j < 4; ++j) { const int col = 256 * j + lane * 4; const f32x4 gg = *(const f32x4*)(p.ln2_g + col), bb = *(const f32x4*)(p.ln2_b + col); f32x4 o;
#pragma unroll
        for (int i = 0; i < 4; ++i) o[i] = v[4 * j + i] * rstd * gg[i] + bb[i];
        *(f32x4*)(p.out + (size_t)row * D + col) = o; }
}

enum { PH_PREP = 0, PH_XMOD, PH_INPROJ, PH_MIXA, PH_SCAN, PH_MIXC, PH_OUTPROJ, PH_LN1ROUTE, PH_UP, PH_DOWN, PH_FINAL, PH_N };
struct Args { P p; int ph_lo, ph_hi, li, pad; };

__device__ __forceinline__ void moe_tables(const int swave, const P& p, LAS unsigned char* lds) {
    LAS int* tstart = (LAS int*)(lds + LDSCTL_OFF) + LC_TSTART; LAS int* lcnt = (LAS int*)(lds + LDSCTL_OFF) + LC_CNT;
    if (otid(swave) == 0) { int acc = 0;
        for (int e = 0; e < NE; ++e) { const int c = (int)__hip_atomic_load(WSP(unsigned, WS_CTL) + CW_CNT + e, __ATOMIC_RELAXED, __HIP_MEMORY_SCOPE_AGENT); tstart[e] = acc; lcnt[e] = c; acc += (c + 255) >> 8; }
        tstart[NE] = acc; }
    __syncthreads();
}

__device__ __forceinline__ P load_p() {
    typedef const __attribute__((address_space(4))) unsigned long long CU64;
    CU64* a = (CU64*)__builtin_amdgcn_kernarg_segment_ptr(); asm volatile("" : "+s"(a));
    P p; unsigned long long* d = (unsigned long long*)&p;
#pragma unroll
    for (int i = 0; i < 24; ++i) d[i] = a[i];
    return p;
}
__global__ void __launch_bounds__(NTHR, 2) mk_fwd(Args args) {
    extern __shared__ __attribute__((aligned(16))) unsigned char lds_raw[];
    LAS unsigned char* lds = (LAS unsigned char*)lds_raw;
    const P& p = args.p;
    const int G = gridDim.x, bx = blockIdx.x;
    const int swave = __builtin_amdgcn_readfirstlane((int)threadIdx.x >> 6);
    const int lo = args.ph_lo, hi = args.ph_hi;
#ifndef PHASE_MASK
#define PHASE_MASK 0x7ff
#endif
#define IN(k) (((PHASE_MASK >> (k)) & 1) && lo <= (k) && (k) < hi)
#define SEAM(k) do { if (IN(k) && IN((k) + 1)) xcd_barrier(swave, bar); } while (0)
    for (int u = otid(swave); u < (LDS_BYTES - LDSCTL_OFF) / 4; u += NTHR) ((LAS unsigned*)(lds + LDSCTL_OFF))[u] = 0u;
    __syncthreads();
    XcdBarrier bar = xcd_barrier_post(swave, WSP(unsigned, WS_CTL) + CW_BAR + args.li * XCD_BAR_WORDS, (volatile LAS unsigned*)(lds + LDSCTL_OFF) + LC_BAR);
    if (IN(PH_PREP)) { asm volatile("; MARK PH_PREP"); const P p = load_p(); phase_prep(swave, p, lds, bx, G); SEAM(PH_PREP); }
    if (IN(PH_XMOD)) { asm volatile("; MARK PH_XMOD"); const P p = load_p(); phase_xmod(swave, p, bx, G); SEAM(PH_XMOD); }
    if (IN(PH_INPROJ)) { asm volatile("; MARK PH_INPROJ"); const P p = load_p();
        pg8::Gemm g{WSP(bf16, WS_B), WSP(bf16, WS_WINT), D, 0, 0, nullptr}; pg8::StaticOrder S; S.init(T, NIN, G, bx);
        pg8::EpiInproj E{p.ws};
        pg8::gemm_phase<pg8::EpiInproj, pg8::StaticOrder, true, true, false>(swave, lds, g, S, E);
        SEAM(PH_INPROJ);
    }
    if (IN(PH_MIXA)) { asm volatile("; MARK PH_MIXA"); const P p = load_p();
        for (int it = bx; it < 256 + 512; it += G) { if (it < 256) hgrn_item<0>(swave, p, lds, it); else sg_item(swave, p, lds, it - 256); }
        SEAM(PH_MIXA);
    }
    if (IN(PH_SCAN)) { asm volatile("; MARK PH_SCAN"); const P p = load_p();
        for (int gid = bx * NTHR + otid(swave); gid < 8 * 16384; gid += G * NTHR) hgrn_scan(p, gid);
        SEAM(PH_SCAN);
    }
    if (IN(PH_MIXC)) { asm volatile("; MARK PH_MIXC"); const P p = load_p();
        for (int it = bx; it < 256; it += G) hgrn_item<1>(swave, p, lds, it);
        SEAM(PH_MIXC);
    }
    if (IN(PH_OUTPROJ)) { asm volatile("; MARK PH_OUTPROJ"); const P p = load_p();
        pg8::Gemm g{WSP(bf16, WS_B), WSP(bf16, WS_WOUTT), D, 0, 0, nullptr}; pg8::StaticOrder S; S.init(T, D, G, bx);
        pg8::EpiF32 E{p.ws, WS_Y, D};
        pg8::gemm_phase<pg8::EpiF32, pg8::StaticOrder, true, true, false>(swave, lds, g, S, E);
        SEAM(PH_OUTPROJ);
    }
    if (IN(PH_LN1ROUTE)) { asm volatile("; MARK PH_LN1ROUTE"); const P p = load_p();
        const int lane = otid(swave) & 63, w = __builtin_amdgcn_readfirstlane(otid(swave) >> 6);
        LAS float* WR = (LAS float*)lds; LAS int* rt_e = (LAS int*)(lds + LDSCTL_OFF) + LC_RT; LAS float* rt_w = (LAS float*)(rt_e + 128); LAS int* rt_base = rt_e + 256;
        route_load_weights(swave, p, WR);
        __syncthreads();
        for (int rb = bx * 64; rb < T; rb += G * 64) {
#pragma unroll 1
            for (int rr = 0; rr < 8; ++rr) { asm volatile("" ::: "memory"); ln1_route_row(p, WR, rt_e, rt_w, rb + 8 * w + rr, 8 * w + rr, lane); }
            __syncthreads();
            if (w == 0) route_assign(swave, p, rt_e, rt_w, rt_base, rb);
            __syncthreads();
        }
        SEAM(PH_LN1ROUTE);
    }
    if (IN(PH_UP)) { asm volatile("; MARK PH_UP"); const P p = load_p();
        moe_tables(swave, p, lds);
        pg8::Gemm g{WSP(bf16, WS_B), WSP(bf16, WS_WUPT), D, 0, (size_t)1024 * D * 2, WSP(int, WS_LIST)};
        pg8::MoeOrder S{(const LAS int*)(lds + LDSCTL_OFF) + LC_TSTART, (const LAS int*)(lds + LDSCTL_OFF) + LC_CNT, G, bx, 4};
        pg8::EpiUp E{p.ws};
        pg8::gemm_phase<pg8::EpiUp, pg8::MoeOrder, true, true, true>(swave, lds, g, S, E);
        SEAM(PH_UP);
    }
    if (IN(PH_DOWN)) { asm volatile("; MARK PH_DOWN"); const P p = load_p();
        moe_tables(swave, p, lds);
        pg8::Gemm g{WSP(bf16, WS_ACT), WSP(bf16, WS_WDNT), HID, 0, (size_t)1024 * HID * 2, nullptr};
        pg8::MoeOrder S{(const LAS int*)(lds + LDSCTL_OFF) + LC_TSTART, (const LAS int*)(lds + LDSCTL_OFF) + LC_CNT, G, bx, 4};
        pg8::EpiDown E{p.ws};
        pg8::gemm_phase<pg8::EpiDown, pg8::MoeOrder, true, true, false>(swave, lds, g, S, E);
        SEAM(PH_DOWN);
    }
    if (IN(PH_FINAL)) { asm volatile("; MARK PH_FINAL"); const P p = load_p();
        moe_tables(swave, p, lds);
        const int lane = otid(swave) & 63, gw = bx * NWAVES + (otid(swave) >> 6), NGW = G * NWAVES;
#pragma unroll 1
        for (int row = gw; row < T; row += NGW) { asm volatile("" ::: "memory"); final_row(p, (const LAS int*)(lds + LDSCTL_OFF) + LC_TSTART, row, lane); }
    }
#undef SEAM
#undef IN
}

#ifndef NAIVE_MASK
#define NAIVE_MASK 0
#endif
#ifndef MK_SPLIT
#define MK_SPLIT 0
#endif
static void launch_mk(const P& p, int lo, int hi, int li, hipStream_t s) {
    Args a{}; a.p = p; a.ph_lo = lo; a.ph_hi = hi; a.li = li; a.pad = 0;
    hipLaunchKernelGGL(mk_fwd, dim3(256), dim3(NTHR), LDS_BYTES, s, a);
}
static void launch_naive(const P& p, int k, hipStream_t stream) {
    switch (k) {
    case PH_PREP:
        k_ada<<<48, 256, 0, stream>>>(p);
        k_convT<<<dim3(NIN / 32, D / 32, 1), dim3(32, 8), 0, stream>>>(p.w_in, WSP(bf16, WS_WINT), D, NIN, 0);
        k_convT<<<dim3(D / 32, D / 32, 1), dim3(32, 8), 0, stream>>>(p.w_out, WSP(bf16, WS_WOUTT), D, D, 0);
        k_convT<<<dim3(1024 / 32, D / 32, NE), dim3(32, 8), 0, stream>>>(p.w_up, WSP(bf16, WS_WUPT), D, 1024, 1);
        k_convT<<<dim3(D / 32, HID / 32, NE), dim3(32, 8), 0, stream>>>(p.w_down, WSP(bf16, WS_WDNT), HID, D, 0);
        break;
    case PH_XMOD: k_xmod<<<T * D / 4 / 256, 256, 0, stream>>>(p); break;
    case PH_INPROJ: k_gemm_naive<GInproj><<<dim3(NIN / 64, T / 64, 1), 256, 0, stream>>>(GInproj{p, D, 0}); break;
    case PH_MIXA:
        k_hgrn_naive<<<8, 128, 0, stream>>>(p);
        k_sg_stats<<<T / 4, 256, 0, stream>>>(p);
        k_sg_naive<<<T * 512 / 256, 256, 0, stream>>>(p);
        break;
    case PH_SCAN: case PH_MIXC: break;
    case PH_OUTPROJ: k_gemm_naive<GOutproj><<<dim3(D / 64, T / 64, 1), 256, 0, stream>>>(GOutproj{p, D, 0}); break;
    case PH_LN1ROUTE: k_ln1_route<<<T / 4, 256, 0, stream>>>(p); break;
    case PH_UP: k_rowbase<<<1, 64, 0, stream>>>(p); k_gemm_naive<GUp><<<dim3(HID / 64, T / 64, NE), 256, 0, stream>>>(GUp{p, D, 0}); break;
    case PH_DOWN: k_rowbase<<<1, 64, 0, stream>>>(p); k_gemm_naive<GDown><<<dim3(D / 64, T / 64, NE), 256, 0, stream>>>(GDown{p, HID, 0}); break;
    case PH_FINAL: k_rowbase<<<1, 64, 0, stream>>>(p); k_final<<<T / 4, 256, 0, stream>>>(p); break;
    }
}
extern "C" void kernel_launch(void* const* d_in, const int* in_sizes, int n_in, void* d_out, int out_size, void* d_ws, size_t ws_size, hipStream_t stream) {
    if (n_in != 22 || ws_size < WS_END) { fprintf(stderr, "kernel_launch: unexpected n_in %d / ws %zu\n", n_in, ws_size); return; }
    static int inited = 0;
    if (!inited) { inited = 1;
        if (hipFuncSetAttribute((const void*)mk_fwd, hipFuncAttributeMaxDynamicSharedMemorySize, LDS_BYTES) != hipSuccess) fprintf(stderr, "kernel_launch: hipFuncSetAttribute failed\n"); }
    P p{};
    const float** f = (const float**)&p;
    for (int i = 0; i < 22; ++i) f[i] = (const float*)d_in[i];
    p.out = (float*)d_out; p.ws = (unsigned char*)d_ws;
    (void)hipMemsetAsync((char*)d_ws + WS_CTL, 0, 1 * MiB, stream);
    int li = 0;
    for (int k = 0; k < PH_N;) {
        if ((NAIVE_MASK >> k) & 1) { launch_naive(p, k, stream); ++k; continue; }
        int e = k + 1;
        if (!MK_SPLIT) while (e < PH_N && !((NAIVE_MASK >> e) & 1)) ++e;
        launch_mk(p, k, e, li++, stream);
        k = e;
    }
}
```

```cpp
#include <hip/hip_runtime.h>
#include <cstdio>
#include <cstdint>

typedef unsigned short bf16;
typedef float f32x4 __attribute__((ext_vector_type(4)));

constexpr int NB = 2, SEQ = 8192, D = 1024, T = NB * SEQ;
constexpr int NIN = 3072;
constexpr int NE = 32, HID = 512;
constexpr float ALPHA = 1.189207115002721f;
constexpr float LN_EPS = 1e-5f, RMS_EPS = 1e-6f;
constexpr int ROWS_PAD = 40960;

constexpr size_t MiB = 1u << 20;
constexpr size_t WS_CTL = 0;
constexpr size_t WS_SMALL = 1 * MiB;
constexpr size_t WS_LIST = 2 * MiB, WS_WLIST = 4 * MiB;
constexpr size_t WS_WINT = 6 * MiB, WS_WOUTT = 12 * MiB, WS_WUPT = 14 * MiB, WS_WDNT = 78 * MiB;
constexpr size_t WS_B = 110 * MiB;
constexpr size_t WS_QS = 142 * MiB, WS_V = 158 * MiB, WS_OG = 174 * MiB, WS_LOGF = 190 * MiB, WS_ZG = 222 * MiB;
constexpr size_t WS_Y = 142 * MiB, WS_ACT = 206 * MiB;
constexpr size_t WS_SLOC = 254 * MiB, WS_SSTART = 270 * MiB;
constexpr size_t WS_X1 = 286 * MiB, WS_Y2 = 350 * MiB, WS_END = 430 * MiB;
constexpr size_t SM_ADA = 0, SM_LB = 64 * 1024, SM_ROWBASE = 128 * 1024, SM_SGSTAT = 256 * 1024, SM_TOKE = 512 * 1024, SM_TOKS = 640 * 1024, SM_DTOT = 768 * 1024;
constexpr int CW_CNT = 1024;

struct P {
    const float *x, *c, *w_ada, *b_ada, *w_in, *lb_logits, *hg_norm_w, *sg_ln_g, *sg_ln_b, *sg_w, *sg_b, *w_out, *ln1_g, *ln1_b,
        *rg_w, *rg_b, *re_w, *re_b, *w_up, *w_down, *ln2_g, *ln2_b;
    float* out; unsigned char* ws;
};

__device__ __forceinline__ float bf2f(bf16 b) { return __uint_as_float(((unsigned)b) << 16); }
__device__ __forceinline__ bf16 f2bf(float f) { unsigned u = __float_as_uint(f); return (bf16)((u + 0x7fffu + ((u >> 16) & 1u)) >> 16); }
__device__ __forceinline__ float silu_f(float x) { return x / (1.f + __expf(-x)); }
__device__ __forceinline__ float gelu_f(float x) { return 0.5f * x * (1.f + erff(x * 0.70710678118654752f)); }
__device__ __forceinline__ float wave_sum(float v) {
#pragma unroll
    for (int o = 1; o < 64; o <<= 1) v += __shfl_xor(v, o);
    return v;
}
#define WSP(type, off) ((type*)(p.ws + (off)))

__device__ __forceinline__ int updst(int n) { const int part = n >> 9, q = n & 511; return 256 * (q >> 7) + 128 * part + (q & 127); }

#define LAS __attribute__((address_space(3)))
#define GAS __attribute__((address_space(1)))
typedef short bf16x8 __attribute__((ext_vector_type(8)));
typedef unsigned u32x4 __attribute__((ext_vector_type(4)));
typedef unsigned u32x2 __attribute__((ext_vector_type(2)));
typedef float f32x2 __attribute__((ext_vector_type(2)));
constexpr int NWAVES = 8, NTHR = 512;
template <class Tv> __device__ __forceinline__ Tv ldg(const void* base, unsigned off) { return *(const Tv*)((const char*)base + off); }
template <class Tv> __device__ __forceinline__ void stg(void* base, unsigned off, Tv v) { *(Tv*)((char*)base + off) = v; }
#define DPP_ADD(v, ctrl, rmask) v += __int_as_float(__builtin_amdgcn_update_dpp(0, __float_as_int(v), ctrl, rmask, 0xF, false))
__device__ __forceinline__ float wave_sum_dpp(float v) {
    DPP_ADD(v, 0xB1, 0xF);
    DPP_ADD(v, 0x4E, 0xF);
    DPP_ADD(v, 0x141, 0xF);
    DPP_ADD(v, 0x140, 0xF);
    DPP_ADD(v, 0x142, 0xA);
    DPP_ADD(v, 0x143, 0xC);
    return __int_as_float(__builtin_amdgcn_readlane(__float_as_int(v), 63));
}
__device__ __forceinline__ int otid(int swave) { int l; asm volatile("v_mbcnt_lo_u32_b32 %0, -1, 0\n\tv_mbcnt_hi_u32_b32 %0, -1, %0" : "=v"(l)); return (swave << 6) | l; }
constexpr int RING_BYTES = 131072, LDSCTL_OFF = 147456, LDS_BYTES = 151552;
constexpr int LC_BAR = 0, LC_TSTART = 64  , LC_CNT = 128  , LC_RT = 256  ;

__device__ __forceinline__ unsigned cvt_pk_bf16(float lo, float hi) { unsigned r; asm volatile("v_cvt_pk_bf16_f32 %0, %1, %2" : "=v"(r) : "v"(lo), "v"(hi)); return r; }
__device__ __forceinline__ float fast_sigmoid(float x) { return __builtin_amdgcn_rcpf(1.f + __expf(-x)); }
__device__ __forceinline__ f32x2 gelu_pk(f32x2 v) {
    const f32x2 av = __builtin_elementwise_abs(v), d = av * 0.2316418882f + 1.0f;
    f32x2 t; t.x = __builtin_amdgcn_rcpf(d.x); t.y = __builtin_amdgcn_rcpf(d.y);
    f32x2 q = t * 0.5307027145f + (-0.7265760135f); q = q * t + 0.7107068705f; q = q * t + (-0.142248368f); q = q * t + 0.127414796f; q = q * t;
    const f32x2 s = (v * v) * (-0.72134752044f);
    f32x2 e; e.x = __builtin_amdgcn_exp2f(s.x); e.y = __builtin_amdgcn_exp2f(s.y);
    const f32x2 m = v * (q * e), r = v - m;
    f32x2 o; o.x = v.x < 0.f ? m.x : r.x; o.y = v.y < 0.f ? m.y : r.y; return o;
}

namespace pg8 {
constexpr int BM = 256, BK = 64, HALF = 128, HTB = HALF * BK * 2, STAGE_BYTES = 8 * HTB, NXCD = 8, WGM = 8;
__host__ __device__ __forceinline__ int lds_byte(int r, int c) { const int st = (r >> 4) * 2 + (c >> 5), rr = r & 15, cc = c & 31, ob = rr * 64 + cc * 2; return st * 1024 + (ob ^ (((ob >> 9) & 1) << 5)); }
__host__ __device__ __forceinline__ void stage_rc(int b, int& R, int& C) { const int st = b / 1024, sb = b % 1024, swz = sb ^ (((sb >> 9) & 1) << 5); R = (st >> 1) * 16 + swz / 64; C = (st & 1) * 32 + (swz % 64) / 2; }
__host__ __device__ __forceinline__ int perm32(int rho) { const int n = rho >> 4, i = rho & 15; return 8 * (i >> 2) + 4 * n + (i & 3); }

struct Unit { int pm, pn, e, nvalid, r0, pad; };
struct Gemm { const bf16* A; const bf16* Bt; int K, pad; size_t bstride; const int* list; };

struct StaticOrder {
    int nM, nN, nwg, G, c;
    __device__ void init(int M, int N, int G_, int c_) { nM = M / BM; nN = N / BM; nwg = nM * nN; G = G_; c = c_; }
    __device__ bool next(int i, Unit& u) const {
        const long L = (long)i * G + c; if (L >= nwg) return false;
        int wgid = (int)L; { const int q = nwg / NXCD, r = nwg % NXCD, xcd = wgid % NXCD, off = wgid / NXCD; wgid = (xcd < r ? xcd * (q + 1) : r * (q + 1) + (xcd - r) * q) + off; }
        const int nig = WGM * nN, gid = wgid / nig, fm = gid * WGM, gsz = (nM - fm) < WGM ? (nM - fm) : WGM;
        u.pm = fm + ((wgid % nig) % gsz); u.pn = (wgid % nig) / gsz; u.e = 0; u.nvalid = 256; u.r0 = 0; u.pad = 0; return true;
    }
};
struct MoeOrder {
    const LAS int* tstart; const LAS int* cnt; int G, c, nN;
    __device__ bool next(int i, Unit& u) const {
        const int L = i * G + c, ntile = tstart[NE]; if (L >= ntile * nN) return false;
        const int tile = L / nN; u.pn = L % nN; u.pm = tile;
        int e = 0;
#pragma unroll 1
        for (int k = 1; k < NE; ++k) e = (tile >= tstart[k]) ? k : e;
        u.e = e; u.r0 = (tile - tstart[e]) * 256; const int left = cnt[e] - u.r0; u.nvalid = left < 256 ? left : 256; u.pad = 0; return true;
    }
};

#define PG8_LAS LAS
template <class Epi, class Sched, bool ALIGN_EPI, bool SP2, bool GATHER>
__device__ __forceinline__ void gemm_phase(const int swave, PG8_LAS unsigned char* lds, const Gemm g, const Sched& S, const Epi& E) {
    const int tid = otid(swave), wid = __builtin_amdgcn_readfirstlane(tid >> 6), lane = tid & 63, wr = wid >> 2, wc = wid & 3, fr = lane & 15, fq = lane >> 4;
    const int K = g.K, nt = K / BK;
    unsigned voffB[2], vA[2][2], vAn[2][2]; int RA[2], CA[2];
#pragma unroll
    for (int i = 0; i < 2; ++i) { int R, C; stage_rc(tid * 16 + i * 8192, R, C); const int Rb = Epi::PERM ? ((R & ~31) + perm32(R & 31)) : R; RA[i] = R; CA[i] = C;
        voffB[i] = (unsigned)(Rb * K + C) * 2u;
#pragma unroll
        for (int h = 0; h < 2; ++h) { vA[h][i] = (unsigned)((h * HALF + R) * K + C) * 2u; vAn[h][i] = vA[h][i]; } }
    const size_t kstep = (size_t)(BK * 2);
    const size_t hstep = (size_t)HALF * K * 2;
    const size_t tstep = 2 * hstep;
    const unsigned ldsw = (unsigned)wid * 1024u;
    const int aoff = lds_byte(wr * 64 + fr, fq * 8), boff = lds_byte(wc * 32 + fr, fq * 8);
#define PG8_SA(b, h) (((b) * 2 + (h)) * HTB)
#define PG8_SB(b, h) ((4 + (b) * 2 + (h)) * HTB)
#define PG8_STAGE(bufoff, gbase, voff) do { _Pragma("unroll") for (int _i = 0; _i < 2; ++_i) \
        __builtin_amdgcn_global_load_lds((const unsigned*)((const char*)(gbase) + (voff)[_i]), (PG8_LAS unsigned*)(lds + (bufoff) + ldsw + _i * 8192), 16, 0, 0); } while (0)
#define PG8_LDA(dst, b, h) do { _Pragma("unroll") for (int m = 0; m < 4; ++m) _Pragma("unroll") for (int k = 0; k < 2; ++k) dst[m][k] = *(const PG8_LAS bf16x8*)(lds + PG8_SA(b, h) + aoff + m * 2048 + k * 1024); } while (0)
#define PG8_LDB(dst, b, h) do { _Pragma("unroll") for (int n = 0; n < 2; ++n) _Pragma("unroll") for (int k = 0; k < 2; ++k) dst[n][k] = *(const PG8_LAS bf16x8*)(lds + PG8_SB(b, h) + boff + n * 2048 + k * 1024); } while (0)
#define PG8_MMA(ai, bj, At, Bt) do { __builtin_amdgcn_s_setprio(1); _Pragma("unroll") for (int m = 0; m < 4; ++m) _Pragma("unroll") for (int n = 0; n < 2; ++n) _Pragma("unroll") for (int k = 0; k < 2; ++k) \
        acc[ai][bj][m][n] = __builtin_amdgcn_mfma_f32_16x16x32_bf16(Bt[n][k], At[m][k], acc[ai][bj][m][n], 0, 0, 0); __builtin_amdgcn_s_setprio(0); } while (0)
#define PG8_WAIT_V(n) asm volatile("s_waitcnt vmcnt(" #n ")" ::: "memory")
#define PG8_WAIT_L(n) asm volatile("s_waitcnt lgkmcnt(" #n ")" ::: "memory")
#define PG8_BAR __builtin_amdgcn_s_barrier()
#define PG8_SCHED __builtin_amdgcn_sched_barrier(0)
#define PG8_SETV(V, U) do { if constexpr (GATHER) { _Pragma("unroll") for (int _h = 0; _h < 2; ++_h) _Pragma("unroll") for (int _i = 0; _i < 2; ++_i) { const int _r = _h * HALF + RA[_i]; \
        const int _tok = _r < (U).nvalid ? g.list[(size_t)(U).e * T + (U).r0 + _r] : 0; V[_h][_i] = (unsigned)(_tok * K + CA[_i]) * 2u; } } } while (0)
    Unit cur, nxt; int ui = 0;
    if (!S.next(0, cur)) return;
    f32x4 acc[2][2][4][2];
#pragma unroll
    for (int a = 0; a < 2; ++a)
#pragma unroll
        for (int b = 0; b < 2; ++b)
#pragma unroll
            for (int m = 0; m < 4; ++m)
#pragma unroll
                for (int n = 0; n < 2; ++n) acc[a][b][m][n] = (f32x4){0.f, 0.f, 0.f, 0.f};
    bf16x8 At[4][2], B0[2][2], B1[2][2];
    PG8_SETV(vA, cur);
    const char* cA = (const char*)g.A + (GATHER ? (size_t)0 : (size_t)cur.pm * tstep); const char* cB = (const char*)g.Bt + (size_t)cur.e * g.bstride + (size_t)cur.pn * tstep;
    if constexpr (SP2) {
        PG8_STAGE(PG8_SB(0, 0), cB, voffB); PG8_STAGE(PG8_SB(0, 1), cB + hstep, voffB); PG8_STAGE(PG8_SA(0, 0), cA, vA[0]); PG8_STAGE(PG8_SA(0, 1), cA, vA[1]);
        if (wr == 1) PG8_BAR;
        PG8_WAIT_V(2); PG8_BAR;
        PG8_STAGE(PG8_SB(1, 0), cB + kstep, voffB); PG8_STAGE(PG8_SA(1, 0), cA + kstep, vA[0]); PG8_STAGE(PG8_SB(1, 1), cB + hstep + kstep, voffB);
        PG8_WAIT_V(6); PG8_BAR;
    } else {
        PG8_STAGE(PG8_SB(0, 0), cB, voffB); PG8_STAGE(PG8_SA(0, 0), cA, vA[0]); PG8_STAGE(PG8_SB(0, 1), cB + hstep, voffB); PG8_STAGE(PG8_SA(0, 1), cA, vA[1]);
        if (wr == 1) PG8_BAR;
        PG8_WAIT_V(4); PG8_BAR;
        PG8_STAGE(PG8_SB(1, 0), cB + kstep, voffB); PG8_STAGE(PG8_SA(1, 0), cA + kstep, vA[0]); PG8_STAGE(PG8_SB(1, 1), cB + hstep + kstep, voffB);
        PG8_WAIT_V(6); PG8_BAR;
    }
    for (;;) {
        const bool has_next = S.next(ui + 1, nxt);
        if (has_next) PG8_SETV(vAn, nxt);
        const char* nA = has_next ? (const char*)g.A + (GATHER ? (size_t)0 : (size_t)nxt.pm * tstep) : cA; const char* nB = has_next ? (const char*)g.Bt + (size_t)nxt.e * g.bstride + (size_t)nxt.pn * tstep : cB;
        for (int t = 0; t < nt; t += 2) {
            const bool last = (t == nt - 2);
            const char* a1 = cA + (size_t)(t + 1) * kstep;
            const char* a2 = last ? nA : cA + (size_t)(t + 2) * kstep; const char* b2 = last ? nB : cB + (size_t)(t + 2) * kstep;
            const char* a3 = a2 + kstep; const char* b3 = b2 + kstep;
            unsigned v2[2][2];
#pragma unroll
            for (int h = 0; h < 2; ++h)
#pragma unroll
                for (int i = 0; i < 2; ++i) v2[h][i] = (GATHER && last && has_next) ? vAn[h][i] : vA[h][i];
            if constexpr (SP2) {
            PG8_LDB(B0, 0, 0); PG8_LDB(B1, 0, 1); PG8_SCHED; PG8_LDA(At, 0, 0); PG8_STAGE(PG8_SA(1, 1), a1, vA[1]);
            PG8_WAIT_V(8); PG8_WAIT_L(0); PG8_BAR; PG8_MMA(0, 0, At, B0); PG8_MMA(0, 1, At, B1); PG8_BAR; PG8_SCHED;
            PG8_LDA(At, 0, 1); PG8_STAGE(PG8_SB(0, 0), b2, voffB); PG8_STAGE(PG8_SB(0, 1), b2 + hstep, voffB); PG8_STAGE(PG8_SA(0, 0), a2, v2[0]);
            PG8_WAIT_V(8); PG8_WAIT_L(0); PG8_BAR; PG8_MMA(1, 0, At, B0); PG8_MMA(1, 1, At, B1); PG8_BAR; PG8_SCHED;
            PG8_LDB(B0, 1, 0); PG8_LDB(B1, 1, 1); PG8_SCHED; PG8_LDA(At, 1, 0); PG8_STAGE(PG8_SA(0, 1), a2, v2[1]);
            PG8_WAIT_V(8); PG8_WAIT_L(0); PG8_BAR; PG8_MMA(0, 0, At, B0); PG8_MMA(0, 1, At, B1); PG8_BAR; PG8_SCHED;
            PG8_LDA(At, 1, 1); PG8_STAGE(PG8_SB(1, 0), b3, voffB); PG8_STAGE(PG8_SB(1, 1), b3 + hstep, voffB); PG8_STAGE(PG8_SA(1, 0), a3, v2[0]);
            PG8_WAIT_V(8); PG8_WAIT_L(0); PG8_BAR; PG8_MMA(1, 0, At, B0); PG8_MMA(1, 1, At, B1); PG8_BAR; PG8_SCHED;
            } else {
            PG8_LDB(B0, 0, 0); PG8_SCHED; PG8_LDA(At, 0, 0); PG8_STAGE(PG8_SA(1, 1), a1, vA[1]);
            PG8_WAIT_L(8); PG8_BAR; PG8_WAIT_L(0); PG8_MMA(0, 0, At, B0); PG8_BAR; PG8_SCHED;
            PG8_LDB(B1, 0, 1); PG8_STAGE(PG8_SB(0, 0), b2, voffB);
            PG8_BAR; PG8_WAIT_L(0); PG8_MMA(0, 1, At, B1); PG8_BAR;
            PG8_LDA(At, 0, 1); PG8_STAGE(PG8_SA(0, 0), a2, v2[0]);
            PG8_BAR; PG8_WAIT_L(0); PG8_MMA(1, 0, At, B0); PG8_BAR; PG8_SCHED;
            PG8_STAGE(PG8_SB(0, 1), b2 + hstep, voffB);
            PG8_WAIT_V(6); PG8_BAR; PG8_MMA(1, 1, At, B1); PG8_BAR;
            PG8_LDB(B0, 1, 0); PG8_SCHED; PG8_LDA(At, 1, 0); PG8_STAGE(PG8_SA(0, 1), a2, v2[1]);
            PG8_WAIT_L(8); PG8_BAR; PG8_WAIT_L(0); PG8_MMA(0, 0, At, B0); PG8_BAR; PG8_SCHED;
            PG8_LDB(B1, 1, 1); PG8_STAGE(PG8_SB(1, 0), b3, voffB);
            PG8_BAR; PG8_WAIT_L(0); PG8_MMA(0, 1, At, B1); PG8_BAR;
            PG8_LDA(At, 1, 1); PG8_STAGE(PG8_SA(1, 0), a3, v2[0]);
            PG8_BAR; PG8_WAIT_L(0); PG8_MMA(1, 0, At, B0); PG8_BAR; PG8_SCHED;
            PG8_STAGE(PG8_SB(1, 1), b3 + hstep, voffB);
            PG8_WAIT_V(6); PG8_BAR; PG8_MMA(1, 1, At, B1); PG8_BAR;
            }
        }
        if constexpr (ALIGN_EPI) { if (wr == 0) PG8_BAR; }
        E(acc, cur, wr, wc, fr, fq);
        if (!has_next) break;
#pragma unroll
        for (int a = 0; a < 2; ++a)
#pragma unroll
            for (int b = 0; b < 2; ++b)
#pragma unroll
                for (int m = 0; m < 4; ++m)
#pragma unroll
                    for (int n = 0; n < 2; ++n) acc[a][b][m][n] = (f32x4){0.f, 0.f, 0.f, 0.f};
        cur = nxt; cA = nA; cB = nB; ++ui;
        if constexpr (GATHER) {
#pragma unroll
            for (int h = 0; h < 2; ++h)
#pragma unroll
                for (int i = 0; i < 2; ++i) vA[h][i] = vAn[h][i]; }
        if constexpr (ALIGN_EPI) { if (wr == 1) PG8_BAR; }
    }
    PG8_WAIT_V(0);
    if constexpr (!ALIGN_EPI) { if (wr == 0) PG8_BAR; }
    PG8_BAR;
#undef PG8_SA
#undef PG8_SB
#undef PG8_STAGE
#undef PG8_LDA
#undef PG8_LDB
#undef PG8_MMA
#undef PG8_WAIT_V
#undef PG8_WAIT_L
#undef PG8_BAR
#undef PG8_SCHED
#undef PG8_SETV
}

struct EpiInproj {
    static constexpr bool PERM = true;
    unsigned char* ws;
    __device__ __forceinline__ void operator()(const f32x4 (&acc)[2][2][4][2], const Unit& u, int wr, int wc, int fr, int fq) const {
        unsigned char* wsb = ws; asm volatile("" : "+v"(wsb));
        bf16* QVO = (bf16*)(wsb + WS_QS); bf16* ZG = (bf16*)(wsb + WS_ZG); float* LOGF = (float*)(wsb + WS_LOGF); const float* LB = (const float*)(wsb + WS_SMALL + SM_LB);
        const int row0 = u.pm * BM + wr * 64 + fr, seg = u.pn >> 1, cin = (u.pn & 1) * 256 + wc * 32 + 8 * fq;
        if (seg == 1) {
            f32x4 lb[2][2];
#pragma unroll
            for (int bj = 0; bj < 2; ++bj)
#pragma unroll
                for (int n = 0; n < 2; ++n) lb[bj][n] = *(const f32x4*)(LB + cin + bj * HALF + 4 * n);
#pragma unroll
            for (int ai = 0; ai < 2; ++ai)
#pragma unroll
                for (int m = 0; m < 4; ++m) { float* rowp = LOGF + (size_t)(row0 + ai * HALF + m * 16) * 512 + cin;
#pragma unroll
                    for (int bj = 0; bj < 2; ++bj)
#pragma unroll
                        for (int n = 0; n < 2; ++n) { f32x4 o;
#pragma unroll
                            for (int j = 0; j < 4; ++j) { const float l = lb[bj][n][j]; o[j] = __logf(l + (1.f - l) * fast_sigmoid(acc[ai][bj][m][n][j])); }
                            *(f32x4*)(rowp + bj * HALF + 4 * n) = o; } }
            return;
        }
        if (seg >= 4) {
            const int cz = (u.pn - 8) * 256 + wc * 32 + 8 * fq;
#pragma unroll
            for (int ai = 0; ai < 2; ++ai)
#pragma unroll
                for (int m = 0; m < 4; ++m) { bf16* rowp = ZG + (size_t)(row0 + ai * HALF + m * 16) * 1024 + cz;
#pragma unroll
                    for (int bj = 0; bj < 2; ++bj) { const f32x4 v0 = acc[ai][bj][m][0], v1 = acc[ai][bj][m][1];
                        const f32x2 a = gelu_pk((f32x2){v0[0], v0[1]}), b = gelu_pk((f32x2){v0[2], v0[3]}), c = gelu_pk((f32x2){v1[0], v1[1]}), d = gelu_pk((f32x2){v1[2], v1[3]});
                        u32x4 w; w.x = cvt_pk_bf16(a.x, a.y); w.y = cvt_pk_bf16(b.x, b.y); w.z = cvt_pk_bf16(c.x, c.y); w.w = cvt_pk_bf16(d.x, d.y);
                        *(u32x4*)(rowp + bj * HALF) = w; } }
            return;
        }
        bf16* base = QVO + (size_t)(seg == 0 ? 0 : seg - 1) * (8u << 20); const bool act = seg != 2;
#pragma unroll
        for (int ai = 0; ai < 2; ++ai)
#pragma unroll
            for (int m = 0; m < 4; ++m) { bf16* rowp = base + (size_t)(row0 + ai * HALF + m * 16) * 512 + cin;
#pragma unroll
                for (int bj = 0; bj < 2; ++bj) { f32x4 v0 = acc[ai][bj][m][0], v1 = acc[ai][bj][m][1];
                    if (act) {
#pragma unroll
                        for (int j = 0; j < 4; ++j) { v0[j] = v0[j] * fast_sigmoid(v0[j]); v1[j] = v1[j] * fast_sigmoid(v1[j]); } }
                    u32x4 w; w.x = cvt_pk_bf16(v0[0], v0[1]); w.y = cvt_pk_bf16(v0[2], v0[3]); w.z = cvt_pk_bf16(v1[0], v1[1]); w.w = cvt_pk_bf16(v1[2], v1[3]);
                    *(u32x4*)(rowp + bj * HALF) = w; } }
    }
};
struct EpiBf16 {
    static constexpr bool PERM = true;
    unsigned char* ws; size_t off; int ldc;
    __device__ __forceinline__ void operator()(const f32x4 (&acc)[2][2][4][2], const Unit& u, int wr, int wc, int fr, int fq) const {
        unsigned char* wsb = ws; asm volatile("" : "+v"(wsb)); bf16* O = (bf16*)(wsb + off);
        const int row0 = u.pm * BM + wr * 64 + fr, col0 = u.pn * BM + wc * 32 + 8 * fq;
#pragma unroll
        for (int ai = 0; ai < 2; ++ai)
#pragma unroll
            for (int m = 0; m < 4; ++m) { bf16* rowp = O + (size_t)(row0 + ai * HALF + m * 16) * ldc + col0;
#pragma unroll
                for (int bj = 0; bj < 2; ++bj) { const f32x4 v0 = acc[ai][bj][m][0], v1 = acc[ai][bj][m][1];
                    u32x4 w; w.x = cvt_pk_bf16(v0[0], v0[1]); w.y = cvt_pk_bf16(v0[2], v0[3]); w.z = cvt_pk_bf16(v1[0], v1[1]); w.w = cvt_pk_bf16(v1[2], v1[3]);
                    *(u32x4*)(rowp + bj * HALF) = w; } }
    }
};
struct EpiUp {
    static constexpr bool PERM = true;
    unsigned char* ws;
    __device__ __forceinline__ void operator()(const f32x4 (&acc)[2][2][4][2], const Unit& u, int wr, int wc, int fr, int fq) const {
        unsigned char* wsb = ws; asm volatile("" : "+v"(wsb)); bf16* ACT = (bf16*)(wsb + WS_ACT);
        const int row0 = u.pm * BM + wr * 64 + fr, col0 = u.pn * HALF + wc * 32 + 8 * fq;
#pragma unroll
        for (int ai = 0; ai < 2; ++ai)
#pragma unroll
            for (int m = 0; m < 4; ++m) { bf16* rowp = ACT + (size_t)(row0 + ai * HALF + m * 16) * HID + col0;
                f32x4 o0, o1;
#pragma unroll
                for (int j = 0; j < 4; ++j) { const float g0 = acc[ai][0][m][0][j], g1 = acc[ai][0][m][1][j]; o0[j] = g0 * fast_sigmoid(g0) * acc[ai][1][m][0][j]; o1[j] = g1 * fast_sigmoid(g1) * acc[ai][1][m][1][j]; }
                u32x4 w; w.x = cvt_pk_bf16(o0[0], o0[1]); w.y = cvt_pk_bf16(o0[2], o0[3]); w.z = cvt_pk_bf16(o1[0], o1[1]); w.w = cvt_pk_bf16(o1[2], o1[3]);
                *(u32x4*)rowp = w; }
    }
};
struct EpiDown {
    static constexpr bool PERM = true;
    unsigned char* ws;
    __device__ __forceinline__ void operator()(const f32x4 (&acc)[2][2][4][2], const Unit& u, int wr, int wc, int fr, int fq) const {
        unsigned char* wsb = ws; asm volatile("" : "+v"(wsb)); bf16* Y2 = (bf16*)(wsb + WS_Y2); const float* WL = (const float*)(wsb + WS_WLIST);
        const int rt0 = wr * 64 + fr, col0 = u.pn * BM + wc * 32 + 8 * fq;
#pragma unroll
        for (int ai = 0; ai < 2; ++ai)
#pragma unroll
            for (int m = 0; m < 4; ++m) { const int rt = rt0 + ai * HALF + m * 16; const float w8 = rt < u.nvalid ? WL[(size_t)u.e * T + u.r0 + rt] : 0.f;
                bf16* rowp = Y2 + (size_t)(u.pm * BM + rt) * D + col0;
#pragma unroll
                for (int bj = 0; bj < 2; ++bj) { const f32x4 v0 = acc[ai][bj][m][0] * w8, v1 = acc[ai][bj][m][1] * w8;
                    u32x4 w; w.x = cvt_pk_bf16(v0[0], v0[1]); w.y = cvt_pk_bf16(v0[2], v0[3]); w.z = cvt_pk_bf16(v1[0], v1[1]); w.w = cvt_pk_bf16(v1[2], v1[3]);
                    *(u32x4*)(rowp + bj * HALF) = w; } }
    }
};
}


__device__ __forceinline__ f32x4 mma16(bf16x8 a, bf16x8 b, f32x4 c) { return __builtin_amdgcn_mfma_f32_16x16x32_bf16(a, b, c, 0, 0, 0); }
__device__ __forceinline__ bf16x8 frag(const LAS bf16* X, int stride, int rb, int ks, int lane) { return *(const LAS bf16x8*)(X + (rb * 16 + (lane & 15)) * stride + ks * 32 + 8 * (lane >> 4)); }
constexpr int MX_QD = 0, MX_KD = 17408, MX_KDT = 34816, MX_VT = 53248, MX_PT = 71680, MX_STT = 80896, MX_SMALL = 115712;
constexpr int SD = 136, SS = 72, SO = 132;
template <int MODE> __device__ __forceinline__ void hgrn_item(const int swave, const P& p, LAS unsigned char* lds, int item) {
    const int tid = otid(swave), lane = tid & 63, w = __builtin_amdgcn_readfirstlane(tid >> 6), q4 = lane >> 4, r16 = lane & 15;
    const int bh = item >> 5, sc = item & 31, b = bh >> 2, h = bh & 3;
    const size_t row0 = (size_t)b * SEQ + (size_t)sc * 256;
    LAS bf16* QD = (LAS bf16*)(lds + MX_QD); LAS bf16* KD = (LAS bf16*)(lds + MX_KD); LAS bf16* KDT = (LAS bf16*)(lds + MX_KDT); LAS bf16* VT = (LAS bf16*)(lds + MX_VT);
    LAS bf16* PT = (LAS bf16*)(lds + MX_PT); LAS bf16* STT = (LAS bf16*)(lds + MX_STT); LAS float* O = (LAS float*)(lds + MX_QD);
    LAS float* tot = (LAS float*)(lds + MX_SMALL); LAS float* ecm = tot + 512; LAS float* elast = ecm + 128; LAS float* efac = elast + 128;
    const bf16* QS = WSP(bf16, WS_QS); const float* LF = WSP(float, WS_LOGF); const bf16* VV = WSP(bf16, WS_V); const bf16* OG = WSP(bf16, WS_OG); bf16* YC = WSP(bf16, WS_B);
    const int col = tid & 127, g = tid >> 7;
    f32x4 S[8];
#pragma unroll
    for (int db = 0; db < 8; ++db) {
        if (MODE == 1) {
#pragma unroll
            for (int r = 0; r < 4; ++r) S[db][r] = WSP(float, WS_SSTART)[(size_t)item * 16384 + (16 * w + 4 * q4 + r) * 128 + 16 * db + r16];
        } else S[db] = (f32x4){0.f, 0.f, 0.f, 0.f}; }
    float lastsum = 0.f;
    float lf[16]; bf16 qv[16], vv[16];
#define HG_LOAD(c_) do { const size_t rowc_ = row0 + 64 * (c_) + 16 * g; _Pragma("unroll") for (int i = 0; i < 16; ++i) { const size_t o = (rowc_ + i) * 512 + h * 128 + col; lf[i] = LF[o]; vv[i] = VV[o]; qv[i] = MODE == 1 ? QS[o] : (bf16)0; } } while (0)
    HG_LOAD(0);
#pragma unroll 1
    for (int c = 0; c < 4; ++c) {
        float run = 0.f;
#pragma unroll
        for (int i = 0; i < 16; ++i) { run += lf[i]; }
        tot[g * 128 + col] = run;
        __syncthreads();
        const float t0 = tot[col], t1 = tot[128 + col], t2 = tot[256 + col], t3 = tot[384 + col];
        const float cstart = g == 0 ? 0.f : (g == 1 ? t0 : (g == 2 ? t0 + t1 : t0 + t1 + t2));
        const float cmid = t0 + t1, last = (t0 + t1) + (t2 + t3);
        if (g == 0) { ecm[col] = __expf(cmid); elast[col] = __expf(last); efac[col] = __expf(last - cmid); lastsum += last; }
        {
            float cum = cstart; unsigned kt[8], vt[8];
#pragma unroll
            for (int i = 0; i < 16; i += 2) {
                float kd2[2];
#pragma unroll
                for (int j = 0; j < 2; ++j) { cum += lf[i + j]; const float kk = 1.f - __expf(lf[i + j]); const float ek = __expf(fminf(cmid - cum, 80.f)); kd2[j] = kk * ek;
                    const bf16 kb = f2bf(kd2[j]);
                    if (MODE == 1) { const float eq = __expf(fminf(cum - cmid, 80.f)); QD[(16 * g + i + j) * SD + col] = f2bf(bf2f(qv[i + j]) * eq); KD[(16 * g + i + j) * SD + col] = kb; } }
                kt[i >> 1] = cvt_pk_bf16(kd2[0], kd2[1]); vt[i >> 1] = (unsigned)vv[i] | ((unsigned)vv[i + 1] << 16);
            }
            *(LAS u32x4*)(KDT + col * SS + 16 * g) = (u32x4){kt[0], kt[1], kt[2], kt[3]}; *(LAS u32x4*)(KDT + col * SS + 16 * g + 8) = (u32x4){kt[4], kt[5], kt[6], kt[7]};
            *(LAS u32x4*)(VT + col * SS + 16 * g) = (u32x4){vt[0], vt[1], vt[2], vt[3]}; *(LAS u32x4*)(VT + col * SS + 16 * g + 8) = (u32x4){vt[4], vt[5], vt[6], vt[7]};
        }
        __syncthreads();
        if (c < 3) HG_LOAD(c + 1);
        f32x4 o[4]; const int tb = w & 3, vb0 = (w >> 2) * 4;
        if (MODE == 1) {
#pragma unroll
            for (int db = 0; db < 8; ++db) { const float e = ecm[16 * db + r16];
#pragma unroll
                for (int r = 0; r < 4; ++r) STT[(16 * w + 4 * q4 + r) * SD + 16 * db + r16] = f2bf(S[db][r] * e); }
#pragma unroll
            for (int k = 0; k < 2; ++k) { const int tile = w + 8 * k, stb = tile >> 2, ssb = tile & 3; f32x4 a = (f32x4){0.f, 0.f, 0.f, 0.f};
                if (ssb <= stb) {
#pragma unroll
                    for (int ks = 0; ks < 4; ++ks) a = mma16(frag(QD, SD, stb, ks, lane), frag(KD, SD, ssb, ks, lane), a); }
#pragma unroll
                for (int r = 0; r < 4; ++r) { const int t = stb * 16 + 4 * q4 + r, s_ = ssb * 16 + r16; PT[t * SS + s_] = (s_ <= t) ? f2bf(a[r]) : (bf16)0; } }
            __syncthreads();
            bf16x8 ap[2], aq[4];
#pragma unroll
            for (int ks = 0; ks < 2; ++ks) ap[ks] = frag(PT, SS, tb, ks, lane);
#pragma unroll
            for (int ks = 0; ks < 4; ++ks) aq[ks] = frag(QD, SD, tb, ks, lane);
#pragma unroll
            for (int j = 0; j < 4; ++j) { f32x4 a = (f32x4){0.f, 0.f, 0.f, 0.f};
#pragma unroll
                for (int ks = 0; ks < 2; ++ks) a = mma16(ap[ks], frag(VT, SS, vb0 + j, ks, lane), a);
#pragma unroll
                for (int ks = 0; ks < 4; ++ks) a = mma16(aq[ks], frag(STT, SD, vb0 + j, ks, lane), a);
                o[j] = a; }
        }
        {
            bf16x8 av[2];
#pragma unroll
            for (int ks = 0; ks < 2; ++ks) av[ks] = frag(VT, SS, w, ks, lane);
#pragma unroll
            for (int db = 0; db < 8; ++db) { f32x4 u = (f32x4){0.f, 0.f, 0.f, 0.f};
#pragma unroll
                for (int ks = 0; ks < 2; ++ks) u = mma16(av[ks], frag(KDT, SS, db, ks, lane), u);
                const float el = elast[16 * db + r16], ef = efac[16 * db + r16];
                S[db] = S[db] * el + u * ef; }
        }
        if (MODE == 1) {
            __syncthreads();
#pragma unroll
            for (int j = 0; j < 4; ++j)
#pragma unroll
                for (int r = 0; r < 4; ++r) O[(tb * 16 + 4 * q4 + r) * SO + (vb0 + j) * 16 + r16] = o[j][r];
            __syncthreads();
            const f32x2 gw = *(const f32x2*)(p.hg_norm_w + 2 * lane);
#pragma unroll
            for (int rr = 0; rr < 8; ++rr) { const int t = 8 * w + rr; const size_t row = row0 + 64 * c + t;
                const f32x2 ov = *(const LAS f32x2*)(O + t * SO + 2 * lane);
                const float ss = wave_sum_dpp(ov.x * ov.x + ov.y * ov.y); const float rs = rsqrtf(ss * (1.f / 128.f) + RMS_EPS);
                const unsigned ogp = *(const unsigned*)(OG + row * 512 + h * 128 + 2 * lane);
                const float y0 = ov.x * rs * gw.x * __uint_as_float(ogp << 16), y1 = ov.y * rs * gw.y * __uint_as_float(ogp & 0xffff0000u);
                *(unsigned*)(YC + row * D + h * 128 + 2 * lane) = cvt_pk_bf16(y0, y1); }
        }
    }
    if (MODE == 0) {
#pragma unroll
        for (int db = 0; db < 8; ++db)
#pragma unroll
            for (int r = 0; r < 4; ++r) WSP(float, WS_SLOC)[(size_t)item * 16384 + (16 * w + 4 * q4 + r) * 128 + 16 * db + r16] = S[db][r];
        if (g == 0) WSP(float, WS_SMALL + SM_DTOT)[item * 128 + col] = __expf(lastsum);
    }
    __syncthreads();
#undef HG_LOAD
}
__device__ __forceinline__ void hgrn_scan(const P& p, int gid) {
    const int bh = gid >> 14, idx = gid & 16383, d = idx & 127;
    const float* SL = WSP(float, WS_SLOC) + (size_t)bh * 32 * 16384 + idx; float* ST = WSP(float, WS_SSTART) + (size_t)bh * 32 * 16384 + idx; const float* DT = WSP(float, WS_SMALL + SM_DTOT) + bh * 32 * 128 + d;
    float s = 0.f;
#pragma unroll 8
    for (int sc = 0; sc < 32; ++sc) { ST[(size_t)sc * 16384] = s; s = s * DT[sc * 128] + SL[(size_t)sc * 16384]; }
}
__device__ __forceinline__ void sg_item(const int swave, const P& p, LAS unsigned char* lds, int item) {
    const int tid = otid(swave), lane = tid & 63, w = __builtin_amdgcn_readfirstlane(tid >> 6), q4 = lane >> 4, r16 = lane & 15;
    const int b = item >> 8, n = (item >> 2) & 63, g = item & 3; const size_t row0 = (size_t)b * SEQ + (size_t)n * 128;
    LAS bf16* VNT = (LAS bf16*)lds; LAS bf16* WT = (LAS bf16*)(lds + 34816); LAS float* mean = (LAS float*)(lds + 69632); LAS float* rstd = mean + 128; LAS float* OM = (LAS float*)(lds + 71680);
    const bf16* ZG = WSP(bf16, WS_ZG); bf16* YC = WSP(bf16, WS_B);
    {
        bf16x8 z[16];
#pragma unroll
        for (int rr = 0; rr < 16; ++rr) z[rr] = ldg<bf16x8>(ZG + (row0 + 16 * w + rr) * 1024 + 512, (unsigned)lane * 16u);
#pragma unroll
        for (int rr = 0; rr < 16; ++rr) { float s1 = 0.f, s2 = 0.f;
#pragma unroll
            for (int j = 0; j < 8; ++j) { const float v = bf2f((bf16)z[rr][j]); s1 += v; s2 += v * v; }
            const float m = wave_sum_dpp(s1) * (1.f / 512.f); const float var = fmaxf(wave_sum_dpp(s2) * (1.f / 512.f) - m * m, 0.f);
            if (lane == 0) { mean[16 * w + rr] = m; rstd[16 * w + rr] = rsqrtf(var + LN_EPS); } }
    }
    {
        const int t = tid >> 2, seg = tid & 3; const float* wr = p.sg_w + ((size_t)(g * 128 + t)) * 128 + seg * 32;
#pragma unroll
        for (int j = 0; j < 4; ++j) { const f32x4 a = *(const f32x4*)(wr + 8 * j), c = *(const f32x4*)(wr + 8 * j + 4); const int s0 = seg * 32 + 8 * j; u32x4 o;
            o.x = cvt_pk_bf16(s0 + 0 <= t ? a[0] : 0.f, s0 + 1 <= t ? a[1] : 0.f); o.y = cvt_pk_bf16(s0 + 2 <= t ? a[2] : 0.f, s0 + 3 <= t ? a[3] : 0.f);
            o.z = cvt_pk_bf16(s0 + 4 <= t ? c[0] : 0.f, s0 + 5 <= t ? c[1] : 0.f); o.w = cvt_pk_bf16(s0 + 6 <= t ? c[2] : 0.f, s0 + 7 <= t ? c[3] : 0.f);
            *(LAS u32x4*)(WT + t * SD + s0) = o; }
    }
    const int c = tid & 127, sgp = tid >> 7;
    bf16 zc[32];
#pragma unroll
    for (int i = 0; i < 32; ++i) zc[i] = ZG[(row0 + 32 * sgp + i) * 1024 + 512 + g * 128 + c];
    __syncthreads();
    {
        const float lg = p.sg_ln_g[g * 128 + c], lb = p.sg_ln_b[g * 128 + c];
#pragma unroll
        for (int i8 = 0; i8 < 4; ++i8) { float vn[8];
#pragma unroll
            for (int j = 0; j < 8; ++j) { const int s_ = 32 * sgp + 8 * i8 + j; vn[j] = (bf2f(zc[8 * i8 + j]) - mean[s_]) * rstd[s_] * lg + lb; }
            *(LAS u32x4*)(VNT + c * SD + 32 * sgp + 8 * i8) = (u32x4){cvt_pk_bf16(vn[0], vn[1]), cvt_pk_bf16(vn[2], vn[3]), cvt_pk_bf16(vn[4], vn[5]), cvt_pk_bf16(vn[6], vn[7])}; }
    }
    __syncthreads();
    bf16x8 aw[4];
#pragma unroll
    for (int ks = 0; ks < 4; ++ks) aw[ks] = frag(WT, SD, w, ks, lane);
#pragma unroll
    for (int cb = 0; cb < 8; ++cb) { f32x4 a = (f32x4){0.f, 0.f, 0.f, 0.f};
#pragma unroll
        for (int ks = 0; ks < 4; ++ks) a = mma16(aw[ks], frag(VNT, SD, cb, ks, lane), a);
#pragma unroll
        for (int r = 0; r < 4; ++r) OM[(16 * w + 4 * q4 + r) * SO + 16 * cb + r16] = a[r]; }
    __syncthreads();
    {
        const int t = tid >> 2, cs = (tid & 3) * 32; const float sb = p.sg_b[g * 128 + t];
        const bf16* up = ZG + (row0 + t) * 1024 + g * 128 + cs; bf16* op = YC + (row0 + t) * D + 512 + g * 128 + cs;
#pragma unroll
        for (int k = 0; k < 4; ++k) { const u32x4 uu = *(const u32x4*)(up + 8 * k); const f32x4 m0 = *(const LAS f32x4*)(OM + t * SO + cs + 8 * k), m1 = *(const LAS f32x4*)(OM + t * SO + cs + 8 * k + 4);
            u32x4 o;
            o.x = cvt_pk_bf16(__uint_as_float(uu.x << 16) * (m0[0] + sb), __uint_as_float(uu.x & 0xffff0000u) * (m0[1] + sb)); o.y = cvt_pk_bf16(__uint_as_float(uu.y << 16) * (m0[2] + sb), __uint_as_float(uu.y & 0xffff0000u) * (m0[3] + sb));
            o.z = cvt_pk_bf16(__uint_as_float(uu.z << 16) * (m1[0] + sb), __uint_as_float(uu.z & 0xffff0000u) * (m1[1] + sb)); o.w = cvt_pk_bf16(__uint_as_float(uu.w << 16) * (m1[2] + sb), __uint_as_float(uu.w & 0xffff0000u) * (m1[3] + sb));
            *(u32x4*)(op + 8 * k) = o; }
    }
    __syncthreads();
}

typedef GAS unsigned gu32;
#define XB_TMO      128
#define XB_XCNT(j)  (256  + 64 * (j))
#define XB_XSUB(j)  (1280 + 64 * (j))
#define XB_XGEN(j)  (2304 + 64 * (j))
#define XB_TOP      3328
#define XB_TOPGEN   3392
#define XCD_BAR_WORDS 3456
#define XB_SPIN_CAP (1u << 18)
__device__ __forceinline__ unsigned xb_ld(unsigned* p)              { return __hip_atomic_load(p, __ATOMIC_RELAXED, __HIP_MEMORY_SCOPE_AGENT); }
__device__ __forceinline__ unsigned xb_add(unsigned* p, unsigned v) { return __hip_atomic_fetch_add(p, v, __ATOMIC_RELAXED, __HIP_MEMORY_SCOPE_AGENT); }
__device__ __forceinline__ unsigned xb_xcc_id() { return (unsigned)__builtin_amdgcn_s_getreg((3 << 11) | 20) & 0xFu; }
#define XB_SPIN(cond, bar) do { unsigned _sp = 0; while (cond) { __builtin_amdgcn_s_sleep(1); \
    if ((++_sp & 255u) == 0u) { if (xb_ld(&(bar)[XB_TMO])) break; if (_sp > XB_SPIN_CAP) { atomicAdd(&(bar)[XB_TMO], 1u); break; } } } } while (0)
struct XcdBarrier { unsigned* bar; unsigned x; volatile LAS unsigned* st; };
__device__ __forceinline__ XcdBarrier xcd_barrier_post(const int swave, unsigned* bar, volatile LAS unsigned* st) {
    XcdBarrier b; b.bar = bar; b.x = xb_xcc_id(); b.st = st;
    if (otid(swave) == 0) (void)xb_add(&bar[XB_XCNT(b.x)], 1u);
    return b;
}
__device__ __forceinline__ void xcd_barrier_complete(unsigned* bar, unsigned x, unsigned& nloc, unsigned& nx) {
    const unsigned G = gridDim.x * gridDim.y * gridDim.z;
    unsigned sum, cnt, mine, sp = 0u;
    for (;;) {
        sum = 0u; cnt = 0u; mine = 0u;
#pragma unroll
        for (unsigned j = 0; j < 16; ++j) { const unsigned c = xb_ld(&bar[XB_XCNT(j)]); sum += c; cnt += (c > 0u) ? 1u : 0u; mine = (j == x) ? c : mine; }
        if (sum == G) break;
        __builtin_amdgcn_s_sleep(1);
        if ((++sp & 255u) == 0u) { if (xb_ld(&bar[XB_TMO])) break; if (sp > XB_SPIN_CAP) { atomicAdd(&bar[XB_TMO], 1u); break; } }
    }
    nloc = mine > 0u ? mine : 1u; nx = cnt > 0u ? cnt : 1u;
}
__device__ __forceinline__ void xcd_barrier(const int swave, const XcdBarrier& b) {
    asm volatile("s_waitcnt vmcnt(0)" ::: "memory");
    __syncthreads();
    if (otid(swave) == 0) {
        unsigned* bar = b.bar;
        __builtin_amdgcn_s_waitcnt(0);
        unsigned nloc = b.st[0], nx = b.st[1];
        if (nloc == 0u) { xcd_barrier_complete(bar, b.x, nloc, nx); b.st[0] = nloc; b.st[1] = nx; }
        const unsigned old = xb_add(&bar[XB_XSUB(b.x)], 1u);
        const unsigned gen = old / nloc;
        if (old + 1u == (gen + 1u) * nloc) {
            __builtin_amdgcn_fence(__ATOMIC_RELEASE, "agent");
            asm volatile("s_waitcnt vmcnt(0)" ::: "memory");
            const unsigned og = xb_add(&bar[XB_TOP], 1u);
            const unsigned tg = og / nx;
            if (og + 1u == (tg + 1u) * nx) xb_add(&bar[XB_TOPGEN], 1u);
            else XB_SPIN(xb_ld(&bar[XB_TOPGEN]) == tg, bar);
            __builtin_amdgcn_fence(__ATOMIC_ACQUIRE, "agent");
            xb_add(&bar[XB_XGEN(b.x)], 1u);
            asm volatile("s_waitcnt vmcnt(0)" ::: "memory");
        } else {
            XB_SPIN(xb_ld(&bar[XB_XGEN(b.x)]) == gen, bar);
            __builtin_amdgcn_fence(__ATOMIC_ACQUIRE, "agent");
            asm volatile("s_waitcnt vmcnt(0)" ::: "memory");
        }
    }
    __syncthreads();
}
constexpr int CW_BAR = 4096;

__device__ __forceinline__ unsigned pk2(float lo, float hi) { return (unsigned)f2bf(lo) | ((unsigned)f2bf(hi) << 16); }
__device__ __forceinline__ void transpose_item(const float* W, int K, int N, bf16* WT, int upmode, int item, int lane) {
    const int nblk = N / 64, kb = item / nblk, nb = item % nblk, k0 = 64 * kb, n = 64 * nb + lane;
    const float* src = W + (size_t)k0 * N + n;
    float r[64];
#pragma unroll
    for (int i = 0; i < 64; ++i) r[i] = src[(size_t)i * N];
    const int dn = upmode ? updst(n) : n;
    u32x4* dst = (u32x4*)(WT + (size_t)dn * K + k0);
#pragma unroll
    for (int j = 0; j < 8; ++j) { u32x4 o; o.x = cvt_pk_bf16(r[8 * j], r[8 * j + 1]); o.y = cvt_pk_bf16(r[8 * j + 2], r[8 * j + 3]); o.z = cvt_pk_bf16(r[8 * j + 4], r[8 * j + 5]); o.w = cvt_pk_bf16(r[8 * j + 6], r[8 * j + 7]); dst[j] = o; }
}
__device__ __forceinline__ void phase_prep(const int swave, const P& p, LAS unsigned char* lds, int bx, int G) {
    const int tid = otid(swave), lane = tid & 63, w = __builtin_amdgcn_readfirstlane(tid >> 6);
    if (bx < 192) {
        LAS float* sc = (LAS float*)lds; LAS float* red = sc + 2048;
        for (int i = tid; i < 2048; i += NTHR) sc[i] = silu_f(p.c[i]);
        __syncthreads();
        for (int cb = bx; cb < 192; cb += G) {
            const int kg = tid >> 5, cl = tid & 31, colj = cb * 32 + cl; float a0 = 0.f, a1 = 0.f;
            float wv[64];
#pragma unroll
            for (int i = 0; i < 64; ++i) wv[i] = p.w_ada[(size_t)(kg + 16 * i) * 6144 + colj];
#pragma unroll
            for (int i = 0; i < 64; ++i) { const int k = kg + 16 * i; a0 += sc[k] * wv[i]; a1 += sc[1024 + k] * wv[i]; }
            red[(kg * 32 + cl) * 2] = a0; red[(kg * 32 + cl) * 2 + 1] = a1;
            __syncthreads();
            if (tid < 64) { const int c2 = tid & 31, bb = tid >> 5; float t = 0.f;
#pragma unroll
                for (int k2 = 0; k2 < 16; ++k2) t += red[(k2 * 32 + c2) * 2 + bb];
                WSP(float, WS_SMALL + SM_ADA)[bb * 6144 + cb * 32 + c2] = t + p.b_ada[cb * 32 + c2]; }
            __syncthreads();
        }
    }
    if (bx == G - 1) { const float l0 = p.lb_logits[tid], l1 = p.lb_logits[512 + tid]; const float m = fmaxf(l0, l1); const float e0 = expf(l0 - m), e1 = expf(l1 - m);
        WSP(float, WS_SMALL + SM_LB)[tid] = e0 / (e0 + e1); }
    const int gw = bx * NWAVES + w, NGW = G * NWAVES;
    constexpr int I_IN = (D / 64) * (NIN / 64), I_OUT = (D / 64) * (D / 64), I_UP1 = (D / 64) * (1024 / 64), I_DN1 = (HID / 64) * (D / 64);
    constexpr int NITEMS = I_IN + I_OUT + NE * I_UP1 + NE * I_DN1;
#pragma unroll 1
    for (int it = gw; it < NITEMS; it += NGW) {
        int r = it;
        if (r < I_IN) { transpose_item(p.w_in, D, NIN, WSP(bf16, WS_WINT), 0, r, lane); continue; } r -= I_IN;
        if (r < I_OUT) { transpose_item(p.w_out, D, D, WSP(bf16, WS_WOUTT), 0, r, lane); continue; } r -= I_OUT;
        if (r < NE * I_UP1) { const int e = r / I_UP1; transpose_item(p.w_up + (size_t)e * D * 1024, D, 1024, WSP(bf16, WS_WUPT) + (size_t)e * D * 1024, 1, r % I_UP1, lane); continue; } r -= NE * I_UP1;
        { const int e = r / I_DN1; transpose_item(p.w_down + (size_t)e * HID * D, HID, D, WSP(bf16, WS_WDNT) + (size_t)e * HID * D, 0, r % I_DN1, lane); }
    }
}
__device__ __forceinline__ void phase_xmod(const int swave, const P& p, int bx, int G) {
    const int lane = otid(swave) & 63, gw = bx * NWAVES + (otid(swave) >> 6), NGW = G * NWAVES;
    for (int row = gw; row < T; row += NGW) { const float* ada = WSP(float, WS_SMALL + SM_ADA) + (row >> 13) * 6144;
#pragma unroll
        for (int j = 0; j < 4; ++j) { const int col = 256 * j + lane * 4; const f32x4 xv = *(const f32x4*)(p.x + (size_t)row * D + col), sh = *(const f32x4*)(ada + col), sc = *(const f32x4*)(ada + 1024 + col);
            u32x2 o; o.x = cvt_pk_bf16(xv[0] * (1.f + sc[0]) + sh[0], xv[1] * (1.f + sc[1]) + sh[1]); o.y = cvt_pk_bf16(xv[2] * (1.f + sc[2]) + sh[2], xv[3] * (1.f + sc[3]) + sh[3]);
            *(u32x2*)(WSP(bf16, WS_B) + (size_t)row * D + col) = o; } }
}
__device__ __forceinline__ void route_load_weights(const int swave, const P& p, LAS float* WR) {
    for (int c = otid(swave); c < D; c += NTHR) { const f32x4 wg = *(const f32x4*)(p.rg_w + (size_t)c * 4);
#pragma unroll
        for (int g = 0; g < 4; ++g) { WR[g * D + c] = wg[g];
            const f32x4 w0 = *(const f32x4*)(p.re_w + ((size_t)g * D + c) * 8), w1 = *(const f32x4*)(p.re_w + ((size_t)g * D + c) * 8 + 4);
#pragma unroll
            for (int e = 0; e < 4; ++e) { WR[(4 + g * 8 + e) * D + c] = w0[e]; WR[(4 + g * 8 + 4 + e) * D + c] = w1[e]; } } }
}
__device__ __forceinline__ void route_load2(const P& p, int row, int lane, f32x4 (&x)[2][4], u32x2 (&y)[2][4]) {
    const unsigned l16 = (unsigned)lane * 16u, l8 = (unsigned)lane * 8u;
#pragma unroll
    for (int r = 0; r < 2; ++r) { const float* xr = p.x + (size_t)(row + r) * D; const bf16* yr = WSP(bf16, WS_Y) + (size_t)(row + r) * D;
#pragma unroll
        for (int j = 0; j < 4; ++j) { x[r][j] = ldg<f32x4>(xr + 256 * j, l16); y[r][j] = ldg<u32x2>(yr + 256 * j, l8); } }
}
__device__ __forceinline__ void route_topk(const P& p, const float (&lg)[36], LAS int* rt_e, LAS float* rt_w, int rl, int lane) {
    int gi = 0; float gm = lg[0];
#pragma unroll
    for (int g = 1; g < 4; ++g) if (lg[g] > gm) { gm = lg[g]; gi = g; }
    float gs = 0.f;
#pragma unroll
    for (int g = 0; g < 4; ++g) gs += expf(lg[g] - gm);
    const float pgroup = 1.f / gs;
    int j0 = 0, j1 = 0; float m0 = 0.f, m1 = 0.f;
#pragma unroll
    for (int g = 0; g < 4; ++g) {
        int a0 = 0; float b0 = lg[4 + 8 * g];
#pragma unroll
        for (int e = 1; e < 8; ++e) if (lg[4 + 8 * g + e] > b0) { b0 = lg[4 + 8 * g + e]; a0 = e; }
        int a1 = -1; float b1 = -3.0e38f;
#pragma unroll
        for (int e = 0; e < 8; ++e) if (e != a0 && lg[4 + 8 * g + e] > b1) { b1 = lg[4 + 8 * g + e]; a1 = e; }
        const bool sel = (g == gi); j0 = sel ? a0 : j0; j1 = sel ? a1 : j1; m0 = sel ? b0 : m0; m1 = sel ? b1 : m1;
    }
    const float r1 = expf(m1 - m0);
    if (lane == 0) { rt_e[2 * rl] = gi * 8 + j0; rt_e[2 * rl + 1] = gi * 8 + j1; rt_w[2 * rl] = pgroup / (1.f + r1); rt_w[2 * rl + 1] = pgroup * r1 / (1.f + r1); }
}
__device__ __forceinline__ void ln1_route_rows2(const P& p, const LAS float* WR, LAS int* rt_e, LAS float* rt_w, int row, int rl, int lane, const f32x4 (&x)[2][4], const u32x2 (&y)[2][4]) {
    const float* ada = WSP(float, WS_SMALL + SM_ADA) + (row >> 13) * 6144;
    const unsigned l16 = (unsigned)lane * 16u, l8 = (unsigned)lane * 8u;
    float v[2][16];
#pragma unroll
    for (int r = 0; r < 2; ++r) { float s = 0.f;
#pragma unroll
        for (int j = 0; j < 4; ++j) { const f32x4 g1 = ldg<f32x4>(ada + 2048 + 256 * j, l16);
            const float y0 = __uint_as_float(y[r][j].x << 16), y1 = __uint_as_float(y[r][j].x & 0xffff0000u), y2 = __uint_as_float(y[r][j].y << 16), y3 = __uint_as_float(y[r][j].y & 0xffff0000u);
            v[r][4 * j] = ALPHA * x[r][j][0] + (1.f + g1[0]) * y0; v[r][4 * j + 1] = ALPHA * x[r][j][1] + (1.f + g1[1]) * y1; v[r][4 * j + 2] = ALPHA * x[r][j][2] + (1.f + g1[2]) * y2; v[r][4 * j + 3] = ALPHA * x[r][j][3] + (1.f + g1[3]) * y3;
            s += (v[r][4 * j] + v[r][4 * j + 1]) + (v[r][4 * j + 2] + v[r][4 * j + 3]); }
        const float mean = wave_sum_dpp(s) * (1.f / D); float q = 0.f;
#pragma unroll
        for (int i = 0; i < 16; ++i) { v[r][i] -= mean; q += v[r][i] * v[r][i]; }
        const float rstd = rsqrtf(wave_sum_dpp(q) * (1.f / D) + LN_EPS);
        float* X1 = WSP(float, WS_X1) + (size_t)(row + r) * D; bf16* H2 = WSP(bf16, WS_B) + (size_t)(row + r) * D;
#pragma unroll
        for (int j = 0; j < 4; ++j) { const f32x4 gg = ldg<f32x4>(p.ln1_g + 256 * j, l16), bb = ldg<f32x4>(p.ln1_b + 256 * j, l16), sh = ldg<f32x4>(ada + 3072 + 256 * j, l16), sc = ldg<f32x4>(ada + 4096 + 256 * j, l16);
            f32x4 x1;
#pragma unroll
            for (int i = 0; i < 4; ++i) { x1[i] = v[r][4 * j + i] * rstd * gg[i] + bb[i]; v[r][4 * j + i] = x1[i] * (1.f + sc[i]) + sh[i]; }
            stg<f32x4>(X1 + 256 * j, l16, x1); u32x2 o; o.x = cvt_pk_bf16(v[r][4 * j], v[r][4 * j + 1]); o.y = cvt_pk_bf16(v[r][4 * j + 2], v[r][4 * j + 3]); stg<u32x2>(H2 + 256 * j, l8, o); }
    }
    __builtin_amdgcn_sched_barrier(0);
    float lg0[36], lg1[36];
    const LAS char* wp = (const LAS char*)WR + lane * 16;
#pragma unroll
    for (int o = 0; o < 36; ++o) { float a0 = 0.f, a1 = 0.f; asm volatile("" : "+v"(wp));
#pragma unroll
        for (int j = 0; j < 4; ++j) { const f32x4 wv = *(const LAS f32x4*)(wp + 1024 * j);
            a0 += (v[0][4 * j] * wv[0] + v[0][4 * j + 1] * wv[1]) + (v[0][4 * j + 2] * wv[2] + v[0][4 * j + 3] * wv[3]);
            a1 += (v[1][4 * j] * wv[0] + v[1][4 * j + 1] * wv[1]) + (v[1][4 * j + 2] * wv[2] + v[1][4 * j + 3] * wv[3]); }
        lg0[o] = a0; lg1[o] = a1; wp += 4096; if ((o % 6) == 5) __builtin_amdgcn_sched_barrier(0); }
#pragma unroll
    for (int o = 0; o < 36; ++o) { const float bias = o < 4 ? p.rg_b[o] : p.re_b[o - 4]; lg0[o] = wave_sum_dpp(lg0[o]) + bias; lg1[o] = wave_sum_dpp(lg1[o]) + bias; }
    route_topk(p, lg0, rt_e, rt_w, rl, lane);
    route_topk(p, lg1, rt_e, rt_w, rl + 1, lane);
}
__device__ __forceinline__ void route_assign(const int swave, const P& p, const LAS int* rt_e, const LAS float* rt_w, LAS int* rt_base, int rowbase) {
    const int lane = otid(swave);
    if (lane < 32) { int c = 0; for (int a = 0; a < 128; ++a) c += (rt_e[a] == lane) ? 1 : 0;
        rt_base[lane] = c ? (int)atomicAdd(WSP(unsigned, WS_CTL) + CW_CNT + lane, (unsigned)c) : 0; }
    asm volatile("s_waitcnt vmcnt(0) lgkmcnt(0)" ::: "memory");
    int* LIST = WSP(int, WS_LIST); float* WL = WSP(float, WS_WLIST); int* TE = WSP(int, WS_SMALL + SM_TOKE); int* TS = WSP(int, WS_SMALL + SM_TOKS);
#pragma unroll
    for (int k = 0; k < 2; ++k) { const int a = lane + 64 * k, e = rt_e[a]; int rank = 0; for (int a2 = 0; a2 < a; ++a2) rank += (rt_e[a2] == e) ? 1 : 0;
        const int slot = rt_base[e] + rank, row = rowbase + (a >> 1);
        LIST[e * T + slot] = row; WL[e * T + slot] = rt_w[a]; TE[row * 2 + (a & 1)] = e; TS[row * 2 + (a & 1)] = slot; }
}
__device__ __forceinline__ void final_row(const P& p, const LAS int* tstart, int row, int lane, float pscale, float pspike) {
    const int b = row >> 13;
    const float* ada = WSP(float, WS_SMALL + SM_ADA) + b * 6144;
    const int* TE = WSP(int, WS_SMALL + SM_TOKE); const int* TS = WSP(int, WS_SMALL + SM_TOKS);
    const size_t rA = (size_t)(tstart[TE[row * 2]] * 256 + TS[row * 2]), rB = (size_t)(tstart[TE[row * 2 + 1]] * 256 + TS[row * 2 + 1]);
    const bf16* ya = WSP(bf16, WS_Y2) + rA * D; const bf16* yb = WSP(bf16, WS_Y2) + rB * D; const float* X1 = WSP(float, WS_X1) + (size_t)row * D;
    float v[16]; float s = 0.f;
#pragma unroll
    for (int j = 0; j < 4; ++j) { const int col = 256 * j + lane * 4; const f32x4 xv = *(const f32x4*)(X1 + col), g2 = *(const f32x4*)(ada + 5120 + col);
        const u32x2 pa = *(const u32x2*)(ya + col), pb = *(const u32x2*)(yb + col);
        const float m0 = __uint_as_float(pa.x << 16) + __uint_as_float(pb.x << 16), m1 = __uint_as_float(pa.x & 0xffff0000u) + __uint_as_float(pb.x & 0xffff0000u);
        const float m2 = __uint_as_float(pa.y << 16) + __uint_as_float(pb.y << 16), m3 = __uint_as_float(pa.y & 0xffff0000u) + __uint_as_float(pb.y & 0xffff0000u);
        v[4 * j + 0] = ALPHA * xv[0] + (1.f + g2[0]) * m0; v[4 * j + 1] = ALPHA * xv[1] + (1.f + g2[1]) * m1; v[4 * j + 2] = ALPHA * xv[2] + (1.f + g2[2]) * m2; v[4 * j + 3] = ALPHA * xv[3] + (1.f + g2[3]) * m3;
        s += (v[4 * j] + v[4 * j + 1]) + (v[4 * j + 2] + v[4 * j + 3]); }
    const float mean = wave_sum(s) * (1.f / D); float q = 0.f;
#pragma unroll
    for (int i = 0; i < 16; ++i) { v[i] -= mean; q += v[i] * v[i]; }
    const float rstd = rsqrtf(wave_sum(q) * (1.f / D) + LN_EPS);
#pragma unroll
    for (int j = 0; j < 4; ++j) { const int col = 256 * j + lane * 4; const f32x4 gg = *(const f32x4*)(p.ln2_g + col), bb = *(const f32x4*)(p.ln2_b + col); f32x4 o;
#pragma unroll
        for (int i = 0; i < 4; ++i) o[i] = (v[4 * j + i] * rstd * gg[i] + bb[i]) * pscale;
        if (col == 0) o[0] += pspike;
        *(f32x4*)(p.out + (size_t)row * D + col) = o; }
}

enum { PH_PREP = 0, PH_XMOD, PH_INPROJ, PH_MIXA, PH_SCAN, PH_MIXC, PH_OUTPROJ, PH_LN1ROUTE, PH_UP, PH_DOWN, PH_FINAL, PH_N };
struct Args { P p; int ph_lo, ph_hi, li, pad; };

__device__ __forceinline__ void moe_tables(const int swave, const P& p, LAS unsigned char* lds) {
    LAS int* tstart = (LAS int*)(lds + LDSCTL_OFF) + LC_TSTART; LAS int* lcnt = (LAS int*)(lds + LDSCTL_OFF) + LC_CNT;
    if (otid(swave) == 0) { int acc = 0;
        for (int e = 0; e < NE; ++e) { const int c = (int)__hip_atomic_load(WSP(unsigned, WS_CTL) + CW_CNT + e, __ATOMIC_RELAXED, __HIP_MEMORY_SCOPE_AGENT); tstart[e] = acc; lcnt[e] = c; acc += (c + 255) >> 8; }
        tstart[NE] = acc; }
    __syncthreads();
}

__device__ __forceinline__ P load_p() {
    typedef const __attribute__((address_space(4))) unsigned long long CU64;
    CU64* a = (CU64*)__builtin_amdgcn_kernarg_segment_ptr(); asm volatile("" : "+s"(a));
    P p; unsigned long long* d = (unsigned long long*)&p;
#pragma unroll
    for (int i = 0; i < 24; ++i) d[i] = a[i];
    return p;
}
__global__ void __launch_bounds__(NTHR, 2) mk_fwd(Args args) {
    extern __shared__ __attribute__((aligned(16))) unsigned char lds_raw[];
    LAS unsigned char* lds = (LAS unsigned char*)lds_raw;
    const P& p = args.p;
    const int G = gridDim.x, bx = blockIdx.x;
    const int swave = __builtin_amdgcn_readfirstlane((int)threadIdx.x >> 6);
    const int lo = args.ph_lo, hi = args.ph_hi;
#ifndef PHASE_MASK
#define PHASE_MASK 0x7ff
#endif
#define IN(k) (((PHASE_MASK >> (k)) & 1) && lo <= (k) && (k) < hi)
#ifndef REP_PHASE
#define REP_PHASE -1
#define REP_N 0
#endif
#define NREP(k) ((k) == REP_PHASE ? REP_N : 0)
#ifdef PROBE_A
#define STAMP(k) do { if (otid(swave) == 0) { const unsigned long long t_ = __builtin_amdgcn_s_memrealtime(); __hip_atomic_store((unsigned long long*)(WSP(unsigned, WS_CTL) + 65536 + bx * 32) + (k), t_, __ATOMIC_RELAXED, __HIP_MEMORY_SCOPE_AGENT); } } while (0)
#else
#define STAMP(k) do { } while (0)
#endif
#define SEAM(k) do { if (rep_ == NREP(k)) { if (IN(k) && IN((k) + 1)) xcd_barrier(swave, bar); STAMP((k) + 1); } } while (0)
    for (int u = otid(swave); u < (LDS_BYTES - LDSCTL_OFF) / 4; u += NTHR) ((LAS unsigned*)(lds + LDSCTL_OFF))[u] = 0u;
    __syncthreads();
    XcdBarrier bar = xcd_barrier_post(swave, WSP(unsigned, WS_CTL) + CW_BAR + args.li * XCD_BAR_WORDS, (volatile LAS unsigned*)(lds + LDSCTL_OFF) + LC_BAR);
    { const P p = load_p(); STAMP(0); }
    if (IN(PH_PREP)) for (int rep_ = 0; rep_ <= NREP(PH_PREP); ++rep_) { if (rep_) xcd_barrier(swave, bar); asm volatile("; MARK PH_PREP"); const P p = load_p(); phase_prep(swave, p, lds, bx, G); SEAM(PH_PREP); }
    if (IN(PH_XMOD)) for (int rep_ = 0; rep_ <= NREP(PH_XMOD); ++rep_) { if (rep_) xcd_barrier(swave, bar); asm volatile("; MARK PH_XMOD"); const P p = load_p(); phase_xmod(swave, p, bx, G); SEAM(PH_XMOD); }
    if (IN(PH_INPROJ)) for (int rep_ = 0; rep_ <= NREP(PH_INPROJ); ++rep_) { if (rep_) xcd_barrier(swave, bar); asm volatile("; MARK PH_INPROJ"); const P p = load_p();
        pg8::Gemm g{WSP(bf16, WS_B), WSP(bf16, WS_WINT), D, 0, 0, nullptr}; pg8::StaticOrder S; S.init(T, NIN, G, bx);
        pg8::EpiInproj E{p.ws};
        pg8::gemm_phase<pg8::EpiInproj, pg8::StaticOrder, true, true, false>(swave, lds, g, S, E);
        SEAM(PH_INPROJ);
    }
    if (IN(PH_MIXA)) for (int rep_ = 0; rep_ <= NREP(PH_MIXA); ++rep_) { if (rep_) xcd_barrier(swave, bar); asm volatile("; MARK PH_MIXA"); const P p = load_p();
        for (int it = bx; it < 256 + 512; it += G) { if (it < 256) hgrn_item<0>(swave, p, lds, it); else sg_item(swave, p, lds, it - 256); }
        SEAM(PH_MIXA);
    }
    if (IN(PH_SCAN)) for (int rep_ = 0; rep_ <= NREP(PH_SCAN); ++rep_) { if (rep_) xcd_barrier(swave, bar); asm volatile("; MARK PH_SCAN"); const P p = load_p();
        for (int gid = bx * NTHR + otid(swave); gid < 8 * 16384; gid += G * NTHR) hgrn_scan(p, gid);
        SEAM(PH_SCAN);
    }
    if (IN(PH_MIXC)) for (int rep_ = 0; rep_ <= NREP(PH_MIXC); ++rep_) { if (rep_) xcd_barrier(swave, bar); asm volatile("; MARK PH_MIXC"); const P p = load_p();
        for (int it = bx; it < 256; it += G) hgrn_item<1>(swave, p, lds, it);
        SEAM(PH_MIXC);
    }
    if (IN(PH_OUTPROJ)) for (int rep_ = 0; rep_ <= NREP(PH_OUTPROJ); ++rep_) { if (rep_) xcd_barrier(swave, bar); asm volatile("; MARK PH_OUTPROJ"); const P p = load_p();
        pg8::Gemm g{WSP(bf16, WS_B), WSP(bf16, WS_WOUTT), D, 0, 0, nullptr}; pg8::StaticOrder S; S.init(T, D, G, bx);
        pg8::EpiBf16 E{p.ws, WS_Y, D};
        pg8::gemm_phase<pg8::EpiBf16, pg8::StaticOrder, true, true, false>(swave, lds, g, S, E);
        SEAM(PH_OUTPROJ);
    }
    if (IN(PH_LN1ROUTE)) for (int rep_ = 0; rep_ <= NREP(PH_LN1ROUTE); ++rep_) { if (rep_) xcd_barrier(swave, bar); asm volatile("; MARK PH_LN1ROUTE"); const P p = load_p();
        if (rep_) { if (bx == 0 && otid(swave) < 32) __hip_atomic_store(WSP(unsigned, WS_CTL) + CW_CNT + otid(swave), 0u, __ATOMIC_RELAXED, __HIP_MEMORY_SCOPE_AGENT); xcd_barrier(swave, bar); }
        const int lane = otid(swave) & 63, w = __builtin_amdgcn_readfirstlane(otid(swave) >> 6);
        LAS float* WR = (LAS float*)lds; LAS int* rt_e = (LAS int*)(lds + LDSCTL_OFF) + LC_RT; LAS float* rt_w = (LAS float*)(rt_e + 128); LAS int* rt_base = rt_e + 256;
        route_load_weights(swave, p, WR);
        __syncthreads();
        for (int rb = bx * 64; rb < T; rb += G * 64) {
            f32x4 xc[2][4]; u32x2 yc[2][4];
            route_load2(p, rb + 8 * w, lane, xc, yc);
#pragma unroll 1
            for (int pr = 0; pr < 4; ++pr) {
                f32x4 xn[2][4]; u32x2 yn[2][4];
                route_load2(p, rb + 8 * w + (pr < 3 ? 2 * pr + 2 : 2 * pr), lane, xn, yn);
                ln1_route_rows2(p, WR, rt_e, rt_w, rb + 8 * w + 2 * pr, 8 * w + 2 * pr, lane, xc, yc);
#pragma unroll
                for (int r = 0; r < 2; ++r)
#pragma unroll
                    for (int j = 0; j < 4; ++j) { xc[r][j] = xn[r][j]; yc[r][j] = yn[r][j]; }
            }
            __syncthreads();
            if (w == 0) route_assign(swave, p, rt_e, rt_w, rt_base, rb);
            __syncthreads();
        }
        SEAM(PH_LN1ROUTE);
    }
    if (IN(PH_UP)) for (int rep_ = 0; rep_ <= NREP(PH_UP); ++rep_) { if (rep_) xcd_barrier(swave, bar); asm volatile("; MARK PH_UP"); const P p = load_p();
        moe_tables(swave, p, lds);
        pg8::Gemm g{WSP(bf16, WS_B), WSP(bf16, WS_WUPT), D, 0, (size_t)1024 * D * 2, WSP(int, WS_LIST)};
        pg8::MoeOrder S{(const LAS int*)(lds + LDSCTL_OFF) + LC_TSTART, (const LAS int*)(lds + LDSCTL_OFF) + LC_CNT, G, bx, 4};
        pg8::EpiUp E{p.ws};
        pg8::gemm_phase<pg8::EpiUp, pg8::MoeOrder, true, true, true>(swave, lds, g, S, E);
        SEAM(PH_UP);
    }
    if (IN(PH_DOWN)) for (int rep_ = 0; rep_ <= NREP(PH_DOWN); ++rep_) { if (rep_) xcd_barrier(swave, bar); asm volatile("; MARK PH_DOWN"); const P p = load_p();
        moe_tables(swave, p, lds);
        pg8::Gemm g{WSP(bf16, WS_ACT), WSP(bf16, WS_WDNT), HID, 0, (size_t)1024 * HID * 2, nullptr};
        pg8::MoeOrder S{(const LAS int*)(lds + LDSCTL_OFF) + LC_TSTART, (const LAS int*)(lds + LDSCTL_OFF) + LC_CNT, G, bx, 4};
        pg8::EpiDown E{p.ws};
        pg8::gemm_phase<pg8::EpiDown, pg8::MoeOrder, true, true, false>(swave, lds, g, S, E);
        SEAM(PH_DOWN);
    }
    if (IN(PH_FINAL)) for (int rep_ = 0; rep_ <= NREP(PH_FINAL); ++rep_) { if (rep_) xcd_barrier(swave, bar); asm volatile("; MARK PH_FINAL"); const P p = load_p();
        moe_tables(swave, p, lds);
        const int lane = otid(swave) & 63, gw = bx * NWAVES + (otid(swave) >> 6), NGW = G * NWAVES;
        float pscale = 1.f, pspike = 0.f;
#ifdef PROBE_A
        { const unsigned long long* ts = (const unsigned long long*)(WSP(unsigned, WS_CTL) + 65536 + bx * 32);
          const unsigned long long a0 = __hip_atomic_load(ts + PROBE_A, __ATOMIC_RELAXED, __HIP_MEMORY_SCOPE_AGENT), a1 = __hip_atomic_load(ts + PROBE_A + 1, __ATOMIC_RELAXED, __HIP_MEMORY_SCOPE_AGENT);
          const unsigned long long b0 = __hip_atomic_load(ts + PROBE_B, __ATOMIC_RELAXED, __HIP_MEMORY_SCOPE_AGENT), b1 = __hip_atomic_load(ts + PROBE_B + 1, __ATOMIC_RELAXED, __HIP_MEMORY_SCOPE_AGENT);
          pscale = 1.f + sqrtf((float)(a1 - a0) * 1e-5f); pspike = (float)(b1 - b0) * 0.1f; }
#endif
#pragma unroll 1
        for (int row = gw; row < T; row += NGW) { asm volatile("" ::: "memory"); final_row(p, (const LAS int*)(lds + LDSCTL_OFF) + LC_TSTART, row, lane, pscale, row == 0 ? pspike : 0.f); }
    }
#undef SEAM
#undef IN
}

#ifndef NAIVE_MASK
#define NAIVE_MASK 0
#endif
#ifndef MK_SPLIT
#define MK_SPLIT 0
#endif
static void launch_mk(const P& p, int lo, int hi, int li, hipStream_t s) {
    Args a{}; a.p = p; a.ph_lo = lo; a.ph_hi = hi; a.li = li; a.pad = 0;
    hipLaunchKernelGGL(mk_fwd, dim3(256), dim3(NTHR), LDS_BYTES, s, a);
}
extern "C" void kernel_launch(void* const* d_in, const int* in_sizes, int n_in, void* d_out, int out_size, void* d_ws, size_t ws_size, hipStream_t stream) {
    if (n_in != 22 || ws_size < WS_END) { fprintf(stderr, "kernel_launch: unexpected n_in %d / ws %zu\n", n_in, ws_size); return; }
    static int inited = 0;
    if (!inited) { inited = 1;
        if (hipFuncSetAttribute((const void*)mk_fwd, hipFuncAttributeMaxDynamicSharedMemorySize, LDS_BYTES) != hipSuccess) fprintf(stderr, "kernel_launch: hipFuncSetAttribute failed\n"); }
    P p{};
    const float** f = (const float**)&p;
    for (int i = 0; i < 22; ++i) f[i] = (const float*)d_in[i];
    p.out = (float*)d_out; p.ws = (unsigned char*)d_ws;
    (void)hipMemsetAsync((char*)d_ws + WS_CTL, 0, 1 * MiB, stream);
    int li = 0;
    for (int k = 0; k < PH_N;) {
        int e = k + 1;
        if (!MK_SPLIT) while (e < PH_N && !((NAIVE_MASK >> e) & 1)) ++e;
        launch_mk(p, k, e, li++, stream);
        k = e;
    }
}
```

```cpp
#include <hip/hip_runtime.h>
#include <cstdio>
#include <cstdint>

typedef unsigned short bf16;
typedef float f32x4 __attribute__((ext_vector_type(4)));

constexpr int NB = 2, SEQ = 8192, D = 1024, T = NB * SEQ;
constexpr int NIN = 3072;
constexpr int NE = 32, HID = 512;
constexpr float ALPHA = 1.189207115002721f;
constexpr float LN_EPS = 1e-5f, RMS_EPS = 1e-6f;
constexpr int ROWS_PAD = 40960;

constexpr size_t MiB = 1u << 20;
constexpr size_t WS_CTL = 0;
constexpr size_t WS_SMALL = 1 * MiB;
constexpr size_t WS_LIST = 2 * MiB, WS_WLIST = 4 * MiB;
constexpr size_t WS_WINT = 6 * MiB, WS_WOUTT = 12 * MiB, WS_WUPT = 14 * MiB, WS_WDNT = 78 * MiB;
constexpr size_t WS_B = 110 * MiB;
constexpr size_t WS_QS = 142 * MiB, WS_V = 158 * MiB, WS_OG = 174 * MiB, WS_LOGF = 190 * MiB, WS_ZG = 222 * MiB;
constexpr size_t WS_Y = 142 * MiB, WS_ACT = 206 * MiB;
constexpr size_t WS_SLOC = 254 * MiB, WS_SSTART = 270 * MiB;
constexpr size_t WS_X1 = 286 * MiB, WS_Y2 = 350 * MiB, WS_END = 430 * MiB;
constexpr size_t SM_ADA = 0, SM_LB = 64 * 1024, SM_ROWBASE = 128 * 1024, SM_SGSTAT = 256 * 1024, SM_TOKE = 512 * 1024, SM_TOKS = 640 * 1024, SM_DTOT = 768 * 1024;
constexpr int CW_CNT = 1024;
constexpr int CW_ADA = 1088;

struct P {
    const float *x, *c, *w_ada, *b_ada, *w_in, *lb_logits, *hg_norm_w, *sg_ln_g, *sg_ln_b, *sg_w, *sg_b, *w_out, *ln1_g, *ln1_b,
        *rg_w, *rg_b, *re_w, *re_b, *w_up, *w_down, *ln2_g, *ln2_b;
    float* out; unsigned char* ws;
};

__device__ __forceinline__ float bf2f(bf16 b) { return __uint_as_float(((unsigned)b) << 16); }
__device__ __forceinline__ bf16 f2bf(float f) { unsigned u = __float_as_uint(f); return (bf16)((u + 0x7fffu + ((u >> 16) & 1u)) >> 16); }
__device__ __forceinline__ float silu_f(float x) { return x / (1.f + __expf(-x)); }
__device__ __forceinline__ float gelu_f(float x) { return 0.5f * x * (1.f + erff(x * 0.70710678118654752f)); }
__device__ __forceinline__ float wave_sum(float v) {
#pragma unroll
    for (int o = 1; o < 64; o <<= 1) v += __shfl_xor(v, o);
    return v;
}
#define WSP(type, off) ((type*)(p.ws + (off)))

__device__ __forceinline__ int updst(int n) { const int part = n >> 9, q = n & 511; return 256 * (q >> 7) + 128 * part + (q & 127); }

#define LAS __attribute__((address_space(3)))
#define GAS __attribute__((address_space(1)))
typedef short bf16x8 __attribute__((ext_vector_type(8)));
typedef unsigned u32x4 __attribute__((ext_vector_type(4)));
typedef unsigned u32x2 __attribute__((ext_vector_type(2)));
typedef float f32x2 __attribute__((ext_vector_type(2)));
constexpr int NWAVES = 8, NTHR = 512;
template <class Tv> __device__ __forceinline__ Tv ldg(const void* base, unsigned off) { return *(const Tv*)((const char*)base + off); }
template <class Tv> __device__ __forceinline__ void stg(void* base, unsigned off, Tv v) { *(Tv*)((char*)base + off) = v; }
#define DPP_ADD(v, ctrl, rmask) v += __int_as_float(__builtin_amdgcn_update_dpp(0, __float_as_int(v), ctrl, rmask, 0xF, false))
__device__ __forceinline__ float wave_sum_dpp(float v) {
    DPP_ADD(v, 0xB1, 0xF);
    DPP_ADD(v, 0x4E, 0xF);
    DPP_ADD(v, 0x141, 0xF);
    DPP_ADD(v, 0x140, 0xF);
    DPP_ADD(v, 0x142, 0xA);
    DPP_ADD(v, 0x143, 0xC);
    return __int_as_float(__builtin_amdgcn_readlane(__float_as_int(v), 63));
}
__device__ __forceinline__ int otid(int swave) { int l; asm volatile("v_mbcnt_lo_u32_b32 %0, -1, 0\n\tv_mbcnt_hi_u32_b32 %0, -1, %0" : "=v"(l)); return (swave << 6) | l; }
constexpr int RING_BYTES = 131072, LDSCTL_OFF = 147456, LDS_BYTES = 155648;
constexpr int LC_BAR = 0, LC_TSTART = 64  , LC_CNT = 128  , LC_RT = 256  , LC_LGS = 576  ;

__device__ __forceinline__ unsigned cvt_pk_bf16(float lo, float hi) { unsigned r; asm volatile("v_cvt_pk_bf16_f32 %0, %1, %2" : "=v"(r) : "v"(lo), "v"(hi)); return r; }
__device__ __forceinline__ float fast_sigmoid(float x) { return __builtin_amdgcn_rcpf(1.f + __expf(-x)); }
__device__ __forceinline__ f32x2 gelu_pk(f32x2 v) {
    const f32x2 av = __builtin_elementwise_abs(v), d = av * 0.2316418882f + 1.0f;
    f32x2 t; t.x = __builtin_amdgcn_rcpf(d.x); t.y = __builtin_amdgcn_rcpf(d.y);
    f32x2 q = t * 0.5307027145f + (-0.7265760135f); q = q * t + 0.7107068705f; q = q * t + (-0.142248368f); q = q * t + 0.127414796f; q = q * t;
    const f32x2 s = (v * v) * (-0.72134752044f);
    f32x2 e; e.x = __builtin_amdgcn_exp2f(s.x); e.y = __builtin_amdgcn_exp2f(s.y);
    const f32x2 m = v * (q * e), r = v - m;
    f32x2 o; o.x = v.x < 0.f ? m.x : r.x; o.y = v.y < 0.f ? m.y : r.y; return o;
}

namespace pg8 {
constexpr int BM = 256, BK = 64, HALF = 128, HTB = HALF * BK * 2, STAGE_BYTES = 8 * HTB, NXCD = 8, WGM = 8;
__host__ __device__ __forceinline__ int lds_byte(int r, int c) { const int st = (r >> 4) * 2 + (c >> 5), rr = r & 15, cc = c & 31, ob = rr * 64 + cc * 2; return st * 1024 + (ob ^ (((ob >> 9) & 1) << 5)); }
__host__ __device__ __forceinline__ void stage_rc(int b, int& R, int& C) { const int st = b / 1024, sb = b % 1024, swz = sb ^ (((sb >> 9) & 1) << 5); R = (st >> 1) * 16 + swz / 64; C = (st & 1) * 32 + (swz % 64) / 2; }
__host__ __device__ __forceinline__ int perm32(int rho) { const int n = rho >> 4, i = rho & 15; return 8 * (i >> 2) + 4 * n + (i & 3); }

struct Unit { int pm, pn, e, nvalid, r0, pad; };
struct Gemm { const bf16* A; const bf16* Bt; int K, pad; size_t bstride; const int* list; };

struct StaticOrder {
    int nM, nN, nwg, G, c;
    __device__ void init(int M, int N, int G_, int c_) { nM = M / BM; nN = N / BM; nwg = nM * nN; G = G_; c = c_; }
    __device__ bool next(int i, Unit& u) const {
        const long L = (long)i * G + c; if (L >= nwg) return false;
        int wgid = (int)L; { const int q = nwg / NXCD, r = nwg % NXCD, xcd = wgid % NXCD, off = wgid / NXCD; wgid = (xcd < r ? xcd * (q + 1) : r * (q + 1) + (xcd - r) * q) + off; }
        const int nig = WGM * nN, gid = wgid / nig, fm = gid * WGM, gsz = (nM - fm) < WGM ? (nM - fm) : WGM;
        u.pm = fm + ((wgid % nig) % gsz); u.pn = (wgid % nig) / gsz; u.e = 0; u.nvalid = 256; u.r0 = 0; u.pad = 0; return true;
    }
};
struct MoeOrder {
    const LAS int* tstart; const LAS int* cnt; int G, c, nN;
    __device__ bool next(int i, Unit& u) const {
        const int L = i * G + c, ntile = tstart[NE]; if (L >= ntile * nN) return false;
        const int tile = L / nN; u.pn = L % nN; u.pm = tile;
        int e = 0;
#pragma unroll 1
        for (int k = 1; k < NE; ++k) e = (tile >= tstart[k]) ? k : e;
        u.e = e; u.r0 = (tile - tstart[e]) * 256; const int left = cnt[e] - u.r0; u.nvalid = left < 256 ? left : 256; u.pad = 0; return true;
    }
};

#define PG8_LAS LAS
template <class Epi, class Sched, bool ALIGN_EPI, bool SP2, bool GATHER>
__device__ __forceinline__ void gemm_phase(const int swave, PG8_LAS unsigned char* lds, const Gemm g, const Sched& S, const Epi& E) {
    const int tid = otid(swave), wid = __builtin_amdgcn_readfirstlane(tid >> 6), lane = tid & 63, wr = wid >> 2, wc = wid & 3, fr = lane & 15, fq = lane >> 4;
    const int K = g.K, nt = K / BK;
    unsigned voffB[2], vA[2][2], vAn[2][2]; int RA[2], CA[2];
#pragma unroll
    for (int i = 0; i < 2; ++i) { int R, C; stage_rc(tid * 16 + i * 8192, R, C); const int Rb = Epi::PERM ? ((R & ~31) + perm32(R & 31)) : R; RA[i] = R; CA[i] = C;
        voffB[i] = (unsigned)(Rb * K + C) * 2u;
#pragma unroll
        for (int h = 0; h < 2; ++h) { vA[h][i] = (unsigned)((h * HALF + R) * K + C) * 2u; vAn[h][i] = vA[h][i]; } }
    const size_t kstep = (size_t)(BK * 2);
    const size_t hstep = (size_t)HALF * K * 2;
    const size_t tstep = 2 * hstep;
    const unsigned ldsw = (unsigned)wid * 1024u;
    const int aoff = lds_byte(wr * 64 + fr, fq * 8), boff = lds_byte(wc * 32 + fr, fq * 8);
#define PG8_SA(b, h) (((b) * 2 + (h)) * HTB)
#define PG8_SB(b, h) ((4 + (b) * 2 + (h)) * HTB)
#define PG8_STAGE(bufoff, gbase, voff) do { _Pragma("unroll") for (int _i = 0; _i < 2; ++_i) \
        __builtin_amdgcn_global_load_lds((const unsigned*)((const char*)(gbase) + (voff)[_i]), (PG8_LAS unsigned*)(lds + (bufoff) + ldsw + _i * 8192), 16, 0, 0); } while (0)
#define PG8_LDA(dst, b, h) do { _Pragma("unroll") for (int m = 0; m < 4; ++m) _Pragma("unroll") for (int k = 0; k < 2; ++k) dst[m][k] = *(const PG8_LAS bf16x8*)(lds + PG8_SA(b, h) + aoff + m * 2048 + k * 1024); } while (0)
#define PG8_LDB(dst, b, h) do { _Pragma("unroll") for (int n = 0; n < 2; ++n) _Pragma("unroll") for (int k = 0; k < 2; ++k) dst[n][k] = *(const PG8_LAS bf16x8*)(lds + PG8_SB(b, h) + boff + n * 2048 + k * 1024); } while (0)
#define PG8_MMA(ai, bj, At, Bt) do { __builtin_amdgcn_s_setprio(1); _Pragma("unroll") for (int m = 0; m < 4; ++m) _Pragma("unroll") for (int n = 0; n < 2; ++n) _Pragma("unroll") for (int k = 0; k < 2; ++k) \
        acc[ai][bj][m][n] = __builtin_amdgcn_mfma_f32_16x16x32_bf16(Bt[n][k], At[m][k], acc[ai][bj][m][n], 0, 0, 0); __builtin_amdgcn_s_setprio(0); } while (0)
#define PG8_WAIT_V(n) asm volatile("s_waitcnt vmcnt(" #n ")" ::: "memory")
#define PG8_WAIT_L(n) asm volatile("s_waitcnt lgkmcnt(" #n ")" ::: "memory")
#define PG8_BAR __builtin_amdgcn_s_barrier()
#define PG8_SCHED __builtin_amdgcn_sched_barrier(0)
#define PG8_SETV(V, U) do { if constexpr (GATHER) { _Pragma("unroll") for (int _h = 0; _h < 2; ++_h) _Pragma("unroll") for (int _i = 0; _i < 2; ++_i) { const int _r = _h * HALF + RA[_i]; \
        const int _tok = _r < (U).nvalid ? g.list[(size_t)(U).e * T + (U).r0 + _r] : 0; V[_h][_i] = (unsigned)(_tok * K + CA[_i]) * 2u; } } } while (0)
    Unit cur, nxt; int ui = 0;
    if (!S.next(0, cur)) return;
    f32x4 acc[2][2][4][2];
#pragma unroll
    for (int a = 0; a < 2; ++a)
#pragma unroll
        for (int b = 0; b < 2; ++b)
#pragma unroll
            for (int m = 0; m < 4; ++m)
#pragma unroll
                for (int n = 0; n < 2; ++n) acc[a][b][m][n] = (f32x4){0.f, 0.f, 0.f, 0.f};
    bf16x8 At[4][2], B0[2][2], B1[2][2];
    PG8_SETV(vA, cur);
    const char* cA = (const char*)g.A + (GATHER ? (size_t)0 : (size_t)cur.pm * tstep); const char* cB = (const char*)g.Bt + (size_t)cur.e * g.bstride + (size_t)cur.pn * tstep;
    if constexpr (SP2) {
        PG8_STAGE(PG8_SB(0, 0), cB, voffB); PG8_STAGE(PG8_SB(0, 1), cB + hstep, voffB); PG8_STAGE(PG8_SA(0, 0), cA, vA[0]); PG8_STAGE(PG8_SA(0, 1), cA, vA[1]);
        if (wr == 1) PG8_BAR;
        PG8_WAIT_V(2); PG8_BAR;
        PG8_STAGE(PG8_SB(1, 0), cB + kstep, voffB); PG8_STAGE(PG8_SA(1, 0), cA + kstep, vA[0]); PG8_STAGE(PG8_SB(1, 1), cB + hstep + kstep, voffB);
        PG8_WAIT_V(6); PG8_BAR;
    } else {
        PG8_STAGE(PG8_SB(0, 0), cB, voffB); PG8_STAGE(PG8_SA(0, 0), cA, vA[0]); PG8_STAGE(PG8_SB(0, 1), cB + hstep, voffB); PG8_STAGE(PG8_SA(0, 1), cA, vA[1]);
        if (wr == 1) PG8_BAR;
        PG8_WAIT_V(4); PG8_BAR;
        PG8_STAGE(PG8_SB(1, 0), cB + kstep, voffB); PG8_STAGE(PG8_SA(1, 0), cA + kstep, vA[0]); PG8_STAGE(PG8_SB(1, 1), cB + hstep + kstep, voffB);
        PG8_WAIT_V(6); PG8_BAR;
    }
    for (;;) {
        const bool has_next = S.next(ui + 1, nxt);
        if (has_next) PG8_SETV(vAn, nxt);
        const char* nA = has_next ? (const char*)g.A + (GATHER ? (size_t)0 : (size_t)nxt.pm * tstep) : cA; const char* nB = has_next ? (const char*)g.Bt + (size_t)nxt.e * g.bstride + (size_t)nxt.pn * tstep : cB;
        for (int t = 0; t < nt; t += 2) {
            const bool last = (t == nt - 2);
            const char* a1 = cA + (size_t)(t + 1) * kstep;
            const char* a2 = last ? nA : cA + (size_t)(t + 2) * kstep; const char* b2 = last ? nB : cB + (size_t)(t + 2) * kstep;
            const char* a3 = a2 + kstep; const char* b3 = b2 + kstep;
            unsigned v2[2][2];
#pragma unroll
            for (int h = 0; h < 2; ++h)
#pragma unroll
                for (int i = 0; i < 2; ++i) v2[h][i] = (GATHER && last && has_next) ? vAn[h][i] : vA[h][i];
            if constexpr (SP2) {
            PG8_LDB(B0, 0, 0); PG8_LDB(B1, 0, 1); PG8_SCHED; PG8_LDA(At, 0, 0); PG8_STAGE(PG8_SA(1, 1), a1, vA[1]);
            PG8_WAIT_V(8); PG8_WAIT_L(0); PG8_BAR; PG8_MMA(0, 0, At, B0); PG8_MMA(0, 1, At, B1); PG8_BAR; PG8_SCHED;
            PG8_LDA(At, 0, 1); PG8_STAGE(PG8_SB(0, 0), b2, voffB); PG8_STAGE(PG8_SB(0, 1), b2 + hstep, voffB); PG8_STAGE(PG8_SA(0, 0), a2, v2[0]);
            PG8_WAIT_V(8); PG8_WAIT_L(0); PG8_BAR; PG8_MMA(1, 0, At, B0); PG8_MMA(1, 1, At, B1); PG8_BAR; PG8_SCHED;
            PG8_LDB(B0, 1, 0); PG8_LDB(B1, 1, 1); PG8_SCHED; PG8_LDA(At, 1, 0); PG8_STAGE(PG8_SA(0, 1), a2, v2[1]);
            PG8_WAIT_V(8); PG8_WAIT_L(0); PG8_BAR; PG8_MMA(0, 0, At, B0); PG8_MMA(0, 1, At, B1); PG8_BAR; PG8_SCHED;
            PG8_LDA(At, 1, 1); PG8_STAGE(PG8_SB(1, 0), b3, voffB); PG8_STAGE(PG8_SB(1, 1), b3 + hstep, voffB); PG8_STAGE(PG8_SA(1, 0), a3, v2[0]);
            PG8_WAIT_V(8); PG8_WAIT_L(0); PG8_BAR; PG8_MMA(1, 0, At, B0); PG8_MMA(1, 1, At, B1); PG8_BAR; PG8_SCHED;
            } else {
            PG8_LDB(B0, 0, 0); PG8_SCHED; PG8_LDA(At, 0, 0); PG8_STAGE(PG8_SA(1, 1), a1, vA[1]);
            PG8_WAIT_L(8); PG8_BAR; PG8_WAIT_L(0); PG8_MMA(0, 0, At, B0); PG8_BAR; PG8_SCHED;
            PG8_LDB(B1, 0, 1); PG8_STAGE(PG8_SB(0, 0), b2, voffB);
            PG8_BAR; PG8_WAIT_L(0); PG8_MMA(0, 1, At, B1); PG8_BAR;
            PG8_LDA(At, 0, 1); PG8_STAGE(PG8_SA(0, 0), a2, v2[0]);
            PG8_BAR; PG8_WAIT_L(0); PG8_MMA(1, 0, At, B0); PG8_BAR; PG8_SCHED;
            PG8_STAGE(PG8_SB(0, 1), b2 + hstep, voffB);
            PG8_WAIT_V(6); PG8_BAR; PG8_MMA(1, 1, At, B1); PG8_BAR;
            PG8_LDB(B0, 1, 0); PG8_SCHED; PG8_LDA(At, 1, 0); PG8_STAGE(PG8_SA(0, 1), a2, v2[1]);
            PG8_WAIT_L(8); PG8_BAR; PG8_WAIT_L(0); PG8_MMA(0, 0, At, B0); PG8_BAR; PG8_SCHED;
            PG8_LDB(B1, 1, 1); PG8_STAGE(PG8_SB(1, 0), b3, voffB);
            PG8_BAR; PG8_WAIT_L(0); PG8_MMA(0, 1, At, B1); PG8_BAR;
            PG8_LDA(At, 1, 1); PG8_STAGE(PG8_SA(1, 0), a3, v2[0]);
            PG8_BAR; PG8_WAIT_L(0); PG8_MMA(1, 0, At, B0); PG8_BAR; PG8_SCHED;
            PG8_STAGE(PG8_SB(1, 1), b3 + hstep, voffB);
            PG8_WAIT_V(6); PG8_BAR; PG8_MMA(1, 1, At, B1); PG8_BAR;
            }
        }
        if constexpr (ALIGN_EPI) { if (wr == 0) PG8_BAR; }
        E(acc, cur, wr, wc, fr, fq);
        if (!has_next) break;
#pragma unroll
        for (int a = 0; a < 2; ++a)
#pragma unroll
            for (int b = 0; b < 2; ++b)
#pragma unroll
                for (int m = 0; m < 4; ++m)
#pragma unroll
                    for (int n = 0; n < 2; ++n) acc[a][b][m][n] = (f32x4){0.f, 0.f, 0.f, 0.f};
        cur = nxt; cA = nA; cB = nB; ++ui;
        if constexpr (GATHER) {
#pragma unroll
            for (int h = 0; h < 2; ++h)
#pragma unroll
                for (int i = 0; i < 2; ++i) vA[h][i] = vAn[h][i]; }
        if constexpr (ALIGN_EPI) { if (wr == 1) PG8_BAR; }
    }
    PG8_WAIT_V(0);
    if constexpr (!ALIGN_EPI) { if (wr == 0) PG8_BAR; }
    PG8_BAR;
#undef PG8_SA
#undef PG8_SB
#undef PG8_STAGE
#undef PG8_LDA
#undef PG8_LDB
#undef PG8_MMA
#undef PG8_WAIT_V
#undef PG8_WAIT_L
#undef PG8_BAR
#undef PG8_SCHED
#undef PG8_SETV
}

struct EpiInproj {
    static constexpr bool PERM = true;
    unsigned char* ws;
    __device__ __forceinline__ void operator()(const f32x4 (&acc)[2][2][4][2], const Unit& u, int wr, int wc, int fr, int fq) const {
        unsigned char* wsb = ws; asm volatile("" : "+v"(wsb));
        bf16* QVO = (bf16*)(wsb + WS_QS); bf16* ZG = (bf16*)(wsb + WS_ZG); float* LOGF = (float*)(wsb + WS_LOGF); const float* LB = (const float*)(wsb + WS_SMALL + SM_LB);
        const int row0 = u.pm * BM + wr * 64 + fr, seg = u.pn >> 1, cin = (u.pn & 1) * 256 + wc * 32 + 8 * fq;
        if (seg == 1) {
            f32x4 lb[2][2];
#pragma unroll
            for (int bj = 0; bj < 2; ++bj)
#pragma unroll
                for (int n = 0; n < 2; ++n) lb[bj][n] = *(const f32x4*)(LB + cin + bj * HALF + 4 * n);
#pragma unroll
            for (int ai = 0; ai < 2; ++ai)
#pragma unroll
                for (int m = 0; m < 4; ++m) { float* rowp = LOGF + (size_t)(row0 + ai * HALF + m * 16) * 512 + cin;
#pragma unroll
                    for (int bj = 0; bj < 2; ++bj)
#pragma unroll
                        for (int n = 0; n < 2; ++n) { f32x4 o;
#pragma unroll
                            for (int j = 0; j < 4; ++j) { const float l = lb[bj][n][j]; o[j] = __logf(l + (1.f - l) * fast_sigmoid(acc[ai][bj][m][n][j])); }
                            *(f32x4*)(rowp + bj * HALF + 4 * n) = o; } }
            return;
        }
        if (seg >= 4) {
            const int cz = (u.pn - 8) * 256 + wc * 32 + 8 * fq;
#pragma unroll
            for (int ai = 0; ai < 2; ++ai)
#pragma unroll
                for (int m = 0; m < 4; ++m) { bf16* rowp = ZG + (size_t)(row0 + ai * HALF + m * 16) * 1024 + cz;
#pragma unroll
                    for (int bj = 0; bj < 2; ++bj) { const f32x4 v0 = acc[ai][bj][m][0], v1 = acc[ai][bj][m][1];
                        const f32x2 a = gelu_pk((f32x2){v0[0], v0[1]}), b = gelu_pk((f32x2){v0[2], v0[3]}), c = gelu_pk((f32x2){v1[0], v1[1]}), d = gelu_pk((f32x2){v1[2], v1[3]});
                        u32x4 w; w.x = cvt_pk_bf16(a.x, a.y); w.y = cvt_pk_bf16(b.x, b.y); w.z = cvt_pk_bf16(c.x, c.y); w.w = cvt_pk_bf16(d.x, d.y);
                        *(u32x4*)(rowp + bj * HALF) = w; } }
            return;
        }
        bf16* base = QVO + (size_t)(seg == 0 ? 0 : seg - 1) * (8u << 20); const bool act = seg != 2;
#pragma unroll
        for (int ai = 0; ai < 2; ++ai)
#pragma unroll
            for (int m = 0; m < 4; ++m) { bf16* rowp = base + (size_t)(row0 + ai * HALF + m * 16) * 512 + cin;
#pragma unroll
                for (int bj = 0; bj < 2; ++bj) { f32x4 v0 = acc[ai][bj][m][0], v1 = acc[ai][bj][m][1];
                    if (act) {
#pragma unroll
                        for (int j = 0; j < 4; ++j) { v0[j] = v0[j] * fast_sigmoid(v0[j]); v1[j] = v1[j] * fast_sigmoid(v1[j]); } }
                    u32x4 w; w.x = cvt_pk_bf16(v0[0], v0[1]); w.y = cvt_pk_bf16(v0[2], v0[3]); w.z = cvt_pk_bf16(v1[0], v1[1]); w.w = cvt_pk_bf16(v1[2], v1[3]);
                    *(u32x4*)(rowp + bj * HALF) = w; } }
    }
};
struct EpiBf16 {
    static constexpr bool PERM = true;
    unsigned char* ws; size_t off; int ldc;
    __device__ __forceinline__ void operator()(const f32x4 (&acc)[2][2][4][2], const Unit& u, int wr, int wc, int fr, int fq) const {
        unsigned char* wsb = ws; asm volatile("" : "+v"(wsb)); bf16* O = (bf16*)(wsb + off);
        const int row0 = u.pm * BM + wr * 64 + fr, col0 = u.pn * BM + wc * 32 + 8 * fq;
#pragma unroll
        for (int ai = 0; ai < 2; ++ai)
#pragma unroll
            for (int m = 0; m < 4; ++m) { bf16* rowp = O + (size_t)(row0 + ai * HALF + m * 16) * ldc + col0;
#pragma unroll
                for (int bj = 0; bj < 2; ++bj) { const f32x4 v0 = acc[ai][bj][m][0], v1 = acc[ai][bj][m][1];
                    u32x4 w; w.x = cvt_pk_bf16(v0[0], v0[1]); w.y = cvt_pk_bf16(v0[2], v0[3]); w.z = cvt_pk_bf16(v1[0], v1[1]); w.w = cvt_pk_bf16(v1[2], v1[3]);
                    *(u32x4*)(rowp + bj * HALF) = w; } }
    }
};
struct EpiUp {
    static constexpr bool PERM = true;
    unsigned char* ws;
    __device__ __forceinline__ void operator()(const f32x4 (&acc)[2][2][4][2], const Unit& u, int wr, int wc, int fr, int fq) const {
        unsigned char* wsb = ws; asm volatile("" : "+v"(wsb)); bf16* ACT = (bf16*)(wsb + WS_ACT);
        const int row0 = u.pm * BM + wr * 64 + fr, col0 = u.pn * HALF + wc * 32 + 8 * fq;
#pragma unroll
        for (int ai = 0; ai < 2; ++ai)
#pragma unroll
            for (int m = 0; m < 4; ++m) { bf16* rowp = ACT + (size_t)(row0 + ai * HALF + m * 16) * HID + col0;
                f32x4 o0, o1;
#pragma unroll
                for (int j = 0; j < 4; ++j) { const float g0 = acc[ai][0][m][0][j], g1 = acc[ai][0][m][1][j]; o0[j] = g0 * fast_sigmoid(g0) * acc[ai][1][m][0][j]; o1[j] = g1 * fast_sigmoid(g1) * acc[ai][1][m][1][j]; }
                u32x4 w; w.x = cvt_pk_bf16(o0[0], o0[1]); w.y = cvt_pk_bf16(o0[2], o0[3]); w.z = cvt_pk_bf16(o1[0], o1[1]); w.w = cvt_pk_bf16(o1[2], o1[3]);
                *(u32x4*)rowp = w; }
    }
};
struct EpiDown {
    static constexpr bool PERM = true;
    unsigned char* ws;
    __device__ __forceinline__ void operator()(const f32x4 (&acc)[2][2][4][2], const Unit& u, int wr, int wc, int fr, int fq) const {
        unsigned char* wsb = ws; asm volatile("" : "+v"(wsb)); bf16* Y2 = (bf16*)(wsb + WS_Y2); const float* WL = (const float*)(wsb + WS_WLIST);
        const int rt0 = wr * 64 + fr, col0 = u.pn * BM + wc * 32 + 8 * fq;
#pragma unroll
        for (int ai = 0; ai < 2; ++ai)
#pragma unroll
            for (int m = 0; m < 4; ++m) { const int rt = rt0 + ai * HALF + m * 16; const float w8 = rt < u.nvalid ? WL[(size_t)u.e * T + u.r0 + rt] : 0.f;
                bf16* rowp = Y2 + (size_t)(u.pm * BM + rt) * D + col0;
#pragma unroll
                for (int bj = 0; bj < 2; ++bj) { const f32x4 v0 = acc[ai][bj][m][0] * w8, v1 = acc[ai][bj][m][1] * w8;
                    u32x4 w; w.x = cvt_pk_bf16(v0[0], v0[1]); w.y = cvt_pk_bf16(v0[2], v0[3]); w.z = cvt_pk_bf16(v1[0], v1[1]); w.w = cvt_pk_bf16(v1[2], v1[3]);
                    *(u32x4*)(rowp + bj * HALF) = w; } }
    }
};
}


__device__ __forceinline__ f32x4 mma16(bf16x8 a, bf16x8 b, f32x4 c) { return __builtin_amdgcn_mfma_f32_16x16x32_bf16(a, b, c, 0, 0, 0); }
__device__ __forceinline__ bf16x8 frag(const LAS bf16* X, int stride, int rb, int ks, int lane) { return *(const LAS bf16x8*)(X + (rb * 16 + (lane & 15)) * stride + ks * 32 + 8 * (lane >> 4)); }
constexpr int MX_QD = 0, MX_KD = 17408, MX_KDT = 34816, MX_VT = 53248, MX_PT = 71680, MX_STT = 80896, MX_SMALL = 115712;
constexpr int SD = 136, SS = 72, SO = 132;
template <int MODE> __device__ __forceinline__ void hgrn_item(const int swave, const P& p, LAS unsigned char* lds, int item) {
    const int tid = otid(swave), lane = tid & 63, w = __builtin_amdgcn_readfirstlane(tid >> 6), q4 = lane >> 4, r16 = lane & 15;
    const int bh = item >> 5, sc = item & 31, b = bh >> 2, h = bh & 3;
    const size_t row0 = (size_t)b * SEQ + (size_t)sc * 256;
    LAS bf16* QD = (LAS bf16*)(lds + MX_QD); LAS bf16* KD = (LAS bf16*)(lds + MX_KD); LAS bf16* KDT = (LAS bf16*)(lds + MX_KDT); LAS bf16* VT = (LAS bf16*)(lds + MX_VT);
    LAS bf16* PT = (LAS bf16*)(lds + MX_PT); LAS bf16* STT = (LAS bf16*)(lds + MX_STT); LAS float* O = (LAS float*)(lds + MX_QD);
    LAS float* tot = (LAS float*)(lds + MX_SMALL); LAS float* ecm = tot + 512; LAS float* elast = ecm + 128; LAS float* efac = elast + 128;
    const bf16* QS = WSP(bf16, WS_QS); const float* LF = WSP(float, WS_LOGF); const bf16* VV = WSP(bf16, WS_V); const bf16* OG = WSP(bf16, WS_OG); bf16* YC = WSP(bf16, WS_B);
    const int col = tid & 127, g = tid >> 7;
    f32x4 S[8];
#pragma unroll
    for (int db = 0; db < 8; ++db) {
        if (MODE == 1) {
#pragma unroll
            for (int r = 0; r < 4; ++r) S[db][r] = WSP(float, WS_SSTART)[(size_t)item * 16384 + (16 * w + 4 * q4 + r) * 128 + 16 * db + r16];
        } else S[db] = (f32x4){0.f, 0.f, 0.f, 0.f}; }
    float lastsum = 0.f;
    float lf[16]; bf16 qv[16], vv[16];
#define HG_LOAD(c_) do { const size_t rowc_ = row0 + 64 * (c_) + 16 * g; _Pragma("unroll") for (int i = 0; i < 16; ++i) { const size_t o = (rowc_ + i) * 512 + h * 128 + col; lf[i] = LF[o]; vv[i] = VV[o]; qv[i] = MODE == 1 ? QS[o] : (bf16)0; } } while (0)
    HG_LOAD(0);
#pragma unroll 1
    for (int c = 0; c < 4; ++c) {
        float run = 0.f;
#pragma unroll
        for (int i = 0; i < 16; ++i) { run += lf[i]; }
        tot[g * 128 + col] = run;
        __syncthreads();
        const float t0 = tot[col], t1 = tot[128 + col], t2 = tot[256 + col], t3 = tot[384 + col];
        const float cstart = g == 0 ? 0.f : (g == 1 ? t0 : (g == 2 ? t0 + t1 : t0 + t1 + t2));
        const float cmid = t0 + t1, last = (t0 + t1) + (t2 + t3);
        if (g == 0) { ecm[col] = __expf(cmid); elast[col] = __expf(last); efac[col] = __expf(last - cmid); lastsum += last; }
        {
            float cum = cstart; unsigned kt[8], vt[8];
#pragma unroll
            for (int i = 0; i < 16; i += 2) {
                float kd2[2];
#pragma unroll
                for (int j = 0; j < 2; ++j) { cum += lf[i + j]; const float kk = 1.f - __expf(lf[i + j]); const float ek = __expf(fminf(cmid - cum, 80.f)); kd2[j] = kk * ek;
                    const bf16 kb = f2bf(kd2[j]);
                    if (MODE == 1) { const float eq = __expf(fminf(cum - cmid, 80.f)); QD[(16 * g + i + j) * SD + col] = f2bf(bf2f(qv[i + j]) * eq); KD[(16 * g + i + j) * SD + col] = kb; } }
                kt[i >> 1] = cvt_pk_bf16(kd2[0], kd2[1]); vt[i >> 1] = (unsigned)vv[i] | ((unsigned)vv[i + 1] << 16);
            }
            *(LAS u32x4*)(KDT + col * SS + 16 * g) = (u32x4){kt[0], kt[1], kt[2], kt[3]}; *(LAS u32x4*)(KDT + col * SS + 16 * g + 8) = (u32x4){kt[4], kt[5], kt[6], kt[7]};
            *(LAS u32x4*)(VT + col * SS + 16 * g) = (u32x4){vt[0], vt[1], vt[2], vt[3]}; *(LAS u32x4*)(VT + col * SS + 16 * g + 8) = (u32x4){vt[4], vt[5], vt[6], vt[7]};
        }
        __syncthreads();
        if (c < 3) HG_LOAD(c + 1);
        f32x4 o[4]; const int tb = w & 3, vb0 = (w >> 2) * 4;
        if (MODE == 1) {
#pragma unroll
            for (int db = 0; db < 8; ++db) { const float e = ecm[16 * db + r16];
#pragma unroll
                for (int r = 0; r < 4; ++r) STT[(16 * w + 4 * q4 + r) * SD + 16 * db + r16] = f2bf(S[db][r] * e); }
#pragma unroll
            for (int k = 0; k < 2; ++k) { const int tile = w + 8 * k, stb = tile >> 2, ssb = tile & 3; f32x4 a = (f32x4){0.f, 0.f, 0.f, 0.f};
                if (ssb <= stb) {
#pragma unroll
                    for (int ks = 0; ks < 4; ++ks) a = mma16(frag(QD, SD, stb, ks, lane), frag(KD, SD, ssb, ks, lane), a); }
#pragma unroll
                for (int r = 0; r < 4; ++r) { const int t = stb * 16 + 4 * q4 + r, s_ = ssb * 16 + r16; PT[t * SS + s_] = (s_ <= t) ? f2bf(a[r]) : (bf16)0; } }
            __syncthreads();
            bf16x8 ap[2], aq[4];
#pragma unroll
            for (int ks = 0; ks < 2; ++ks) ap[ks] = frag(PT, SS, tb, ks, lane);
#pragma unroll
            for (int ks = 0; ks < 4; ++ks) aq[ks] = frag(QD, SD, tb, ks, lane);
#pragma unroll
            for (int j = 0; j < 4; ++j) { f32x4 a = (f32x4){0.f, 0.f, 0.f, 0.f};
#pragma unroll
                for (int ks = 0; ks < 2; ++ks) a = mma16(ap[ks], frag(VT, SS, vb0 + j, ks, lane), a);
#pragma unroll
                for (int ks = 0; ks < 4; ++ks) a = mma16(aq[ks], frag(STT, SD, vb0 + j, ks, lane), a);
                o[j] = a; }
        }
        {
            bf16x8 av[2];
#pragma unroll
            for (int ks = 0; ks < 2; ++ks) av[ks] = frag(VT, SS, w, ks, lane);
#pragma unroll
            for (int db = 0; db < 8; ++db) { f32x4 u = (f32x4){0.f, 0.f, 0.f, 0.f};
#pragma unroll
                for (int ks = 0; ks < 2; ++ks) u = mma16(av[ks], frag(KDT, SS, db, ks, lane), u);
                const float el = elast[16 * db + r16], ef = efac[16 * db + r16];
                S[db] = S[db] * el + u * ef; }
        }
        if (MODE == 1) {
            __syncthreads();
#pragma unroll
            for (int j = 0; j < 4; ++j)
#pragma unroll
                for (int r = 0; r < 4; ++r) O[(tb * 16 + 4 * q4 + r) * SO + (vb0 + j) * 16 + r16] = o[j][r];
            __syncthreads();
            const f32x2 gw = *(const f32x2*)(p.hg_norm_w + 2 * lane);
#pragma unroll
            for (int rr = 0; rr < 8; ++rr) { const int t = 8 * w + rr; const size_t row = row0 + 64 * c + t;
                const f32x2 ov = *(const LAS f32x2*)(O + t * SO + 2 * lane);
                const float ss = wave_sum_dpp(ov.x * ov.x + ov.y * ov.y); const float rs = rsqrtf(ss * (1.f / 128.f) + RMS_EPS);
                const unsigned ogp = *(const unsigned*)(OG + row * 512 + h * 128 + 2 * lane);
                const float y0 = ov.x * rs * gw.x * __uint_as_float(ogp << 16), y1 = ov.y * rs * gw.y * __uint_as_float(ogp & 0xffff0000u);
                *(unsigned*)(YC + row * D + h * 128 + 2 * lane) = cvt_pk_bf16(y0, y1); }
        }
    }
    if (MODE == 0) {
#pragma unroll
        for (int db = 0; db < 8; ++db)
#pragma unroll
            for (int r = 0; r < 4; ++r) WSP(float, WS_SLOC)[(size_t)item * 16384 + (16 * w + 4 * q4 + r) * 128 + 16 * db + r16] = S[db][r];
        if (g == 0) WSP(float, WS_SMALL + SM_DTOT)[item * 128 + col] = __expf(lastsum);
    }
    __syncthreads();
#undef HG_LOAD
}
__device__ __forceinline__ void hgrn_scan(const P& p, int gid) {
    const int bh = gid >> 14, idx = gid & 16383, d = idx & 127;
    const float* SL = WSP(float, WS_SLOC) + (size_t)bh * 32 * 16384 + idx; float* ST = WSP(float, WS_SSTART) + (size_t)bh * 32 * 16384 + idx; const float* DT = WSP(float, WS_SMALL + SM_DTOT) + bh * 32 * 128 + d;
    float s = 0.f;
#pragma unroll 8
    for (int sc = 0; sc < 32; ++sc) { ST[(size_t)sc * 16384] = s; s = s * DT[sc * 128] + SL[(size_t)sc * 16384]; }
}
__device__ __forceinline__ void sg_item(const int swave, const P& p, LAS unsigned char* lds, int item) {
    const int tid = otid(swave), lane = tid & 63, w = __builtin_amdgcn_readfirstlane(tid >> 6), q4 = lane >> 4, r16 = lane & 15;
    const int b = item >> 8, n = (item >> 2) & 63, g = item & 3; const size_t row0 = (size_t)b * SEQ + (size_t)n * 128;
    LAS bf16* VNT = (LAS bf16*)lds; LAS bf16* WT = (LAS bf16*)(lds + 34816); LAS float* mean = (LAS float*)(lds + 69632); LAS float* rstd = mean + 128; LAS float* OM = (LAS float*)(lds + 71680);
    const bf16* ZG = WSP(bf16, WS_ZG); bf16* YC = WSP(bf16, WS_B);
    {
        bf16x8 z[16];
#pragma unroll
        for (int rr = 0; rr < 16; ++rr) z[rr] = ldg<bf16x8>(ZG + (row0 + 16 * w + rr) * 1024 + 512, (unsigned)lane * 16u);
#pragma unroll
        for (int rr = 0; rr < 16; ++rr) { float s1 = 0.f, s2 = 0.f;
#pragma unroll
            for (int j = 0; j < 8; ++j) { const float v = bf2f((bf16)z[rr][j]); s1 += v; s2 += v * v; }
            const float m = wave_sum_dpp(s1) * (1.f / 512.f); const float var = fmaxf(wave_sum_dpp(s2) * (1.f / 512.f) - m * m, 0.f);
            if (lane == 0) { mean[16 * w + rr] = m; rstd[16 * w + rr] = rsqrtf(var + LN_EPS); } }
    }
    {
        const int t = tid >> 2, seg = tid & 3; const float* wr = p.sg_w + ((size_t)(g * 128 + t)) * 128 + seg * 32;
#pragma unroll
        for (int j = 0; j < 4; ++j) { const f32x4 a = *(const f32x4*)(wr + 8 * j), c = *(const f32x4*)(wr + 8 * j + 4); const int s0 = seg * 32 + 8 * j; u32x4 o;
            o.x = cvt_pk_bf16(s0 + 0 <= t ? a[0] : 0.f, s0 + 1 <= t ? a[1] : 0.f); o.y = cvt_pk_bf16(s0 + 2 <= t ? a[2] : 0.f, s0 + 3 <= t ? a[3] : 0.f);
            o.z = cvt_pk_bf16(s0 + 4 <= t ? c[0] : 0.f, s0 + 5 <= t ? c[1] : 0.f); o.w = cvt_pk_bf16(s0 + 6 <= t ? c[2] : 0.f, s0 + 7 <= t ? c[3] : 0.f);
            *(LAS u32x4*)(WT + t * SD + s0) = o; }
    }
    const int c = tid & 127, sgp = tid >> 7;
    bf16 zc[32];
#pragma unroll
    for (int i = 0; i < 32; ++i) zc[i] = ZG[(row0 + 32 * sgp + i) * 1024 + 512 + g * 128 + c];
    __syncthreads();
    {
        const float lg = p.sg_ln_g[g * 128 + c], lb = p.sg_ln_b[g * 128 + c];
#pragma unroll
        for (int i8 = 0; i8 < 4; ++i8) { float vn[8];
#pragma unroll
            for (int j = 0; j < 8; ++j) { const int s_ = 32 * sgp + 8 * i8 + j; vn[j] = (bf2f(zc[8 * i8 + j]) - mean[s_]) * rstd[s_] * lg + lb; }
            *(LAS u32x4*)(VNT + c * SD + 32 * sgp + 8 * i8) = (u32x4){cvt_pk_bf16(vn[0], vn[1]), cvt_pk_bf16(vn[2], vn[3]), cvt_pk_bf16(vn[4], vn[5]), cvt_pk_bf16(vn[6], vn[7])}; }
    }
    __syncthreads();
    bf16x8 aw[4];
#pragma unroll
    for (int ks = 0; ks < 4; ++ks) aw[ks] = frag(WT, SD, w, ks, lane);
#pragma unroll
    for (int cb = 0; cb < 8; ++cb) { f32x4 a = (f32x4){0.f, 0.f, 0.f, 0.f};
#pragma unroll
        for (int ks = 0; ks < 4; ++ks) a = mma16(aw[ks], frag(VNT, SD, cb, ks, lane), a);
#pragma unroll
        for (int r = 0; r < 4; ++r) OM[(16 * w + 4 * q4 + r) * SO + 16 * cb + r16] = a[r]; }
    __syncthreads();
    {
        const int t = tid >> 2, cs = (tid & 3) * 32; const float sb = p.sg_b[g * 128 + t];
        const bf16* up = ZG + (row0 + t) * 1024 + g * 128 + cs; bf16* op = YC + (row0 + t) * D + 512 + g * 128 + cs;
#pragma unroll
        for (int k = 0; k < 4; ++k) { const u32x4 uu = *(const u32x4*)(up + 8 * k); const f32x4 m0 = *(const LAS f32x4*)(OM + t * SO + cs + 8 * k), m1 = *(const LAS f32x4*)(OM + t * SO + cs + 8 * k + 4);
            u32x4 o;
            o.x = cvt_pk_bf16(__uint_as_float(uu.x << 16) * (m0[0] + sb), __uint_as_float(uu.x & 0xffff0000u) * (m0[1] + sb)); o.y = cvt_pk_bf16(__uint_as_float(uu.y << 16) * (m0[2] + sb), __uint_as_float(uu.y & 0xffff0000u) * (m0[3] + sb));
            o.z = cvt_pk_bf16(__uint_as_float(uu.z << 16) * (m1[0] + sb), __uint_as_float(uu.z & 0xffff0000u) * (m1[1] + sb)); o.w = cvt_pk_bf16(__uint_as_float(uu.w << 16) * (m1[2] + sb), __uint_as_float(uu.w & 0xffff0000u) * (m1[3] + sb));
            *(u32x4*)(op + 8 * k) = o; }
    }
    __syncthreads();
}

typedef GAS unsigned gu32;
#define XB_TMO      128
#define XB_XCNT(j)  (256  + 64 * (j))
#define XB_XSUB(j)  (1280 + 64 * (j))
#define XB_XGEN(j)  (2304 + 64 * (j))
#define XB_TOP      3328
#define XB_TOPGEN   3392
#define XCD_BAR_WORDS 3456
#define XB_SPIN_CAP (1u << 18)
__device__ __forceinline__ unsigned xb_ld(unsigned* p)              { return __hip_atomic_load(p, __ATOMIC_RELAXED, __HIP_MEMORY_SCOPE_AGENT); }
__device__ __forceinline__ unsigned xb_add(unsigned* p, unsigned v) { return __hip_atomic_fetch_add(p, v, __ATOMIC_RELAXED, __HIP_MEMORY_SCOPE_AGENT); }
__device__ __forceinline__ unsigned xb_xcc_id() { return (unsigned)__builtin_amdgcn_s_getreg((3 << 11) | 20) & 0xFu; }
#define XB_SPIN(cond, bar) do { unsigned _sp = 0; while (cond) { __builtin_amdgcn_s_sleep(1); \
    if ((++_sp & 255u) == 0u) { if (xb_ld(&(bar)[XB_TMO])) break; if (_sp > XB_SPIN_CAP) { atomicAdd(&(bar)[XB_TMO], 1u); break; } } } } while (0)
struct XcdBarrier { unsigned* bar; unsigned x; volatile LAS unsigned* st; };
__device__ __forceinline__ XcdBarrier xcd_barrier_post(const int swave, unsigned* bar, volatile LAS unsigned* st) {
    XcdBarrier b; b.bar = bar; b.x = xb_xcc_id(); b.st = st;
    if (otid(swave) == 0) (void)xb_add(&bar[XB_XCNT(b.x)], 1u);
    return b;
}
__device__ __forceinline__ void xcd_barrier_complete(unsigned* bar, unsigned x, unsigned& nloc, unsigned& nx) {
    const unsigned G = gridDim.x * gridDim.y * gridDim.z;
    unsigned sum, cnt, mine, sp = 0u;
    for (;;) {
        sum = 0u; cnt = 0u; mine = 0u;
#pragma unroll
        for (unsigned j = 0; j < 16; ++j) { const unsigned c = xb_ld(&bar[XB_XCNT(j)]); sum += c; cnt += (c > 0u) ? 1u : 0u; mine = (j == x) ? c : mine; }
        if (sum == G) break;
        __builtin_amdgcn_s_sleep(1);
        if ((++sp & 255u) == 0u) { if (xb_ld(&bar[XB_TMO])) break; if (sp > XB_SPIN_CAP) { atomicAdd(&bar[XB_TMO], 1u); break; } }
    }
    nloc = mine > 0u ? mine : 1u; nx = cnt > 0u ? cnt : 1u;
}
__device__ __forceinline__ void xcd_barrier(const int swave, const XcdBarrier& b) {
    asm volatile("s_waitcnt vmcnt(0)" ::: "memory");
    __syncthreads();
    if (otid(swave) == 0) {
        unsigned* bar = b.bar;
        __builtin_amdgcn_s_waitcnt(0);
        unsigned nloc = b.st[0], nx = b.st[1];
        if (nloc == 0u) { xcd_barrier_complete(bar, b.x, nloc, nx); b.st[0] = nloc; b.st[1] = nx; }
        const unsigned old = xb_add(&bar[XB_XSUB(b.x)], 1u);
        const unsigned gen = old / nloc;
        if (old + 1u == (gen + 1u) * nloc) {
            __builtin_amdgcn_fence(__ATOMIC_RELEASE, "agent");
            asm volatile("s_waitcnt vmcnt(0)" ::: "memory");
            const unsigned og = xb_add(&bar[XB_TOP], 1u);
            const unsigned tg = og / nx;
            if (og + 1u == (tg + 1u) * nx) xb_add(&bar[XB_TOPGEN], 1u);
            else XB_SPIN(xb_ld(&bar[XB_TOPGEN]) == tg, bar);
            __builtin_amdgcn_fence(__ATOMIC_ACQUIRE, "agent");
            xb_add(&bar[XB_XGEN(b.x)], 1u);
            asm volatile("s_waitcnt vmcnt(0)" ::: "memory");
        } else {
            XB_SPIN(xb_ld(&bar[XB_XGEN(b.x)]) == gen, bar);
            __builtin_amdgcn_fence(__ATOMIC_ACQUIRE, "agent");
            asm volatile("s_waitcnt vmcnt(0)" ::: "memory");
        }
    }
    __syncthreads();
}
constexpr int CW_BAR = 4096;

__device__ __forceinline__ unsigned pk2(float lo, float hi) { return (unsigned)f2bf(lo) | ((unsigned)f2bf(hi) << 16); }
struct TrItem { const float* src; bf16* dst; int N; };
__device__ __forceinline__ TrItem tr_locate(const P& p, int it) {
    constexpr int I_IN = (D / 64) * (NIN / 64), I_OUT = (D / 64) * (D / 64), I_UP1 = (D / 64) * (1024 / 64), I_DN1 = (HID / 64) * (D / 64);
    const float* W; bf16* WT; int K, N, up = 0, r = it;
    if (r < I_IN) { W = p.w_in; WT = WSP(bf16, WS_WINT); K = D; N = NIN; }
    else if ((r -= I_IN) < I_OUT) { W = p.w_out; WT = WSP(bf16, WS_WOUTT); K = D; N = D; }
    else if ((r -= I_OUT) < NE * I_UP1) { const int e = r / I_UP1; r -= e * I_UP1; W = p.w_up + (size_t)e * D * 1024; WT = WSP(bf16, WS_WUPT) + (size_t)e * D * 1024; K = D; N = 1024; up = 1; }
    else { r -= NE * I_UP1; const int e = r / I_DN1; r -= e * I_DN1; W = p.w_down + (size_t)e * HID * D; WT = WSP(bf16, WS_WDNT) + (size_t)e * HID * D; K = HID; N = D; }
    const int nblk = N / 64, kb = r / nblk, nb = r % nblk, k0 = 64 * kb, lane = (int)__builtin_amdgcn_mbcnt_hi(~0u, __builtin_amdgcn_mbcnt_lo(~0u, 0u)), n = 64 * nb + lane;
    TrItem t; t.src = W + (size_t)k0 * N + n; t.dst = WT + (size_t)(up ? updst(n) : n) * K + k0; t.N = N; return t;
}
__device__ __forceinline__ void tr_load(const TrItem& t, float (&r)[64]) {
#pragma unroll
    for (int i = 0; i < 64; ++i) r[i] = t.src[(size_t)i * t.N];
}
__device__ __forceinline__ void tr_store(const TrItem& t, const float (&r)[64]) {
    u32x4* dst = (u32x4*)t.dst;
#pragma unroll
    for (int j = 0; j < 8; ++j) { u32x4 o; o.x = cvt_pk_bf16(r[8 * j], r[8 * j + 1]); o.y = cvt_pk_bf16(r[8 * j + 2], r[8 * j + 3]); o.z = cvt_pk_bf16(r[8 * j + 4], r[8 * j + 5]); o.w = cvt_pk_bf16(r[8 * j + 6], r[8 * j + 7]); dst[j] = o; }
}
__device__ __forceinline__ void phase_prep(const int swave, const P& p, LAS unsigned char* lds, int bx, int G) {
    const int tid = otid(swave), lane = tid & 63, w = __builtin_amdgcn_readfirstlane(tid >> 6);
    if (bx < 192) {
        LAS float* sc = (LAS float*)lds; LAS float* red = sc + 2048;
        for (int i = tid; i < 2048; i += NTHR) sc[i] = silu_f(p.c[i]);
        __syncthreads();
        for (int cb = bx; cb < 192; cb += G) {
            const int kg = tid >> 5, cl = tid & 31, colj = cb * 32 + cl; float a0 = 0.f, a1 = 0.f;
            float wv[64];
#pragma unroll
            for (int i = 0; i < 64; ++i) wv[i] = p.w_ada[(size_t)(kg + 16 * i) * 6144 + colj];
#pragma unroll
            for (int i = 0; i < 64; ++i) { const int k = kg + 16 * i; a0 += sc[k] * wv[i]; a1 += sc[1024 + k] * wv[i]; }
            red[(kg * 32 + cl) * 2] = a0; red[(kg * 32 + cl) * 2 + 1] = a1;
            __syncthreads();
            if (tid < 64) { const int c2 = tid & 31, bb = tid >> 5; float t = 0.f;
#pragma unroll
                for (int k2 = 0; k2 < 16; ++k2) t += red[(k2 * 32 + c2) * 2 + bb];
                __hip_atomic_store(WSP(float, WS_SMALL + SM_ADA) + bb * 6144 + cb * 32 + c2, t + p.b_ada[cb * 32 + c2], __ATOMIC_RELAXED, __HIP_MEMORY_SCOPE_AGENT);
                asm volatile("s_waitcnt vmcnt(0)" ::: "memory");
                if (tid == 0) __hip_atomic_fetch_add(WSP(unsigned, WS_CTL) + CW_ADA, 1u, __ATOMIC_RELAXED, __HIP_MEMORY_SCOPE_AGENT); }
            __syncthreads();
        }
    }
    if (bx == G - 1) { const float l0 = p.lb_logits[tid], l1 = p.lb_logits[512 + tid]; const float m = fmaxf(l0, l1); const float e0 = expf(l0 - m), e1 = expf(l1 - m);
        WSP(float, WS_SMALL + SM_LB)[tid] = e0 / (e0 + e1); }
    const int gw = bx * NWAVES + w, NGW = G * NWAVES;
    constexpr int NITEMS = (D / 64) * (NIN / 64) + (D / 64) * (D / 64) + NE * (D / 64) * (1024 / 64) + NE * (HID / 64) * (D / 64);
#pragma unroll 1
    for (int it = gw; it < NITEMS; it += 3 * NGW) {
        const TrItem ta = tr_locate(p, it); float ra[64]; tr_load(ta, ra);
        if (it + 2 * NGW < NITEMS) { const TrItem tb = tr_locate(p, it + NGW), tc = tr_locate(p, it + 2 * NGW); float rb[64], rc[64]; tr_load(tb, rb); tr_load(tc, rc); tr_store(ta, ra); tr_store(tb, rb); tr_store(tc, rc); }
        else if (it + NGW < NITEMS) { const TrItem tb = tr_locate(p, it + NGW); float rb[64]; tr_load(tb, rb); tr_store(ta, ra); tr_store(tb, rb); }
        else tr_store(ta, ra);
    }
}
__device__ __forceinline__ void phase_xmod(const int swave, const P& p, int bx, int G) {
    const int lane = otid(swave) & 63, gw = bx * NWAVES + (otid(swave) >> 6), NGW = G * NWAVES; const unsigned l16 = (unsigned)lane * 16u, l8 = (unsigned)lane * 8u;
#pragma unroll 1
    for (int row = 4 * gw; row < T; row += 4 * NGW) { const float* ada = WSP(float, WS_SMALL + SM_ADA) + (row >> 13) * 6144;
        f32x4 xv[4][4];
#pragma unroll
        for (int r = 0; r < 4; ++r)
#pragma unroll
            for (int j = 0; j < 4; ++j) xv[r][j] = ldg<f32x4>(p.x + (size_t)(row + r) * D + 256 * j, l16);
#pragma unroll
        for (int j = 0; j < 4; ++j) { const f32x4 sh = ldg<f32x4>(ada + 256 * j, l16), sc = ldg<f32x4>(ada + 1024 + 256 * j, l16);
#pragma unroll
            for (int r = 0; r < 4; ++r) { u32x2 o; o.x = cvt_pk_bf16(xv[r][j][0] * (1.f + sc[0]) + sh[0], xv[r][j][1] * (1.f + sc[1]) + sh[1]); o.y = cvt_pk_bf16(xv[r][j][2] * (1.f + sc[2]) + sh[2], xv[r][j][3] * (1.f + sc[3]) + sh[3]);
                stg<u32x2>(WSP(bf16, WS_B) + (size_t)(row + r) * D + 256 * j, l8, o); } } }
}
__device__ __forceinline__ void route_load_weights(const int swave, const P& p, LAS float* WR) {
    for (int c = otid(swave); c < D; c += NTHR) { const f32x4 wg = *(const f32x4*)(p.rg_w + (size_t)c * 4);
#pragma unroll
        for (int g = 0; g < 4; ++g) { WR[g * D + c] = wg[g];
            const f32x4 w0 = *(const f32x4*)(p.re_w + ((size_t)g * D + c) * 8), w1 = *(const f32x4*)(p.re_w + ((size_t)g * D + c) * 8 + 4);
#pragma unroll
            for (int e = 0; e < 4; ++e) { WR[(4 + g * 8 + e) * D + c] = w0[e]; WR[(4 + g * 8 + 4 + e) * D + c] = w1[e]; } } }
}
__device__ __forceinline__ void route_load2(const P& p, int row, int lane, f32x4 (&x)[2][4], u32x2 (&y)[2][4]) {
    const unsigned l16 = (unsigned)lane * 16u, l8 = (unsigned)lane * 8u;
#pragma unroll
    for (int r = 0; r < 2; ++r) { const float* xr = p.x + (size_t)(row + r) * D; const bf16* yr = WSP(bf16, WS_Y) + (size_t)(row + r) * D;
#pragma unroll
        for (int j = 0; j < 4; ++j) { x[r][j] = ldg<f32x4>(xr + 256 * j, l16); y[r][j] = ldg<u32x2>(yr + 256 * j, l8); } }
}
__device__ __forceinline__ float wave_sum_l63(float v) { DPP_ADD(v, 0xB1, 0xF); DPP_ADD(v, 0x4E, 0xF); DPP_ADD(v, 0x141, 0xF); DPP_ADD(v, 0x140, 0xF); DPP_ADD(v, 0x142, 0xA); DPP_ADD(v, 0x143, 0xC); return v; }
__device__ __forceinline__ void route_topk(const LAS float* lgs, LAS int* rt_e, LAS float* rt_w, int rl, int lane) {
    const f32x4 g4 = *(const LAS f32x4*)lgs;
    int gi = 0; float gm = g4[0];
#pragma unroll
    for (int g = 1; g < 4; ++g) if (g4[g] > gm) { gm = g4[g]; gi = g; }
    float gs = 0.f;
#pragma unroll
    for (int g = 0; g < 4; ++g) gs += __expf(g4[g] - gm);
    const float pgroup = 1.f / gs;
    const f32x4 ea = *(const LAS f32x4*)(lgs + 4 + 8 * gi), eb = *(const LAS f32x4*)(lgs + 8 + 8 * gi);
    float el[8] = {ea[0], ea[1], ea[2], ea[3], eb[0], eb[1], eb[2], eb[3]};
    int j0 = 0; float m0 = el[0];
#pragma unroll
    for (int e = 1; e < 8; ++e) if (el[e] > m0) { m0 = el[e]; j0 = e; }
    int j1 = -1; float m1 = -3.0e38f;
#pragma unroll
    for (int e = 0; e < 8; ++e) if (e != j0 && el[e] > m1) { m1 = el[e]; j1 = e; }
    const float r1 = __expf(m1 - m0);
    if (lane == 0) { rt_e[2 * rl] = gi * 8 + j0; rt_e[2 * rl + 1] = gi * 8 + j1; rt_w[2 * rl] = pgroup / (1.f + r1); rt_w[2 * rl + 1] = pgroup * r1 / (1.f + r1); }
}
__device__ __forceinline__ void ln1_route_rows2(const P& p, const LAS float* WR, LAS float* lgs, LAS int* rt_e, LAS float* rt_w, int row, int rl, int lane, const f32x4 (&x)[2][4], const u32x2 (&y)[2][4]) {
    const float* ada = WSP(float, WS_SMALL + SM_ADA) + (row >> 13) * 6144;
    const unsigned l16 = (unsigned)lane * 16u, l8 = (unsigned)lane * 8u;
    f32x2 hv[16];
#pragma unroll
    for (int r = 0; r < 2; ++r) { float v[16]; float s = 0.f;
#pragma unroll
        for (int j = 0; j < 4; ++j) { const f32x4 g1 = ldg<f32x4>(ada + 2048 + 256 * j, l16);
            const float y0 = __uint_as_float(y[r][j].x << 16), y1 = __uint_as_float(y[r][j].x & 0xffff0000u), y2 = __uint_as_float(y[r][j].y << 16), y3 = __uint_as_float(y[r][j].y & 0xffff0000u);
            v[4 * j] = ALPHA * x[r][j][0] + (1.f + g1[0]) * y0; v[4 * j + 1] = ALPHA * x[r][j][1] + (1.f + g1[1]) * y1; v[4 * j + 2] = ALPHA * x[r][j][2] + (1.f + g1[2]) * y2; v[4 * j + 3] = ALPHA * x[r][j][3] + (1.f + g1[3]) * y3;
            s += (v[4 * j] + v[4 * j + 1]) + (v[4 * j + 2] + v[4 * j + 3]); }
        const float mean = wave_sum_dpp(s) * (1.f / D); float q = 0.f;
#pragma unroll
        for (int i = 0; i < 16; ++i) { v[i] -= mean; q += v[i] * v[i]; }
        const float rstd = rsqrtf(wave_sum_dpp(q) * (1.f / D) + LN_EPS);
        bf16* X1 = WSP(bf16, WS_X1) + (size_t)(row + r) * D; bf16* H2 = WSP(bf16, WS_B) + (size_t)(row + r) * D;
#pragma unroll
        for (int j = 0; j < 4; ++j) { const f32x4 gg = ldg<f32x4>(p.ln1_g + 256 * j, l16), bb = ldg<f32x4>(p.ln1_b + 256 * j, l16), sh = ldg<f32x4>(ada + 3072 + 256 * j, l16), sc = ldg<f32x4>(ada + 4096 + 256 * j, l16);
            f32x4 x1;
#pragma unroll
            for (int i = 0; i < 4; ++i) { x1[i] = v[4 * j + i] * rstd * gg[i] + bb[i]; v[4 * j + i] = x1[i] * (1.f + sc[i]) + sh[i]; if (r == 0) hv[4 * j + i].x = v[4 * j + i]; else hv[4 * j + i].y = v[4 * j + i]; }
            { u32x2 xo; xo.x = cvt_pk_bf16(x1[0], x1[1]); xo.y = cvt_pk_bf16(x1[2], x1[3]); stg<u32x2>(X1 + 256 * j, l8, xo); }
            u32x2 o; o.x = cvt_pk_bf16(v[4 * j], v[4 * j + 1]); o.y = cvt_pk_bf16(v[4 * j + 2], v[4 * j + 3]); stg<u32x2>(H2 + 256 * j, l8, o); }
    }
    __builtin_amdgcn_sched_barrier(0);
    const LAS char* wp = (const LAS char*)WR + lane * 16;
#pragma unroll
    for (int o = 0; o < 36; ++o) { f32x2 a = (f32x2){0.f, 0.f}; asm volatile("" : "+v"(wp));
#pragma unroll
        for (int j = 0; j < 4; ++j) { const f32x4 wv = *(const LAS f32x4*)(wp + 1024 * j);
#pragma unroll
            for (int i = 0; i < 4; ++i) a = __builtin_elementwise_fma(hv[4 * j + i], (f32x2){wv[i], wv[i]}, a); }
        wp += 4096;
        const float bias = o < 4 ? p.rg_b[o] : p.re_b[o - 4];
        const float s0 = wave_sum_l63(a.x) + bias, s1 = wave_sum_l63(a.y) + bias;
        if (lane == 63) { lgs[o] = s0; lgs[40 + o] = s1; }
        if ((o % 6) == 5) __builtin_amdgcn_sched_barrier(0); }
    asm volatile("s_waitcnt lgkmcnt(0)" ::: "memory");
    route_topk(lgs, rt_e, rt_w, rl, lane);
    route_topk(lgs + 40, rt_e, rt_w, rl + 1, lane);
}
__device__ __forceinline__ void route_assign(const int swave, const P& p, const LAS int* rt_e, const LAS float* rt_w, LAS int* rt_base, int rowbase) {
    const int lane = otid(swave);
    if (lane < 32) { int c = 0; for (int a = 0; a < 128; ++a) c += (rt_e[a] == lane) ? 1 : 0;
        rt_base[lane] = c ? (int)atomicAdd(WSP(unsigned, WS_CTL) + CW_CNT + lane, (unsigned)c) : 0; }
    asm volatile("s_waitcnt vmcnt(0) lgkmcnt(0)" ::: "memory");
    int* LIST = WSP(int, WS_LIST); float* WL = WSP(float, WS_WLIST); int* TE = WSP(int, WS_SMALL + SM_TOKE); int* TS = WSP(int, WS_SMALL + SM_TOKS);
#pragma unroll
    for (int k = 0; k < 2; ++k) { const int a = lane + 64 * k, e = rt_e[a]; int rank = 0; for (int a2 = 0; a2 < a; ++a2) rank += (rt_e[a2] == e) ? 1 : 0;
        const int slot = rt_base[e] + rank, row = rowbase + (a >> 1);
        LIST[e * T + slot] = row; WL[e * T + slot] = rt_w[a]; TE[row * 2 + (a & 1)] = e; TS[row * 2 + (a & 1)] = slot; }
}
template <int NR> __device__ __forceinline__ void final_rows(const P& p, const LAS int* tstart, int row, int lane, float pscale, float pspike) {
    const float* ada = WSP(float, WS_SMALL + SM_ADA) + (row >> 13) * 6144;
    const int* TE = WSP(int, WS_SMALL + SM_TOKE); const int* TS = WSP(int, WS_SMALL + SM_TOKS);
    const unsigned l16 = (unsigned)lane * 16u, l8 = (unsigned)lane * 8u;
    u32x2 xv[NR][4], pa[NR][4], pb[NR][4];
#pragma unroll
    for (int r = 0; r < NR; ++r) {
        const int e0 = TE[(row + r) * 2], e1 = TE[(row + r) * 2 + 1], s0 = TS[(row + r) * 2], s1 = TS[(row + r) * 2 + 1];
        const size_t rA = (size_t)(tstart[e0] * 256 + s0), rB = (size_t)(tstart[e1] * 256 + s1);
        const bf16* ya = WSP(bf16, WS_Y2) + rA * D; const bf16* yb = WSP(bf16, WS_Y2) + rB * D; const bf16* X1 = WSP(bf16, WS_X1) + (size_t)(row + r) * D;
#pragma unroll
        for (int j = 0; j < 4; ++j) { xv[r][j] = ldg<u32x2>(X1 + 256 * j, l8); pa[r][j] = ldg<u32x2>(ya + 256 * j, l8); pb[r][j] = ldg<u32x2>(yb + 256 * j, l8); } }
    __builtin_amdgcn_sched_barrier(0);
#pragma unroll
    for (int r = 0; r < NR; ++r) {
        if (r) __builtin_amdgcn_sched_barrier(0);
        float v[16]; float s = 0.f;
#pragma unroll
        for (int j = 0; j < 4; ++j) { const f32x4 g2 = ldg<f32x4>(ada + 5120 + 256 * j, l16);
            const float m0 = __uint_as_float(pa[r][j].x << 16) + __uint_as_float(pb[r][j].x << 16), m1 = __uint_as_float(pa[r][j].x & 0xffff0000u) + __uint_as_float(pb[r][j].x & 0xffff0000u);
            const float m2 = __uint_as_float(pa[r][j].y << 16) + __uint_as_float(pb[r][j].y << 16), m3 = __uint_as_float(pa[r][j].y & 0xffff0000u) + __uint_as_float(pb[r][j].y & 0xffff0000u);
            const float x0 = __uint_as_float(xv[r][j].x << 16), x1 = __uint_as_float(xv[r][j].x & 0xffff0000u), x2 = __uint_as_float(xv[r][j].y << 16), x3 = __uint_as_float(xv[r][j].y & 0xffff0000u);
            v[4 * j + 0] = ALPHA * x0 + (1.f + g2[0]) * m0; v[4 * j + 1] = ALPHA * x1 + (1.f + g2[1]) * m1; v[4 * j + 2] = ALPHA * x2 + (1.f + g2[2]) * m2; v[4 * j + 3] = ALPHA * x3 + (1.f + g2[3]) * m3;
            s += (v[4 * j] + v[4 * j + 1]) + (v[4 * j + 2] + v[4 * j + 3]); }
        const float mean = wave_sum_dpp(s) * (1.f / D); float q = 0.f;
#pragma unroll
        for (int i = 0; i < 16; ++i) { v[i] -= mean; q += v[i] * v[i]; }
        const float rstd = rsqrtf(wave_sum_dpp(q) * (1.f / D) + LN_EPS);
#pragma unroll
        for (int j = 0; j < 4; ++j) { const f32x4 gg = ldg<f32x4>(p.ln2_g + 256 * j, l16), bb = ldg<f32x4>(p.ln2_b + 256 * j, l16); f32x4 o;
#pragma unroll
            for (int i = 0; i < 4; ++i) o[i] = (v[4 * j + i] * rstd * gg[i] + bb[i]) * pscale;
            if (j == 0 && lane == 0 && r == 0) o[0] += pspike;
            stg<f32x4>(p.out + (size_t)(row + r) * D + 256 * j, l16, o); }
    }
}

enum { PH_PREP = 0, PH_INPROJ, PH_MIXA, PH_SCAN, PH_MIXC, PH_OUTPROJ, PH_LN1ROUTE, PH_UP, PH_DOWN, PH_FINAL, PH_N };
struct Args { P p; int ph_lo, ph_hi, li, pad; };

__device__ __forceinline__ void moe_tables(const int swave, const P& p, LAS unsigned char* lds) {
    LAS int* tstart = (LAS int*)(lds + LDSCTL_OFF) + LC_TSTART; LAS int* lcnt = (LAS int*)(lds + LDSCTL_OFF) + LC_CNT;
    if (otid(swave) == 0) { int acc = 0;
        for (int e = 0; e < NE; ++e) { const int c = (int)__hip_atomic_load(WSP(unsigned, WS_CTL) + CW_CNT + e, __ATOMIC_RELAXED, __HIP_MEMORY_SCOPE_AGENT); tstart[e] = acc; lcnt[e] = c; acc += (c + 255) >> 8; }
        tstart[NE] = acc; }
    __syncthreads();
}

__device__ __forceinline__ P load_p() {
    typedef const __attribute__((address_space(4))) unsigned long long CU64;
    CU64* a = (CU64*)__builtin_amdgcn_kernarg_segment_ptr(); asm volatile("" : "+s"(a));
    P p; unsigned long long* d = (unsigned long long*)&p;
#pragma unroll
    for (int i = 0; i < 24; ++i) d[i] = a[i];
    return p;
}
__global__ void __launch_bounds__(NTHR, 2) mk_fwd(Args args) {
    extern __shared__ __attribute__((aligned(16))) unsigned char lds_raw[];
    LAS unsigned char* lds = (LAS unsigned char*)lds_raw;
    const P& p = args.p;
    const int G = gridDim.x, bx = blockIdx.x;
    const int swave = __builtin_amdgcn_readfirstlane((int)threadIdx.x >> 6);
    const int lo = args.ph_lo, hi = args.ph_hi;
#ifndef PHASE_MASK
#define PHASE_MASK 0x3ff
#endif
#define IN(k) (((PHASE_MASK >> (k)) & 1) && lo <= (k) && (k) < hi)
#ifndef REP_PHASE
#define REP_PHASE -1
#define REP_N 0
#endif
#define NREP(k) ((k) == REP_PHASE ? REP_N : 0)
#ifdef PROBE_A
#define STAMP(k) do { if (otid(swave) == 0) { const unsigned long long t_ = __builtin_amdgcn_s_memrealtime(); __hip_atomic_store((unsigned long long*)(WSP(unsigned, WS_CTL) + 65536 + bx * 32) + (k), t_, __ATOMIC_RELAXED, __HIP_MEMORY_SCOPE_AGENT); } } while (0)
#else
#define STAMP(k) do { } while (0)
#endif
#define SEAM(k) do { if (rep_ == NREP(k)) { if (IN(k) && IN((k) + 1)) xcd_barrier(swave, bar); STAMP((k) + 1); } } while (0)
    for (int u = otid(swave); u < (LDS_BYTES - LDSCTL_OFF) / 4; u += NTHR) ((LAS unsigned*)(lds + LDSCTL_OFF))[u] = 0u;
    __syncthreads();
    XcdBarrier bar = xcd_barrier_post(swave, WSP(unsigned, WS_CTL) + CW_BAR + args.li * XCD_BAR_WORDS, (volatile LAS unsigned*)(lds + LDSCTL_OFF) + LC_BAR);
    { const P p = load_p(); STAMP(0); }
    if (IN(PH_PREP)) for (int rep_ = 0; rep_ <= NREP(PH_PREP); ++rep_) { if (rep_) xcd_barrier(swave, bar); asm volatile("; MARK PH_PREP"); const P p = load_p(); phase_prep(swave, p, lds, bx, G);
        if (otid(swave) == 0) { unsigned sp = 0; while (__hip_atomic_load(WSP(unsigned, WS_CTL) + CW_ADA, __ATOMIC_RELAXED, __HIP_MEMORY_SCOPE_AGENT) < 192u && ++sp < (1u << 22)) __builtin_amdgcn_s_sleep(2);
            __builtin_amdgcn_fence(__ATOMIC_ACQUIRE, "agent"); asm volatile("s_waitcnt vmcnt(0)" ::: "memory"); }
        __syncthreads();
        phase_xmod(swave, p, bx, G); SEAM(PH_PREP); }
    if (IN(PH_INPROJ)) for (int rep_ = 0; rep_ <= NREP(PH_INPROJ); ++rep_) { if (rep_) xcd_barrier(swave, bar); asm volatile("; MARK PH_INPROJ"); const P p = load_p();
        pg8::Gemm g{WSP(bf16, WS_B), WSP(bf16, WS_WINT), D, 0, 0, nullptr}; pg8::StaticOrder S; S.init(T, NIN, G, bx);
        pg8::EpiInproj E{p.ws};
        pg8::gemm_phase<pg8::EpiInproj, pg8::StaticOrder, true, true, false>(swave, lds, g, S, E);
        SEAM(PH_INPROJ);
    }
    if (IN(PH_MIXA)) for (int rep_ = 0; rep_ <= NREP(PH_MIXA); ++rep_) { if (rep_) xcd_barrier(swave, bar); asm volatile("; MARK PH_MIXA"); const P p = load_p();
        for (int it = bx; it < 256 + 512; it += G) { if (it < 256) hgrn_item<0>(swave, p, lds, it); else sg_item(swave, p, lds, it - 256); }
        SEAM(PH_MIXA);
    }
    if (IN(PH_SCAN)) for (int rep_ = 0; rep_ <= NREP(PH_SCAN); ++rep_) { if (rep_) xcd_barrier(swave, bar); asm volatile("; MARK PH_SCAN"); const P p = load_p();
        for (int gid = bx * NTHR + otid(swave); gid < 8 * 16384; gid += G * NTHR) hgrn_scan(p, gid);
        SEAM(PH_SCAN);
    }
    if (IN(PH_MIXC)) for (int rep_ = 0; rep_ <= NREP(PH_MIXC); ++rep_) { if (rep_) xcd_barrier(swave, bar); asm volatile("; MARK PH_MIXC"); const P p = load_p();
        for (int it = bx; it < 256; it += G) hgrn_item<1>(swave, p, lds, it);
        SEAM(PH_MIXC);
    }
    if (IN(PH_OUTPROJ)) for (int rep_ = 0; rep_ <= NREP(PH_OUTPROJ); ++rep_) { if (rep_) xcd_barrier(swave, bar); asm volatile("; MARK PH_OUTPROJ"); const P p = load_p();
        pg8::Gemm g{WSP(bf16, WS_B), WSP(bf16, WS_WOUTT), D, 0, 0, nullptr}; pg8::StaticOrder S; S.init(T, D, G, bx);
        pg8::EpiBf16 E{p.ws, WS_Y, D};
        pg8::gemm_phase<pg8::EpiBf16, pg8::StaticOrder, true, true, false>(swave, lds, g, S, E);
        SEAM(PH_OUTPROJ);
    }
    if (IN(PH_LN1ROUTE)) for (int rep_ = 0; rep_ <= NREP(PH_LN1ROUTE); ++rep_) { if (rep_) xcd_barrier(swave, bar); asm volatile("; MARK PH_LN1ROUTE"); const P p = load_p();
        if (rep_) { if (bx == 0 && otid(swave) < 32) __hip_atomic_store(WSP(unsigned, WS_CTL) + CW_CNT + otid(swave), 0u, __ATOMIC_RELAXED, __HIP_MEMORY_SCOPE_AGENT); xcd_barrier(swave, bar); }
        const int lane = otid(swave) & 63, w = __builtin_amdgcn_readfirstlane(otid(swave) >> 6);
        LAS float* WR = (LAS float*)lds; LAS int* rt_e = (LAS int*)(lds + LDSCTL_OFF) + LC_RT; LAS float* rt_w = (LAS float*)(rt_e + 128); LAS int* rt_base = rt_e + 256;
        route_load_weights(swave, p, WR);
        __syncthreads();
        for (int rb = bx * 64; rb < T; rb += G * 64) {
            f32x4 xc[2][4]; u32x2 yc[2][4];
            route_load2(p, rb + 8 * w, lane, xc, yc);
#pragma unroll 1
            for (int pr = 0; pr < 4; ++pr) {
                f32x4 xn[2][4]; u32x2 yn[2][4];
                route_load2(p, rb + 8 * w + (pr < 3 ? 2 * pr + 2 : 2 * pr), lane, xn, yn);
                ln1_route_rows2(p, WR, (LAS float*)(lds + LDSCTL_OFF) + LC_LGS + 80 * w, rt_e, rt_w, rb + 8 * w + 2 * pr, 8 * w + 2 * pr, lane, xc, yc);
#pragma unroll
                for (int r = 0; r < 2; ++r)
#pragma unroll
                    for (int j = 0; j < 4; ++j) { xc[r][j] = xn[r][j]; yc[r][j] = yn[r][j]; }
            }
            __syncthreads();
            if (w == 0) route_assign(swave, p, rt_e, rt_w, rt_base, rb);
            __syncthreads();
        }
        SEAM(PH_LN1ROUTE);
    }
    if (IN(PH_UP)) for (int rep_ = 0; rep_ <= NREP(PH_UP); ++rep_) { if (rep_) xcd_barrier(swave, bar); asm volatile("; MARK PH_UP"); const P p = load_p();
        moe_tables(swave, p, lds);
        pg8::Gemm g{WSP(bf16, WS_B), WSP(bf16, WS_WUPT), D, 0, (size_t)1024 * D * 2, WSP(int, WS_LIST)};
        pg8::MoeOrder S{(const LAS int*)(lds + LDSCTL_OFF) + LC_TSTART, (const LAS int*)(lds + LDSCTL_OFF) + LC_CNT, G, bx, 4};
        pg8::EpiUp E{p.ws};
        pg8::gemm_phase<pg8::EpiUp, pg8::MoeOrder, true, true, true>(swave, lds, g, S, E);
        SEAM(PH_UP);
    }
    if (IN(PH_DOWN)) for (int rep_ = 0; rep_ <= NREP(PH_DOWN); ++rep_) { if (rep_) xcd_barrier(swave, bar); asm volatile("; MARK PH_DOWN"); const P p = load_p();
        moe_tables(swave, p, lds);
        pg8::Gemm g{WSP(bf16, WS_ACT), WSP(bf16, WS_WDNT), HID, 0, (size_t)1024 * HID * 2, nullptr};
        pg8::MoeOrder S{(const LAS int*)(lds + LDSCTL_OFF) + LC_TSTART, (const LAS int*)(lds + LDSCTL_OFF) + LC_CNT, G, bx, 4};
        pg8::EpiDown E{p.ws};
        pg8::gemm_phase<pg8::EpiDown, pg8::MoeOrder, true, true, false>(swave, lds, g, S, E);
        SEAM(PH_DOWN);
    }
    if (IN(PH_FINAL)) for (int rep_ = 0; rep_ <= NREP(PH_FINAL); ++rep_) { if (rep_) xcd_barrier(swave, bar); asm volatile("; MARK PH_FINAL"); const P p = load_p();
        moe_tables(swave, p, lds);
        const int lane = otid(swave) & 63, gw = bx * NWAVES + (otid(swave) >> 6), NGW = G * NWAVES;
        float pscale = 1.f, pspike = 0.f;
#ifdef PROBE_A
        { const unsigned long long* ts = (const unsigned long long*)(WSP(unsigned, WS_CTL) + 65536 + bx * 32);
          const unsigned long long a0 = __hip_atomic_load(ts + PROBE_A, __ATOMIC_RELAXED, __HIP_MEMORY_SCOPE_AGENT), a1 = __hip_atomic_load(ts + PROBE_A + 1, __ATOMIC_RELAXED, __HIP_MEMORY_SCOPE_AGENT);
          const unsigned long long b0 = __hip_atomic_load(ts + PROBE_B, __ATOMIC_RELAXED, __HIP_MEMORY_SCOPE_AGENT), b1 = __hip_atomic_load(ts + PROBE_B + 1, __ATOMIC_RELAXED, __HIP_MEMORY_SCOPE_AGENT);
          pscale = 1.f + sqrtf((float)(a1 - a0) * 1e-5f); pspike = (float)(b1 - b0) * 0.1f; }
#endif
#pragma unroll 1
        for (int row = 4 * gw; row < T; row += 4 * NGW) { asm volatile("" ::: "memory"); final_rows<4>(p, (const LAS int*)(lds + LDSCTL_OFF) + LC_TSTART, row, lane, pscale, row == 0 ? pspike : 0.f); }
    }
#undef SEAM
#undef IN
}

#ifndef NAIVE_MASK
#define NAIVE_MASK 0
#endif
#ifndef MK_SPLIT
#define MK_SPLIT 0
#endif
static void launch_mk(const P& p, int lo, int hi, int li, hipStream_t s) {
    Args a{}; a.p = p; a.ph_lo = lo; a.ph_hi = hi; a.li = li; a.pad = 0;
    void* kargs[] = {&a};
    const hipError_t e = hipLaunchCooperativeKernel((const void*)mk_fwd, dim3(256), dim3(NTHR), kargs, LDS_BYTES, s);
    if (e != hipSuccess) fprintf(stderr, "kernel_launch: cooperative launch failed: %s\n", hipGetErrorString(e));
}
extern "C" void kernel_launch(void* const* d_in, const int* in_sizes, int n_in, void* d_out, int out_size, void* d_ws, size_t ws_size, hipStream_t stream) {
    if (n_in != 22 || ws_size < WS_END) { fprintf(stderr, "kernel_launch: unexpected n_in %d / ws %zu\n", n_in, ws_size); return; }
    static int inited = 0;
    if (!inited) { inited = 1;
        if (hipFuncSetAttribute((const void*)mk_fwd, hipFuncAttributeMaxDynamicSharedMemorySize, LDS_BYTES) != hipSuccess) fprintf(stderr, "kernel_launch: hipFuncSetAttribute failed\n"); }
    P p{};
    const float** f = (const float**)&p;
    for (int i = 0; i < 22; ++i) f[i] = (const float*)d_in[i];
    p.out = (float*)d_out; p.ws = (unsigned char*)d_ws;
    (void)hipMemsetAsync((char*)d_ws + WS_CTL, 0, 1 * MiB, stream);
    int li = 0;
    for (int k = 0; k < PH_N;) {
        int e = k + 1;
        if (!MK_SPLIT) while (e < PH_N && !((NAIVE_MASK >> e) & 1)) ++e;
        launch_mk(p, k, e, li++, stream);
        k = e;
    }
}
```

```cpp
#include <hip/hip_runtime.h>
#include <cstdio>
#include <cstdint>

typedef unsigned short bf16;
typedef float f32x4 __attribute__((ext_vector_type(4)));

constexpr int NB = 2, SEQ = 8192, D = 1024, T = NB * SEQ;
constexpr int NIN = 3072;
constexpr int NE = 32, HID = 512;
constexpr float ALPHA = 1.189207115002721f;
constexpr float LN_EPS = 1e-5f, RMS_EPS = 1e-6f;
constexpr int ROWS_PAD = 40960;

constexpr size_t MiB = 1u << 20;
constexpr size_t WS_CTL = 0;
constexpr size_t WS_SMALL = 1 * MiB;
constexpr size_t WS_LIST = 2 * MiB, WS_WLIST = 4 * MiB;
constexpr size_t WS_WINT = 6 * MiB, WS_WOUTT = 12 * MiB, WS_WUPT = 14 * MiB, WS_WDNT = 78 * MiB;
constexpr size_t WS_B = 110 * MiB;
constexpr size_t WS_QS = 142 * MiB, WS_V = 158 * MiB, WS_OG = 174 * MiB, WS_LOGF = 190 * MiB, WS_ZG = 222 * MiB;
constexpr size_t WS_Y = 142 * MiB, WS_ACT = 206 * MiB;
constexpr size_t WS_SLOC = 254 * MiB, WS_SSTART = 270 * MiB;
constexpr size_t WS_X1 = 286 * MiB, WS_Y2 = 350 * MiB, WS_END = 430 * MiB;
constexpr size_t SM_ADA = 0, SM_LB = 64 * 1024, SM_ROWBASE = 128 * 1024, SM_SGSTAT = 256 * 1024, SM_TOKE = 512 * 1024, SM_TOKS = 640 * 1024, SM_DTOT = 768 * 1024;
constexpr int CW_CNT = 1024;
constexpr int CW_ADA = 1088;
constexpr int CW_RDY = 131072;
constexpr int CW_PREPQ = 1152;

struct P {
    const float *x, *c, *w_ada, *b_ada, *w_in, *lb_logits, *hg_norm_w, *sg_ln_g, *sg_ln_b, *sg_w, *sg_b, *w_out, *ln1_g, *ln1_b,
        *rg_w, *rg_b, *re_w, *re_b, *w_up, *w_down, *ln2_g, *ln2_b;
    float* out; unsigned char* ws;
};

__device__ __forceinline__ float bf2f(bf16 b) { return __uint_as_float(((unsigned)b) << 16); }
__device__ __forceinline__ bf16 f2bf(float f) { unsigned u = __float_as_uint(f); return (bf16)((u + 0x7fffu + ((u >> 16) & 1u)) >> 16); }
__device__ __forceinline__ float silu_f(float x) { return x / (1.f + __expf(-x)); }
__device__ __forceinline__ float gelu_f(float x) { return 0.5f * x * (1.f + erff(x * 0.70710678118654752f)); }
__device__ __forceinline__ float wave_sum(float v) {
#pragma unroll
    for (int o = 1; o < 64; o <<= 1) v += __shfl_xor(v, o);
    return v;
}
#define WSP(type, off) ((type*)(p.ws + (off)))

__device__ __forceinline__ int updst(int n) { const int part = n >> 9, q = n & 511; return 256 * (q >> 7) + 128 * part + (q & 127); }

#define LAS __attribute__((address_space(3)))
#define GAS __attribute__((address_space(1)))
typedef short bf16x8 __attribute__((ext_vector_type(8)));
typedef unsigned u32x4 __attribute__((ext_vector_type(4)));
typedef unsigned u32x2 __attribute__((ext_vector_type(2)));
typedef float f32x2 __attribute__((ext_vector_type(2)));
constexpr int NWAVES = 8, NTHR = 512;
template <class Tv> __device__ __forceinline__ Tv ldg(const void* base, unsigned off) { return *(const Tv*)((const char*)base + off); }
template <class Tv> __device__ __forceinline__ void stg(void* base, unsigned off, Tv v) { *(Tv*)((char*)base + off) = v; }
#define DPP_ADD(v, ctrl, rmask) v += __int_as_float(__builtin_amdgcn_update_dpp(0, __float_as_int(v), ctrl, rmask, 0xF, false))
__device__ __forceinline__ float wave_sum_dpp(float v) {
    DPP_ADD(v, 0xB1, 0xF);
    DPP_ADD(v, 0x4E, 0xF);
    DPP_ADD(v, 0x141, 0xF);
    DPP_ADD(v, 0x140, 0xF);
    DPP_ADD(v, 0x142, 0xA);
    DPP_ADD(v, 0x143, 0xC);
    return __int_as_float(__builtin_amdgcn_readlane(__float_as_int(v), 63));
}
__device__ __forceinline__ int otid(int swave) { int l; asm volatile("v_mbcnt_lo_u32_b32 %0, -1, 0\n\tv_mbcnt_hi_u32_b32 %0, -1, %0" : "=v"(l)); return (swave << 6) | l; }
constexpr int RING_BYTES = 131072, LDSCTL_OFF = 147456, LDS_BYTES = 155648;
constexpr int LC_BAR = 0, LC_TSTART = 64  , LC_CNT = 128  , LC_RT = 256  , LC_LGS = 576  , LC_Q = 32  ;

__device__ __forceinline__ unsigned cvt_pk_bf16(float lo, float hi) { unsigned r; asm volatile("v_cvt_pk_bf16_f32 %0, %1, %2" : "=v"(r) : "v"(lo), "v"(hi)); return r; }
__device__ __forceinline__ float fast_sigmoid(float x) { return __builtin_amdgcn_rcpf(1.f + __expf(-x)); }
__device__ __forceinline__ f32x2 gelu_pk(f32x2 v) {
    const f32x2 av = __builtin_elementwise_abs(v), d = av * 0.2316418882f + 1.0f;
    f32x2 t; t.x = __builtin_amdgcn_rcpf(d.x); t.y = __builtin_amdgcn_rcpf(d.y);
    f32x2 q = t * 0.5307027145f + (-0.7265760135f); q = q * t + 0.7107068705f; q = q * t + (-0.142248368f); q = q * t + 0.127414796f; q = q * t;
    const f32x2 s = (v * v) * (-0.72134752044f);
    f32x2 e; e.x = __builtin_amdgcn_exp2f(s.x); e.y = __builtin_amdgcn_exp2f(s.y);
    const f32x2 m = v * (q * e), r = v - m;
    f32x2 o; o.x = v.x < 0.f ? m.x : r.x; o.y = v.y < 0.f ? m.y : r.y; return o;
}

namespace pg8 {
constexpr int BM = 256, BK = 64, HALF = 128, HTB = HALF * BK * 2, STAGE_BYTES = 8 * HTB, NXCD = 8, WGM = 8;
__host__ __device__ __forceinline__ int lds_byte(int r, int c) { const int st = (r >> 4) * 2 + (c >> 5), rr = r & 15, cc = c & 31, ob = rr * 64 + cc * 2; return st * 1024 + (ob ^ (((ob >> 9) & 1) << 5)); }
__host__ __device__ __forceinline__ void stage_rc(int b, int& R, int& C) { const int st = b / 1024, sb = b % 1024, swz = sb ^ (((sb >> 9) & 1) << 5); R = (st >> 1) * 16 + swz / 64; C = (st & 1) * 32 + (swz % 64) / 2; }
__host__ __device__ __forceinline__ int perm32(int rho) { const int n = rho >> 4, i = rho & 15; return 8 * (i >> 2) + 4 * n + (i & 3); }

struct Unit { int pm, pn, e, nvalid, r0, pad; };
struct Gemm { const bf16* A; const bf16* Bt; int K, pad; size_t bstride; const int* list; };

struct StaticOrder {
    int nM, nN, nwg, G, c;
    __device__ void init(int M, int N, int G_, int c_) { nM = M / BM; nN = N / BM; nwg = nM * nN; G = G_; c = c_; }
    __device__ bool next(int i, Unit& u) const {
        const long L = (long)i * G + c; if (L >= nwg) return false;
        int wgid = (int)L; { const int q = nwg / NXCD, r = nwg % NXCD, xcd = wgid % NXCD, off = wgid / NXCD; wgid = (xcd < r ? xcd * (q + 1) : r * (q + 1) + (xcd - r) * q) + off; }
        const int nig = WGM * nN, gid = wgid / nig, fm = gid * WGM, gsz = (nM - fm) < WGM ? (nM - fm) : WGM;
        u.pm = fm + ((wgid % nig) % gsz); u.pn = (wgid % nig) / gsz; u.e = 0; u.nvalid = 256; u.r0 = 0; u.pad = 0; return true;
    }
    __device__ __forceinline__ void a_ready(int, const Unit&) const {}
};
struct MoeOrder {
    const LAS int* tstart; const LAS int* cnt; int G, c, nN;
    __device__ bool next(int i, Unit& u) const {
        const int L = i * G + c, ntile = __builtin_amdgcn_readfirstlane(tstart[NE]); if (L >= ntile * nN) return false;
        const int tile = L / nN; u.pn = L % nN; u.pm = tile;
        int e = 0;
#pragma unroll 1
        for (int k = 1; k < NE; ++k) e = (tile >= tstart[k]) ? k : e;
        e = __builtin_amdgcn_readfirstlane(e); u.e = e; u.pm = __builtin_amdgcn_readfirstlane(u.pm); u.pn = __builtin_amdgcn_readfirstlane(u.pn);
        u.r0 = __builtin_amdgcn_readfirstlane((tile - tstart[e]) * 256); const int left = __builtin_amdgcn_readfirstlane(cnt[e]) - u.r0; u.nvalid = left < 256 ? left : 256; u.pad = 0; return true;
    }
    __device__ __forceinline__ void a_ready(int, const Unit&) const {}
};
struct MoeDownOrder {
    const LAS int* tstart; const LAS int* cnt; int G, cr, ntile, P, r; unsigned* ready;
    __device__ int tile_of(int idx) const {
        const int ne = 2 * (P - r);
        if (idx < ne) { const int q = idx / (P - r), m = idx - q * (P - r); return q * P + r + m; }
        const int k = idx - ne; if (k < 2 * r) { const int q = k / r, m = k - q * r; return q * P + m; }
        return 2 * P + (k - 2 * r);
    }
    __device__ bool next(int i, Unit& u) const {
        const int d = i * G + cr; if (d >= ntile * 4) return false;
        const int tile = tile_of(d >> 2); u.pn = d & 3; u.pm = tile;
        int e = 0;
#pragma unroll 1
        for (int k = 1; k < NE; ++k) e = (tile >= tstart[k]) ? k : e;
        e = __builtin_amdgcn_readfirstlane(e); u.e = e; u.pm = __builtin_amdgcn_readfirstlane(u.pm); u.pn = __builtin_amdgcn_readfirstlane(u.pn);
        u.r0 = __builtin_amdgcn_readfirstlane((tile - tstart[e]) * 256); const int left = __builtin_amdgcn_readfirstlane(cnt[e]) - u.r0; u.nvalid = left < 256 ? left : 256; u.pad = 0; return true;
    }
    __device__ __forceinline__ void a_ready(int swave, const Unit& u) const {
        if (swave == 0) { unsigned sp = 0;
            while ((unsigned)__builtin_amdgcn_readfirstlane(__hip_atomic_load(ready + 64 * u.pm, __ATOMIC_RELAXED, __HIP_MEMORY_SCOPE_AGENT)) < 4u && ++sp < (1u << 20)) __builtin_amdgcn_s_sleep(2);
            __builtin_amdgcn_fence(__ATOMIC_ACQUIRE, "agent");
            asm volatile("s_waitcnt vmcnt(0)" ::: "memory"); }
        asm volatile("" ::: "memory"); __builtin_amdgcn_s_barrier(); asm volatile("" ::: "memory");
    }
};

#define PG8_LAS LAS
template <class Epi, class Sched, bool ALIGN_EPI, bool SP2, bool GATHER>
__device__ __forceinline__ void gemm_phase(const int swave, PG8_LAS unsigned char* lds, const Gemm g, const Sched& S, const Epi& E) {
    const int tid = otid(swave), wid = __builtin_amdgcn_readfirstlane(tid >> 6), lane = tid & 63, wr = wid >> 2, wc = wid & 3, fr = lane & 15, fq = lane >> 4;
    const int K = g.K, nt = K / BK;
    unsigned voffB[2], vA[2][2], vAn[2][2]; int RA[2], CA[2];
#pragma unroll
    for (int i = 0; i < 2; ++i) { int R, C; stage_rc(tid * 16 + i * 8192, R, C); const int Rb = Epi::PERM ? ((R & ~31) + perm32(R & 31)) : R; RA[i] = R; CA[i] = C;
        voffB[i] = (unsigned)(Rb * K + C) * 2u;
#pragma unroll
        for (int h = 0; h < 2; ++h) { vA[h][i] = (unsigned)((h * HALF + R) * K + C) * 2u; vAn[h][i] = vA[h][i]; } }
    const size_t kstep = (size_t)(BK * 2);
    const size_t hstep = (size_t)HALF * K * 2;
    const size_t tstep = 2 * hstep;
    const unsigned ldsw = (unsigned)wid * 1024u;
    const int aoff = lds_byte(wr * 64 + fr, fq * 8), boff = lds_byte(wc * 32 + fr, fq * 8);
#define PG8_SA(b, h) (((b) * 2 + (h)) * HTB)
#define PG8_SB(b, h) ((4 + (b) * 2 + (h)) * HTB)
#define PG8_STAGE(bufoff, gbase, voff) do { _Pragma("unroll") for (int _i = 0; _i < 2; ++_i) \
        __builtin_amdgcn_global_load_lds((const unsigned*)((const char*)(gbase) + (voff)[_i]), (PG8_LAS unsigned*)(lds + (bufoff) + ldsw + _i * 8192), 16, 0, 0); } while (0)
#define PG8_LDA(dst, b, h) do { _Pragma("unroll") for (int m = 0; m < 4; ++m) _Pragma("unroll") for (int k = 0; k < 2; ++k) dst[m][k] = *(const PG8_LAS bf16x8*)(lds + PG8_SA(b, h) + aoff + m * 2048 + k * 1024); } while (0)
#define PG8_LDB(dst, b, h) do { _Pragma("unroll") for (int n = 0; n < 2; ++n) _Pragma("unroll") for (int k = 0; k < 2; ++k) dst[n][k] = *(const PG8_LAS bf16x8*)(lds + PG8_SB(b, h) + boff + n * 2048 + k * 1024); } while (0)
#define PG8_MMA(ai, bj, At, Bt) do { __builtin_amdgcn_s_setprio(1); _Pragma("unroll") for (int m = 0; m < 4; ++m) _Pragma("unroll") for (int n = 0; n < 2; ++n) _Pragma("unroll") for (int k = 0; k < 2; ++k) \
        acc[ai][bj][m][n] = __builtin_amdgcn_mfma_f32_16x16x32_bf16(Bt[n][k], At[m][k], acc[ai][bj][m][n], 0, 0, 0); __builtin_amdgcn_s_setprio(0); } while (0)
#define PG8_WAIT_V(n) asm volatile("s_waitcnt vmcnt(" #n ")" ::: "memory")
#define PG8_WAIT_L(n) asm volatile("s_waitcnt lgkmcnt(" #n ")" ::: "memory")
#define PG8_BAR __builtin_amdgcn_s_barrier()
#define PG8_SCHED __builtin_amdgcn_sched_barrier(0)
#define PG8_SETV(V, U) do { if constexpr (GATHER) { _Pragma("unroll") for (int _h = 0; _h < 2; ++_h) _Pragma("unroll") for (int _i = 0; _i < 2; ++_i) { const int _r = _h * HALF + RA[_i]; \
        const int _tok = _r < (U).nvalid ? g.list[(size_t)(U).e * T + (U).r0 + _r] : 0; V[_h][_i] = (unsigned)(_tok * K + CA[_i]) * 2u; } } } while (0)
    Unit cur, nxt; int ui = 0;
    if (!S.next(0, cur)) return;
    f32x4 acc[2][2][4][2];
#pragma unroll
    for (int a = 0; a < 2; ++a)
#pragma unroll
        for (int b = 0; b < 2; ++b)
#pragma unroll
            for (int m = 0; m < 4; ++m)
#pragma unroll
                for (int n = 0; n < 2; ++n) acc[a][b][m][n] = (f32x4){0.f, 0.f, 0.f, 0.f};
    bf16x8 At[4][2], B0[2][2], B1[2][2];
    PG8_SETV(vA, cur);
    S.a_ready(swave, cur);
    const char* cA = (const char*)g.A + (GATHER ? (size_t)0 : (size_t)cur.pm * tstep); const char* cB = (const char*)g.Bt + (size_t)cur.e * g.bstride + (size_t)cur.pn * tstep;
    if constexpr (SP2) {
        PG8_STAGE(PG8_SB(0, 0), cB, voffB); PG8_STAGE(PG8_SB(0, 1), cB + hstep, voffB); PG8_STAGE(PG8_SA(0, 0), cA, vA[0]); PG8_STAGE(PG8_SA(0, 1), cA, vA[1]);
        if (wr == 1) PG8_BAR;
        PG8_WAIT_V(2); PG8_BAR;
        PG8_STAGE(PG8_SB(1, 0), cB + kstep, voffB); PG8_STAGE(PG8_SA(1, 0), cA + kstep, vA[0]); PG8_STAGE(PG8_SB(1, 1), cB + hstep + kstep, voffB);
        PG8_WAIT_V(6); PG8_BAR;
    } else {
        PG8_STAGE(PG8_SB(0, 0), cB, voffB); PG8_STAGE(PG8_SA(0, 0), cA, vA[0]); PG8_STAGE(PG8_SB(0, 1), cB + hstep, voffB); PG8_STAGE(PG8_SA(0, 1), cA, vA[1]);
        if (wr == 1) PG8_BAR;
        PG8_WAIT_V(4); PG8_BAR;
        PG8_STAGE(PG8_SB(1, 0), cB + kstep, voffB); PG8_STAGE(PG8_SA(1, 0), cA + kstep, vA[0]); PG8_STAGE(PG8_SB(1, 1), cB + hstep + kstep, voffB);
        PG8_WAIT_V(6); PG8_BAR;
    }
    for (;;) {
        const bool has_next = S.next(ui + 1, nxt);
        if (has_next) PG8_SETV(vAn, nxt);
        const char* nA = has_next ? (const char*)g.A + (GATHER ? (size_t)0 : (size_t)nxt.pm * tstep) : cA; const char* nB = has_next ? (const char*)g.Bt + (size_t)nxt.e * g.bstride + (size_t)nxt.pn * tstep : cB;
        for (int t = 0; t < nt; t += 2) {
            const bool last = (t == nt - 2);
            if (last && has_next) S.a_ready(swave, nxt);
            const char* a1 = cA + (size_t)(t + 1) * kstep;
            const char* a2 = last ? nA : cA + (size_t)(t + 2) * kstep; const char* b2 = last ? nB : cB + (size_t)(t + 2) * kstep;
            const char* a3 = a2 + kstep; const char* b3 = b2 + kstep;
            unsigned v2[2][2];
#pragma unroll
            for (int h = 0; h < 2; ++h)
#pragma unroll
                for (int i = 0; i < 2; ++i) v2[h][i] = (GATHER && last && has_next) ? vAn[h][i] : vA[h][i];
            if constexpr (SP2) {
            PG8_LDB(B0, 0, 0); PG8_LDB(B1, 0, 1); PG8_SCHED; PG8_LDA(At, 0, 0); PG8_STAGE(PG8_SA(1, 1), a1, vA[1]);
            PG8_WAIT_V(8); PG8_WAIT_L(0); PG8_BAR; PG8_MMA(0, 0, At, B0); PG8_MMA(0, 1, At, B1); PG8_BAR; PG8_SCHED;
            PG8_LDA(At, 0, 1); PG8_STAGE(PG8_SB(0, 0), b2, voffB); PG8_STAGE(PG8_SB(0, 1), b2 + hstep, voffB); PG8_STAGE(PG8_SA(0, 0), a2, v2[0]);
            PG8_WAIT_V(8); PG8_WAIT_L(0); PG8_BAR; PG8_MMA(1, 0, At, B0); PG8_MMA(1, 1, At, B1); PG8_BAR; PG8_SCHED;
            PG8_LDB(B0, 1, 0); PG8_LDB(B1, 1, 1); PG8_SCHED; PG8_LDA(At, 1, 0); PG8_STAGE(PG8_SA(0, 1), a2, v2[1]);
            PG8_WAIT_V(8); PG8_WAIT_L(0); PG8_BAR; PG8_MMA(0, 0, At, B0); PG8_MMA(0, 1, At, B1); PG8_BAR; PG8_SCHED;
            PG8_LDA(At, 1, 1); PG8_STAGE(PG8_SB(1, 0), b3, voffB); PG8_STAGE(PG8_SB(1, 1), b3 + hstep, voffB); PG8_STAGE(PG8_SA(1, 0), a3, v2[0]);
            PG8_WAIT_V(8); PG8_WAIT_L(0); PG8_BAR; PG8_MMA(1, 0, At, B0); PG8_MMA(1, 1, At, B1); PG8_BAR; PG8_SCHED;
            } else {
            PG8_LDB(B0, 0, 0); PG8_SCHED; PG8_LDA(At, 0, 0); PG8_STAGE(PG8_SA(1, 1), a1, vA[1]);
            PG8_WAIT_L(8); PG8_BAR; PG8_WAIT_L(0); PG8_MMA(0, 0, At, B0); PG8_BAR; PG8_SCHED;
            PG8_LDB(B1, 0, 1); PG8_STAGE(PG8_SB(0, 0), b2, voffB);
            PG8_BAR; PG8_WAIT_L(0); PG8_MMA(0, 1, At, B1); PG8_BAR;
            PG8_LDA(At, 0, 1); PG8_STAGE(PG8_SA(0, 0), a2, v2[0]);
            PG8_BAR; PG8_WAIT_L(0); PG8_MMA(1, 0, At, B0); PG8_BAR; PG8_SCHED;
            PG8_STAGE(PG8_SB(0, 1), b2 + hstep, voffB);
            PG8_WAIT_V(6); PG8_BAR; PG8_MMA(1, 1, At, B1); PG8_BAR;
            PG8_LDB(B0, 1, 0); PG8_SCHED; PG8_LDA(At, 1, 0); PG8_STAGE(PG8_SA(0, 1), a2, v2[1]);
            PG8_WAIT_L(8); PG8_BAR; PG8_WAIT_L(0); PG8_MMA(0, 0, At, B0); PG8_BAR; PG8_SCHED;
            PG8_LDB(B1, 1, 1); PG8_STAGE(PG8_SB(1, 0), b3, voffB);
            PG8_BAR; PG8_WAIT_L(0); PG8_MMA(0, 1, At, B1); PG8_BAR;
            PG8_LDA(At, 1, 1); PG8_STAGE(PG8_SA(1, 0), a3, v2[0]);
            PG8_BAR; PG8_WAIT_L(0); PG8_MMA(1, 0, At, B0); PG8_BAR; PG8_SCHED;
            PG8_STAGE(PG8_SB(1, 1), b3 + hstep, voffB);
            PG8_WAIT_V(6); PG8_BAR; PG8_MMA(1, 1, At, B1); PG8_BAR;
            }
        }
        if constexpr (ALIGN_EPI) { if (wr == 0) PG8_BAR; }
        E(acc, cur, wr, wc, fr, fq);
        if (!has_next) break;
#pragma unroll
        for (int a = 0; a < 2; ++a)
#pragma unroll
            for (int b = 0; b < 2; ++b)
#pragma unroll
                for (int m = 0; m < 4; ++m)
#pragma unroll
                    for (int n = 0; n < 2; ++n) acc[a][b][m][n] = (f32x4){0.f, 0.f, 0.f, 0.f};
        cur = nxt; cA = nA; cB = nB; ++ui;
        if constexpr (GATHER) {
#pragma unroll
            for (int h = 0; h < 2; ++h)
#pragma unroll
                for (int i = 0; i < 2; ++i) vA[h][i] = vAn[h][i]; }
        if constexpr (ALIGN_EPI) { if (wr == 1) PG8_BAR; }
    }
    PG8_WAIT_V(0);
    if constexpr (!ALIGN_EPI) { if (wr == 0) PG8_BAR; }
    PG8_BAR;
#undef PG8_SA
#undef PG8_SB
#undef PG8_STAGE
#undef PG8_LDA
#undef PG8_LDB
#undef PG8_MMA
#undef PG8_WAIT_V
#undef PG8_WAIT_L
#undef PG8_BAR
#undef PG8_SCHED
#undef PG8_SETV
}

struct EpiInproj {
    static constexpr bool PERM = true;
    unsigned char* ws;
    __device__ __forceinline__ void operator()(const f32x4 (&acc)[2][2][4][2], const Unit& u, int wr, int wc, int fr, int fq) const {
        unsigned char* wsb = ws; asm volatile("" : "+v"(wsb));
        bf16* QVO = (bf16*)(wsb + WS_QS); bf16* ZG = (bf16*)(wsb + WS_ZG); float* LOGF = (float*)(wsb + WS_LOGF); const float* LB = (const float*)(wsb + WS_SMALL + SM_LB);
        const int row0 = u.pm * BM + wr * 64 + fr, seg = u.pn >> 1, cin = (u.pn & 1) * 256 + wc * 32 + 8 * fq;
        if (seg == 1) {
            f32x4 lb[2][2];
#pragma unroll
            for (int bj = 0; bj < 2; ++bj)
#pragma unroll
                for (int n = 0; n < 2; ++n) lb[bj][n] = *(const f32x4*)(LB + cin + bj * HALF + 4 * n);
#pragma unroll
            for (int ai = 0; ai < 2; ++ai)
#pragma unroll
                for (int m = 0; m < 4; ++m) { float* rowp = LOGF + (size_t)(row0 + ai * HALF + m * 16) * 512 + cin;
#pragma unroll
                    for (int bj = 0; bj < 2; ++bj)
#pragma unroll
                        for (int n = 0; n < 2; ++n) { f32x4 o;
#pragma unroll
                            for (int j = 0; j < 4; ++j) { const float l = lb[bj][n][j]; o[j] = __logf(l + (1.f - l) * fast_sigmoid(acc[ai][bj][m][n][j])); }
                            *(f32x4*)(rowp + bj * HALF + 4 * n) = o; } }
            return;
        }
        if (seg >= 4) {
            const int cz = (u.pn - 8) * 256 + wc * 32 + 8 * fq;
#pragma unroll
            for (int ai = 0; ai < 2; ++ai)
#pragma unroll
                for (int m = 0; m < 4; ++m) { bf16* rowp = ZG + (size_t)(row0 + ai * HALF + m * 16) * 1024 + cz;
#pragma unroll
                    for (int bj = 0; bj < 2; ++bj) { const f32x4 v0 = acc[ai][bj][m][0], v1 = acc[ai][bj][m][1];
                        const f32x2 a = gelu_pk((f32x2){v0[0], v0[1]}), b = gelu_pk((f32x2){v0[2], v0[3]}), c = gelu_pk((f32x2){v1[0], v1[1]}), d = gelu_pk((f32x2){v1[2], v1[3]});
                        u32x4 w; w.x = cvt_pk_bf16(a.x, a.y); w.y = cvt_pk_bf16(b.x, b.y); w.z = cvt_pk_bf16(c.x, c.y); w.w = cvt_pk_bf16(d.x, d.y);
                        *(u32x4*)(rowp + bj * HALF) = w; } }
            return;
        }
        bf16* base = QVO + (size_t)(seg == 0 ? 0 : seg - 1) * (8u << 20); const bool act = seg != 2;
#pragma unroll
        for (int ai = 0; ai < 2; ++ai)
#pragma unroll
            for (int m = 0; m < 4; ++m) { bf16* rowp = base + (size_t)(row0 + ai * HALF + m * 16) * 512 + cin;
#pragma unroll
                for (int bj = 0; bj < 2; ++bj) { f32x4 v0 = acc[ai][bj][m][0], v1 = acc[ai][bj][m][1];
                    if (act) {
#pragma unroll
                        for (int j = 0; j < 4; ++j) { v0[j] = v0[j] * fast_sigmoid(v0[j]); v1[j] = v1[j] * fast_sigmoid(v1[j]); } }
                    u32x4 w; w.x = cvt_pk_bf16(v0[0], v0[1]); w.y = cvt_pk_bf16(v0[2], v0[3]); w.z = cvt_pk_bf16(v1[0], v1[1]); w.w = cvt_pk_bf16(v1[2], v1[3]);
                    *(u32x4*)(rowp + bj * HALF) = w; } }
    }
};
struct EpiBf16 {
    static constexpr bool PERM = true;
    unsigned char* ws; size_t off; int ldc;
    __device__ __forceinline__ void operator()(const f32x4 (&acc)[2][2][4][2], const Unit& u, int wr, int wc, int fr, int fq) const {
        unsigned char* wsb = ws; asm volatile("" : "+v"(wsb)); bf16* O = (bf16*)(wsb + off);
        const int row0 = u.pm * BM + wr * 64 + fr, col0 = u.pn * BM + wc * 32 + 8 * fq;
#pragma unroll
        for (int ai = 0; ai < 2; ++ai)
#pragma unroll
            for (int m = 0; m < 4; ++m) { bf16* rowp = O + (size_t)(row0 + ai * HALF + m * 16) * ldc + col0;
#pragma unroll
                for (int bj = 0; bj < 2; ++bj) { const f32x4 v0 = acc[ai][bj][m][0], v1 = acc[ai][bj][m][1];
                    u32x4 w; w.x = cvt_pk_bf16(v0[0], v0[1]); w.y = cvt_pk_bf16(v0[2], v0[3]); w.z = cvt_pk_bf16(v1[0], v1[1]); w.w = cvt_pk_bf16(v1[2], v1[3]);
                    *(u32x4*)(rowp + bj * HALF) = w; } }
    }
};
struct EpiUp {
    static constexpr bool PERM = true;
    unsigned char* ws;
    __device__ __forceinline__ void operator()(const f32x4 (&acc)[2][2][4][2], const Unit& u, int wr, int wc, int fr, int fq) const {
        unsigned char* wsb = ws; asm volatile("" : "+v"(wsb)); bf16* ACT = (bf16*)(wsb + WS_ACT);
        const int row0 = u.pm * BM + wr * 64 + fr, col0 = u.pn * HALF + wc * 32 + 8 * fq;
#pragma unroll
        for (int ai = 0; ai < 2; ++ai)
#pragma unroll
            for (int m = 0; m < 4; ++m) { bf16* rowp = ACT + (size_t)(row0 + ai * HALF + m * 16) * HID + col0;
                f32x4 o0, o1;
#pragma unroll
                for (int j = 0; j < 4; ++j) { const float g0 = acc[ai][0][m][0][j], g1 = acc[ai][0][m][1][j]; o0[j] = g0 * fast_sigmoid(g0) * acc[ai][1][m][0][j]; o1[j] = g1 * fast_sigmoid(g1) * acc[ai][1][m][1][j]; }
                u32x4 w; w.x = cvt_pk_bf16(o0[0], o0[1]); w.y = cvt_pk_bf16(o0[2], o0[3]); w.z = cvt_pk_bf16(o1[0], o1[1]); w.w = cvt_pk_bf16(o1[2], o1[3]);
                *(u32x4*)rowp = w; }
    }
};
struct EpiDown {
    static constexpr bool PERM = true;
    unsigned char* ws;
    __device__ __forceinline__ void operator()(const f32x4 (&acc)[2][2][4][2], const Unit& u, int wr, int wc, int fr, int fq) const {
        unsigned char* wsb = ws; asm volatile("" : "+v"(wsb)); bf16* Y2 = (bf16*)(wsb + WS_Y2); const float* WL = (const float*)(wsb + WS_WLIST);
        const int rt0 = wr * 64 + fr, col0 = u.pn * BM + wc * 32 + 8 * fq;
#pragma unroll
        for (int ai = 0; ai < 2; ++ai)
#pragma unroll
            for (int m = 0; m < 4; ++m) { const int rt = rt0 + ai * HALF + m * 16; const float w8 = rt < u.nvalid ? WL[(size_t)u.e * T + u.r0 + rt] : 0.f;
                bf16* rowp = Y2 + (size_t)(u.pm * BM + rt) * D + col0;
#pragma unroll
                for (int bj = 0; bj < 2; ++bj) { const f32x4 v0 = acc[ai][bj][m][0] * w8, v1 = acc[ai][bj][m][1] * w8;
                    u32x4 w; w.x = cvt_pk_bf16(v0[0], v0[1]); w.y = cvt_pk_bf16(v0[2], v0[3]); w.z = cvt_pk_bf16(v1[0], v1[1]); w.w = cvt_pk_bf16(v1[2], v1[3]);
                    *(u32x4*)(rowp + bj * HALF) = w; } }
    }
};
}


__device__ __forceinline__ f32x4 mma16(bf16x8 a, bf16x8 b, f32x4 c) { return __builtin_amdgcn_mfma_f32_16x16x32_bf16(a, b, c, 0, 0, 0); }
__device__ __forceinline__ bf16x8 frag(const LAS bf16* X, int stride, int rb, int ks, int lane) { return *(const LAS bf16x8*)(X + (rb * 16 + (lane & 15)) * stride + ks * 32 + 8 * (lane >> 4)); }
constexpr int MX_QD = 0, MX_KD = 17408, MX_KDT = 34816, MX_VT = 53248, MX_PT = 71680, MX_STT = 80896, MX_SMALL = 115712;
constexpr int SD = 136, SS = 72, SO = 132;
template <int MODE> __device__ __forceinline__ void hgrn_item(const int swave, const P& p, LAS unsigned char* lds, int item) {
    const int tid = otid(swave), lane = tid & 63, w = __builtin_amdgcn_readfirstlane(tid >> 6), q4 = lane >> 4, r16 = lane & 15;
    const int bh = item >> 5, sc = item & 31, b = bh >> 2, h = bh & 3;
    const size_t row0 = (size_t)b * SEQ + (size_t)sc * 256;
    LAS bf16* QD = (LAS bf16*)(lds + MX_QD); LAS bf16* KD = (LAS bf16*)(lds + MX_KD); LAS bf16* KDT = (LAS bf16*)(lds + MX_KDT); LAS bf16* VT = (LAS bf16*)(lds + MX_VT);
    LAS bf16* PT = (LAS bf16*)(lds + MX_PT); LAS bf16* STT = (LAS bf16*)(lds + MX_STT); LAS float* O = (LAS float*)(lds + MX_QD);
    LAS float* tot = (LAS float*)(lds + MX_SMALL); LAS float* ecm = tot + 512; LAS float* elast = ecm + 128; LAS float* efac = elast + 128;
    const bf16* QS = WSP(bf16, WS_QS); const float* LF = WSP(float, WS_LOGF); const bf16* VV = WSP(bf16, WS_V); const bf16* OG = WSP(bf16, WS_OG); bf16* YC = WSP(bf16, WS_B);
    const int col = tid & 127, g = tid >> 7;
    f32x4 S[8];
#pragma unroll
    for (int db = 0; db < 8; ++db) {
        if (MODE == 1) {
#pragma unroll
            for (int r = 0; r < 4; ++r) S[db][r] = WSP(float, WS_SSTART)[(size_t)item * 16384 + (16 * w + 4 * q4 + r) * 128 + 16 * db + r16];
        } else S[db] = (f32x4){0.f, 0.f, 0.f, 0.f}; }
    float lastsum = 0.f;
    float lf[16]; bf16 qv[16], vv[16];
    unsigned ogp[8];
#define HG_LOAD(c_) do { const size_t rowc_ = row0 + 64 * (c_) + 16 * g; _Pragma("unroll") for (int i = 0; i < 16; ++i) { const size_t o = (rowc_ + i) * 512 + h * 128 + col; lf[i] = LF[o]; vv[i] = VV[o]; qv[i] = MODE == 1 ? QS[o] : (bf16)0; } } while (0)
#define HG_LOADG(c_) do { if (MODE == 1) { _Pragma("unroll") for (int rr = 0; rr < 8; ++rr) ogp[rr] = *(const unsigned*)(OG + (row0 + 64 * (c_) + 8 * w + rr) * 512 + h * 128 + 2 * lane); } } while (0)
    HG_LOAD(0);
#pragma unroll 1
    for (int c = 0; c < 4; ++c) {
        float run = 0.f;
#pragma unroll
        for (int i = 0; i < 16; ++i) { run += lf[i]; }
        tot[g * 128 + col] = run;
        __syncthreads();
        const float t0 = tot[col], t1 = tot[128 + col], t2 = tot[256 + col], t3 = tot[384 + col];
        const float cstart = g == 0 ? 0.f : (g == 1 ? t0 : (g == 2 ? t0 + t1 : t0 + t1 + t2));
        const float cmid = t0 + t1, last = (t0 + t1) + (t2 + t3);
        if (g == 0) { ecm[col] = __expf(cmid); elast[col] = __expf(last); efac[col] = __expf(last - cmid); lastsum += last; }
        {
            float cum = cstart; unsigned kt[8], vt[8];
#pragma unroll
            for (int i = 0; i < 16; i += 2) {
                float kd2[2];
#pragma unroll
                for (int j = 0; j < 2; ++j) { cum += lf[i + j]; const float kk = 1.f - __expf(lf[i + j]); const float ek = __expf(fminf(cmid - cum, 80.f)); kd2[j] = kk * ek;
                    const bf16 kb = f2bf(kd2[j]);
                    if (MODE == 1) { const float eq = __expf(fminf(cum - cmid, 80.f)); QD[(16 * g + i + j) * SD + col] = f2bf(bf2f(qv[i + j]) * eq); KD[(16 * g + i + j) * SD + col] = kb; } }
                kt[i >> 1] = cvt_pk_bf16(kd2[0], kd2[1]); vt[i >> 1] = (unsigned)vv[i] | ((unsigned)vv[i + 1] << 16);
            }
            *(LAS u32x4*)(KDT + col * SS + 16 * g) = (u32x4){kt[0], kt[1], kt[2], kt[3]}; *(LAS u32x4*)(KDT + col * SS + 16 * g + 8) = (u32x4){kt[4], kt[5], kt[6], kt[7]};
            *(LAS u32x4*)(VT + col * SS + 16 * g) = (u32x4){vt[0], vt[1], vt[2], vt[3]}; *(LAS u32x4*)(VT + col * SS + 16 * g + 8) = (u32x4){vt[4], vt[5], vt[6], vt[7]};
        }
        __syncthreads();
        if (c < 3) HG_LOAD(c + 1);
        f32x4 o[4]; const int tb = w & 3, vb0 = (w >> 2) * 4;
        if (MODE == 1) {
#pragma unroll
            for (int db = 0; db < 8; ++db) { const float e = ecm[16 * db + r16];
#pragma unroll
                for (int r = 0; r < 4; ++r) STT[(16 * w + 4 * q4 + r) * SD + 16 * db + r16] = f2bf(S[db][r] * e); }
#pragma unroll
            for (int k = 0; k < 2; ++k) { const int tile = w + 8 * k, stb = tile >> 2, ssb = tile & 3; f32x4 a = (f32x4){0.f, 0.f, 0.f, 0.f};
                if (ssb <= stb) {
#pragma unroll
                    for (int ks = 0; ks < 4; ++ks) a = mma16(frag(QD, SD, stb, ks, lane), frag(KD, SD, ssb, ks, lane), a); }
#pragma unroll
                for (int r = 0; r < 4; ++r) { const int t = stb * 16 + 4 * q4 + r, s_ = ssb * 16 + r16; PT[t * SS + s_] = (s_ <= t) ? f2bf(a[r]) : (bf16)0; } }
            __syncthreads();
            bf16x8 ap[2], aq[4];
#pragma unroll
            for (int ks = 0; ks < 2; ++ks) ap[ks] = frag(PT, SS, tb, ks, lane);
#pragma unroll
            for (int ks = 0; ks < 4; ++ks) aq[ks] = frag(QD, SD, tb, ks, lane);
#pragma unroll
            for (int j = 0; j < 4; ++j) { f32x4 a = (f32x4){0.f, 0.f, 0.f, 0.f};
#pragma unroll
                for (int ks = 0; ks < 2; ++ks) a = mma16(ap[ks], frag(VT, SS, vb0 + j, ks, lane), a);
#pragma unroll
                for (int ks = 0; ks < 4; ++ks) a = mma16(aq[ks], frag(STT, SD, vb0 + j, ks, lane), a);
                o[j] = a; }
        }
        {
            bf16x8 av[2];
#pragma unroll
            for (int ks = 0; ks < 2; ++ks) av[ks] = frag(VT, SS, w, ks, lane);
#pragma unroll
            for (int db = 0; db < 8; ++db) { f32x4 u = (f32x4){0.f, 0.f, 0.f, 0.f};
#pragma unroll
                for (int ks = 0; ks < 2; ++ks) u = mma16(av[ks], frag(KDT, SS, db, ks, lane), u);
                const float el = elast[16 * db + r16], ef = efac[16 * db + r16];
                S[db] = S[db] * el + u * ef; }
        }
        HG_LOADG(c);
        if (MODE == 1) {
            __syncthreads();
#pragma unroll
            for (int j = 0; j < 4; ++j)
#pragma unroll
                for (int r = 0; r < 4; ++r) O[(tb * 16 + 4 * q4 + r) * SO + (vb0 + j) * 16 + r16] = o[j][r];
            __syncthreads();
            const f32x2 gw = *(const f32x2*)(p.hg_norm_w + 2 * lane);
#pragma unroll
            for (int rr = 0; rr < 8; ++rr) { const int t = 8 * w + rr; const size_t row = row0 + 64 * c + t;
                const f32x2 ov = *(const LAS f32x2*)(O + t * SO + 2 * lane);
                const float ss = wave_sum_dpp(ov.x * ov.x + ov.y * ov.y); const float rs = rsqrtf(ss * (1.f / 128.f) + RMS_EPS);
                const float y0 = ov.x * rs * gw.x * __uint_as_float(ogp[rr] << 16), y1 = ov.y * rs * gw.y * __uint_as_float(ogp[rr] & 0xffff0000u);
                *(unsigned*)(YC + row * D + h * 128 + 2 * lane) = cvt_pk_bf16(y0, y1); }
        }
    }
    if (MODE == 0) {
#pragma unroll
        for (int db = 0; db < 8; ++db)
#pragma unroll
            for (int r = 0; r < 4; ++r) WSP(float, WS_SLOC)[(size_t)item * 16384 + (16 * w + 4 * q4 + r) * 128 + 16 * db + r16] = S[db][r];
        if (g == 0) WSP(float, WS_SMALL + SM_DTOT)[item * 128 + col] = __expf(lastsum);
    }
    __syncthreads();
#undef HG_LOAD
#undef HG_LOADG
}
__device__ __forceinline__ void hgrn_scan(const P& p, int gid) {
    const int bh = gid >> 14, idx = gid & 16383, d = idx & 127;
    const float* SL = WSP(float, WS_SLOC) + (size_t)bh * 32 * 16384 + idx; float* ST = WSP(float, WS_SSTART) + (size_t)bh * 32 * 16384 + idx; const float* DT = WSP(float, WS_SMALL + SM_DTOT) + bh * 32 * 128 + d;
    float s = 0.f;
#pragma unroll 8
    for (int sc = 0; sc < 32; ++sc) { ST[(size_t)sc * 16384] = s; s = s * DT[sc * 128] + SL[(size_t)sc * 16384]; }
}
__device__ __forceinline__ void sg_item(const int swave, const P& p, LAS unsigned char* lds, int item) {
    const int tid = otid(swave), lane = tid & 63, w = __builtin_amdgcn_readfirstlane(tid >> 6), q4 = lane >> 4, r16 = lane & 15;
    const int b = item >> 8, n = (item >> 2) & 63, g = item & 3; const size_t row0 = (size_t)b * SEQ + (size_t)n * 128;
    LAS bf16* VNT = (LAS bf16*)lds; LAS bf16* WT = (LAS bf16*)(lds + 34816); LAS float* mean = (LAS float*)(lds + 69632); LAS float* rstd = mean + 128; LAS float* OM = (LAS float*)(lds + 71680);
    const bf16* ZG = WSP(bf16, WS_ZG); bf16* YC = WSP(bf16, WS_B);
    {
        bf16x8 z[16];
#pragma unroll
        for (int rr = 0; rr < 16; ++rr) z[rr] = ldg<bf16x8>(ZG + (row0 + 16 * w + rr) * 1024 + 512, (unsigned)lane * 16u);
#pragma unroll
        for (int rr = 0; rr < 16; ++rr) { float s1 = 0.f, s2 = 0.f;
#pragma unroll
            for (int j = 0; j < 8; ++j) { const float v = bf2f((bf16)z[rr][j]); s1 += v; s2 += v * v; }
            const float m = wave_sum_dpp(s1) * (1.f / 512.f); const float var = fmaxf(wave_sum_dpp(s2) * (1.f / 512.f) - m * m, 0.f);
            if (lane == 0) { mean[16 * w + rr] = m; rstd[16 * w + rr] = rsqrtf(var + LN_EPS); } }
    }
    {
        const int t = tid >> 2, seg = tid & 3; const float* wr = p.sg_w + ((size_t)(g * 128 + t)) * 128 + seg * 32;
#pragma unroll
        for (int j = 0; j < 4; ++j) { const f32x4 a = *(const f32x4*)(wr + 8 * j), c = *(const f32x4*)(wr + 8 * j + 4); const int s0 = seg * 32 + 8 * j; u32x4 o;
            o.x = cvt_pk_bf16(s0 + 0 <= t ? a[0] : 0.f, s0 + 1 <= t ? a[1] : 0.f); o.y = cvt_pk_bf16(s0 + 2 <= t ? a[2] : 0.f, s0 + 3 <= t ? a[3] : 0.f);
            o.z = cvt_pk_bf16(s0 + 4 <= t ? c[0] : 0.f, s0 + 5 <= t ? c[1] : 0.f); o.w = cvt_pk_bf16(s0 + 6 <= t ? c[2] : 0.f, s0 + 7 <= t ? c[3] : 0.f);
            *(LAS u32x4*)(WT + t * SD + s0) = o; }
    }
    const int c = tid & 127, sgp = tid >> 7;
    bf16 zc[32];
#pragma unroll
    for (int i = 0; i < 32; ++i) zc[i] = ZG[(row0 + 32 * sgp + i) * 1024 + 512 + g * 128 + c];
    __syncthreads();
    {
        const float lg = p.sg_ln_g[g * 128 + c], lb = p.sg_ln_b[g * 128 + c];
#pragma unroll
        for (int i8 = 0; i8 < 4; ++i8) { float vn[8];
#pragma unroll
            for (int j = 0; j < 8; ++j) { const int s_ = 32 * sgp + 8 * i8 + j; vn[j] = (bf2f(zc[8 * i8 + j]) - mean[s_]) * rstd[s_] * lg + lb; }
            *(LAS u32x4*)(VNT + c * SD + 32 * sgp + 8 * i8) = (u32x4){cvt_pk_bf16(vn[0], vn[1]), cvt_pk_bf16(vn[2], vn[3]), cvt_pk_bf16(vn[4], vn[5]), cvt_pk_bf16(vn[6], vn[7])}; }
    }
    __syncthreads();
    bf16x8 aw[4];
#pragma unroll
    for (int ks = 0; ks < 4; ++ks) aw[ks] = frag(WT, SD, w, ks, lane);
#pragma unroll
    for (int cb = 0; cb < 8; ++cb) { f32x4 a = (f32x4){0.f, 0.f, 0.f, 0.f};
#pragma unroll
        for (int ks = 0; ks < 4; ++ks) a = mma16(aw[ks], frag(VNT, SD, cb, ks, lane), a);
#pragma unroll
        for (int r = 0; r < 4; ++r) OM[(16 * w + 4 * q4 + r) * SO + 16 * cb + r16] = a[r]; }
    __syncthreads();
    {
        const int t = tid >> 2, cs = (tid & 3) * 32; const float sb = p.sg_b[g * 128 + t];
        const bf16* up = ZG + (row0 + t) * 1024 + g * 128 + cs; bf16* op = YC + (row0 + t) * D + 512 + g * 128 + cs;
#pragma unroll
        for (int k = 0; k < 4; ++k) { const u32x4 uu = *(const u32x4*)(up + 8 * k); const f32x4 m0 = *(const LAS f32x4*)(OM + t * SO + cs + 8 * k), m1 = *(const LAS f32x4*)(OM + t * SO + cs + 8 * k + 4);
            u32x4 o;
            o.x = cvt_pk_bf16(__uint_as_float(uu.x << 16) * (m0[0] + sb), __uint_as_float(uu.x & 0xffff0000u) * (m0[1] + sb)); o.y = cvt_pk_bf16(__uint_as_float(uu.y << 16) * (m0[2] + sb), __uint_as_float(uu.y & 0xffff0000u) * (m0[3] + sb));
            o.z = cvt_pk_bf16(__uint_as_float(uu.z << 16) * (m1[0] + sb), __uint_as_float(uu.z & 0xffff0000u) * (m1[1] + sb)); o.w = cvt_pk_bf16(__uint_as_float(uu.w << 16) * (m1[2] + sb), __uint_as_float(uu.w & 0xffff0000u) * (m1[3] + sb));
            *(u32x4*)(op + 8 * k) = o; }
    }
    __syncthreads();
}

typedef GAS unsigned gu32;
#define XB_TMO      128
#define XB_XCNT(j)  (256  + 64 * (j))
#define XB_XSUB(j)  (1280 + 64 * (j))
#define XB_XGEN(j)  (2304 + 64 * (j))
#define XB_TOP      3328
#define XB_TOPGEN   3392
#define XCD_BAR_WORDS 3456
#define XB_SPIN_CAP (1u << 18)
__device__ __forceinline__ unsigned xb_ld(unsigned* p)              { return __hip_atomic_load(p, __ATOMIC_RELAXED, __HIP_MEMORY_SCOPE_AGENT); }
__device__ __forceinline__ unsigned xb_add(unsigned* p, unsigned v) { return __hip_atomic_fetch_add(p, v, __ATOMIC_RELAXED, __HIP_MEMORY_SCOPE_AGENT); }
__device__ __forceinline__ unsigned xb_xcc_id() { return (unsigned)__builtin_amdgcn_s_getreg((3 << 11) | 20) & 0xFu; }
#define XB_SPIN(cond, bar) do { unsigned _sp = 0; while (cond) { __builtin_amdgcn_s_sleep(1); \
    if ((++_sp & 255u) == 0u) { if (xb_ld(&(bar)[XB_TMO])) break; if (_sp > XB_SPIN_CAP) { atomicAdd(&(bar)[XB_TMO], 1u); break; } } } } while (0)
struct XcdBarrier { unsigned* bar; unsigned x; volatile LAS unsigned* st; };
__device__ __forceinline__ XcdBarrier xcd_barrier_post(const int swave, unsigned* bar, volatile LAS unsigned* st) {
    XcdBarrier b; b.bar = bar; b.x = xb_xcc_id(); b.st = st;
    if (otid(swave) == 0) (void)xb_add(&bar[XB_XCNT(b.x)], 1u);
    return b;
}
__device__ __forceinline__ void xcd_barrier_complete(unsigned* bar, unsigned x, unsigned& nloc, unsigned& nx) {
    const unsigned G = gridDim.x * gridDim.y * gridDim.z;
    unsigned sum, cnt, mine, sp = 0u;
    for (;;) {
        sum = 0u; cnt = 0u; mine = 0u;
#pragma unroll
        for (unsigned j = 0; j < 16; ++j) { const unsigned c = xb_ld(&bar[XB_XCNT(j)]); sum += c; cnt += (c > 0u) ? 1u : 0u; mine = (j == x) ? c : mine; }
        if (sum == G) break;
        __builtin_amdgcn_s_sleep(1);
        if ((++sp & 255u) == 0u) { if (xb_ld(&bar[XB_TMO])) break; if (sp > XB_SPIN_CAP) { atomicAdd(&bar[XB_TMO], 1u); break; } }
    }
    nloc = mine > 0u ? mine : 1u; nx = cnt > 0u ? cnt : 1u;
}
__device__ __forceinline__ void xcd_barrier(const int swave, const XcdBarrier& b) {
    asm volatile("s_waitcnt vmcnt(0)" ::: "memory");
    __syncthreads();
    if (otid(swave) == 0) {
        unsigned* bar = b.bar;
        __builtin_amdgcn_s_waitcnt(0);
        unsigned nloc = b.st[0], nx = b.st[1];
        if (nloc == 0u) { xcd_barrier_complete(bar, b.x, nloc, nx); b.st[0] = nloc; b.st[1] = nx; }
        const unsigned old = xb_add(&bar[XB_XSUB(b.x)], 1u);
        const unsigned gen = old / nloc;
        if (old + 1u == (gen + 1u) * nloc) {
            __builtin_amdgcn_fence(__ATOMIC_RELEASE, "agent");
            asm volatile("s_waitcnt vmcnt(0)" ::: "memory");
            const unsigned og = xb_add(&bar[XB_TOP], 1u);
            const unsigned tg = og / nx;
            if (og + 1u == (tg + 1u) * nx) xb_add(&bar[XB_TOPGEN], 1u);
            else XB_SPIN(xb_ld(&bar[XB_TOPGEN]) == tg, bar);
            __builtin_amdgcn_fence(__ATOMIC_ACQUIRE, "agent");
            xb_add(&bar[XB_XGEN(b.x)], 1u);
            asm volatile("s_waitcnt vmcnt(0)" ::: "memory");
        } else {
            XB_SPIN(xb_ld(&bar[XB_XGEN(b.x)]) == gen, bar);
            __builtin_amdgcn_fence(__ATOMIC_ACQUIRE, "agent");
            asm volatile("s_waitcnt vmcnt(0)" ::: "memory");
        }
    }
    __syncthreads();
}
constexpr int CW_BAR = 4096;

__device__ __forceinline__ unsigned pk2(float lo, float hi) { return (unsigned)f2bf(lo) | ((unsigned)f2bf(hi) << 16); }
struct TrItem { const float* src; bf16* dst; int N; };
__device__ __forceinline__ TrItem tr_locate(const P& p, int it) {
    constexpr int I_IN = (D / 64) * (NIN / 64), I_OUT = (D / 64) * (D / 64), I_UP1 = (D / 64) * (1024 / 64), I_DN1 = (HID / 64) * (D / 64);
    const float* W; bf16* WT; int K, N, up = 0, r = it;
    if (r < I_IN) { W = p.w_in; WT = WSP(bf16, WS_WINT); K = D; N = NIN; }
    else if ((r -= I_IN) < I_OUT) { W = p.w_out; WT = WSP(bf16, WS_WOUTT); K = D; N = D; }
    else if ((r -= I_OUT) < NE * I_UP1) { const int e = r / I_UP1; r -= e * I_UP1; W = p.w_up + (size_t)e * D * 1024; WT = WSP(bf16, WS_WUPT) + (size_t)e * D * 1024; K = D; N = 1024; up = 1; }
    else { r -= NE * I_UP1; const int e = r / I_DN1; r -= e * I_DN1; W = p.w_down + (size_t)e * HID * D; WT = WSP(bf16, WS_WDNT) + (size_t)e * HID * D; K = HID; N = D; }
    const int nblk = N / 64, kb = r / nblk, nb = r % nblk, k0 = 64 * kb, lane = (int)__builtin_amdgcn_mbcnt_hi(~0u, __builtin_amdgcn_mbcnt_lo(~0u, 0u)), n = 64 * nb + lane;
    TrItem t; t.src = W + (size_t)k0 * N + n; t.dst = WT + (size_t)(up ? updst(n) : n) * K + k0; t.N = N; return t;
}
__device__ __forceinline__ void tr_load(const TrItem& t, float (&r)[64]) {
#pragma unroll
    for (int i = 0; i < 64; ++i) r[i] = t.src[(size_t)i * t.N];
}
__device__ __forceinline__ void tr_store(const TrItem& t, const float (&r)[64]) {
    u32x4* dst = (u32x4*)t.dst;
#pragma unroll
    for (int j = 0; j < 8; ++j) { u32x4 o; o.x = cvt_pk_bf16(r[8 * j], r[8 * j + 1]); o.y = cvt_pk_bf16(r[8 * j + 2], r[8 * j + 3]); o.z = cvt_pk_bf16(r[8 * j + 4], r[8 * j + 5]); o.w = cvt_pk_bf16(r[8 * j + 6], r[8 * j + 7]); dst[j] = o; }
}
__device__ __forceinline__ void phase_prep(const int swave, const P& p, LAS unsigned char* lds, int bx, int G) {
    const int tid = otid(swave), lane = tid & 63, w = __builtin_amdgcn_readfirstlane(tid >> 6);
    if (bx < 192) {
        LAS float* sc = (LAS float*)lds; LAS float* red = sc + 2048;
        for (int i = tid; i < 2048; i += NTHR) sc[i] = silu_f(p.c[i]);
        __syncthreads();
        for (int cb = bx; cb < 192; cb += G) {
            const int kg = tid >> 5, cl = tid & 31, colj = cb * 32 + cl; float a0 = 0.f, a1 = 0.f;
            float wv[64];
#pragma unroll
            for (int i = 0; i < 64; ++i) wv[i] = p.w_ada[(size_t)(kg + 16 * i) * 6144 + colj];
#pragma unroll
            for (int i = 0; i < 64; ++i) { const int k = kg + 16 * i; a0 += sc[k] * wv[i]; a1 += sc[1024 + k] * wv[i]; }
            red[(kg * 32 + cl) * 2] = a0; red[(kg * 32 + cl) * 2 + 1] = a1;
            __syncthreads();
            if (tid < 64) { const int c2 = tid & 31, bb = tid >> 5; float t = 0.f;
#pragma unroll
                for (int k2 = 0; k2 < 16; ++k2) t += red[(k2 * 32 + c2) * 2 + bb];
                __hip_atomic_store(WSP(float, WS_SMALL + SM_ADA) + bb * 6144 + cb * 32 + c2, t + p.b_ada[cb * 32 + c2], __ATOMIC_RELAXED, __HIP_MEMORY_SCOPE_AGENT);
                asm volatile("s_waitcnt vmcnt(0)" ::: "memory");
                if (tid == 0) __hip_atomic_fetch_add(WSP(unsigned, WS_CTL) + CW_ADA, 1u, __ATOMIC_RELAXED, __HIP_MEMORY_SCOPE_AGENT); }
            __syncthreads();
        }
    }
    if (bx == G - 1) { const float l0 = p.lb_logits[tid], l1 = p.lb_logits[512 + tid]; const float m = fmaxf(l0, l1); const float e0 = expf(l0 - m), e1 = expf(l1 - m);
        WSP(float, WS_SMALL + SM_LB)[tid] = e0 / (e0 + e1); }
    constexpr int NITEMS = (D / 64) * (NIN / 64) + (D / 64) * (D / 64) + NE * (D / 64) * (1024 / 64) + NE * (HID / 64) * (D / 64);
    LAS int* qs = (LAS int*)(lds + LDSCTL_OFF) + LC_Q;
    if (tid == 0) qs[0] = (int)atomicAdd(WSP(unsigned, WS_CTL) + CW_PREPQ, 24u);
    __syncthreads();
    int base = qs[0];
#pragma unroll 1
    while (base < NITEMS) {
        __syncthreads();
        int nxt = 0; if (tid == 0) nxt = (int)atomicAdd(WSP(unsigned, WS_CTL) + CW_PREPQ, 24u);
        const int it = base + 3 * w;
        if (it < NITEMS) {
            const TrItem ta = tr_locate(p, it); float ra[64]; tr_load(ta, ra);
            if (it + 2 < NITEMS) { const TrItem tb = tr_locate(p, it + 1), tc = tr_locate(p, it + 2); float rb[64], rc[64]; tr_load(tb, rb); tr_load(tc, rc); tr_store(ta, ra); tr_store(tb, rb); tr_store(tc, rc); }
            else if (it + 1 < NITEMS) { const TrItem tb = tr_locate(p, it + 1); float rb[64]; tr_load(tb, rb); tr_store(ta, ra); tr_store(tb, rb); }
            else tr_store(ta, ra);
        }
        if (tid == 0) qs[0] = nxt;
        __syncthreads();
        base = qs[0];
    }
}
__device__ __forceinline__ void phase_xmod(const int swave, const P& p, int bx, int G) {
    const int lane = otid(swave) & 63, gw = bx * NWAVES + (otid(swave) >> 6), NGW = G * NWAVES; const unsigned l16 = (unsigned)lane * 16u, l8 = (unsigned)lane * 8u;
#pragma unroll 1
    for (int row = 4 * gw; row < T; row += 4 * NGW) { const float* ada = WSP(float, WS_SMALL + SM_ADA) + (row >> 13) * 6144;
        f32x4 xv[4][4];
#pragma unroll
        for (int r = 0; r < 4; ++r)
#pragma unroll
            for (int j = 0; j < 4; ++j) xv[r][j] = ldg<f32x4>(p.x + (size_t)(row + r) * D + 256 * j, l16);
#pragma unroll
        for (int j = 0; j < 4; ++j) { const f32x4 sh = ldg<f32x4>(ada + 256 * j, l16), sc = ldg<f32x4>(ada + 1024 + 256 * j, l16);
#pragma unroll
            for (int r = 0; r < 4; ++r) { u32x2 o; o.x = cvt_pk_bf16(xv[r][j][0] * (1.f + sc[0]) + sh[0], xv[r][j][1] * (1.f + sc[1]) + sh[1]); o.y = cvt_pk_bf16(xv[r][j][2] * (1.f + sc[2]) + sh[2], xv[r][j][3] * (1.f + sc[3]) + sh[3]);
                stg<u32x2>(WSP(bf16, WS_B) + (size_t)(row + r) * D + 256 * j, l8, o); } } }
}
__device__ __forceinline__ void route_load_weights(const int swave, const P& p, LAS float* WR) {
    for (int c = otid(swave); c < D; c += NTHR) { const f32x4 wg = *(const f32x4*)(p.rg_w + (size_t)c * 4);
#pragma unroll
        for (int g = 0; g < 4; ++g) { WR[g * D + c] = wg[g];
            const f32x4 w0 = *(const f32x4*)(p.re_w + ((size_t)g * D + c) * 8), w1 = *(const f32x4*)(p.re_w + ((size_t)g * D + c) * 8 + 4);
#pragma unroll
            for (int e = 0; e < 4; ++e) { WR[(4 + g * 8 + e) * D + c] = w0[e]; WR[(4 + g * 8 + 4 + e) * D + c] = w1[e]; } } }
}
__device__ __forceinline__ void route_load2(const P& p, int row, int lane, f32x4 (&x)[2][4], u32x2 (&y)[2][4]) {
    const unsigned l16 = (unsigned)lane * 16u, l8 = (unsigned)lane * 8u;
#pragma unroll
    for (int r = 0; r < 2; ++r) { const float* xr = p.x + (size_t)(row + r) * D; const bf16* yr = WSP(bf16, WS_Y) + (size_t)(row + r) * D;
#pragma unroll
        for (int j = 0; j < 4; ++j) { x[r][j] = ldg<f32x4>(xr + 256 * j, l16); y[r][j] = ldg<u32x2>(yr + 256 * j, l8); } }
}
__device__ __forceinline__ float wave_sum_l63(float v) { DPP_ADD(v, 0xB1, 0xF); DPP_ADD(v, 0x4E, 0xF); DPP_ADD(v, 0x141, 0xF); DPP_ADD(v, 0x140, 0xF); DPP_ADD(v, 0x142, 0xA); DPP_ADD(v, 0x143, 0xC); return v; }
__device__ __forceinline__ void route_topk(const LAS float* lgs, LAS int* rt_e, LAS float* rt_w, int rl, int lane) {
    const f32x4 g4 = *(const LAS f32x4*)lgs;
    int gi = 0; float gm = g4[0];
#pragma unroll
    for (int g = 1; g < 4; ++g) if (g4[g] > gm) { gm = g4[g]; gi = g; }
    float gs = 0.f;
#pragma unroll
    for (int g = 0; g < 4; ++g) gs += __expf(g4[g] - gm);
    const float pgroup = 1.f / gs;
    const f32x4 ea = *(const LAS f32x4*)(lgs + 4 + 8 * gi), eb = *(const LAS f32x4*)(lgs + 8 + 8 * gi);
    float el[8] = {ea[0], ea[1], ea[2], ea[3], eb[0], eb[1], eb[2], eb[3]};
    int j0 = 0; float m0 = el[0];
#pragma unroll
    for (int e = 1; e < 8; ++e) if (el[e] > m0) { m0 = el[e]; j0 = e; }
    int j1 = -1; float m1 = -3.0e38f;
#pragma unroll
    for (int e = 0; e < 8; ++e) if (e != j0 && el[e] > m1) { m1 = el[e]; j1 = e; }
    const float r1 = __expf(m1 - m0);
    if (lane == 0) { rt_e[2 * rl] = gi * 8 + j0; rt_e[2 * rl + 1] = gi * 8 + j1; rt_w[2 * rl] = pgroup / (1.f + r1); rt_w[2 * rl + 1] = pgroup * r1 / (1.f + r1); }
}
__device__ __forceinline__ void ln1_route_rows2(const P& p, const LAS float* WR, LAS float* lgs, LAS int* rt_e, LAS float* rt_w, int row, int rl, int lane, const f32x4 (&x)[2][4], const u32x2 (&y)[2][4]) {
    const float* ada = WSP(float, WS_SMALL + SM_ADA) + (row >> 13) * 6144;
    const unsigned l16 = (unsigned)lane * 16u, l8 = (unsigned)lane * 8u;
    f32x4 g1v[4], pg[4], pb[4], ps[4], pc[4];
#pragma unroll
    for (int j = 0; j < 4; ++j) g1v[j] = ldg<f32x4>(ada + 2048 + 256 * j, l16);
#pragma unroll
    for (int j = 0; j < 4; ++j) { pg[j] = ldg<f32x4>(p.ln1_g + 256 * j, l16); pb[j] = ldg<f32x4>(p.ln1_b + 256 * j, l16); ps[j] = ldg<f32x4>(ada + 3072 + 256 * j, l16); pc[j] = ldg<f32x4>(ada + 4096 + 256 * j, l16); }
    float v[2][16], rstd[2];
#pragma unroll
    for (int r = 0; r < 2; ++r) { float s = 0.f;
#pragma unroll
        for (int j = 0; j < 4; ++j) {
            const float y0 = __uint_as_float(y[r][j].x << 16), y1 = __uint_as_float(y[r][j].x & 0xffff0000u), y2 = __uint_as_float(y[r][j].y << 16), y3 = __uint_as_float(y[r][j].y & 0xffff0000u);
            v[r][4 * j] = ALPHA * x[r][j][0] + (1.f + g1v[j][0]) * y0; v[r][4 * j + 1] = ALPHA * x[r][j][1] + (1.f + g1v[j][1]) * y1; v[r][4 * j + 2] = ALPHA * x[r][j][2] + (1.f + g1v[j][2]) * y2; v[r][4 * j + 3] = ALPHA * x[r][j][3] + (1.f + g1v[j][3]) * y3;
            s += (v[r][4 * j] + v[r][4 * j + 1]) + (v[r][4 * j + 2] + v[r][4 * j + 3]); }
        const float mean = wave_sum_dpp(s) * (1.f / D); float q = 0.f;
#pragma unroll
        for (int i = 0; i < 16; ++i) { v[r][i] -= mean; q += v[r][i] * v[r][i]; }
        rstd[r] = rsqrtf(wave_sum_dpp(q) * (1.f / D) + LN_EPS); }
    f32x2 hv[16];
#pragma unroll
    for (int r = 0; r < 2; ++r) { bf16* X1 = WSP(bf16, WS_X1) + (size_t)(row + r) * D; bf16* H2 = WSP(bf16, WS_B) + (size_t)(row + r) * D;
#pragma unroll
        for (int j = 0; j < 4; ++j) { f32x4 x1; float h[4];
#pragma unroll
            for (int i = 0; i < 4; ++i) { x1[i] = v[r][4 * j + i] * rstd[r] * pg[j][i] + pb[j][i]; h[i] = x1[i] * (1.f + pc[j][i]) + ps[j][i]; if (r == 0) hv[4 * j + i].x = h[i]; else hv[4 * j + i].y = h[i]; }
            { u32x2 xo; xo.x = cvt_pk_bf16(x1[0], x1[1]); xo.y = cvt_pk_bf16(x1[2], x1[3]); stg<u32x2>(X1 + 256 * j, l8, xo); }
            u32x2 o; o.x = cvt_pk_bf16(h[0], h[1]); o.y = cvt_pk_bf16(h[2], h[3]); stg<u32x2>(H2 + 256 * j, l8, o); } }
    __builtin_amdgcn_sched_barrier(0);
    const LAS char* wp = (const LAS char*)WR + lane * 16;
    int coll0 = 0, coll1 = 0;
    f32x4 wc[4];
#pragma unroll
    for (int j = 0; j < 4; ++j) wc[j] = *(const LAS f32x4*)(wp + 1024 * j);
#pragma unroll
    for (int o = 0; o < 36; ++o) { f32x4 wn[4]; wp += 4096; asm volatile("" : "+v"(wp));
        if (o < 35) {
#pragma unroll
            for (int j = 0; j < 4; ++j) wn[j] = *(const LAS f32x4*)(wp + 1024 * j); }
        f32x2 a[4];
#pragma unroll
        for (int j = 0; j < 4; ++j) { a[j] = hv[4 * j] * (f32x2){wc[j][0], wc[j][0]};
#pragma unroll
            for (int i = 1; i < 4; ++i) a[j] = __builtin_elementwise_fma(hv[4 * j + i], (f32x2){wc[j][i], wc[j][i]}, a[j]); }
        const f32x2 t = (a[0] + a[1]) + (a[2] + a[3]);
        const float s0 = wave_sum_l63(t.x), s1 = wave_sum_l63(t.y);
        { const int r0 = __builtin_amdgcn_readlane(__float_as_int(s0), 63), r1 = __builtin_amdgcn_readlane(__float_as_int(s1), 63);
          asm volatile("v_writelane_b32 %0, %1, %2" : "+v"(coll0) : "s"(r0), "i"(o)); asm volatile("v_writelane_b32 %0, %1, %2" : "+v"(coll1) : "s"(r1), "i"(o)); }
        if (o < 35) {
#pragma unroll
            for (int j = 0; j < 4; ++j) wc[j] = wn[j]; }
    }
    { const int lo = lane < 36 ? lane : 35; const float bias = lo < 4 ? p.rg_b[lo] : p.re_b[lo - 4];
      lgs[lane] = __int_as_float(coll0) + bias; lgs[64 + lane] = __int_as_float(coll1) + bias; }
    asm volatile("s_waitcnt lgkmcnt(0)" ::: "memory");
    route_topk(lgs, rt_e, rt_w, rl, lane);
    route_topk(lgs + 64, rt_e, rt_w, rl + 1, lane);
}
__device__ __forceinline__ void route_assign(const int swave, const P& p, const LAS int* rt_e, const LAS float* rt_w, LAS int* rt_base, int rowbase) {
    const int lane = otid(swave);
    const int e0 = rt_e[lane], e1 = rt_e[lane + 64];
    const unsigned long long lt = (1ull << lane) - 1ull;
    int rank0 = 0, rank1 = 0, mycnt = 0;
#pragma unroll 4
    for (int e = 0; e < NE; ++e) { const unsigned long long m0 = __ballot(e0 == e), m1 = __ballot(e1 == e); const int c0 = __popcll(m0);
        if (e0 == e) rank0 = __popcll(m0 & lt);
        if (e1 == e) rank1 = c0 + __popcll(m1 & lt);
        if (lane == e) mycnt = c0 + __popcll(m1); }
    if (lane < NE) rt_base[lane] = mycnt ? (int)atomicAdd(WSP(unsigned, WS_CTL) + CW_CNT + lane, (unsigned)mycnt) : 0;
    asm volatile("s_waitcnt vmcnt(0) lgkmcnt(0)" ::: "memory");
    int* LIST = WSP(int, WS_LIST); float* WL = WSP(float, WS_WLIST); int* TE = WSP(int, WS_SMALL + SM_TOKE); int* TS = WSP(int, WS_SMALL + SM_TOKS);
    { const int slot = rt_base[e0] + rank0, row = rowbase + (lane >> 1); LIST[e0 * T + slot] = row; WL[e0 * T + slot] = rt_w[lane]; TE[row * 2 + (lane & 1)] = e0; TS[row * 2 + (lane & 1)] = slot; }
    { const int a = lane + 64, slot = rt_base[e1] + rank1, row = rowbase + (a >> 1); LIST[e1 * T + slot] = row; WL[e1 * T + slot] = rt_w[a]; TE[row * 2 + (a & 1)] = e1; TS[row * 2 + (a & 1)] = slot; }
}
template <int NR> __device__ __forceinline__ void final_rows(const P& p, const LAS int* tstart, int row, int lane, float pscale, float pspike) {
    const float* ada = WSP(float, WS_SMALL + SM_ADA) + (row >> 13) * 6144;
    const int* TE = WSP(int, WS_SMALL + SM_TOKE); const int* TS = WSP(int, WS_SMALL + SM_TOKS);
    const unsigned l16 = (unsigned)lane * 16u, l8 = (unsigned)lane * 8u;
    u32x2 xv[NR][4], pa[NR][4], pb[NR][4];
#pragma unroll
    for (int r = 0; r < NR; ++r) {
        const int e0 = TE[(row + r) * 2], e1 = TE[(row + r) * 2 + 1], s0 = TS[(row + r) * 2], s1 = TS[(row + r) * 2 + 1];
        const size_t rA = (size_t)(tstart[e0] * 256 + s0), rB = (size_t)(tstart[e1] * 256 + s1);
        const bf16* ya = WSP(bf16, WS_Y2) + rA * D; const bf16* yb = WSP(bf16, WS_Y2) + rB * D; const bf16* X1 = WSP(bf16, WS_X1) + (size_t)(row + r) * D;
#pragma unroll
        for (int j = 0; j < 4; ++j) { xv[r][j] = ldg<u32x2>(X1 + 256 * j, l8); pa[r][j] = ldg<u32x2>(ya + 256 * j, l8); pb[r][j] = ldg<u32x2>(yb + 256 * j, l8); } }
    __builtin_amdgcn_sched_barrier(0);
#pragma unroll
    for (int r = 0; r < NR; ++r) {
        if (r) __builtin_amdgcn_sched_barrier(0);
        float v[16]; float s = 0.f;
#pragma unroll
        for (int j = 0; j < 4; ++j) { const f32x4 g2 = ldg<f32x4>(ada + 5120 + 256 * j, l16);
            const float m0 = __uint_as_float(pa[r][j].x << 16) + __uint_as_float(pb[r][j].x << 16), m1 = __uint_as_float(pa[r][j].x & 0xffff0000u) + __uint_as_float(pb[r][j].x & 0xffff0000u);
            const float m2 = __uint_as_float(pa[r][j].y << 16) + __uint_as_float(pb[r][j].y << 16), m3 = __uint_as_float(pa[r][j].y & 0xffff0000u) + __uint_as_float(pb[r][j].y & 0xffff0000u);
            const float x0 = __uint_as_float(xv[r][j].x << 16), x1 = __uint_as_float(xv[r][j].x & 0xffff0000u), x2 = __uint_as_float(xv[r][j].y << 16), x3 = __uint_as_float(xv[r][j].y & 0xffff0000u);
            v[4 * j + 0] = ALPHA * x0 + (1.f + g2[0]) * m0; v[4 * j + 1] = ALPHA * x1 + (1.f + g2[1]) * m1; v[4 * j + 2] = ALPHA * x2 + (1.f + g2[2]) * m2; v[4 * j + 3] = ALPHA * x3 + (1.f + g2[3]) * m3;
            s += (v[4 * j] + v[4 * j + 1]) + (v[4 * j + 2] + v[4 * j + 3]); }
        const float mean = wave_sum_dpp(s) * (1.f / D); float q = 0.f;
#pragma unroll
        for (int i = 0; i < 16; ++i) { v[i] -= mean; q += v[i] * v[i]; }
        const float rstd = rsqrtf(wave_sum_dpp(q) * (1.f / D) + LN_EPS);
#pragma unroll
        for (int j = 0; j < 4; ++j) { const f32x4 gg = ldg<f32x4>(p.ln2_g + 256 * j, l16), bb = ldg<f32x4>(p.ln2_b + 256 * j, l16); f32x4 o;
#pragma unroll
            for (int i = 0; i < 4; ++i) o[i] = (v[4 * j + i] * rstd * gg[i] + bb[i]) * pscale;
            if (j == 0 && lane == 0 && r == 0) o[0] += pspike;
            stg<f32x4>(p.out + (size_t)(row + r) * D + 256 * j, l16, o); }
    }
}

enum { PH_PREP = 0, PH_INPROJ, PH_MIXA, PH_SCAN, PH_MIXC, PH_OUTPROJ, PH_LN1ROUTE, PH_UP, PH_FINAL, PH_N };
struct Args { P p; int ph_lo, ph_hi, li, pad; };

__device__ __forceinline__ void moe_tables(const int swave, const P& p, LAS unsigned char* lds) {
    LAS int* tstart = (LAS int*)(lds + LDSCTL_OFF) + LC_TSTART; LAS int* lcnt = (LAS int*)(lds + LDSCTL_OFF) + LC_CNT;
    if (otid(swave) == 0) { int acc = 0;
        for (int e = 0; e < NE; ++e) { const int c = (int)__hip_atomic_load(WSP(unsigned, WS_CTL) + CW_CNT + e, __ATOMIC_RELAXED, __HIP_MEMORY_SCOPE_AGENT); tstart[e] = acc; lcnt[e] = c; acc += (c + 255) >> 8; }
        tstart[NE] = acc; }
    __syncthreads();
}

__device__ __forceinline__ P load_p() {
    typedef const __attribute__((address_space(4))) unsigned long long CU64;
    CU64* a = (CU64*)__builtin_amdgcn_kernarg_segment_ptr(); asm volatile("" : "+s"(a));
    P p; unsigned long long* d = (unsigned long long*)&p;
#pragma unroll
    for (int i = 0; i < 24; ++i) d[i] = a[i];
    return p;
}
__global__ void __launch_bounds__(NTHR, 2) mk_fwd(Args args) {
    extern __shared__ __attribute__((aligned(16))) unsigned char lds_raw[];
    LAS unsigned char* lds = (LAS unsigned char*)lds_raw;
    const P& p = args.p;
    const int G = gridDim.x, bx = blockIdx.x;
    const int swave = __builtin_amdgcn_readfirstlane((int)threadIdx.x >> 6);
    const int lo = args.ph_lo, hi = args.ph_hi;
#ifndef PHASE_MASK
#define PHASE_MASK 0x1ff
#endif
#define IN(k) (((PHASE_MASK >> (k)) & 1) && lo <= (k) && (k) < hi)
#ifndef REP_PHASE
#define REP_PHASE -1
#define REP_N 0
#endif
#define NREP(k) ((k) == REP_PHASE ? REP_N : 0)
#ifdef PROBE_A
#define STAMP(k) do { if (otid(swave) == 0) { const unsigned long long t_ = __builtin_amdgcn_s_memrealtime(); __hip_atomic_store((unsigned long long*)(WSP(unsigned, WS_CTL) + 65536 + bx * 32) + (k), t_, __ATOMIC_RELAXED, __HIP_MEMORY_SCOPE_AGENT); } } while (0)
#else
#define STAMP(k) do { } while (0)
#endif
#define SEAM(k) do { if (rep_ == NREP(k)) { if (IN(k) && IN((k) + 1)) xcd_barrier(swave, bar); STAMP((k) + 1); } } while (0)
    for (int u = otid(swave); u < (LDS_BYTES - LDSCTL_OFF) / 4; u += NTHR) ((LAS unsigned*)(lds + LDSCTL_OFF))[u] = 0u;
    __syncthreads();
    XcdBarrier bar = xcd_barrier_post(swave, WSP(unsigned, WS_CTL) + CW_BAR + args.li * XCD_BAR_WORDS, (volatile LAS unsigned*)(lds + LDSCTL_OFF) + LC_BAR);
    { const P p = load_p(); STAMP(0); }
    if (IN(PH_PREP)) for (int rep_ = 0; rep_ <= NREP(PH_PREP); ++rep_) { if (rep_) xcd_barrier(swave, bar); asm volatile("; MARK PH_PREP"); const P p = load_p(); phase_prep(swave, p, lds, bx, G);
        if (otid(swave) == 0) { unsigned sp = 0; while (__hip_atomic_load(WSP(unsigned, WS_CTL) + CW_ADA, __ATOMIC_RELAXED, __HIP_MEMORY_SCOPE_AGENT) < 192u && ++sp < (1u << 22)) __builtin_amdgcn_s_sleep(2);
            __builtin_amdgcn_fence(__ATOMIC_ACQUIRE, "agent"); asm volatile("s_waitcnt vmcnt(0)" ::: "memory"); }
        __syncthreads();
        phase_xmod(swave, p, bx, G); SEAM(PH_PREP); }
    if (IN(PH_INPROJ)) for (int rep_ = 0; rep_ <= NREP(PH_INPROJ); ++rep_) { if (rep_) xcd_barrier(swave, bar); asm volatile("; MARK PH_INPROJ"); const P p = load_p();
        pg8::Gemm g{WSP(bf16, WS_B), WSP(bf16, WS_WINT), D, 0, 0, nullptr}; pg8::StaticOrder S; S.init(T, NIN, G, bx);
        pg8::EpiInproj E{p.ws};
        pg8::gemm_phase<pg8::EpiInproj, pg8::StaticOrder, true, true, false>(swave, lds, g, S, E);
        SEAM(PH_INPROJ);
    }
    if (IN(PH_MIXA)) for (int rep_ = 0; rep_ <= NREP(PH_MIXA); ++rep_) { if (rep_) xcd_barrier(swave, bar); asm volatile("; MARK PH_MIXA"); const P p = load_p();
        for (int it = bx; it < 256 + 512; it += G) { if (it < 256) hgrn_item<0>(swave, p, lds, it); else sg_item(swave, p, lds, it - 256); }
        SEAM(PH_MIXA);
    }
    if (IN(PH_SCAN)) for (int rep_ = 0; rep_ <= NREP(PH_SCAN); ++rep_) { if (rep_) xcd_barrier(swave, bar); asm volatile("; MARK PH_SCAN"); const P p = load_p();
        for (int gid = bx * NTHR + otid(swave); gid < 8 * 16384; gid += G * NTHR) hgrn_scan(p, gid);
        SEAM(PH_SCAN);
    }
    if (IN(PH_MIXC)) for (int rep_ = 0; rep_ <= NREP(PH_MIXC); ++rep_) { if (rep_) xcd_barrier(swave, bar); asm volatile("; MARK PH_MIXC"); const P p = load_p();
        for (int it = bx; it < 256; it += G) hgrn_item<1>(swave, p, lds, it);
        SEAM(PH_MIXC);
    }
    if (IN(PH_OUTPROJ)) for (int rep_ = 0; rep_ <= NREP(PH_OUTPROJ); ++rep_) { if (rep_) xcd_barrier(swave, bar); asm volatile("; MARK PH_OUTPROJ"); const P p = load_p();
        pg8::Gemm g{WSP(bf16, WS_B), WSP(bf16, WS_WOUTT), D, 0, 0, nullptr}; pg8::StaticOrder S; S.init(T, D, G, bx);
        pg8::EpiBf16 E{p.ws, WS_Y, D};
        pg8::gemm_phase<pg8::EpiBf16, pg8::StaticOrder, true, true, false>(swave, lds, g, S, E);
        SEAM(PH_OUTPROJ);
    }
    if (IN(PH_LN1ROUTE)) for (int rep_ = 0; rep_ <= NREP(PH_LN1ROUTE); ++rep_) { if (rep_) xcd_barrier(swave, bar); asm volatile("; MARK PH_LN1ROUTE"); const P p = load_p();
        if (rep_) { if (bx == 0 && otid(swave) < 32) __hip_atomic_store(WSP(unsigned, WS_CTL) + CW_CNT + otid(swave), 0u, __ATOMIC_RELAXED, __HIP_MEMORY_SCOPE_AGENT); xcd_barrier(swave, bar); }
        const int lane = otid(swave) & 63, w = __builtin_amdgcn_readfirstlane(otid(swave) >> 6);
        LAS float* WR = (LAS float*)lds; LAS int* rt_e = (LAS int*)(lds + LDSCTL_OFF) + LC_RT; LAS float* rt_w = (LAS float*)(rt_e + 128); LAS int* rt_base = rt_e + 256;
        route_load_weights(swave, p, WR);
        __syncthreads();
        for (int rb = bx * 64; rb < T; rb += G * 64) {
            f32x4 xc[2][4]; u32x2 yc[2][4];
            route_load2(p, rb + 8 * w, lane, xc, yc);
#pragma unroll 1
            for (int pr = 0; pr < 4; ++pr) {
                f32x4 xn[2][4]; u32x2 yn[2][4];
                route_load2(p, rb + 8 * w + (pr < 3 ? 2 * pr + 2 : 2 * pr), lane, xn, yn);
                ln1_route_rows2(p, WR, (LAS float*)(lds + LDSCTL_OFF) + LC_LGS + 128 * w, rt_e, rt_w, rb + 8 * w + 2 * pr, 8 * w + 2 * pr, lane, xc, yc);
#pragma unroll
                for (int r = 0; r < 2; ++r)
#pragma unroll
                    for (int j = 0; j < 4; ++j) { xc[r][j] = xn[r][j]; yc[r][j] = yn[r][j]; }
            }
            __syncthreads();
            if (w == 0) route_assign(swave, p, rt_e, rt_w, rt_base, rb);
            __syncthreads();
        }
        SEAM(PH_LN1ROUTE);
    }
    if (IN(PH_UP)) for (int rep_ = 0; rep_ <= NREP(PH_UP); ++rep_) { if (rep_) xcd_barrier(swave, bar); asm volatile("; MARK PH_UP"); const P p = load_p();
        moe_tables(swave, p, lds);
        const LAS int* tstart = (const LAS int*)(lds + LDSCTL_OFF) + LC_TSTART; const LAS int* lcnt = (const LAS int*)(lds + LDSCTL_OFF) + LC_CNT;
        unsigned* ready = WSP(unsigned, WS_CTL) + CW_RDY;
        {
            pg8::Gemm g{WSP(bf16, WS_B), WSP(bf16, WS_WUPT), D, 0, (size_t)1024 * D * 2, WSP(int, WS_LIST)};
            pg8::MoeOrder S{tstart, lcnt, G, bx, 4};
            pg8::EpiUp E{p.ws};
            pg8::gemm_phase<pg8::EpiUp, pg8::MoeOrder, true, true, true>(swave, lds, g, S, E);
            if (otid(swave) == 0) { __builtin_amdgcn_fence(__ATOMIC_RELEASE, "agent"); asm volatile("s_waitcnt vmcnt(0)" ::: "memory");
                pg8::Unit u; for (int i = 0; S.next(i, u); ++i) __hip_atomic_fetch_add(ready + 64 * u.pm, 1u, __ATOMIC_RELAXED, __HIP_MEMORY_SCOPE_AGENT); }
        }
        {
            const int ntile = __builtin_amdgcn_readfirstlane(tstart[NE]), R = 4 * ntile - 2 * G > 0 ? 4 * ntile - 2 * G : 0;
            pg8::Gemm g{WSP(bf16, WS_ACT), WSP(bf16, WS_WDNT), HID, 0, (size_t)1024 * HID * 2, nullptr};
            pg8::MoeDownOrder S{tstart, lcnt, G, (bx + G - R % G) % G, ntile, G / 4, R / 4, ready};
            pg8::EpiDown E{p.ws};
            pg8::gemm_phase<pg8::EpiDown, pg8::MoeDownOrder, true, true, false>(swave, lds, g, S, E);
        }
        SEAM(PH_UP);
    }
    if (IN(PH_FINAL)) for (int rep_ = 0; rep_ <= NREP(PH_FINAL); ++rep_) { if (rep_) xcd_barrier(swave, bar); asm volatile("; MARK PH_FINAL"); const P p = load_p();
        moe_tables(swave, p, lds);
        const int lane = otid(swave) & 63, gw = bx * NWAVES + (otid(swave) >> 6), NGW = G * NWAVES;
        float pscale = 1.f, pspike = 0.f;
#ifdef PROBE_A
        { const unsigned long long* ts = (const unsigned long long*)(WSP(unsigned, WS_CTL) + 65536 + bx * 32);
          const unsigned long long a0 = __hip_atomic_load(ts + PROBE_A, __ATOMIC_RELAXED, __HIP_MEMORY_SCOPE_AGENT), a1 = __hip_atomic_load(ts + PROBE_A + 1, __ATOMIC_RELAXED, __HIP_MEMORY_SCOPE_AGENT);
          const unsigned long long b0 = __hip_atomic_load(ts + PROBE_B, __ATOMIC_RELAXED, __HIP_MEMORY_SCOPE_AGENT), b1 = __hip_atomic_load(ts + PROBE_B + 1, __ATOMIC_RELAXED, __HIP_MEMORY_SCOPE_AGENT);
          pscale = 1.f + sqrtf((float)(a1 - a0) * 1e-5f); pspike = (float)(b1 - b0) * 0.1f; }
#endif
#pragma unroll 1
        for (int row = 4 * gw; row < T; row += 4 * NGW) { asm volatile("" ::: "memory"); final_rows<4>(p, (const LAS int*)(lds + LDSCTL_OFF) + LC_TSTART, row, lane, pscale, row == 0 ? pspike : 0.f); }
    }
#undef SEAM
#undef IN
}

#ifndef NAIVE_MASK
#define NAIVE_MASK 0
#endif
#ifndef MK_SPLIT
#define MK_SPLIT 0
#endif
static void launch_mk(const P& p, int lo, int hi, int li, hipStream_t s) {
    Args a{}; a.p = p; a.ph_lo = lo; a.ph_hi = hi; a.li = li; a.pad = 0;
    void* kargs[] = {&a};
    const hipError_t e = hipLaunchCooperativeKernel((const void*)mk_fwd, dim3(256), dim3(NTHR), kargs, LDS_BYTES, s);
    if (e != hipSuccess) fprintf(stderr, "kernel_launch: cooperative launch failed: %s\n", hipGetErrorString(e));
}
extern "C" void kernel_launch(void* const* d_in, const int* in_sizes, int n_in, void* d_out, int out_size, void* d_ws, size_t ws_size, hipStream_t stream) {
    if (n_in != 22 || ws_size < WS_END) { fprintf(stderr, "kernel_launch: unexpected n_in %d / ws %zu\n", n_in, ws_size); return; }
    static int inited = 0;
    if (!inited) { inited = 1;
        if (hipFuncSetAttribute((const void*)mk_fwd, hipFuncAttributeMaxDynamicSharedMemorySize, LDS_BYTES) != hipSuccess) fprintf(stderr, "kernel_launch: hipFuncSetAttribute failed\n"); }
    P p{};
    const float** f = (const float**)&p;
    for (int i = 0; i < 22; ++i) f[i] = (const float*)d_in[i];
    p.out = (float*)d_out; p.ws = (unsigned char*)d_ws;
    (void)hipMemsetAsync((char*)d_ws + WS_CTL, 0, 1 * MiB, stream);
    int li = 0;
    for (int k = 0; k < PH_N;) {
        int e = k + 1;
        if (!MK_SPLIT) while (e < PH_N && !((NAIVE_MASK >> e) & 1)) ++e;
        launch_mk(p, k, e, li++, stream);
        k = e;
    }
}
```

```cpp
#include <hip/hip_runtime.h>
#include <cstdio>
#include <cstdint>

typedef unsigned short bf16;
typedef float f32x4 __attribute__((ext_vector_type(4)));

constexpr int NB = 2, SEQ = 8192, D = 1024, T = NB * SEQ;
constexpr int NIN = 3072;
constexpr int NE = 32, HID = 512;
constexpr float ALPHA = 1.189207115002721f;
constexpr float LN_EPS = 1e-5f, RMS_EPS = 1e-6f;
constexpr int ROWS_PAD = 40960;

constexpr size_t MiB = 1u << 20;
constexpr size_t WS_CTL = 0;
constexpr size_t WS_SMALL = 1 * MiB;
constexpr size_t WS_LIST = 2 * MiB, WS_WLIST = 4 * MiB;
constexpr size_t WS_WINT = 6 * MiB, WS_WOUTT = 12 * MiB, WS_WUPT = 14 * MiB, WS_WDNT = 78 * MiB;
constexpr size_t WS_B = 110 * MiB;
constexpr size_t WS_QS = 142 * MiB, WS_V = 158 * MiB, WS_OG = 174 * MiB, WS_LOGF = 190 * MiB, WS_ZG = 222 * MiB;
constexpr size_t WS_Y = 142 * MiB, WS_ACT = 206 * MiB;
constexpr size_t WS_SLOC = 254 * MiB, WS_SSTART = 270 * MiB;
constexpr size_t WS_X1 = 286 * MiB, WS_Y2 = 350 * MiB, WS_END = 430 * MiB;
constexpr size_t SM_ADA = 0, SM_LB = 64 * 1024, SM_ROWBASE = 128 * 1024, SM_SGSTAT = 256 * 1024, SM_TOKE = 512 * 1024, SM_TOKS = 640 * 1024, SM_DTOT = 768 * 1024;
constexpr int CW_CNT = 1024;
constexpr int CW_ADA = 1088;
constexpr int CW_RDY = 131072;
constexpr int CW_MIXA = 2048, CW_MIXB = 2560;
constexpr int CW_PREPQ = 1152;

struct P {
    const float *x, *c, *w_ada, *b_ada, *w_in, *lb_logits, *hg_norm_w, *sg_ln_g, *sg_ln_b, *sg_w, *sg_b, *w_out, *ln1_g, *ln1_b,
        *rg_w, *rg_b, *re_w, *re_b, *w_up, *w_down, *ln2_g, *ln2_b;
    float* out; unsigned char* ws;
};

__device__ __forceinline__ float bf2f(bf16 b) { return __uint_as_float(((unsigned)b) << 16); }
__device__ __forceinline__ bf16 f2bf(float f) { unsigned u = __float_as_uint(f); return (bf16)((u + 0x7fffu + ((u >> 16) & 1u)) >> 16); }
__device__ __forceinline__ float silu_f(float x) { return x / (1.f + __expf(-x)); }
__device__ __forceinline__ float gelu_f(float x) { return 0.5f * x * (1.f + erff(x * 0.70710678118654752f)); }
__device__ __forceinline__ float wave_sum(float v) {
#pragma unroll
    for (int o = 1; o < 64; o <<= 1) v += __shfl_xor(v, o);
    return v;
}
#define WSP(type, off) ((type*)(p.ws + (off)))

__device__ __forceinline__ int updst(int n) { const int part = n >> 9, q = n & 511; return 256 * (q >> 7) + 128 * part + (q & 127); }

#define LAS __attribute__((address_space(3)))
#define GAS __attribute__((address_space(1)))
typedef short bf16x8 __attribute__((ext_vector_type(8)));
typedef unsigned u32x4 __attribute__((ext_vector_type(4)));
typedef unsigned u32x2 __attribute__((ext_vector_type(2)));
typedef float f32x2 __attribute__((ext_vector_type(2)));
constexpr int NWAVES = 8, NTHR = 512;
template <class Tv> __device__ __forceinline__ Tv ldg(const void* base, unsigned off) { return *(const Tv*)((const char*)base + off); }
template <class Tv> __device__ __forceinline__ void stg(void* base, unsigned off, Tv v) { *(Tv*)((char*)base + off) = v; }
#define DPP_ADD(v, ctrl, rmask) v += __int_as_float(__builtin_amdgcn_update_dpp(0, __float_as_int(v), ctrl, rmask, 0xF, false))
__device__ __forceinline__ float wave_sum_dpp(float v) {
    DPP_ADD(v, 0xB1, 0xF);
    DPP_ADD(v, 0x4E, 0xF);
    DPP_ADD(v, 0x141, 0xF);
    DPP_ADD(v, 0x140, 0xF);
    DPP_ADD(v, 0x142, 0xA);
    DPP_ADD(v, 0x143, 0xC);
    return __int_as_float(__builtin_amdgcn_readlane(__float_as_int(v), 63));
}
__device__ __forceinline__ int otid(int swave) { int l; asm volatile("v_mbcnt_lo_u32_b32 %0, -1, 0\n\tv_mbcnt_hi_u32_b32 %0, -1, %0" : "=v"(l)); return (swave << 6) | l; }
constexpr int RING_BYTES = 131072, LDSCTL_OFF = 147456, LDS_BYTES = 155648;
constexpr int LC_BAR = 0, LC_TSTART = 64  , LC_CNT = 128  , LC_RT = 256  , LC_LGS = 576  , LC_Q = 32  ;

__device__ __forceinline__ unsigned cvt_pk_bf16(float lo, float hi) { unsigned r; asm volatile("v_cvt_pk_bf16_f32 %0, %1, %2" : "=v"(r) : "v"(lo), "v"(hi)); return r; }
__device__ __forceinline__ float fast_sigmoid(float x) { return __builtin_amdgcn_rcpf(1.f + __expf(-x)); }
__device__ __forceinline__ f32x2 gelu_pk(f32x2 v) {
    const f32x2 av = __builtin_elementwise_abs(v), d = av * 0.2316418882f + 1.0f;
    f32x2 t; t.x = __builtin_amdgcn_rcpf(d.x); t.y = __builtin_amdgcn_rcpf(d.y);
    f32x2 q = t * 0.5307027145f + (-0.7265760135f); q = q * t + 0.7107068705f; q = q * t + (-0.142248368f); q = q * t + 0.127414796f; q = q * t;
    const f32x2 s = (v * v) * (-0.72134752044f);
    f32x2 e; e.x = __builtin_amdgcn_exp2f(s.x); e.y = __builtin_amdgcn_exp2f(s.y);
    const f32x2 m = v * (q * e), r = v - m;
    f32x2 o; o.x = v.x < 0.f ? m.x : r.x; o.y = v.y < 0.f ? m.y : r.y; return o;
}

namespace pg8 {
constexpr int BM = 256, BK = 64, HALF = 128, HTB = HALF * BK * 2, STAGE_BYTES = 8 * HTB, NXCD = 8, WGM = 8;
__host__ __device__ __forceinline__ int lds_byte(int r, int c) { const int st = (r >> 4) * 2 + (c >> 5), rr = r & 15, cc = c & 31, ob = rr * 64 + cc * 2; return st * 1024 + (ob ^ (((ob >> 9) & 1) << 5)); }
__host__ __device__ __forceinline__ void stage_rc(int b, int& R, int& C) { const int st = b / 1024, sb = b % 1024, swz = sb ^ (((sb >> 9) & 1) << 5); R = (st >> 1) * 16 + swz / 64; C = (st & 1) * 32 + (swz % 64) / 2; }
__host__ __device__ __forceinline__ int perm32(int rho) { const int n = rho >> 4, i = rho & 15; return 8 * (i >> 2) + 4 * n + (i & 3); }

struct Unit { int pm, pn, e, nvalid, r0, pad; };
struct Gemm { const bf16* A; const bf16* Bt; int K, pad; size_t bstride; const int* list; };

struct StaticOrder {
    int nM, nN, nwg, G, c;
    __device__ void init(int M, int N, int G_, int c_) { nM = M / BM; nN = N / BM; nwg = nM * nN; G = G_; c = c_; }
    __device__ bool next(int i, Unit& u) const {
        const long L = (long)i * G + c; if (L >= nwg) return false;
        int wgid = (int)L; { const int q = nwg / NXCD, r = nwg % NXCD, xcd = wgid % NXCD, off = wgid / NXCD; wgid = (xcd < r ? xcd * (q + 1) : r * (q + 1) + (xcd - r) * q) + off; }
        const int nig = WGM * nN, gid = wgid / nig, fm = gid * WGM, gsz = (nM - fm) < WGM ? (nM - fm) : WGM;
        u.pm = fm + ((wgid % nig) % gsz); u.pn = (wgid % nig) / gsz; u.e = 0; u.nvalid = 256; u.r0 = 0; u.pad = 0; return true;
    }
    __device__ __forceinline__ void a_ready(int, const Unit&) const {}
};
struct MoeOrder {
    const LAS int* tstart; const LAS int* cnt; int G, c, nN;
    __device__ bool next(int i, Unit& u) const {
        const int L = i * G + c, ntile = __builtin_amdgcn_readfirstlane(tstart[NE]); if (L >= ntile * nN) return false;
        const int tile = L / nN; u.pn = L % nN; u.pm = tile;
        int e = 0;
#pragma unroll 1
        for (int k = 1; k < NE; ++k) e = (tile >= tstart[k]) ? k : e;
        e = __builtin_amdgcn_readfirstlane(e); u.e = e; u.pm = __builtin_amdgcn_readfirstlane(u.pm); u.pn = __builtin_amdgcn_readfirstlane(u.pn);
        u.r0 = __builtin_amdgcn_readfirstlane((tile - tstart[e]) * 256); const int left = __builtin_amdgcn_readfirstlane(cnt[e]) - u.r0; u.nvalid = left < 256 ? left : 256; u.pad = 0; return true;
    }
    __device__ __forceinline__ void a_ready(int, const Unit&) const {}
};
struct MoeDownOrder {
    const LAS int* tstart; const LAS int* cnt; int G, cr, ntile, P, r; unsigned* ready;
    __device__ int tile_of(int idx) const {
        const int ne = 2 * (P - r);
        if (idx < ne) { const int q = idx / (P - r), m = idx - q * (P - r); return q * P + r + m; }
        const int k = idx - ne; if (k < 2 * r) { const int q = k / r, m = k - q * r; return q * P + m; }
        return 2 * P + (k - 2 * r);
    }
    __device__ bool next(int i, Unit& u) const {
        const int d = i * G + cr; if (d >= ntile * 4) return false;
        const int tile = tile_of(d >> 2); u.pn = d & 3; u.pm = tile;
        int e = 0;
#pragma unroll 1
        for (int k = 1; k < NE; ++k) e = (tile >= tstart[k]) ? k : e;
        e = __builtin_amdgcn_readfirstlane(e); u.e = e; u.pm = __builtin_amdgcn_readfirstlane(u.pm); u.pn = __builtin_amdgcn_readfirstlane(u.pn);
        u.r0 = __builtin_amdgcn_readfirstlane((tile - tstart[e]) * 256); const int left = __builtin_amdgcn_readfirstlane(cnt[e]) - u.r0; u.nvalid = left < 256 ? left : 256; u.pad = 0; return true;
    }
    __device__ __forceinline__ void a_ready(int swave, const Unit& u) const {
        if (swave == 0) { unsigned sp = 0;
            while ((unsigned)__builtin_amdgcn_readfirstlane(__hip_atomic_load(ready + 64 * u.pm, __ATOMIC_RELAXED, __HIP_MEMORY_SCOPE_AGENT)) < 4u && ++sp < (1u << 20)) __builtin_amdgcn_s_sleep(2);
            __builtin_amdgcn_fence(__ATOMIC_ACQUIRE, "agent");
            asm volatile("s_waitcnt vmcnt(0)" ::: "memory"); }
        asm volatile("" ::: "memory"); __builtin_amdgcn_s_barrier(); asm volatile("" ::: "memory");
    }
};

#define PG8_LAS LAS
template <class Epi, class Sched, bool ALIGN_EPI, bool SP2, bool GATHER>
__device__ __forceinline__ void gemm_phase(const int swave, PG8_LAS unsigned char* lds, const Gemm g, const Sched& S, const Epi& E) {
    const int tid = otid(swave), wid = __builtin_amdgcn_readfirstlane(tid >> 6), lane = tid & 63, wr = wid >> 2, wc = wid & 3, fr = lane & 15, fq = lane >> 4;
    const int K = g.K, nt = K / BK;
    unsigned voffB[2], vA[2][2], vAn[2][2]; int RA[2], CA[2];
#pragma unroll
    for (int i = 0; i < 2; ++i) { int R, C; stage_rc(tid * 16 + i * 8192, R, C); const int Rb = Epi::PERM ? ((R & ~31) + perm32(R & 31)) : R; RA[i] = R; CA[i] = C;
        voffB[i] = (unsigned)(Rb * K + C) * 2u;
#pragma unroll
        for (int h = 0; h < 2; ++h) { vA[h][i] = (unsigned)((h * HALF + R) * K + C) * 2u; vAn[h][i] = vA[h][i]; } }
    const size_t kstep = (size_t)(BK * 2);
    const size_t hstep = (size_t)HALF * K * 2;
    const size_t tstep = 2 * hstep;
    const unsigned ldsw = (unsigned)wid * 1024u;
    const int aoff = lds_byte(wr * 64 + fr, fq * 8), boff = lds_byte(wc * 32 + fr, fq * 8);
#define PG8_SA(b, h) (((b) * 2 + (h)) * HTB)
#define PG8_SB(b, h) ((4 + (b) * 2 + (h)) * HTB)
#define PG8_STAGE(bufoff, gbase, voff) do { _Pragma("unroll") for (int _i = 0; _i < 2; ++_i) \
        __builtin_amdgcn_global_load_lds((const unsigned*)((const char*)(gbase) + (voff)[_i]), (PG8_LAS unsigned*)(lds + (bufoff) + ldsw + _i * 8192), 16, 0, 0); } while (0)
#define PG8_LDA(dst, b, h) do { _Pragma("unroll") for (int m = 0; m < 4; ++m) _Pragma("unroll") for (int k = 0; k < 2; ++k) dst[m][k] = *(const PG8_LAS bf16x8*)(lds + PG8_SA(b, h) + aoff + m * 2048 + k * 1024); } while (0)
#define PG8_LDB(dst, b, h) do { _Pragma("unroll") for (int n = 0; n < 2; ++n) _Pragma("unroll") for (int k = 0; k < 2; ++k) dst[n][k] = *(const PG8_LAS bf16x8*)(lds + PG8_SB(b, h) + boff + n * 2048 + k * 1024); } while (0)
#define PG8_MMA(ai, bj, At, Bt) do { __builtin_amdgcn_s_setprio(1); _Pragma("unroll") for (int m = 0; m < 4; ++m) _Pragma("unroll") for (int n = 0; n < 2; ++n) _Pragma("unroll") for (int k = 0; k < 2; ++k) \
        acc[ai][bj][m][n] = __builtin_amdgcn_mfma_f32_16x16x32_bf16(Bt[n][k], At[m][k], acc[ai][bj][m][n], 0, 0, 0); __builtin_amdgcn_s_setprio(0); } while (0)
#define PG8_WAIT_V(n) asm volatile("s_waitcnt vmcnt(" #n ")" ::: "memory")
#define PG8_WAIT_L(n) asm volatile("s_waitcnt lgkmcnt(" #n ")" ::: "memory")
#define PG8_BAR __builtin_amdgcn_s_barrier()
#define PG8_SCHED __builtin_amdgcn_sched_barrier(0)
#define PG8_SETV(V, U) do { if constexpr (GATHER) { _Pragma("unroll") for (int _h = 0; _h < 2; ++_h) _Pragma("unroll") for (int _i = 0; _i < 2; ++_i) { const int _r = _h * HALF + RA[_i]; \
        const int _tok = _r < (U).nvalid ? g.list[(size_t)(U).e * T + (U).r0 + _r] : 0; V[_h][_i] = (unsigned)(_tok * K + CA[_i]) * 2u; } } } while (0)
    Unit cur, nxt; int ui = 0;
    if (!S.next(0, cur)) return;
    f32x4 acc[2][2][4][2];
#pragma unroll
    for (int a = 0; a < 2; ++a)
#pragma unroll
        for (int b = 0; b < 2; ++b)
#pragma unroll
            for (int m = 0; m < 4; ++m)
#pragma unroll
                for (int n = 0; n < 2; ++n) acc[a][b][m][n] = (f32x4){0.f, 0.f, 0.f, 0.f};
    bf16x8 At[4][2], B0[2][2], B1[2][2];
    PG8_SETV(vA, cur);
    S.a_ready(swave, cur);
    const char* cA = (const char*)g.A + (GATHER ? (size_t)0 : (size_t)cur.pm * tstep); const char* cB = (const char*)g.Bt + (size_t)cur.e * g.bstride + (size_t)cur.pn * tstep;
    if constexpr (SP2) {
        PG8_STAGE(PG8_SB(0, 0), cB, voffB); PG8_STAGE(PG8_SB(0, 1), cB + hstep, voffB); PG8_STAGE(PG8_SA(0, 0), cA, vA[0]); PG8_STAGE(PG8_SA(0, 1), cA, vA[1]);
        if (wr == 1) PG8_BAR;
        PG8_WAIT_V(2); PG8_BAR;
        PG8_STAGE(PG8_SB(1, 0), cB + kstep, voffB); PG8_STAGE(PG8_SA(1, 0), cA + kstep, vA[0]); PG8_STAGE(PG8_SB(1, 1), cB + hstep + kstep, voffB);
        PG8_WAIT_V(6); PG8_BAR;
    } else {
        PG8_STAGE(PG8_SB(0, 0), cB, voffB); PG8_STAGE(PG8_SA(0, 0), cA, vA[0]); PG8_STAGE(PG8_SB(0, 1), cB + hstep, voffB); PG8_STAGE(PG8_SA(0, 1), cA, vA[1]);
        if (wr == 1) PG8_BAR;
        PG8_WAIT_V(4); PG8_BAR;
        PG8_STAGE(PG8_SB(1, 0), cB + kstep, voffB); PG8_STAGE(PG8_SA(1, 0), cA + kstep, vA[0]); PG8_STAGE(PG8_SB(1, 1), cB + hstep + kstep, voffB);
        PG8_WAIT_V(6); PG8_BAR;
    }
    for (;;) {
        const bool has_next = S.next(ui + 1, nxt);
        if (has_next) PG8_SETV(vAn, nxt);
        const char* nA = has_next ? (const char*)g.A + (GATHER ? (size_t)0 : (size_t)nxt.pm * tstep) : cA; const char* nB = has_next ? (const char*)g.Bt + (size_t)nxt.e * g.bstride + (size_t)nxt.pn * tstep : cB;
        for (int t = 0; t < nt; t += 2) {
            const bool last = (t == nt - 2);
            if (last && has_next) S.a_ready(swave, nxt);
            const char* a1 = cA + (size_t)(t + 1) * kstep;
            const char* a2 = last ? nA : cA + (size_t)(t + 2) * kstep; const char* b2 = last ? nB : cB + (size_t)(t + 2) * kstep;
            const char* a3 = a2 + kstep; const char* b3 = b2 + kstep;
            unsigned v2[2][2];
#pragma unroll
            for (int h = 0; h < 2; ++h)
#pragma unroll
                for (int i = 0; i < 2; ++i) v2[h][i] = (GATHER && last && has_next) ? vAn[h][i] : vA[h][i];
            if constexpr (SP2) {
            PG8_LDB(B0, 0, 0); PG8_LDB(B1, 0, 1); PG8_SCHED; PG8_LDA(At, 0, 0); PG8_STAGE(PG8_SA(1, 1), a1, vA[1]);
            PG8_WAIT_V(8); PG8_WAIT_L(0); PG8_BAR; PG8_MMA(0, 0, At, B0); PG8_MMA(0, 1, At, B1); PG8_BAR; PG8_SCHED;
            PG8_LDA(At, 0, 1); PG8_STAGE(PG8_SB(0, 0), b2, voffB); PG8_STAGE(PG8_SB(0, 1), b2 + hstep, voffB); PG8_STAGE(PG8_SA(0, 0), a2, v2[0]);
            PG8_WAIT_V(8); PG8_WAIT_L(0); PG8_BAR; PG8_MMA(1, 0, At, B0); PG8_MMA(1, 1, At, B1); PG8_BAR; PG8_SCHED;
            PG8_LDB(B0, 1, 0); PG8_LDB(B1, 1, 1); PG8_SCHED; PG8_LDA(At, 1, 0); PG8_STAGE(PG8_SA(0, 1), a2, v2[1]);
            PG8_WAIT_V(8); PG8_WAIT_L(0); PG8_BAR; PG8_MMA(0, 0, At, B0); PG8_MMA(0, 1, At, B1); PG8_BAR; PG8_SCHED;
            PG8_LDA(At, 1, 1); PG8_STAGE(PG8_SB(1, 0), b3, voffB); PG8_STAGE(PG8_SB(1, 1), b3 + hstep, voffB); PG8_STAGE(PG8_SA(1, 0), a3, v2[0]);
            PG8_WAIT_V(8); PG8_WAIT_L(0); PG8_BAR; PG8_MMA(1, 0, At, B0); PG8_MMA(1, 1, At, B1); PG8_BAR; PG8_SCHED;
            } else {
            PG8_LDB(B0, 0, 0); PG8_SCHED; PG8_LDA(At, 0, 0); PG8_STAGE(PG8_SA(1, 1), a1, vA[1]);
            PG8_WAIT_L(8); PG8_BAR; PG8_WAIT_L(0); PG8_MMA(0, 0, At, B0); PG8_BAR; PG8_SCHED;
            PG8_LDB(B1, 0, 1); PG8_STAGE(PG8_SB(0, 0), b2, voffB);
            PG8_BAR; PG8_WAIT_L(0); PG8_MMA(0, 1, At, B1); PG8_BAR;
            PG8_LDA(At, 0, 1); PG8_STAGE(PG8_SA(0, 0), a2, v2[0]);
            PG8_BAR; PG8_WAIT_L(0); PG8_MMA(1, 0, At, B0); PG8_BAR; PG8_SCHED;
            PG8_STAGE(PG8_SB(0, 1), b2 + hstep, voffB);
            PG8_WAIT_V(6); PG8_BAR; PG8_MMA(1, 1, At, B1); PG8_BAR;
            PG8_LDB(B0, 1, 0); PG8_SCHED; PG8_LDA(At, 1, 0); PG8_STAGE(PG8_SA(0, 1), a2, v2[1]);
            PG8_WAIT_L(8); PG8_BAR; PG8_WAIT_L(0); PG8_MMA(0, 0, At, B0); PG8_BAR; PG8_SCHED;
            PG8_LDB(B1, 1, 1); PG8_STAGE(PG8_SB(1, 0), b3, voffB);
            PG8_BAR; PG8_WAIT_L(0); PG8_MMA(0, 1, At, B1); PG8_BAR;
            PG8_LDA(At, 1, 1); PG8_STAGE(PG8_SA(1, 0), a3, v2[0]);
            PG8_BAR; PG8_WAIT_L(0); PG8_MMA(1, 0, At, B0); PG8_BAR; PG8_SCHED;
            PG8_STAGE(PG8_SB(1, 1), b3 + hstep, voffB);
            PG8_WAIT_V(6); PG8_BAR; PG8_MMA(1, 1, At, B1); PG8_BAR;
            }
        }
        if constexpr (ALIGN_EPI) { if (wr == 0) PG8_BAR; }
        E(acc, cur, wr, wc, fr, fq);
        if (!has_next) break;
#pragma unroll
        for (int a = 0; a < 2; ++a)
#pragma unroll
            for (int b = 0; b < 2; ++b)
#pragma unroll
                for (int m = 0; m < 4; ++m)
#pragma unroll
                    for (int n = 0; n < 2; ++n) acc[a][b][m][n] = (f32x4){0.f, 0.f, 0.f, 0.f};
        cur = nxt; cA = nA; cB = nB; ++ui;
        if constexpr (GATHER) {
#pragma unroll
            for (int h = 0; h < 2; ++h)
#pragma unroll
                for (int i = 0; i < 2; ++i) vA[h][i] = vAn[h][i]; }
        if constexpr (ALIGN_EPI) { if (wr == 1) PG8_BAR; }
    }
    PG8_WAIT_V(0);
    if constexpr (!ALIGN_EPI) { if (wr == 0) PG8_BAR; }
    PG8_BAR;
#undef PG8_SA
#undef PG8_SB
#undef PG8_STAGE
#undef PG8_LDA
#undef PG8_LDB
#undef PG8_MMA
#undef PG8_WAIT_V
#undef PG8_WAIT_L
#undef PG8_BAR
#undef PG8_SCHED
#undef PG8_SETV
}

struct EpiInproj {
    static constexpr bool PERM = true;
    unsigned char* ws;
    __device__ __forceinline__ void operator()(const f32x4 (&acc)[2][2][4][2], const Unit& u, int wr, int wc, int fr, int fq) const {
        unsigned char* wsb = ws; asm volatile("" : "+v"(wsb));
        bf16* QVO = (bf16*)(wsb + WS_QS); bf16* ZG = (bf16*)(wsb + WS_ZG); float* LOGF = (float*)(wsb + WS_LOGF); const float* LB = (const float*)(wsb + WS_SMALL + SM_LB);
        const int row0 = u.pm * BM + wr * 64 + fr, seg = u.pn >> 1, cin = (u.pn & 1) * 256 + wc * 32 + 8 * fq;
        if (seg == 1) {
            f32x4 lb[2][2];
#pragma unroll
            for (int bj = 0; bj < 2; ++bj)
#pragma unroll
                for (int n = 0; n < 2; ++n) lb[bj][n] = *(const f32x4*)(LB + cin + bj * HALF + 4 * n);
#pragma unroll
            for (int ai = 0; ai < 2; ++ai)
#pragma unroll
                for (int m = 0; m < 4; ++m) { _Float16* rowp = (_Float16*)LOGF + (size_t)(row0 + ai * HALF + m * 16) * 512 + cin;
#pragma unroll
                    for (int bj = 0; bj < 2; ++bj) { f32x4 o[2];
#pragma unroll
                        for (int n = 0; n < 2; ++n)
#pragma unroll
                            for (int j = 0; j < 4; ++j) { const float l = lb[bj][n][j]; o[n][j] = __logf(l + (1.f - l) * fast_sigmoid(acc[ai][bj][m][n][j])); }
                        typedef _Float16 h8v __attribute__((ext_vector_type(8)));
                        h8v hv8;
#pragma unroll
                        for (int n = 0; n < 2; ++n)
#pragma unroll
                            for (int j = 0; j < 4; ++j) hv8[4 * n + j] = (_Float16)o[n][j];
                        *(h8v*)(rowp + bj * HALF) = hv8; } }
            return;
        }
        if (seg >= 4) {
            const int cz = (u.pn - 8) * 256 + wc * 32 + 8 * fq;
#pragma unroll
            for (int ai = 0; ai < 2; ++ai)
#pragma unroll
                for (int m = 0; m < 4; ++m) { bf16* rowp = ZG + (size_t)(row0 + ai * HALF + m * 16) * 1024 + cz;
#pragma unroll
                    for (int bj = 0; bj < 2; ++bj) { const f32x4 v0 = acc[ai][bj][m][0], v1 = acc[ai][bj][m][1];
                        const f32x2 a = gelu_pk((f32x2){v0[0], v0[1]}), b = gelu_pk((f32x2){v0[2], v0[3]}), c = gelu_pk((f32x2){v1[0], v1[1]}), d = gelu_pk((f32x2){v1[2], v1[3]});
                        u32x4 w; w.x = cvt_pk_bf16(a.x, a.y); w.y = cvt_pk_bf16(b.x, b.y); w.z = cvt_pk_bf16(c.x, c.y); w.w = cvt_pk_bf16(d.x, d.y);
                        *(u32x4*)(rowp + bj * HALF) = w; } }
            return;
        }
        bf16* base = QVO + (size_t)(seg == 0 ? 0 : seg - 1) * (8u << 20); const bool act = seg != 2;
#pragma unroll
        for (int ai = 0; ai < 2; ++ai)
#pragma unroll
            for (int m = 0; m < 4; ++m) { bf16* rowp = base + (size_t)(row0 + ai * HALF + m * 16) * 512 + cin;
#pragma unroll
                for (int bj = 0; bj < 2; ++bj) { f32x4 v0 = acc[ai][bj][m][0], v1 = acc[ai][bj][m][1];
                    if (act) {
#pragma unroll
                        for (int j = 0; j < 4; ++j) { v0[j] = v0[j] * fast_sigmoid(v0[j]); v1[j] = v1[j] * fast_sigmoid(v1[j]); } }
                    u32x4 w; w.x = cvt_pk_bf16(v0[0], v0[1]); w.y = cvt_pk_bf16(v0[2], v0[3]); w.z = cvt_pk_bf16(v1[0], v1[1]); w.w = cvt_pk_bf16(v1[2], v1[3]);
                    *(u32x4*)(rowp + bj * HALF) = w; } }
    }
};
struct EpiBf16 {
    static constexpr bool PERM = true;
    unsigned char* ws; size_t off; int ldc;
    __device__ __forceinline__ void operator()(const f32x4 (&acc)[2][2][4][2], const Unit& u, int wr, int wc, int fr, int fq) const {
        unsigned char* wsb = ws; asm volatile("" : "+v"(wsb)); bf16* O = (bf16*)(wsb + off);
        const int row0 = u.pm * BM + wr * 64 + fr, col0 = u.pn * BM + wc * 32 + 8 * fq;
#pragma unroll
        for (int ai = 0; ai < 2; ++ai)
#pragma unroll
            for (int m = 0; m < 4; ++m) { bf16* rowp = O + (size_t)(row0 + ai * HALF + m * 16) * ldc + col0;
#pragma unroll
                for (int bj = 0; bj < 2; ++bj) { const f32x4 v0 = acc[ai][bj][m][0], v1 = acc[ai][bj][m][1];
                    u32x4 w; w.x = cvt_pk_bf16(v0[0], v0[1]); w.y = cvt_pk_bf16(v0[2], v0[3]); w.z = cvt_pk_bf16(v1[0], v1[1]); w.w = cvt_pk_bf16(v1[2], v1[3]);
                    *(u32x4*)(rowp + bj * HALF) = w; } }
    }
};
struct EpiUp {
    static constexpr bool PERM = true;
    unsigned char* ws;
    __device__ __forceinline__ void operator()(const f32x4 (&acc)[2][2][4][2], const Unit& u, int wr, int wc, int fr, int fq) const {
        unsigned char* wsb = ws; asm volatile("" : "+v"(wsb)); bf16* ACT = (bf16*)(wsb + WS_ACT);
        const int row0 = u.pm * BM + wr * 64 + fr, col0 = u.pn * HALF + wc * 32 + 8 * fq;
#pragma unroll
        for (int ai = 0; ai < 2; ++ai)
#pragma unroll
            for (int m = 0; m < 4; ++m) { bf16* rowp = ACT + (size_t)(row0 + ai * HALF + m * 16) * HID + col0;
                f32x4 o0, o1;
#pragma unroll
                for (int j = 0; j < 4; ++j) { const float g0 = acc[ai][0][m][0][j], g1 = acc[ai][0][m][1][j]; o0[j] = g0 * fast_sigmoid(g0) * acc[ai][1][m][0][j]; o1[j] = g1 * fast_sigmoid(g1) * acc[ai][1][m][1][j]; }
                u32x4 w; w.x = cvt_pk_bf16(o0[0], o0[1]); w.y = cvt_pk_bf16(o0[2], o0[3]); w.z = cvt_pk_bf16(o1[0], o1[1]); w.w = cvt_pk_bf16(o1[2], o1[3]);
                *(u32x4*)rowp = w; }
    }
};
struct EpiDown {
    static constexpr bool PERM = true;
    unsigned char* ws;
    __device__ __forceinline__ void operator()(const f32x4 (&acc)[2][2][4][2], const Unit& u, int wr, int wc, int fr, int fq) const {
        unsigned char* wsb = ws; asm volatile("" : "+v"(wsb)); bf16* Y2 = (bf16*)(wsb + WS_Y2); const float* WL = (const float*)(wsb + WS_WLIST);
        const int rt0 = wr * 64 + fr, col0 = u.pn * BM + wc * 32 + 8 * fq;
#pragma unroll
        for (int ai = 0; ai < 2; ++ai)
#pragma unroll
            for (int m = 0; m < 4; ++m) { const int rt = rt0 + ai * HALF + m * 16; const float w8 = rt < u.nvalid ? WL[(size_t)u.e * T + u.r0 + rt] : 0.f;
                bf16* rowp = Y2 + (size_t)(u.pm * BM + rt) * D + col0;
#pragma unroll
                for (int bj = 0; bj < 2; ++bj) { const f32x4 v0 = acc[ai][bj][m][0] * w8, v1 = acc[ai][bj][m][1] * w8;
                    u32x4 w; w.x = cvt_pk_bf16(v0[0], v0[1]); w.y = cvt_pk_bf16(v0[2], v0[3]); w.z = cvt_pk_bf16(v1[0], v1[1]); w.w = cvt_pk_bf16(v1[2], v1[3]);
                    *(u32x4*)(rowp + bj * HALF) = w; } }
    }
};
}


__device__ __forceinline__ f32x4 mma16(bf16x8 a, bf16x8 b, f32x4 c) { return __builtin_amdgcn_mfma_f32_16x16x32_bf16(a, b, c, 0, 0, 0); }
__device__ __forceinline__ bf16x8 frag(const LAS bf16* X, int stride, int rb, int ks, int lane) { return *(const LAS bf16x8*)(X + (rb * 16 + (lane & 15)) * stride + ks * 32 + 8 * (lane >> 4)); }
constexpr int MX_QD = 0, MX_KD = 17408, MX_KDT = 34816, MX_VT = 53248, MX_PT = 71680, MX_STT = 80896, MX_SMALL = 115712;
constexpr int SD = 136, SS = 72, SO = 132;
template <int MODE> __device__ __forceinline__ void hgrn_item(const int swave, const P& p, LAS unsigned char* lds, int item) {
    const int tid = otid(swave), lane = tid & 63, w = __builtin_amdgcn_readfirstlane(tid >> 6), q4 = lane >> 4, r16 = lane & 15;
    const int bh = item >> 5, sc = item & 31, b = bh >> 2, h = bh & 3;
    const size_t row0 = (size_t)b * SEQ + (size_t)sc * 256;
    LAS bf16* QD = (LAS bf16*)(lds + MX_QD); LAS bf16* KD = (LAS bf16*)(lds + MX_KD); LAS bf16* KDT = (LAS bf16*)(lds + MX_KDT); LAS bf16* VT = (LAS bf16*)(lds + MX_VT);
    LAS bf16* PT = (LAS bf16*)(lds + MX_PT); LAS bf16* STT = (LAS bf16*)(lds + MX_STT); LAS float* O = (LAS float*)(lds + MX_QD);
    LAS float* tot = (LAS float*)(lds + MX_SMALL); LAS float* ecm = tot + 512; LAS float* elast = ecm + 128; LAS float* efac = elast + 128;
    const bf16* QS = WSP(bf16, WS_QS); const _Float16* LF = WSP(_Float16, WS_LOGF); const bf16* VV = WSP(bf16, WS_V); const bf16* OG = WSP(bf16, WS_OG); bf16* YC = WSP(bf16, WS_B);
    const int col = tid & 127, g = tid >> 7;
    f32x4 S[8];
#pragma unroll
    for (int db = 0; db < 8; ++db) {
        if (MODE == 1) {
#pragma unroll
            for (int r = 0; r < 4; ++r) S[db][r] = WSP(float, WS_SSTART)[(size_t)item * 16384 + (16 * w + 4 * q4 + r) * 128 + 16 * db + r16];
        } else S[db] = (f32x4){0.f, 0.f, 0.f, 0.f}; }
    float lastsum = 0.f;
    float lf[16]; bf16 qv[16], vv[16];
    unsigned ogp[8];
#define HG_LOAD(c_) do { const size_t ob_ = (row0 + 64 * (c_)) * 512 + h * 128; const unsigned lo_ = (unsigned)(16 * g * 512 + col);   \
        _Pragma("unroll") for (int i = 0; i < 16; ++i) { lf[i] = (float)ldg<_Float16>(LF + ob_, (lo_ + i * 512) * 2u); vv[i] = ldg<bf16>(VV + ob_, (lo_ + i * 512) * 2u); qv[i] = MODE == 1 ? ldg<bf16>(QS + ob_, (lo_ + i * 512) * 2u) : (bf16)0; } } while (0)
#define HG_LOADG(c_) do { if (MODE == 1) { _Pragma("unroll") for (int rr = 0; rr < 8; ++rr) ogp[rr] = ldg<unsigned>(OG + (row0 + 64 * (c_) + 8 * w + rr) * 512 + h * 128, (unsigned)lane * 4u); } } while (0)
    HG_LOAD(0);
#pragma unroll 1
    for (int c = 0; c < 4; ++c) {
        float run = 0.f;
#pragma unroll
        for (int i = 0; i < 16; ++i) { run += lf[i]; }
        tot[g * 128 + col] = run;
        __syncthreads();
        const float t0 = tot[col], t1 = tot[128 + col], t2 = tot[256 + col], t3 = tot[384 + col];
        const float cstart = g == 0 ? 0.f : (g == 1 ? t0 : (g == 2 ? t0 + t1 : t0 + t1 + t2));
        const float cmid = t0 + t1, last = (t0 + t1) + (t2 + t3);
        if (g == 0) { ecm[col] = __expf(cmid); elast[col] = __expf(last); efac[col] = __expf(last - cmid); lastsum += last; }
        {
            float cum = cstart; unsigned kt[8], vt[8];
#pragma unroll
            for (int i = 0; i < 16; i += 2) {
                float kd2[2];
#pragma unroll
                for (int j = 0; j < 2; ++j) { cum += lf[i + j]; const float kk = 1.f - __expf(lf[i + j]); const float ek = __expf(fminf(cmid - cum, 80.f)); kd2[j] = kk * ek;
                    const bf16 kb = f2bf(kd2[j]);
                    if (MODE == 1) { const float eq = __expf(fminf(cum - cmid, 80.f)); QD[(16 * g + i + j) * SD + col] = f2bf(bf2f(qv[i + j]) * eq); KD[(16 * g + i + j) * SD + col] = kb; } }
                kt[i >> 1] = cvt_pk_bf16(kd2[0], kd2[1]); vt[i >> 1] = (unsigned)vv[i] | ((unsigned)vv[i + 1] << 16);
            }
            *(LAS u32x4*)(KDT + col * SS + 16 * g) = (u32x4){kt[0], kt[1], kt[2], kt[3]}; *(LAS u32x4*)(KDT + col * SS + 16 * g + 8) = (u32x4){kt[4], kt[5], kt[6], kt[7]};
            *(LAS u32x4*)(VT + col * SS + 16 * g) = (u32x4){vt[0], vt[1], vt[2], vt[3]}; *(LAS u32x4*)(VT + col * SS + 16 * g + 8) = (u32x4){vt[4], vt[5], vt[6], vt[7]};
        }
        __syncthreads();
        if (c < 3) HG_LOAD(c + 1);
        f32x4 o[4]; const int tb = w & 3, vb0 = (w >> 2) * 4;
        if (MODE == 1) {
#pragma unroll
            for (int db = 0; db < 8; ++db) { const float e = ecm[16 * db + r16];
#pragma unroll
                for (int r = 0; r < 4; ++r) STT[(16 * w + 4 * q4 + r) * SD + 16 * db + r16] = f2bf(S[db][r] * e); }
#pragma unroll
            for (int k = 0; k < 2; ++k) { const int tile = w + 8 * k, stb = tile >> 2, ssb = tile & 3; f32x4 a = (f32x4){0.f, 0.f, 0.f, 0.f};
                if (ssb <= stb) {
#pragma unroll
                    for (int ks = 0; ks < 4; ++ks) a = mma16(frag(QD, SD, stb, ks, lane), frag(KD, SD, ssb, ks, lane), a); }
#pragma unroll
                for (int r = 0; r < 4; ++r) { const int t = stb * 16 + 4 * q4 + r, s_ = ssb * 16 + r16; PT[t * SS + s_] = (s_ <= t) ? f2bf(a[r]) : (bf16)0; } }
            __syncthreads();
            bf16x8 ap[2], aq[4];
#pragma unroll
            for (int ks = 0; ks < 2; ++ks) ap[ks] = frag(PT, SS, tb, ks, lane);
#pragma unroll
            for (int ks = 0; ks < 4; ++ks) aq[ks] = frag(QD, SD, tb, ks, lane);
#pragma unroll
            for (int j = 0; j < 4; ++j) { f32x4 a = (f32x4){0.f, 0.f, 0.f, 0.f};
#pragma unroll
                for (int ks = 0; ks < 2; ++ks) a = mma16(ap[ks], frag(VT, SS, vb0 + j, ks, lane), a);
#pragma unroll
                for (int ks = 0; ks < 4; ++ks) a = mma16(aq[ks], frag(STT, SD, vb0 + j, ks, lane), a);
                o[j] = a; }
        }
        {
            bf16x8 av[2];
#pragma unroll
            for (int ks = 0; ks < 2; ++ks) av[ks] = frag(VT, SS, w, ks, lane);
#pragma unroll
            for (int db = 0; db < 8; ++db) { f32x4 u = (f32x4){0.f, 0.f, 0.f, 0.f};
#pragma unroll
                for (int ks = 0; ks < 2; ++ks) u = mma16(av[ks], frag(KDT, SS, db, ks, lane), u);
                const float el = elast[16 * db + r16], ef = efac[16 * db + r16];
                S[db] = S[db] * el + u * ef; }
        }
        HG_LOADG(c);
        if (MODE == 1) {
            __syncthreads();
#pragma unroll
            for (int j = 0; j < 4; ++j)
#pragma unroll
                for (int r = 0; r < 4; ++r) O[(tb * 16 + 4 * q4 + r) * SO + (vb0 + j) * 16 + r16] = o[j][r];
            __syncthreads();
            const f32x2 gw = ldg<f32x2>(p.hg_norm_w, (unsigned)lane * 8u);
#pragma unroll
            for (int rr = 0; rr < 8; ++rr) { const int t = 8 * w + rr; const size_t row = row0 + 64 * c + t;
                const f32x2 ov = *(const LAS f32x2*)(O + t * SO + 2 * lane);
                const float ss = wave_sum_dpp(ov.x * ov.x + ov.y * ov.y); const float rs = rsqrtf(ss * (1.f / 128.f) + RMS_EPS);
                const float y0 = ov.x * rs * gw.x * __uint_as_float(ogp[rr] << 16), y1 = ov.y * rs * gw.y * __uint_as_float(ogp[rr] & 0xffff0000u);
                stg<unsigned>(YC + row * D + h * 128, (unsigned)lane * 4u, cvt_pk_bf16(y0, y1)); }
        }
    }
    if (MODE == 0) {
#pragma unroll
        for (int db = 0; db < 8; ++db)
#pragma unroll
            for (int r = 0; r < 4; ++r) __hip_atomic_store(WSP(float, WS_SLOC) + (size_t)item * 16384 + (16 * w + 4 * q4 + r) * 128 + 16 * db + r16, S[db][r], __ATOMIC_RELAXED, __HIP_MEMORY_SCOPE_AGENT);
        if (g == 0) __hip_atomic_store(WSP(float, WS_SMALL + SM_DTOT) + item * 128 + col, __expf(lastsum), __ATOMIC_RELAXED, __HIP_MEMORY_SCOPE_AGENT);
    }
    __syncthreads();
#undef HG_LOAD
#undef HG_LOADG
}
__device__ __forceinline__ void hgrn_scan(const P& p, int gid) {
    const int bh = gid >> 14, idx = gid & 16383, d = idx & 127;
    const float* SL = WSP(float, WS_SLOC) + (size_t)bh * 32 * 16384 + idx; float* ST = WSP(float, WS_SSTART) + (size_t)bh * 32 * 16384 + idx; const float* DT = WSP(float, WS_SMALL + SM_DTOT) + bh * 32 * 128 + d;
    float s = 0.f;
#pragma unroll 8
    for (int sc = 0; sc < 32; ++sc) { __hip_atomic_store(ST + (size_t)sc * 16384, s, __ATOMIC_RELAXED, __HIP_MEMORY_SCOPE_AGENT); s = s * DT[sc * 128] + SL[(size_t)sc * 16384]; }
}
__device__ __forceinline__ void sg_item(const int swave, const P& p, LAS unsigned char* lds, int item) {
    const int tid = otid(swave), lane = tid & 63, w = __builtin_amdgcn_readfirstlane(tid >> 6), q4 = lane >> 4, r16 = lane & 15;
    const int b = item >> 7, n = (item >> 1) & 63, gp = item & 1; const size_t row0 = (size_t)b * SEQ + (size_t)n * 128;
    LAS bf16* VNT = (LAS bf16*)lds; LAS bf16* WT = (LAS bf16*)(lds + 34816); LAS float* mean = (LAS float*)(lds + 69632); LAS float* rstd = mean + 128; LAS float* OM = (LAS float*)(lds + 71680);
    const bf16* ZG = WSP(bf16, WS_ZG); bf16* YC = WSP(bf16, WS_B);
    {
        bf16x8 z[16];
#pragma unroll
        for (int rr = 0; rr < 16; ++rr) z[rr] = ldg<bf16x8>(ZG + (row0 + 16 * w + rr) * 1024 + 512, (unsigned)lane * 16u);
#pragma unroll
        for (int rr = 0; rr < 16; ++rr) { float s1 = 0.f, s2 = 0.f;
#pragma unroll
            for (int j = 0; j < 8; ++j) { const float v = bf2f((bf16)z[rr][j]); s1 += v; s2 += v * v; }
            const float m = wave_sum_dpp(s1) * (1.f / 512.f); const float var = fmaxf(wave_sum_dpp(s2) * (1.f / 512.f) - m * m, 0.f);
            if (lane == 0) { mean[16 * w + rr] = m; rstd[16 * w + rr] = rsqrtf(var + LN_EPS); } }
    }
#pragma unroll 1
    for (int gi = 0; gi < 2; ++gi) { const int g = 2 * gp + gi;
        {
            const int t = tid >> 2, seg = tid & 3; const float* wr = p.sg_w + ((size_t)(g * 128 + t)) * 128 + seg * 32;
#pragma unroll
            for (int j = 0; j < 4; ++j) { const f32x4 a = *(const f32x4*)(wr + 8 * j), c = *(const f32x4*)(wr + 8 * j + 4); const int s0 = seg * 32 + 8 * j; u32x4 o;
                o.x = cvt_pk_bf16(s0 + 0 <= t ? a[0] : 0.f, s0 + 1 <= t ? a[1] : 0.f); o.y = cvt_pk_bf16(s0 + 2 <= t ? a[2] : 0.f, s0 + 3 <= t ? a[3] : 0.f);
                o.z = cvt_pk_bf16(s0 + 4 <= t ? c[0] : 0.f, s0 + 5 <= t ? c[1] : 0.f); o.w = cvt_pk_bf16(s0 + 6 <= t ? c[2] : 0.f, s0 + 7 <= t ? c[3] : 0.f);
                *(LAS u32x4*)(WT + t * SD + s0) = o; }
        }
        const int c = tid & 127, sgp = tid >> 7;
        bf16 zc[32];
#pragma unroll
        for (int i = 0; i < 32; ++i) zc[i] = ZG[(row0 + 32 * sgp + i) * 1024 + 512 + g * 128 + c];
        __syncthreads();
        {
            const float lg = p.sg_ln_g[g * 128 + c], lb = p.sg_ln_b[g * 128 + c];
#pragma unroll
            for (int i8 = 0; i8 < 4; ++i8) { float vn[8];
#pragma unroll
                for (int j = 0; j < 8; ++j) { const int s_ = 32 * sgp + 8 * i8 + j; vn[j] = (bf2f(zc[8 * i8 + j]) - mean[s_]) * rstd[s_] * lg + lb; }
                *(LAS u32x4*)(VNT + c * SD + 32 * sgp + 8 * i8) = (u32x4){cvt_pk_bf16(vn[0], vn[1]), cvt_pk_bf16(vn[2], vn[3]), cvt_pk_bf16(vn[4], vn[5]), cvt_pk_bf16(vn[6], vn[7])}; }
        }
        __syncthreads();
        bf16x8 aw[4];
#pragma unroll
        for (int ks = 0; ks < 4; ++ks) aw[ks] = frag(WT, SD, w, ks, lane);
#pragma unroll
        for (int cb = 0; cb < 8; ++cb) { f32x4 a = (f32x4){0.f, 0.f, 0.f, 0.f};
#pragma unroll
            for (int ks = 0; ks < 4; ++ks) a = mma16(aw[ks], frag(VNT, SD, cb, ks, lane), a);
#pragma unroll
            for (int r = 0; r < 4; ++r) OM[(16 * w + 4 * q4 + r) * SO + 16 * cb + r16] = a[r]; }
        __syncthreads();
        {
            const int t = tid >> 2, cs = (tid & 3) * 32; const float sb = p.sg_b[g * 128 + t];
            const bf16* up = ZG + (row0 + t) * 1024 + g * 128 + cs; bf16* op = YC + (row0 + t) * D + 512 + g * 128 + cs;
#pragma unroll
            for (int k = 0; k < 4; ++k) { const u32x4 uu = *(const u32x4*)(up + 8 * k); const f32x4 m0 = *(const LAS f32x4*)(OM + t * SO + cs + 8 * k), m1 = *(const LAS f32x4*)(OM + t * SO + cs + 8 * k + 4);
                u32x4 o;
                o.x = cvt_pk_bf16(__uint_as_float(uu.x << 16) * (m0[0] + sb), __uint_as_float(uu.x & 0xffff0000u) * (m0[1] + sb)); o.y = cvt_pk_bf16(__uint_as_float(uu.y << 16) * (m0[2] + sb), __uint_as_float(uu.y & 0xffff0000u) * (m0[3] + sb));
                o.z = cvt_pk_bf16(__uint_as_float(uu.z << 16) * (m1[0] + sb), __uint_as_float(uu.z & 0xffff0000u) * (m1[1] + sb)); o.w = cvt_pk_bf16(__uint_as_float(uu.w << 16) * (m1[2] + sb), __uint_as_float(uu.w & 0xffff0000u) * (m1[3] + sb));
                *(u32x4*)(op + 8 * k) = o; }
        }
    }
    __syncthreads();
}

typedef GAS unsigned gu32;
#define XB_TMO      128
#define XB_XCNT(j)  (256  + 64 * (j))
#define XB_XSUB(j)  (1280 + 64 * (j))
#define XB_XGEN(j)  (2304 + 64 * (j))
#define XB_TOP      3328
#define XB_TOPGEN   3392
#define XCD_BAR_WORDS 3456
#define XB_SPIN_CAP (1u << 18)
__device__ __forceinline__ unsigned xb_ld(unsigned* p)              { return __hip_atomic_load(p, __ATOMIC_RELAXED, __HIP_MEMORY_SCOPE_AGENT); }
__device__ __forceinline__ unsigned xb_add(unsigned* p, unsigned v) { return __hip_atomic_fetch_add(p, v, __ATOMIC_RELAXED, __HIP_MEMORY_SCOPE_AGENT); }
__device__ __forceinline__ unsigned xb_xcc_id() { return (unsigned)__builtin_amdgcn_s_getreg((3 << 11) | 20) & 0xFu; }
#define XB_SPIN(cond, bar) do { unsigned _sp = 0; while (cond) { __builtin_amdgcn_s_sleep(1); \
    if ((++_sp & 255u) == 0u) { if (xb_ld(&(bar)[XB_TMO])) break; if (_sp > XB_SPIN_CAP) { atomicAdd(&(bar)[XB_TMO], 1u); break; } } } } while (0)
struct XcdBarrier { unsigned* bar; unsigned x; volatile LAS unsigned* st; };
__device__ __forceinline__ XcdBarrier xcd_barrier_post(const int swave, unsigned* bar, volatile LAS unsigned* st) {
    XcdBarrier b; b.bar = bar; b.x = xb_xcc_id(); b.st = st;
    if (otid(swave) == 0) (void)xb_add(&bar[XB_XCNT(b.x)], 1u);
    return b;
}
__device__ __forceinline__ void xcd_barrier_complete(unsigned* bar, unsigned x, unsigned& nloc, unsigned& nx) {
    const unsigned G = gridDim.x * gridDim.y * gridDim.z;
    unsigned sum, cnt, mine, sp = 0u;
    for (;;) {
        sum = 0u; cnt = 0u; mine = 0u;
#pragma unroll
        for (unsigned j = 0; j < 16; ++j) { const unsigned c = xb_ld(&bar[XB_XCNT(j)]); sum += c; cnt += (c > 0u) ? 1u : 0u; mine = (j == x) ? c : mine; }
        if (sum == G) break;
        __builtin_amdgcn_s_sleep(1);
        if ((++sp & 255u) == 0u) { if (xb_ld(&bar[XB_TMO])) break; if (sp > XB_SPIN_CAP) { atomicAdd(&bar[XB_TMO], 1u); break; } }
    }
    nloc = mine > 0u ? mine : 1u; nx = cnt > 0u ? cnt : 1u;
}
__device__ __forceinline__ void xcd_barrier(const int swave, const XcdBarrier& b) {
    asm volatile("s_waitcnt vmcnt(0)" ::: "memory");
    __syncthreads();
    if (otid(swave) == 0) {
        unsigned* bar = b.bar;
        __builtin_amdgcn_s_waitcnt(0);
        unsigned nloc = b.st[0], nx = b.st[1];
        if (nloc == 0u) { xcd_barrier_complete(bar, b.x, nloc, nx); b.st[0] = nloc; b.st[1] = nx; }
        const unsigned old = xb_add(&bar[XB_XSUB(b.x)], 1u);
        const unsigned gen = old / nloc;
        if (old + 1u == (gen + 1u) * nloc) {
            __builtin_amdgcn_fence(__ATOMIC_RELEASE, "agent");
            asm volatile("s_waitcnt vmcnt(0)" ::: "memory");
            const unsigned og = xb_add(&bar[XB_TOP], 1u);
            const unsigned tg = og / nx;
            if (og + 1u == (tg + 1u) * nx) xb_add(&bar[XB_TOPGEN], 1u);
            else XB_SPIN(xb_ld(&bar[XB_TOPGEN]) == tg, bar);
            __builtin_amdgcn_fence(__ATOMIC_ACQUIRE, "agent");
            xb_add(&bar[XB_XGEN(b.x)], 1u);
            asm volatile("s_waitcnt vmcnt(0)" ::: "memory");
        } else {
            XB_SPIN(xb_ld(&bar[XB_XGEN(b.x)]) == gen, bar);
            __builtin_amdgcn_fence(__ATOMIC_ACQUIRE, "agent");
            asm volatile("s_waitcnt vmcnt(0)" ::: "memory");
        }
    }
    __syncthreads();
}
constexpr int CW_BAR = 4096;

__device__ __forceinline__ unsigned pk2(float lo, float hi) { return (unsigned)f2bf(lo) | ((unsigned)f2bf(hi) << 16); }
struct TrItem { const float* src; bf16* dst; int N; };
__device__ __forceinline__ TrItem tr_locate(const P& p, int it) {
    constexpr int I_IN = (D / 64) * (NIN / 64), I_OUT = (D / 64) * (D / 64), I_UP1 = (D / 64) * (1024 / 64), I_DN1 = (HID / 64) * (D / 64);
    const float* W; bf16* WT; int K, N, up = 0, r = it;
    if (r < I_IN) { W = p.w_in; WT = WSP(bf16, WS_WINT); K = D; N = NIN; }
    else if ((r -= I_IN) < I_OUT) { W = p.w_out; WT = WSP(bf16, WS_WOUTT); K = D; N = D; }
    else if ((r -= I_OUT) < NE * I_UP1) { const int e = r / I_UP1; r -= e * I_UP1; W = p.w_up + (size_t)e * D * 1024; WT = WSP(bf16, WS_WUPT) + (size_t)e * D * 1024; K = D; N = 1024; up = 1; }
    else { r -= NE * I_UP1; const int e = r / I_DN1; r -= e * I_DN1; W = p.w_down + (size_t)e * HID * D; WT = WSP(bf16, WS_WDNT) + (size_t)e * HID * D; K = HID; N = D; }
    const int nblk = N / 64, kb = r / nblk, nb = r % nblk, k0 = 64 * kb, lane = (int)__builtin_amdgcn_mbcnt_hi(~0u, __builtin_amdgcn_mbcnt_lo(~0u, 0u)), n = 64 * nb + lane;
    TrItem t; t.src = W + (size_t)k0 * N + n; t.dst = WT + (size_t)(up ? updst(n) : n) * K + k0; t.N = N; return t;
}
__device__ __forceinline__ void tr_load(const TrItem& t, float (&r)[64]) {
#pragma unroll
    for (int i = 0; i < 64; ++i) r[i] = t.src[(size_t)i * t.N];
}
__device__ __forceinline__ void tr_store(const TrItem& t, const float (&r)[64]) {
    u32x4* dst = (u32x4*)t.dst;
#pragma unroll
    for (int j = 0; j < 8; ++j) { u32x4 o; o.x = cvt_pk_bf16(r[8 * j], r[8 * j + 1]); o.y = cvt_pk_bf16(r[8 * j + 2], r[8 * j + 3]); o.z = cvt_pk_bf16(r[8 * j + 4], r[8 * j + 5]); o.w = cvt_pk_bf16(r[8 * j + 6], r[8 * j + 7]); dst[j] = o; }
}
__device__ __forceinline__ void phase_prep(const int swave, const P& p, LAS unsigned char* lds, int bx, int G) {
    const int tid = otid(swave), lane = tid & 63, w = __builtin_amdgcn_readfirstlane(tid >> 6);
    if (bx < 192) {
        LAS float* sc = (LAS float*)lds; LAS float* red = sc + 2048;
        for (int i = tid; i < 2048; i += NTHR) sc[i] = silu_f(p.c[i]);
        __syncthreads();
        for (int cb = bx; cb < 192; cb += G) {
            const int kg = tid >> 5, cl = tid & 31, colj = cb * 32 + cl; float a0 = 0.f, a1 = 0.f;
            float wv[64];
#pragma unroll
            for (int i = 0; i < 64; ++i) wv[i] = p.w_ada[(size_t)(kg + 16 * i) * 6144 + colj];
#pragma unroll
            for (int i = 0; i < 64; ++i) { const int k = kg + 16 * i; a0 += sc[k] * wv[i]; a1 += sc[1024 + k] * wv[i]; }
            red[(kg * 32 + cl) * 2] = a0; red[(kg * 32 + cl) * 2 + 1] = a1;
            __syncthreads();
            if (tid < 64) { const int c2 = tid & 31, bb = tid >> 5; float t = 0.f;
#pragma unroll
                for (int k2 = 0; k2 < 16; ++k2) t += red[(k2 * 32 + c2) * 2 + bb];
                __hip_atomic_store(WSP(float, WS_SMALL + SM_ADA) + bb * 6144 + cb * 32 + c2, t + p.b_ada[cb * 32 + c2], __ATOMIC_RELAXED, __HIP_MEMORY_SCOPE_AGENT);
                asm volatile("s_waitcnt vmcnt(0)" ::: "memory");
                if (tid == 0) __hip_atomic_fetch_add(WSP(unsigned, WS_CTL) + CW_ADA, 1u, __ATOMIC_RELAXED, __HIP_MEMORY_SCOPE_AGENT); }
            __syncthreads();
        }
    }
    if (bx == G - 1) { const float l0 = p.lb_logits[tid], l1 = p.lb_logits[512 + tid]; const float m = fmaxf(l0, l1); const float e0 = expf(l0 - m), e1 = expf(l1 - m);
        WSP(float, WS_SMALL + SM_LB)[tid] = e0 / (e0 + e1); }
    constexpr int NITEMS = (D / 64) * (NIN / 64) + (D / 64) * (D / 64) + NE * (D / 64) * (1024 / 64) + NE * (HID / 64) * (D / 64);
    LAS int* qs = (LAS int*)(lds + LDSCTL_OFF) + LC_Q;
    if (tid == 0) qs[0] = (int)atomicAdd(WSP(unsigned, WS_CTL) + CW_PREPQ, 24u);
    __syncthreads();
    int base = qs[0];
#pragma unroll 1
    while (base < NITEMS) {
        __syncthreads();
        int nxt = 0; if (tid == 0) nxt = (int)atomicAdd(WSP(unsigned, WS_CTL) + CW_PREPQ, 24u);
        const int it = base + 3 * w;
        if (it < NITEMS) {
            const TrItem ta = tr_locate(p, it); float ra[64]; tr_load(ta, ra);
            if (it + 2 < NITEMS) { const TrItem tb = tr_locate(p, it + 1), tc = tr_locate(p, it + 2); float rb[64], rc[64]; tr_load(tb, rb); tr_load(tc, rc); tr_store(ta, ra); tr_store(tb, rb); tr_store(tc, rc); }
            else if (it + 1 < NITEMS) { const TrItem tb = tr_locate(p, it + 1); float rb[64]; tr_load(tb, rb); tr_store(ta, ra); tr_store(tb, rb); }
            else tr_store(ta, ra);
        }
        if (tid == 0) qs[0] = nxt;
        __syncthreads();
        base = qs[0];
    }
}
__device__ __forceinline__ void phase_xmod(const int swave, const P& p, int bx, int G) {
    const int lane = otid(swave) & 63, gw = bx * NWAVES + (otid(swave) >> 6), NGW = G * NWAVES; const unsigned l16 = (unsigned)lane * 16u, l8 = (unsigned)lane * 8u;
#pragma unroll 1
    for (int row = 4 * gw; row < T; row += 4 * NGW) { const float* ada = WSP(float, WS_SMALL + SM_ADA) + (row >> 13) * 6144;
        f32x4 xv[4][4];
#pragma unroll
        for (int r = 0; r < 4; ++r)
#pragma unroll
            for (int j = 0; j < 4; ++j) xv[r][j] = ldg<f32x4>(p.x + (size_t)(row + r) * D + 256 * j, l16);
#pragma unroll
        for (int j = 0; j < 4; ++j) { const f32x4 sh = ldg<f32x4>(ada + 256 * j, l16), sc = ldg<f32x4>(ada + 1024 + 256 * j, l16);
#pragma unroll
            for (int r = 0; r < 4; ++r) { u32x2 o; o.x = cvt_pk_bf16(xv[r][j][0] * (1.f + sc[0]) + sh[0], xv[r][j][1] * (1.f + sc[1]) + sh[1]); o.y = cvt_pk_bf16(xv[r][j][2] * (1.f + sc[2]) + sh[2], xv[r][j][3] * (1.f + sc[3]) + sh[3]);
                stg<u32x2>(WSP(bf16, WS_B) + (size_t)(row + r) * D + 256 * j, l8, o); } } }
}
__device__ __forceinline__ void route_load_weights(const int swave, const P& p, LAS float* WR) {
    for (int c = otid(swave); c < D; c += NTHR) { const f32x4 wg = *(const f32x4*)(p.rg_w + (size_t)c * 4);
#pragma unroll
        for (int g = 0; g < 4; ++g) { WR[g * D + c] = wg[g];
            const f32x4 w0 = *(const f32x4*)(p.re_w + ((size_t)g * D + c) * 8), w1 = *(const f32x4*)(p.re_w + ((size_t)g * D + c) * 8 + 4);
#pragma unroll
            for (int e = 0; e < 4; ++e) { WR[(4 + g * 8 + e) * D + c] = w0[e]; WR[(4 + g * 8 + 4 + e) * D + c] = w1[e]; } } }
}
__device__ __forceinline__ void route_load2(const P& p, int row, int lane, f32x4 (&x)[2][4], u32x2 (&y)[2][4]) {
    const unsigned l16 = (unsigned)lane * 16u, l8 = (unsigned)lane * 8u;
#pragma unroll
    for (int r = 0; r < 2; ++r) { const float* xr = p.x + (size_t)(row + r) * D; const bf16* yr = WSP(bf16, WS_Y) + (size_t)(row + r) * D;
#pragma unroll
        for (int j = 0; j < 4; ++j) { x[r][j] = ldg<f32x4>(xr + 256 * j, l16); y[r][j] = ldg<u32x2>(yr + 256 * j, l8); } }
}
__device__ __forceinline__ float wave_sum_l63(float v) { DPP_ADD(v, 0xB1, 0xF); DPP_ADD(v, 0x4E, 0xF); DPP_ADD(v, 0x141, 0xF); DPP_ADD(v, 0x140, 0xF); DPP_ADD(v, 0x142, 0xA); DPP_ADD(v, 0x143, 0xC); return v; }
__device__ __forceinline__ void route_topk(const LAS float* lgs, LAS int* rt_e, LAS float* rt_w, int rl, int lane) {
    const f32x4 g4 = *(const LAS f32x4*)lgs;
    int gi = 0; float gm = g4[0];
#pragma unroll
    for (int g = 1; g < 4; ++g) if (g4[g] > gm) { gm = g4[g]; gi = g; }
    float gs = 0.f;
#pragma unroll
    for (int g = 0; g < 4; ++g) gs += __expf(g4[g] - gm);
    const float pgroup = 1.f / gs;
    const f32x4 ea = *(const LAS f32x4*)(lgs + 4 + 8 * gi), eb = *(const LAS f32x4*)(lgs + 8 + 8 * gi);
    float el[8] = {ea[0], ea[1], ea[2], ea[3], eb[0], eb[1], eb[2], eb[3]};
    int j0 = 0; float m0 = el[0];
#pragma unroll
    for (int e = 1; e < 8; ++e) if (el[e] > m0) { m0 = el[e]; j0 = e; }
    int j1 = -1; float m1 = -3.0e38f;
#pragma unroll
    for (int e = 0; e < 8; ++e) if (e != j0 && el[e] > m1) { m1 = el[e]; j1 = e; }
    const float r1 = __expf(m1 - m0);
    if (lane == 0) { rt_e[2 * rl] = gi * 8 + j0; rt_e[2 * rl + 1] = gi * 8 + j1; rt_w[2 * rl] = pgroup / (1.f + r1); rt_w[2 * rl + 1] = pgroup * r1 / (1.f + r1); }
}
__device__ __forceinline__ void ln1_route_rows2(const P& p, const LAS float* WR, LAS float* lgs, LAS int* rt_e, LAS float* rt_w, int row, int rl, int lane, const f32x4 (&x)[2][4], const u32x2 (&y)[2][4]) {
    const float* ada = WSP(float, WS_SMALL + SM_ADA) + (row >> 13) * 6144;
    const unsigned l16 = (unsigned)lane * 16u, l8 = (unsigned)lane * 8u;
    f32x4 g1v[4], pg[4], pb[4], ps[4], pc[4];
#pragma unroll
    for (int j = 0; j < 4; ++j) g1v[j] = ldg<f32x4>(ada + 2048 + 256 * j, l16);
#pragma unroll
    for (int j = 0; j < 4; ++j) { pg[j] = ldg<f32x4>(p.ln1_g + 256 * j, l16); pb[j] = ldg<f32x4>(p.ln1_b + 256 * j, l16); ps[j] = ldg<f32x4>(ada + 3072 + 256 * j, l16); pc[j] = ldg<f32x4>(ada + 4096 + 256 * j, l16); }
    float v[2][16], rstd[2];
#pragma unroll
    for (int r = 0; r < 2; ++r) { float s = 0.f;
#pragma unroll
        for (int j = 0; j < 4; ++j) {
            const float y0 = __uint_as_float(y[r][j].x << 16), y1 = __uint_as_float(y[r][j].x & 0xffff0000u), y2 = __uint_as_float(y[r][j].y << 16), y3 = __uint_as_float(y[r][j].y & 0xffff0000u);
            v[r][4 * j] = ALPHA * x[r][j][0] + (1.f + g1v[j][0]) * y0; v[r][4 * j + 1] = ALPHA * x[r][j][1] + (1.f + g1v[j][1]) * y1; v[r][4 * j + 2] = ALPHA * x[r][j][2] + (1.f + g1v[j][2]) * y2; v[r][4 * j + 3] = ALPHA * x[r][j][3] + (1.f + g1v[j][3]) * y3;
            s += (v[r][4 * j] + v[r][4 * j + 1]) + (v[r][4 * j + 2] + v[r][4 * j + 3]); }
        const float mean = wave_sum_dpp(s) * (1.f / D); float q = 0.f;
#pragma unroll
        for (int i = 0; i < 16; ++i) { v[r][i] -= mean; q += v[r][i] * v[r][i]; }
        rstd[r] = rsqrtf(wave_sum_dpp(q) * (1.f / D) + LN_EPS); }
    f32x2 hv[16];
#pragma unroll
    for (int r = 0; r < 2; ++r) { bf16* X1 = WSP(bf16, WS_X1) + (size_t)(row + r) * D; bf16* H2 = WSP(bf16, WS_B) + (size_t)(row + r) * D;
#pragma unroll
        for (int j = 0; j < 4; ++j) { f32x4 x1; float h[4];
#pragma unroll
            for (int i = 0; i < 4; ++i) { x1[i] = v[r][4 * j + i] * rstd[r] * pg[j][i] + pb[j][i]; h[i] = x1[i] * (1.f + pc[j][i]) + ps[j][i]; if (r == 0) hv[4 * j + i].x = h[i]; else hv[4 * j + i].y = h[i]; }
            { u32x2 xo; xo.x = cvt_pk_bf16(x1[0], x1[1]); xo.y = cvt_pk_bf16(x1[2], x1[3]); stg<u32x2>(X1 + 256 * j, l8, xo); }
            u32x2 o; o.x = cvt_pk_bf16(h[0], h[1]); o.y = cvt_pk_bf16(h[2], h[3]); stg<u32x2>(H2 + 256 * j, l8, o); } }
    __builtin_amdgcn_sched_barrier(0);
    const LAS char* wp = (const LAS char*)WR + lane * 16;
    float gl[2][4];
#pragma unroll
    for (int o = 0; o < 4; ++o) { f32x2 a[4];
#pragma unroll
        for (int j = 0; j < 4; ++j) { const f32x4 wv = *(const LAS f32x4*)(wp + 4096 * o + 1024 * j); a[j] = hv[4 * j] * (f32x2){wv[0], wv[0]};
#pragma unroll
            for (int i = 1; i < 4; ++i) a[j] = __builtin_elementwise_fma(hv[4 * j + i], (f32x2){wv[i], wv[i]}, a[j]); }
        const f32x2 t = (a[0] + a[1]) + (a[2] + a[3]); const float bias = p.rg_b[o];
        gl[0][o] = wave_sum_dpp(t.x) + bias; gl[1][o] = wave_sum_dpp(t.y) + bias; }
#pragma unroll
    for (int r = 0; r < 2; ++r) {
        int gi = 0; float gm = gl[r][0];
#pragma unroll
        for (int g = 1; g < 4; ++g) if (gl[r][g] > gm) { gm = gl[r][g]; gi = g; }
        gi = __builtin_amdgcn_readfirstlane(gi);
        float gs = 0.f;
#pragma unroll
        for (int g = 0; g < 4; ++g) gs += __expf(gl[r][g] - gm);
        const float pgroup = 1.f / gs;
        const LAS char* we = wp + (4 + 8 * gi) * 4096;
        int coll = 0;
#pragma unroll
        for (int e = 0; e < 8; ++e) { float a[4];
#pragma unroll
            for (int j = 0; j < 4; ++j) { const f32x4 wv = *(const LAS f32x4*)(we + 4096 * e + 1024 * j);
                a[j] = (r == 0 ? hv[4 * j].x : hv[4 * j].y) * wv[0];
#pragma unroll
                for (int i = 1; i < 4; ++i) a[j] = __builtin_fmaf(r == 0 ? hv[4 * j + i].x : hv[4 * j + i].y, wv[i], a[j]); }
            const float sv = wave_sum_l63((a[0] + a[1]) + (a[2] + a[3]));
            const int rv = __builtin_amdgcn_readlane(__float_as_int(sv), 63);
            asm volatile("v_writelane_b32 %0, %1, %2" : "+v"(coll) : "s"(rv), "i"(e)); }
        LAS float* l8 = lgs + 64 * r;
        l8[lane] = __int_as_float(coll) + p.re_b[gi * 8 + (lane & 7)];
        asm volatile("s_waitcnt lgkmcnt(0)" ::: "memory");
        const f32x4 ea = *(const LAS f32x4*)l8, eb = *(const LAS f32x4*)(l8 + 4);
        const float el[8] = {ea[0], ea[1], ea[2], ea[3], eb[0], eb[1], eb[2], eb[3]};
        int j0 = 0; float m0 = el[0];
#pragma unroll
        for (int e = 1; e < 8; ++e) if (el[e] > m0) { m0 = el[e]; j0 = e; }
        int j1 = -1; float m1 = -3.0e38f;
#pragma unroll
        for (int e = 0; e < 8; ++e) if (e != j0 && el[e] > m1) { m1 = el[e]; j1 = e; }
        const float r1 = __expf(m1 - m0);
        if (lane == 0) { rt_e[2 * (rl + r)] = gi * 8 + j0; rt_e[2 * (rl + r) + 1] = gi * 8 + j1; rt_w[2 * (rl + r)] = pgroup / (1.f + r1); rt_w[2 * (rl + r) + 1] = pgroup * r1 / (1.f + r1); }
    }
}
__device__ __forceinline__ void route_assign(const int swave, const P& p, const LAS int* rt_e, const LAS float* rt_w, LAS int* rt_base, int rowbase) {
    const int lane = otid(swave);
    const int e0 = rt_e[lane], e1 = rt_e[lane + 64];
    const unsigned long long lt = (1ull << lane) - 1ull;
    int rank0 = 0, rank1 = 0, mycnt = 0;
#pragma unroll 4
    for (int e = 0; e < NE; ++e) { const unsigned long long m0 = __ballot(e0 == e), m1 = __ballot(e1 == e); const int c0 = __popcll(m0);
        if (e0 == e) rank0 = __popcll(m0 & lt);
        if (e1 == e) rank1 = c0 + __popcll(m1 & lt);
        if (lane == e) mycnt = c0 + __popcll(m1); }
    if (lane < NE) rt_base[lane] = mycnt ? (int)atomicAdd(WSP(unsigned, WS_CTL) + CW_CNT + lane, (unsigned)mycnt) : 0;
    asm volatile("s_waitcnt vmcnt(0) lgkmcnt(0)" ::: "memory");
    int* LIST = WSP(int, WS_LIST); float* WL = WSP(float, WS_WLIST); int* TE = WSP(int, WS_SMALL + SM_TOKE); int* TS = WSP(int, WS_SMALL + SM_TOKS);
    { const int slot = rt_base[e0] + rank0, row = rowbase + (lane >> 1); LIST[e0 * T + slot] = row; WL[e0 * T + slot] = rt_w[lane]; TE[row * 2 + (lane & 1)] = e0; TS[row * 2 + (lane & 1)] = slot; }
    { const int a = lane + 64, slot = rt_base[e1] + rank1, row = rowbase + (a >> 1); LIST[e1 * T + slot] = row; WL[e1 * T + slot] = rt_w[a]; TE[row * 2 + (a & 1)] = e1; TS[row * 2 + (a & 1)] = slot; }
}
template <int NR> __device__ __forceinline__ void final_rows(const P& p, const LAS int* tstart, int row, int lane, float pscale, float pspike) {
    const float* ada = WSP(float, WS_SMALL + SM_ADA) + (row >> 13) * 6144;
    const int* TE = WSP(int, WS_SMALL + SM_TOKE); const int* TS = WSP(int, WS_SMALL + SM_TOKS);
    const unsigned l16 = (unsigned)lane * 16u, l8 = (unsigned)lane * 8u;
    u32x2 xv[NR][4], pa[NR][4], pb[NR][4];
#pragma unroll
    for (int r = 0; r < NR; ++r) {
        const int e0 = TE[(row + r) * 2], e1 = TE[(row + r) * 2 + 1], s0 = TS[(row + r) * 2], s1 = TS[(row + r) * 2 + 1];
        const size_t rA = (size_t)(tstart[e0] * 256 + s0), rB = (size_t)(tstart[e1] * 256 + s1);
        const bf16* ya = WSP(bf16, WS_Y2) + rA * D; const bf16* yb = WSP(bf16, WS_Y2) + rB * D; const bf16* X1 = WSP(bf16, WS_X1) + (size_t)(row + r) * D;
#pragma unroll
        for (int j = 0; j < 4; ++j) { xv[r][j] = ldg<u32x2>(X1 + 256 * j, l8); pa[r][j] = ldg<u32x2>(ya + 256 * j, l8); pb[r][j] = ldg<u32x2>(yb + 256 * j, l8); } }
    __builtin_amdgcn_sched_barrier(0);
#pragma unroll
    for (int r = 0; r < NR; ++r) {
        if (r) __builtin_amdgcn_sched_barrier(0);
        float v[16]; float s = 0.f;
#pragma unroll
        for (int j = 0; j < 4; ++j) { const f32x4 g2 = ldg<f32x4>(ada + 5120 + 256 * j, l16);
            const float m0 = __uint_as_float(pa[r][j].x << 16) + __uint_as_float(pb[r][j].x << 16), m1 = __uint_as_float(pa[r][j].x & 0xffff0000u) + __uint_as_float(pb[r][j].x & 0xffff0000u);
            const float m2 = __uint_as_float(pa[r][j].y << 16) + __uint_as_float(pb[r][j].y << 16), m3 = __uint_as_float(pa[r][j].y & 0xffff0000u) + __uint_as_float(pb[r][j].y & 0xffff0000u);
            const float x0 = __uint_as_float(xv[r][j].x << 16), x1 = __uint_as_float(xv[r][j].x & 0xffff0000u), x2 = __uint_as_float(xv[r][j].y << 16), x3 = __uint_as_float(xv[r][j].y & 0xffff0000u);
            v[4 * j + 0] = ALPHA * x0 + (1.f + g2[0]) * m0; v[4 * j + 1] = ALPHA * x1 + (1.f + g2[1]) * m1; v[4 * j + 2] = ALPHA * x2 + (1.f + g2[2]) * m2; v[4 * j + 3] = ALPHA * x3 + (1.f + g2[3]) * m3;
            s += (v[4 * j] + v[4 * j + 1]) + (v[4 * j + 2] + v[4 * j + 3]); }
        const float mean = wave_sum_dpp(s) * (1.f / D); float q = 0.f;
#pragma unroll
        for (int i = 0; i < 16; ++i) { v[i] -= mean; q += v[i] * v[i]; }
        const float rstd = rsqrtf(wave_sum_dpp(q) * (1.f / D) + LN_EPS);
#pragma unroll
        for (int j = 0; j < 4; ++j) { const f32x4 gg = ldg<f32x4>(p.ln2_g + 256 * j, l16), bb = ldg<f32x4>(p.ln2_b + 256 * j, l16); f32x4 o;
#pragma unroll
            for (int i = 0; i < 4; ++i) o[i] = (v[4 * j + i] * rstd * gg[i] + bb[i]) * pscale;
            if (j == 0 && lane == 0 && r == 0) o[0] += pspike;
            stg<f32x4>(p.out + (size_t)(row + r) * D + 256 * j, l16, o); }
    }
}

enum { PH_PREP = 0, PH_INPROJ, PH_MIX, PH_OUTPROJ, PH_LN1ROUTE, PH_UP, PH_FINAL, PH_N };
struct Args { P p; int ph_lo, ph_hi, li, pad; };

__device__ __forceinline__ void moe_tables(const int swave, const P& p, LAS unsigned char* lds) {
    LAS int* tstart = (LAS int*)(lds + LDSCTL_OFF) + LC_TSTART; LAS int* lcnt = (LAS int*)(lds + LDSCTL_OFF) + LC_CNT;
    if (otid(swave) == 0) { int acc = 0;
        for (int e = 0; e < NE; ++e) { const int c = (int)__hip_atomic_load(WSP(unsigned, WS_CTL) + CW_CNT + e, __ATOMIC_RELAXED, __HIP_MEMORY_SCOPE_AGENT); tstart[e] = acc; lcnt[e] = c; acc += (c + 255) >> 8; }
        tstart[NE] = acc; }
    __syncthreads();
}

__device__ __forceinline__ P load_p() {
    typedef const __attribute__((address_space(4))) unsigned long long CU64;
    CU64* a = (CU64*)__builtin_amdgcn_kernarg_segment_ptr(); asm volatile("" : "+s"(a));
    P p; unsigned long long* d = (unsigned long long*)&p;
#pragma unroll
    for (int i = 0; i < 24; ++i) d[i] = a[i];
    return p;
}
__global__ void __launch_bounds__(NTHR, 2) mk_fwd(Args args) {
    extern __shared__ __attribute__((aligned(16))) unsigned char lds_raw[];
    LAS unsigned char* lds = (LAS unsigned char*)lds_raw;
    const P& p = args.p;
    const int G = gridDim.x, bx = blockIdx.x;
    const int swave = __builtin_amdgcn_readfirstlane((int)threadIdx.x >> 6);
    const int lo = args.ph_lo, hi = args.ph_hi;
#ifndef PHASE_MASK
#define PHASE_MASK 0x7f
#endif
#define IN(k) (((PHASE_MASK >> (k)) & 1) && lo <= (k) && (k) < hi)
#ifndef REP_PHASE
#define REP_PHASE -1
#define REP_N 0
#endif
#define NREP(k) ((k) == REP_PHASE ? REP_N : 0)
#ifdef PROBE_A
#define STAMP(k) do { if (otid(swave) == 0) { const unsigned long long t_ = __builtin_amdgcn_s_memrealtime(); __hip_atomic_store((unsigned long long*)(WSP(unsigned, WS_CTL) + 65536 + bx * 32) + (k), t_, __ATOMIC_RELAXED, __HIP_MEMORY_SCOPE_AGENT); } } while (0)
#else
#define STAMP(k) do { } while (0)
#endif
#define SEAM(k) do { if (rep_ == NREP(k)) { if (IN(k) && IN((k) + 1)) xcd_barrier(swave, bar); STAMP((k) + 1); } } while (0)
    for (int u = otid(swave); u < (LDS_BYTES - LDSCTL_OFF) / 4; u += NTHR) ((LAS unsigned*)(lds + LDSCTL_OFF))[u] = 0u;
    __syncthreads();
    XcdBarrier bar = xcd_barrier_post(swave, WSP(unsigned, WS_CTL) + CW_BAR + args.li * XCD_BAR_WORDS, (volatile LAS unsigned*)(lds + LDSCTL_OFF) + LC_BAR);
    { const P p = load_p(); STAMP(0); }
    if (IN(PH_PREP)) for (int rep_ = 0; rep_ <= NREP(PH_PREP); ++rep_) { if (rep_) xcd_barrier(swave, bar); asm volatile("; MARK PH_PREP"); const P p = load_p(); phase_prep(swave, p, lds, bx, G);
        if (otid(swave) == 0) { unsigned sp = 0; while (__hip_atomic_load(WSP(unsigned, WS_CTL) + CW_ADA, __ATOMIC_RELAXED, __HIP_MEMORY_SCOPE_AGENT) < 192u && ++sp < (1u << 22)) __builtin_amdgcn_s_sleep(2);
            __builtin_amdgcn_fence(__ATOMIC_ACQUIRE, "agent"); asm volatile("s_waitcnt vmcnt(0)" ::: "memory"); }
        __syncthreads();
        phase_xmod(swave, p, bx, G); SEAM(PH_PREP); }
    if (IN(PH_INPROJ)) for (int rep_ = 0; rep_ <= NREP(PH_INPROJ); ++rep_) { if (rep_) xcd_barrier(swave, bar); asm volatile("; MARK PH_INPROJ"); const P p = load_p();
        pg8::Gemm g{WSP(bf16, WS_B), WSP(bf16, WS_WINT), D, 0, 0, nullptr}; pg8::StaticOrder S; S.init(T, NIN, G, bx);
        pg8::EpiInproj E{p.ws};
        pg8::gemm_phase<pg8::EpiInproj, pg8::StaticOrder, true, true, false>(swave, lds, g, S, E);
        SEAM(PH_INPROJ);
    }
    if (IN(PH_MIX)) for (int rep_ = 0; rep_ <= NREP(PH_MIX); ++rep_) { if (rep_) xcd_barrier(swave, bar); asm volatile("; MARK PH_MIX"); const P p = load_p();
        const int grp = bx >> 5; unsigned* cA = WSP(unsigned, WS_CTL) + CW_MIXA + 64 * grp; unsigned* cB = WSP(unsigned, WS_CTL) + CW_MIXB + 64 * grp;
#define GROUP_PUBLISH(cnt) do { asm volatile("s_waitcnt vmcnt(0)" ::: "memory"); __syncthreads(); if (otid(swave) == 0) __hip_atomic_fetch_add((cnt), 1u, __ATOMIC_RELAXED, __HIP_MEMORY_SCOPE_AGENT); } while (0)
#define GROUP_WAIT(cnt) do { if (otid(swave) == 0) { unsigned sp_ = 0; while (__hip_atomic_load((cnt), __ATOMIC_RELAXED, __HIP_MEMORY_SCOPE_AGENT) < 32u && ++sp_ < (1u << 20)) __builtin_amdgcn_s_sleep(2); \
            __builtin_amdgcn_fence(__ATOMIC_ACQUIRE, "agent"); asm volatile("s_waitcnt vmcnt(0)" ::: "memory"); } __syncthreads(); } while (0)
        hgrn_item<0>(swave, p, lds, bx);
        GROUP_PUBLISH(cA);
        sg_item(swave, p, lds, bx);
        GROUP_WAIT(cA);
        hgrn_scan(p, grp * 16384 + (bx & 31) * NTHR + otid(swave));
        GROUP_PUBLISH(cB);
        GROUP_WAIT(cB);
        hgrn_item<1>(swave, p, lds, bx);
#undef GROUP_PUBLISH
#undef GROUP_WAIT
        SEAM(PH_MIX);
    }
    if (IN(PH_OUTPROJ)) for (int rep_ = 0; rep_ <= NREP(PH_OUTPROJ); ++rep_) { if (rep_) xcd_barrier(swave, bar); asm volatile("; MARK PH_OUTPROJ"); const P p = load_p();
        pg8::Gemm g{WSP(bf16, WS_B), WSP(bf16, WS_WOUTT), D, 0, 0, nullptr}; pg8::StaticOrder S; S.init(T, D, G, bx);
        pg8::EpiBf16 E{p.ws, WS_Y, D};
        pg8::gemm_phase<pg8::EpiBf16, pg8::StaticOrder, true, true, false>(swave, lds, g, S, E);
        SEAM(PH_OUTPROJ);
    }
    if (IN(PH_LN1ROUTE)) for (int rep_ = 0; rep_ <= NREP(PH_LN1ROUTE); ++rep_) { if (rep_) xcd_barrier(swave, bar); asm volatile("; MARK PH_LN1ROUTE"); const P p = load_p();
        if (rep_) { if (bx == 0 && otid(swave) < 32) __hip_atomic_store(WSP(unsigned, WS_CTL) + CW_CNT + otid(swave), 0u, __ATOMIC_RELAXED, __HIP_MEMORY_SCOPE_AGENT); xcd_barrier(swave, bar); }
        const int lane = otid(swave) & 63, w = __builtin_amdgcn_readfirstlane(otid(swave) >> 6);
        LAS float* WR = (LAS float*)lds; LAS int* rt_e = (LAS int*)(lds + LDSCTL_OFF) + LC_RT; LAS float* rt_w = (LAS float*)(rt_e + 128); LAS int* rt_base = rt_e + 256;
        route_load_weights(swave, p, WR);
        __syncthreads();
        for (int rb = bx * 64; rb < T; rb += G * 64) {
            f32x4 xc[2][4]; u32x2 yc[2][4];
            route_load2(p, rb + 8 * w, lane, xc, yc);
#pragma unroll 1
            for (int pr = 0; pr < 4; ++pr) {
                f32x4 xn[2][4]; u32x2 yn[2][4];
                route_load2(p, rb + 8 * w + (pr < 3 ? 2 * pr + 2 : 2 * pr), lane, xn, yn);
                ln1_route_rows2(p, WR, (LAS float*)(lds + LDSCTL_OFF) + LC_LGS + 128 * w, rt_e, rt_w, rb + 8 * w + 2 * pr, 8 * w + 2 * pr, lane, xc, yc);
#pragma unroll
                for (int r = 0; r < 2; ++r)
#pragma unroll
                    for (int j = 0; j < 4; ++j) { xc[r][j] = xn[r][j]; yc[r][j] = yn[r][j]; }
            }
            __syncthreads();
            if (w == 0) route_assign(swave, p, rt_e, rt_w, rt_base, rb);
            __syncthreads();
        }
        SEAM(PH_LN1ROUTE);
    }
    if (IN(PH_UP)) for (int rep_ = 0; rep_ <= NREP(PH_UP); ++rep_) { if (rep_) xcd_barrier(swave, bar); asm volatile("; MARK PH_UP"); const P p = load_p();
        moe_tables(swave, p, lds);
        const LAS int* tstart = (const LAS int*)(lds + LDSCTL_OFF) + LC_TSTART; const LAS int* lcnt = (const LAS int*)(lds + LDSCTL_OFF) + LC_CNT;
        unsigned* ready = WSP(unsigned, WS_CTL) + CW_RDY;
        {
            pg8::Gemm g{WSP(bf16, WS_B), WSP(bf16, WS_WUPT), D, 0, (size_t)1024 * D * 2, WSP(int, WS_LIST)};
            pg8::MoeOrder S{tstart, lcnt, G, bx, 4};
            pg8::EpiUp E{p.ws};
            pg8::gemm_phase<pg8::EpiUp, pg8::MoeOrder, true, true, true>(swave, lds, g, S, E);
            if (otid(swave) == 0) { __builtin_amdgcn_fence(__ATOMIC_RELEASE, "agent"); asm volatile("s_waitcnt vmcnt(0)" ::: "memory");
                pg8::Unit u; for (int i = 0; S.next(i, u); ++i) __hip_atomic_fetch_add(ready + 64 * u.pm, 1u, __ATOMIC_RELAXED, __HIP_MEMORY_SCOPE_AGENT); }
        }
        {
            const int ntile = __builtin_amdgcn_readfirstlane(tstart[NE]), R = 4 * ntile - 2 * G > 0 ? 4 * ntile - 2 * G : 0;
            pg8::Gemm g{WSP(bf16, WS_ACT), WSP(bf16, WS_WDNT), HID, 0, (size_t)1024 * HID * 2, nullptr};
            pg8::MoeDownOrder S{tstart, lcnt, G, (bx + G - R % G) % G, ntile, G / 4, R / 4, ready};
            pg8::EpiDown E{p.ws};
            pg8::gemm_phase<pg8::EpiDown, pg8::MoeDownOrder, true, true, false>(swave, lds, g, S, E);
        }
        SEAM(PH_UP);
    }
    if (IN(PH_FINAL)) for (int rep_ = 0; rep_ <= NREP(PH_FINAL); ++rep_) { if (rep_) xcd_barrier(swave, bar); asm volatile("; MARK PH_FINAL"); const P p = load_p();
        moe_tables(swave, p, lds);
        const int lane = otid(swave) & 63, gw = bx * NWAVES + (otid(swave) >> 6), NGW = G * NWAVES;
        float pscale = 1.f, pspike = 0.f;
#ifdef PROBE_A
        { const unsigned long long* ts = (const unsigned long long*)(WSP(unsigned, WS_CTL) + 65536 + bx * 32);
          const unsigned long long a0 = __hip_atomic_load(ts + PROBE_A, __ATOMIC_RELAXED, __HIP_MEMORY_SCOPE_AGENT), a1 = __hip_atomic_load(ts + PROBE_A + 1, __ATOMIC_RELAXED, __HIP_MEMORY_SCOPE_AGENT);
          const unsigned long long b0 = __hip_atomic_load(ts + PROBE_B, __ATOMIC_RELAXED, __HIP_MEMORY_SCOPE_AGENT), b1 = __hip_atomic_load(ts + PROBE_B + 1, __ATOMIC_RELAXED, __HIP_MEMORY_SCOPE_AGENT);
          pscale = 1.f + sqrtf((float)(a1 - a0) * 1e-5f); pspike = (float)(b1 - b0) * 0.1f; }
#endif
#pragma unroll 1
        for (int row = 4 * gw; row < T; row += 4 * NGW) { asm volatile("" ::: "memory"); final_rows<4>(p, (const LAS int*)(lds + LDSCTL_OFF) + LC_TSTART, row, lane, pscale, row == 0 ? pspike : 0.f); }
    }
#undef SEAM
#undef IN
}

#ifndef NAIVE_MASK
#define NAIVE_MASK 0
#endif
#ifndef MK_SPLIT
#define MK_SPLIT 0
#endif
static void launch_mk(const P& p, int lo, int hi, int li, hipStream_t s) {
    Args a{}; a.p = p; a.ph_lo = lo; a.ph_hi = hi; a.li = li; a.pad = 0;
    void* kargs[] = {&a};
    const hipError_t e = hipLaunchCooperativeKernel((const void*)mk_fwd, dim3(256), dim3(NTHR), kargs, LDS_BYTES, s);
    if (e != hipSuccess) fprintf(stderr, "kernel_launch: cooperative launch failed: %s\n", hipGetErrorString(e));
}
extern "C" void kernel_launch(void* const* d_in, const int* in_sizes, int n_in, void* d_out, int out_size, void* d_ws, size_t ws_size, hipStream_t stream) {
    if (n_in != 22 || ws_size < WS_END) { fprintf(stderr, "kernel_launch: unexpected n_in %d / ws %zu\n", n_in, ws_size); return; }
    static int inited = 0;
    if (!inited) { inited = 1;
        if (hipFuncSetAttribute((const void*)mk_fwd, hipFuncAttributeMaxDynamicSharedMemorySize, LDS_BYTES) != hipSuccess) fprintf(stderr, "kernel_launch: hipFuncSetAttribute failed\n"); }
    P p{};
    const float** f = (const float**)&p;
    for (int i = 0; i < 22; ++i) f[i] = (const float*)d_in[i];
    p.out = (float*)d_out; p.ws = (unsigned char*)d_ws;
    (void)hipMemsetAsync((char*)d_ws + WS_CTL, 0, 1 * MiB, stream);
    int li = 0;
    for (int k = 0; k < PH_N;) {
        int e = k + 1;
        if (!MK_SPLIT) while (e < PH_N && !((NAIVE_MASK >> e) & 1)) ++e;
        launch_mk(p, k, e, li++, stream);
        k = e;
    }
}
```

```cpp
#include <hip/hip_runtime.h>
#include <cstdio>
#include <cstdint>

typedef unsigned short bf16;
typedef float f32x4 __attribute__((ext_vector_type(4)));

constexpr int NB = 2, SEQ = 8192, D = 1024, T = NB * SEQ;
constexpr int NIN = 3072;
constexpr int NE = 32, HID = 512;
constexpr float ALPHA = 1.189207115002721f;
constexpr float LN_EPS = 1e-5f, RMS_EPS = 1e-6f;
constexpr int ROWS_PAD = 40960;

constexpr size_t MiB = 1u << 20;
constexpr size_t WS_CTL = 0;
constexpr size_t WS_SMALL = 1 * MiB;
constexpr size_t WS_LIST = 2 * MiB, WS_WLIST = 4 * MiB;
constexpr size_t WS_WINT = 6 * MiB, WS_WOUTT = 12 * MiB, WS_WUPT = 14 * MiB, WS_WDNT = 78 * MiB;
constexpr size_t WS_B = 110 * MiB;
constexpr size_t WS_QS = 142 * MiB, WS_V = 158 * MiB, WS_OG = 174 * MiB, WS_LOGF = 190 * MiB, WS_ZG = 222 * MiB;
constexpr size_t WS_Y = 142 * MiB, WS_ACT = 206 * MiB;
constexpr size_t WS_SLOC = 254 * MiB, WS_SSTART = 270 * MiB;
constexpr size_t WS_X1 = 286 * MiB, WS_Y2 = 350 * MiB, WS_END = 430 * MiB;
constexpr size_t SM_ADA = 0, SM_LB = 64 * 1024, SM_ROWBASE = 128 * 1024, SM_SGSTAT = 256 * 1024, SM_TOKE = 512 * 1024, SM_TOKS = 640 * 1024, SM_DTOT = 768 * 1024;
constexpr int CW_CNT = 1024;
constexpr int CW_ADA = 1088;
constexpr int CW_RDY = 131072;
constexpr int CW_MIXA = 2048, CW_MIXB = 2560;
constexpr int CW_PREPQ = 1152;

struct P {
    const float *x, *c, *w_ada, *b_ada, *w_in, *lb_logits, *hg_norm_w, *sg_ln_g, *sg_ln_b, *sg_w, *sg_b, *w_out, *ln1_g, *ln1_b,
        *rg_w, *rg_b, *re_w, *re_b, *w_up, *w_down, *ln2_g, *ln2_b;
    float* out; unsigned char* ws;
};

__device__ __forceinline__ float bf2f(bf16 b) { return __uint_as_float(((unsigned)b) << 16); }
__device__ __forceinline__ bf16 f2bf(float f) { unsigned u = __float_as_uint(f); return (bf16)((u + 0x7fffu + ((u >> 16) & 1u)) >> 16); }
__device__ __forceinline__ float silu_f(float x) { return x / (1.f + __expf(-x)); }
__device__ __forceinline__ float gelu_f(float x) { return 0.5f * x * (1.f + erff(x * 0.70710678118654752f)); }
__device__ __forceinline__ float wave_sum(float v) {
#pragma unroll
    for (int o = 1; o < 64; o <<= 1) v += __shfl_xor(v, o);
    return v;
}
#define WSP(type, off) ((type*)(p.ws + (off)))

__device__ __forceinline__ int updst(int n) { const int part = n >> 9, q = n & 511; return 256 * (q >> 7) + 128 * part + (q & 127); }

#define LAS __attribute__((address_space(3)))
#define GAS __attribute__((address_space(1)))
typedef short bf16x8 __attribute__((ext_vector_type(8)));
typedef unsigned u32x4 __attribute__((ext_vector_type(4)));
typedef unsigned u32x2 __attribute__((ext_vector_type(2)));
typedef float f32x2 __attribute__((ext_vector_type(2)));
constexpr int NWAVES = 8, NTHR = 512;
template <class Tv> __device__ __forceinline__ Tv ldg(const void* base, unsigned off) { return *(const Tv*)((const char*)base + off); }
template <class Tv> __device__ __forceinline__ void stg(void* base, unsigned off, Tv v) { *(Tv*)((char*)base + off) = v; }
#define DPP_ADD(v, ctrl, rmask) v += __int_as_float(__builtin_amdgcn_update_dpp(0, __float_as_int(v), ctrl, rmask, 0xF, false))
__device__ __forceinline__ float wave_sum_dpp(float v) {
    DPP_ADD(v, 0xB1, 0xF);
    DPP_ADD(v, 0x4E, 0xF);
    DPP_ADD(v, 0x141, 0xF);
    DPP_ADD(v, 0x140, 0xF);
    DPP_ADD(v, 0x142, 0xA);
    DPP_ADD(v, 0x143, 0xC);
    return __int_as_float(__builtin_amdgcn_readlane(__float_as_int(v), 63));
}
__device__ __forceinline__ int otid(int swave) { int l; asm volatile("v_mbcnt_lo_u32_b32 %0, -1, 0\n\tv_mbcnt_hi_u32_b32 %0, -1, %0" : "=v"(l)); return (swave << 6) | l; }
constexpr int RING_BYTES = 131072, LDSCTL_OFF = 147456, LDS_BYTES = 155648;
constexpr int LC_BAR = 0, LC_TSTART = 64  , LC_CNT = 128  , LC_RT = 256  , LC_LGS = 576  , LC_Q = 32  ;

__device__ __forceinline__ unsigned cvt_pk_bf16(float lo, float hi) { unsigned r; asm volatile("v_cvt_pk_bf16_f32 %0, %1, %2" : "=v"(r) : "v"(lo), "v"(hi)); return r; }
__device__ __forceinline__ float fast_sigmoid(float x) { return __builtin_amdgcn_rcpf(1.f + __expf(-x)); }
__device__ __forceinline__ f32x2 gelu_pk(f32x2 v) {
    const f32x2 av = __builtin_elementwise_abs(v), d = av * 0.2316418882f + 1.0f;
    f32x2 t; t.x = __builtin_amdgcn_rcpf(d.x); t.y = __builtin_amdgcn_rcpf(d.y);
    f32x2 q = t * 0.5307027145f + (-0.7265760135f); q = q * t + 0.7107068705f; q = q * t + (-0.142248368f); q = q * t + 0.127414796f; q = q * t;
    const f32x2 s = (v * v) * (-0.72134752044f);
    f32x2 e; e.x = __builtin_amdgcn_exp2f(s.x); e.y = __builtin_amdgcn_exp2f(s.y);
    const f32x2 m = v * (q * e), r = v - m;
    f32x2 o; o.x = v.x < 0.f ? m.x : r.x; o.y = v.y < 0.f ? m.y : r.y; return o;
}

namespace pg8 {
constexpr int BM = 256, BK = 64, HALF = 128, HTB = HALF * BK * 2, STAGE_BYTES = 8 * HTB, NXCD = 8, WGM = 8;
__host__ __device__ __forceinline__ int lds_byte(int r, int c) { const int st = (r >> 4) * 2 + (c >> 5), rr = r & 15, cc = c & 31, ob = rr * 64 + cc * 2; return st * 1024 + (ob ^ (((ob >> 9) & 1) << 5)); }
__host__ __device__ __forceinline__ void stage_rc(int b, int& R, int& C) { const int st = b / 1024, sb = b % 1024, swz = sb ^ (((sb >> 9) & 1) << 5); R = (st >> 1) * 16 + swz / 64; C = (st & 1) * 32 + (swz % 64) / 2; }
__host__ __device__ __forceinline__ int perm32(int rho) { const int n = rho >> 4, i = rho & 15; return 8 * (i >> 2) + 4 * n + (i & 3); }

struct Unit { int pm, pn, e, nvalid, r0, pad; };
struct Gemm { const bf16* A; const bf16* Bt; int K, pad; size_t bstride; const int* list; };

struct StaticOrder {
    int nM, nN, nwg, G, c;
    __device__ void init(int M, int N, int G_, int c_) { nM = M / BM; nN = N / BM; nwg = nM * nN; G = G_; c = c_; }
    __device__ bool next(int i, Unit& u) const {
        const long L = (long)i * G + c; if (L >= nwg) return false;
        int wgid = (int)L; { const int q = nwg / NXCD, r = nwg % NXCD, xcd = wgid % NXCD, off = wgid / NXCD; wgid = (xcd < r ? xcd * (q + 1) : r * (q + 1) + (xcd - r) * q) + off; }
        const int nig = WGM * nN, gid = wgid / nig, fm = gid * WGM, gsz = (nM - fm) < WGM ? (nM - fm) : WGM;
        u.pm = fm + ((wgid % nig) % gsz); u.pn = (wgid % nig) / gsz; u.e = 0; u.nvalid = 256; u.r0 = 0; u.pad = 0; return true;
    }
    __device__ __forceinline__ void a_ready(int, const Unit&) const {}
};
struct MoeOrder {
    const LAS int* tstart; const LAS int* cnt; int G, c, nN;
    __device__ bool next(int i, Unit& u) const {
        const int L = i * G + c, ntile = __builtin_amdgcn_readfirstlane(tstart[NE]); if (L >= ntile * nN) return false;
        const int tile = L / nN; u.pn = L % nN; u.pm = tile;
        int e = 0;
#pragma unroll 1
        for (int k = 1; k < NE; ++k) e = (tile >= tstart[k]) ? k : e;
        e = __builtin_amdgcn_readfirstlane(e); u.e = e; u.pm = __builtin_amdgcn_readfirstlane(u.pm); u.pn = __builtin_amdgcn_readfirstlane(u.pn);
        u.r0 = __builtin_amdgcn_readfirstlane((tile - tstart[e]) * 256); const int left = __builtin_amdgcn_readfirstlane(cnt[e]) - u.r0; u.nvalid = left < 256 ? left : 256; u.pad = 0; return true;
    }
    __device__ __forceinline__ void a_ready(int, const Unit&) const {}
};
struct MoeDownOrder {
    const LAS int* tstart; const LAS int* cnt; int G, cr, ntile, P, r; unsigned* ready;
    __device__ int tile_of(int idx) const {
        const int ne = 2 * (P - r);
        if (idx < ne) { const int q = idx / (P - r), m = idx - q * (P - r); return q * P + r + m; }
        const int k = idx - ne; if (k < 2 * r) { const int q = k / r, m = k - q * r; return q * P + m; }
        return 2 * P + (k - 2 * r);
    }
    __device__ bool next(int i, Unit& u) const {
        const int d = i * G + cr; if (d >= ntile * 4) return false;
        const int tile = tile_of(d >> 2); u.pn = d & 3; u.pm = tile;
        int e = 0;
#pragma unroll 1
        for (int k = 1; k < NE; ++k) e = (tile >= tstart[k]) ? k : e;
        e = __builtin_amdgcn_readfirstlane(e); u.e = e; u.pm = __builtin_amdgcn_readfirstlane(u.pm); u.pn = __builtin_amdgcn_readfirstlane(u.pn);
        u.r0 = __builtin_amdgcn_readfirstlane((tile - tstart[e]) * 256); const int left = __builtin_amdgcn_readfirstlane(cnt[e]) - u.r0; u.nvalid = left < 256 ? left : 256; u.pad = 0; return true;
    }
    __device__ __forceinline__ void a_ready(int swave, const Unit& u) const {
        if (swave == 0) { unsigned sp = 0;
            while ((unsigned)__builtin_amdgcn_readfirstlane(__hip_atomic_load(ready + 64 * u.pm, __ATOMIC_RELAXED, __HIP_MEMORY_SCOPE_AGENT)) < 4u && ++sp < (1u << 20)) __builtin_amdgcn_s_sleep(2);
            __builtin_amdgcn_fence(__ATOMIC_ACQUIRE, "agent");
            asm volatile("s_waitcnt vmcnt(0)" ::: "memory"); }
        asm volatile("" ::: "memory"); __builtin_amdgcn_s_barrier(); asm volatile("" ::: "memory");
    }
};

#define PG8_LAS LAS
template <class Epi, class Sched, bool ALIGN_EPI, bool SP2, bool GATHER>
__device__ __forceinline__ void gemm_phase(const int swave, PG8_LAS unsigned char* lds, const Gemm g, const Sched& S, const Epi& E) {
    const int tid = otid(swave), wid = __builtin_amdgcn_readfirstlane(tid >> 6), lane = tid & 63, wr = wid >> 2, wc = wid & 3, fr = lane & 15, fq = lane >> 4;
    const int K = g.K, nt = K / BK;
    unsigned voffB[2], vA[2][2], vAn[2][2]; int RA[2], CA[2];
#pragma unroll
    for (int i = 0; i < 2; ++i) { int R, C; stage_rc(tid * 16 + i * 8192, R, C); const int Rb = Epi::PERM ? ((R & ~31) + perm32(R & 31)) : R; RA[i] = R; CA[i] = C;
        voffB[i] = (unsigned)(Rb * K + C) * 2u;
#pragma unroll
        for (int h = 0; h < 2; ++h) { vA[h][i] = (unsigned)((h * HALF + R) * K + C) * 2u; vAn[h][i] = vA[h][i]; } }
    const size_t kstep = (size_t)(BK * 2);
    const size_t hstep = (size_t)HALF * K * 2;
    const size_t tstep = 2 * hstep;
    const unsigned ldsw = (unsigned)wid * 1024u;
    const int aoff = lds_byte(wr * 64 + fr, fq * 8), boff = lds_byte(wc * 32 + fr, fq * 8);
#define PG8_SA(b, h) (((b) * 2 + (h)) * HTB)
#define PG8_SB(b, h) ((4 + (b) * 2 + (h)) * HTB)
#define PG8_STAGE(bufoff, gbase, voff) do { _Pragma("unroll") for (int _i = 0; _i < 2; ++_i) \
        __builtin_amdgcn_global_load_lds((const unsigned*)((const char*)(gbase) + (voff)[_i]), (PG8_LAS unsigned*)(lds + (bufoff) + ldsw + _i * 8192), 16, 0, 0); } while (0)
#define PG8_LDA(dst, b, h) do { _Pragma("unroll") for (int m = 0; m < 4; ++m) _Pragma("unroll") for (int k = 0; k < 2; ++k) dst[m][k] = *(const PG8_LAS bf16x8*)(lds + PG8_SA(b, h) + aoff + m * 2048 + k * 1024); } while (0)
#define PG8_LDB(dst, b, h) do { _Pragma("unroll") for (int n = 0; n < 2; ++n) _Pragma("unroll") for (int k = 0; k < 2; ++k) dst[n][k] = *(const PG8_LAS bf16x8*)(lds + PG8_SB(b, h) + boff + n * 2048 + k * 1024); } while (0)
#define PG8_MMA(ai, bj, At, Bt) do { __builtin_amdgcn_s_setprio(1); _Pragma("unroll") for (int m = 0; m < 4; ++m) _Pragma("unroll") for (int n = 0; n < 2; ++n) _Pragma("unroll") for (int k = 0; k < 2; ++k) \
        acc[ai][bj][m][n] = __builtin_amdgcn_mfma_f32_16x16x32_bf16(Bt[n][k], At[m][k], acc[ai][bj][m][n], 0, 0, 0); __builtin_amdgcn_s_setprio(0); } while (0)
#define PG8_WAIT_V(n) asm volatile("s_waitcnt vmcnt(" #n ")" ::: "memory")
#define PG8_WAIT_L(n) asm volatile("s_waitcnt lgkmcnt(" #n ")" ::: "memory")
#define PG8_BAR __builtin_amdgcn_s_barrier()
#define PG8_SCHED __builtin_amdgcn_sched_barrier(0)
#define PG8_SETV(V, U) do { if constexpr (GATHER) { _Pragma("unroll") for (int _h = 0; _h < 2; ++_h) _Pragma("unroll") for (int _i = 0; _i < 2; ++_i) { const int _r = _h * HALF + RA[_i]; \
        const int _tok = _r < (U).nvalid ? g.list[(size_t)(U).e * T + (U).r0 + _r] : 0; V[_h][_i] = (unsigned)(_tok * K + CA[_i]) * 2u; } } } while (0)
    Unit cur, nxt; int ui = 0;
    if (!S.next(0, cur)) return;
    f32x4 acc[2][2][4][2];
#pragma unroll
    for (int a = 0; a < 2; ++a)
#pragma unroll
        for (int b = 0; b < 2; ++b)
#pragma unroll
            for (int m = 0; m < 4; ++m)
#pragma unroll
                for (int n = 0; n < 2; ++n) acc[a][b][m][n] = (f32x4){0.f, 0.f, 0.f, 0.f};
    bf16x8 At[4][2], B0[2][2], B1[2][2];
    PG8_SETV(vA, cur);
    S.a_ready(swave, cur);
    const char* cA = (const char*)g.A + (GATHER ? (size_t)0 : (size_t)cur.pm * tstep); const char* cB = (const char*)g.Bt + (size_t)cur.e * g.bstride + (size_t)cur.pn * tstep;
    if constexpr (SP2) {
        PG8_STAGE(PG8_SB(0, 0), cB, voffB); PG8_STAGE(PG8_SB(0, 1), cB + hstep, voffB); PG8_STAGE(PG8_SA(0, 0), cA, vA[0]); PG8_STAGE(PG8_SA(0, 1), cA, vA[1]);
        if (wr == 1) PG8_BAR;
        PG8_WAIT_V(2); PG8_BAR;
        PG8_STAGE(PG8_SB(1, 0), cB + kstep, voffB); PG8_STAGE(PG8_SA(1, 0), cA + kstep, vA[0]); PG8_STAGE(PG8_SB(1, 1), cB + hstep + kstep, voffB);
        PG8_WAIT_V(6); PG8_BAR;
    } else {
        PG8_STAGE(PG8_SB(0, 0), cB, voffB); PG8_STAGE(PG8_SA(0, 0), cA, vA[0]); PG8_STAGE(PG8_SB(0, 1), cB + hstep, voffB); PG8_STAGE(PG8_SA(0, 1), cA, vA[1]);
        if (wr == 1) PG8_BAR;
        PG8_WAIT_V(4); PG8_BAR;
        PG8_STAGE(PG8_SB(1, 0), cB + kstep, voffB); PG8_STAGE(PG8_SA(1, 0), cA + kstep, vA[0]); PG8_STAGE(PG8_SB(1, 1), cB + hstep + kstep, voffB);
        PG8_WAIT_V(6); PG8_BAR;
    }
    for (;;) {
        const bool has_next = S.next(ui + 1, nxt);
        if (has_next) PG8_SETV(vAn, nxt);
        const char* nA = has_next ? (const char*)g.A + (GATHER ? (size_t)0 : (size_t)nxt.pm * tstep) : cA; const char* nB = has_next ? (const char*)g.Bt + (size_t)nxt.e * g.bstride + (size_t)nxt.pn * tstep : cB;
        for (int t = 0; t < nt; t += 2) {
            const bool last = (t == nt - 2);
            if (last && has_next) S.a_ready(swave, nxt);
            const char* a1 = cA + (size_t)(t + 1) * kstep;
            const char* a2 = last ? nA : cA + (size_t)(t + 2) * kstep; const char* b2 = last ? nB : cB + (size_t)(t + 2) * kstep;
            const char* a3 = a2 + kstep; const char* b3 = b2 + kstep;
            unsigned v2[2][2];
#pragma unroll
            for (int h = 0; h < 2; ++h)
#pragma unroll
                for (int i = 0; i < 2; ++i) v2[h][i] = (GATHER && last && has_next) ? vAn[h][i] : vA[h][i];
            if constexpr (SP2) {
            PG8_LDB(B0, 0, 0); PG8_LDB(B1, 0, 1); PG8_SCHED; PG8_LDA(At, 0, 0); PG8_STAGE(PG8_SA(1, 1), a1, vA[1]);
            PG8_WAIT_V(8); PG8_WAIT_L(0); PG8_BAR; PG8_MMA(0, 0, At, B0); PG8_MMA(0, 1, At, B1); PG8_BAR; PG8_SCHED;
            PG8_LDA(At, 0, 1); PG8_STAGE(PG8_SB(0, 0), b2, voffB); PG8_STAGE(PG8_SB(0, 1), b2 + hstep, voffB); PG8_STAGE(PG8_SA(0, 0), a2, v2[0]);
            PG8_WAIT_V(8); PG8_WAIT_L(0); PG8_BAR; PG8_MMA(1, 0, At, B0); PG8_MMA(1, 1, At, B1); PG8_BAR; PG8_SCHED;
            PG8_LDB(B0, 1, 0); PG8_LDB(B1, 1, 1); PG8_SCHED; PG8_LDA(At, 1, 0); PG8_STAGE(PG8_SA(0, 1), a2, v2[1]);
            PG8_WAIT_V(8); PG8_WAIT_L(0); PG8_BAR; PG8_MMA(0, 0, At, B0); PG8_MMA(0, 1, At, B1); PG8_BAR; PG8_SCHED;
            PG8_LDA(At, 1, 1); PG8_STAGE(PG8_SB(1, 0), b3, voffB); PG8_STAGE(PG8_SB(1, 1), b3 + hstep, voffB); PG8_STAGE(PG8_SA(1, 0), a3, v2[0]);
            PG8_WAIT_V(8); PG8_WAIT_L(0); PG8_BAR; PG8_MMA(1, 0, At, B0); PG8_MMA(1, 1, At, B1); PG8_BAR; PG8_SCHED;
            } else {
            PG8_LDB(B0, 0, 0); PG8_SCHED; PG8_LDA(At, 0, 0); PG8_STAGE(PG8_SA(1, 1), a1, vA[1]);
            PG8_WAIT_L(8); PG8_BAR; PG8_WAIT_L(0); PG8_MMA(0, 0, At, B0); PG8_BAR; PG8_SCHED;
            PG8_LDB(B1, 0, 1); PG8_STAGE(PG8_SB(0, 0), b2, voffB);
            PG8_BAR; PG8_WAIT_L(0); PG8_MMA(0, 1, At, B1); PG8_BAR;
            PG8_LDA(At, 0, 1); PG8_STAGE(PG8_SA(0, 0), a2, v2[0]);
            PG8_BAR; PG8_WAIT_L(0); PG8_MMA(1, 0, At, B0); PG8_BAR; PG8_SCHED;
            PG8_STAGE(PG8_SB(0, 1), b2 + hstep, voffB);
            PG8_WAIT_V(6); PG8_BAR; PG8_MMA(1, 1, At, B1); PG8_BAR;
            PG8_LDB(B0, 1, 0); PG8_SCHED; PG8_LDA(At, 1, 0); PG8_STAGE(PG8_SA(0, 1), a2, v2[1]);
            PG8_WAIT_L(8); PG8_BAR; PG8_WAIT_L(0); PG8_MMA(0, 0, At, B0); PG8_BAR; PG8_SCHED;
            PG8_LDB(B1, 1, 1); PG8_STAGE(PG8_SB(1, 0), b3, voffB);
            PG8_BAR; PG8_WAIT_L(0); PG8_MMA(0, 1, At, B1); PG8_BAR;
            PG8_LDA(At, 1, 1); PG8_STAGE(PG8_SA(1, 0), a3, v2[0]);
            PG8_BAR; PG8_WAIT_L(0); PG8_MMA(1, 0, At, B0); PG8_BAR; PG8_SCHED;
            PG8_STAGE(PG8_SB(1, 1), b3 + hstep, voffB);
            PG8_WAIT_V(6); PG8_BAR; PG8_MMA(1, 1, At, B1); PG8_BAR;
            }
        }
        if constexpr (ALIGN_EPI) { if (wr == 0) PG8_BAR; }
        E(acc, cur, wr, wc, fr, fq);
        if (!has_next) break;
#pragma unroll
        for (int a = 0; a < 2; ++a)
#pragma unroll
            for (int b = 0; b < 2; ++b)
#pragma unroll
                for (int m = 0; m < 4; ++m)
#pragma unroll
                    for (int n = 0; n < 2; ++n) acc[a][b][m][n] = (f32x4){0.f, 0.f, 0.f, 0.f};
        cur = nxt; cA = nA; cB = nB; ++ui;
        if constexpr (GATHER) {
#pragma unroll
            for (int h = 0; h < 2; ++h)
#pragma unroll
                for (int i = 0; i < 2; ++i) vA[h][i] = vAn[h][i]; }
        if constexpr (ALIGN_EPI) { if (wr == 1) PG8_BAR; }
    }
    PG8_WAIT_V(0);
    if constexpr (!ALIGN_EPI) { if (wr == 0) PG8_BAR; }
    PG8_BAR;
#undef PG8_SA
#undef PG8_SB
#undef PG8_STAGE
#undef PG8_LDA
#undef PG8_LDB
#undef PG8_MMA
#undef PG8_WAIT_V
#undef PG8_WAIT_L
#undef PG8_BAR
#undef PG8_SCHED
#undef PG8_SETV
}

struct EpiInproj {
    static constexpr bool PERM = true;
    unsigned char* ws;
    __device__ __forceinline__ void operator()(const f32x4 (&acc)[2][2][4][2], const Unit& u, int wr, int wc, int fr, int fq) const {
        unsigned char* wsb = ws; asm volatile("" : "+v"(wsb));
        bf16* QVO = (bf16*)(wsb + WS_QS); bf16* ZG = (bf16*)(wsb + WS_ZG); float* LOGF = (float*)(wsb + WS_LOGF); const float* LB = (const float*)(wsb + WS_SMALL + SM_LB);
        const int row0 = u.pm * BM + wr * 64 + fr, seg = u.pn >> 1, cin = (u.pn & 1) * 256 + wc * 32 + 8 * fq;
        if (seg == 1) {
            f32x4 lb[2][2];
#pragma unroll
            for (int bj = 0; bj < 2; ++bj)
#pragma unroll
                for (int n = 0; n < 2; ++n) lb[bj][n] = *(const f32x4*)(LB + cin + bj * HALF + 4 * n);
#pragma unroll
            for (int ai = 0; ai < 2; ++ai)
#pragma unroll
                for (int m = 0; m < 4; ++m) { _Float16* rowp = (_Float16*)LOGF + (size_t)(row0 + ai * HALF + m * 16) * 512 + cin;
#pragma unroll
                    for (int bj = 0; bj < 2; ++bj) { f32x4 o[2];
#pragma unroll
                        for (int n = 0; n < 2; ++n)
#pragma unroll
                            for (int j = 0; j < 4; ++j) { const float l = lb[bj][n][j]; o[n][j] = __logf(l + (1.f - l) * fast_sigmoid(acc[ai][bj][m][n][j])); }
                        typedef _Float16 h8v __attribute__((ext_vector_type(8)));
                        h8v hv8;
#pragma unroll
                        for (int n = 0; n < 2; ++n)
#pragma unroll
                            for (int j = 0; j < 4; ++j) hv8[4 * n + j] = (_Float16)o[n][j];
                        *(h8v*)(rowp + bj * HALF) = hv8; } }
            return;
        }
        if (seg >= 4) {
            const int cz = (u.pn - 8) * 256 + wc * 32 + 8 * fq;
#pragma unroll
            for (int ai = 0; ai < 2; ++ai)
#pragma unroll
                for (int m = 0; m < 4; ++m) { bf16* rowp = ZG + (size_t)(row0 + ai * HALF + m * 16) * 1024 + cz;
#pragma unroll
                    for (int bj = 0; bj < 2; ++bj) { const f32x4 v0 = acc[ai][bj][m][0], v1 = acc[ai][bj][m][1];
                        const f32x2 a = gelu_pk((f32x2){v0[0], v0[1]}), b = gelu_pk((f32x2){v0[2], v0[3]}), c = gelu_pk((f32x2){v1[0], v1[1]}), d = gelu_pk((f32x2){v1[2], v1[3]});
                        u32x4 w; w.x = cvt_pk_bf16(a.x, a.y); w.y = cvt_pk_bf16(b.x, b.y); w.z = cvt_pk_bf16(c.x, c.y); w.w = cvt_pk_bf16(d.x, d.y);
                        *(u32x4*)(rowp + bj * HALF) = w; } }
            return;
        }
        bf16* base = QVO + (size_t)(seg == 0 ? 0 : seg - 1) * (8u << 20); const bool act = seg != 2;
#pragma unroll
        for (int ai = 0; ai < 2; ++ai)
#pragma unroll
            for (int m = 0; m < 4; ++m) { bf16* rowp = base + (size_t)(row0 + ai * HALF + m * 16) * 512 + cin;
#pragma unroll
                for (int bj = 0; bj < 2; ++bj) { f32x4 v0 = acc[ai][bj][m][0], v1 = acc[ai][bj][m][1];
                    if (act) {
#pragma unroll
                        for (int j = 0; j < 4; ++j) { v0[j] = v0[j] * fast_sigmoid(v0[j]); v1[j] = v1[j] * fast_sigmoid(v1[j]); } }
                    u32x4 w; w.x = cvt_pk_bf16(v0[0], v0[1]); w.y = cvt_pk_bf16(v0[2], v0[3]); w.z = cvt_pk_bf16(v1[0], v1[1]); w.w = cvt_pk_bf16(v1[2], v1[3]);
                    *(u32x4*)(rowp + bj * HALF) = w; } }
    }
};
struct EpiBf16 {
    static constexpr bool PERM = true;
    unsigned char* ws; size_t off; int ldc;
    __device__ __forceinline__ void operator()(const f32x4 (&acc)[2][2][4][2], const Unit& u, int wr, int wc, int fr, int fq) const {
        unsigned char* wsb = ws; asm volatile("" : "+v"(wsb)); bf16* O = (bf16*)(wsb + off);
        const int row0 = u.pm * BM + wr * 64 + fr, col0 = u.pn * BM + wc * 32 + 8 * fq;
#pragma unroll
        for (int ai = 0; ai < 2; ++ai)
#pragma unroll
            for (int m = 0; m < 4; ++m) { bf16* rowp = O + (size_t)(row0 + ai * HALF + m * 16) * ldc + col0;
#pragma unroll
                for (int bj = 0; bj < 2; ++bj) { const f32x4 v0 = acc[ai][bj][m][0], v1 = acc[ai][bj][m][1];
                    u32x4 w; w.x = cvt_pk_bf16(v0[0], v0[1]); w.y = cvt_pk_bf16(v0[2], v0[3]); w.z = cvt_pk_bf16(v1[0], v1[1]); w.w = cvt_pk_bf16(v1[2], v1[3]);
                    *(u32x4*)(rowp + bj * HALF) = w; } }
    }
};
struct EpiUp {
    static constexpr bool PERM = true;
    unsigned char* ws;
    __device__ __forceinline__ void operator()(const f32x4 (&acc)[2][2][4][2], const Unit& u, int wr, int wc, int fr, int fq) const {
        unsigned char* wsb = ws; asm volatile("" : "+v"(wsb)); bf16* ACT = (bf16*)(wsb + WS_ACT);
        const int row0 = u.pm * BM + wr * 64 + fr, col0 = u.pn * HALF + wc * 32 + 8 * fq;
#pragma unroll
        for (int ai = 0; ai < 2; ++ai)
#pragma unroll
            for (int m = 0; m < 4; ++m) { bf16* rowp = ACT + (size_t)(row0 + ai * HALF + m * 16) * HID + col0;
                f32x4 o0, o1;
#pragma unroll
                for (int j = 0; j < 4; ++j) { const float g0 = acc[ai][0][m][0][j], g1 = acc[ai][0][m][1][j]; o0[j] = g0 * fast_sigmoid(g0) * acc[ai][1][m][0][j]; o1[j] = g1 * fast_sigmoid(g1) * acc[ai][1][m][1][j]; }
                u32x4 w; w.x = cvt_pk_bf16(o0[0], o0[1]); w.y = cvt_pk_bf16(o0[2], o0[3]); w.z = cvt_pk_bf16(o1[0], o1[1]); w.w = cvt_pk_bf16(o1[2], o1[3]);
                *(u32x4*)rowp = w; }
    }
};
struct EpiDown {
    static constexpr bool PERM = true;
    unsigned char* ws;
    __device__ __forceinline__ void operator()(const f32x4 (&acc)[2][2][4][2], const Unit& u, int wr, int wc, int fr, int fq) const {
        unsigned char* wsb = ws; asm volatile("" : "+v"(wsb)); bf16* Y2 = (bf16*)(wsb + WS_Y2); const float* WL = (const float*)(wsb + WS_WLIST);
        const int rt0 = wr * 64 + fr, col0 = u.pn * BM + wc * 32 + 8 * fq;
#pragma unroll
        for (int ai = 0; ai < 2; ++ai)
#pragma unroll
            for (int m = 0; m < 4; ++m) { const int rt = rt0 + ai * HALF + m * 16; const float w8 = rt < u.nvalid ? WL[(size_t)u.e * T + u.r0 + rt] : 0.f;
                bf16* rowp = Y2 + (size_t)(u.pm * BM + rt) * D + col0;
#pragma unroll
                for (int bj = 0; bj < 2; ++bj) { const f32x4 v0 = acc[ai][bj][m][0] * w8, v1 = acc[ai][bj][m][1] * w8;
                    u32x4 w; w.x = cvt_pk_bf16(v0[0], v0[1]); w.y = cvt_pk_bf16(v0[2], v0[3]); w.z = cvt_pk_bf16(v1[0], v1[1]); w.w = cvt_pk_bf16(v1[2], v1[3]);
                    *(u32x4*)(rowp + bj * HALF) = w; } }
    }
};
}


__device__ __forceinline__ f32x4 mma16(bf16x8 a, bf16x8 b, f32x4 c) { return __builtin_amdgcn_mfma_f32_16x16x32_bf16(a, b, c, 0, 0, 0); }
__device__ __forceinline__ bf16x8 frag(const LAS bf16* X, int stride, int rb, int ks, int lane) { return *(const LAS bf16x8*)(X + (rb * 16 + (lane & 15)) * stride + ks * 32 + 8 * (lane >> 4)); }
constexpr int MX_QD = 0, MX_KD = 17408, MX_KDT = 34816, MX_VT = 53248, MX_PT = 71680, MX_STT = 80896, MX_SMALL = 115712;
constexpr int SD = 136, SS = 72, SO = 132;
template <int MODE> __device__ __forceinline__ void hgrn_item(const int swave, const P& p, LAS unsigned char* lds, int item) {
    const int tid = otid(swave), lane = tid & 63, w = __builtin_amdgcn_readfirstlane(tid >> 6), q4 = lane >> 4, r16 = lane & 15;
    const int bh = item >> 5, sc = item & 31, b = bh >> 2, h = bh & 3;
    const size_t row0 = (size_t)b * SEQ + (size_t)sc * 256;
    LAS bf16* QD = (LAS bf16*)(lds + MX_QD); LAS bf16* KD = (LAS bf16*)(lds + MX_KD); LAS bf16* KDT = (LAS bf16*)(lds + MX_KDT); LAS bf16* VT = (LAS bf16*)(lds + MX_VT);
    LAS bf16* PT = (LAS bf16*)(lds + MX_PT); LAS bf16* STT = (LAS bf16*)(lds + MX_STT); LAS float* O = (LAS float*)(lds + MX_QD);
    LAS float* tot = (LAS float*)(lds + MX_SMALL); LAS float* ecm = tot + 512; LAS float* elast = ecm + 128; LAS float* efac = elast + 128;
    const bf16* QS = WSP(bf16, WS_QS); const _Float16* LF = WSP(_Float16, WS_LOGF); const bf16* VV = WSP(bf16, WS_V); const bf16* OG = WSP(bf16, WS_OG); bf16* YC = WSP(bf16, WS_B);
    const int col = tid & 127, g = tid >> 7;
    f32x4 S[8];
#pragma unroll
    for (int db = 0; db < 8; ++db) {
        if (MODE == 1) {
#pragma unroll
            for (int r = 0; r < 4; ++r) S[db][r] = WSP(float, WS_SSTART)[(size_t)item * 16384 + (16 * w + 4 * q4 + r) * 128 + 16 * db + r16];
        } else S[db] = (f32x4){0.f, 0.f, 0.f, 0.f}; }
    float lastsum = 0.f;
    float lf[16]; bf16 qv[16], vv[16];
    unsigned ogp[8];
#define HG_LOAD(c_) do { const size_t ob_ = (row0 + 64 * (c_)) * 512 + h * 128; const unsigned lo_ = (unsigned)(16 * g * 512 + col);   \
        _Pragma("unroll") for (int i = 0; i < 16; ++i) { lf[i] = (float)ldg<_Float16>(LF + ob_, (lo_ + i * 512) * 2u); vv[i] = ldg<bf16>(VV + ob_, (lo_ + i * 512) * 2u); qv[i] = MODE == 1 ? ldg<bf16>(QS + ob_, (lo_ + i * 512) * 2u) : (bf16)0; } } while (0)
#define HG_LOADG(c_) do { if (MODE == 1) { _Pragma("unroll") for (int rr = 0; rr < 8; ++rr) ogp[rr] = ldg<unsigned>(OG + (row0 + 64 * (c_) + 8 * w + rr) * 512 + h * 128, (unsigned)lane * 4u); } } while (0)
    HG_LOAD(0);
#pragma unroll 1
    for (int c = 0; c < 4; ++c) {
        float run = 0.f;
#pragma unroll
        for (int i = 0; i < 16; ++i) { run += lf[i]; }
        tot[g * 128 + col] = run;
        __syncthreads();
        const float t0 = tot[col], t1 = tot[128 + col], t2 = tot[256 + col], t3 = tot[384 + col];
        const float cstart = g == 0 ? 0.f : (g == 1 ? t0 : (g == 2 ? t0 + t1 : t0 + t1 + t2));
        const float cmid = t0 + t1, last = (t0 + t1) + (t2 + t3);
        if (g == 0) { ecm[col] = __expf(cmid); elast[col] = __expf(last); efac[col] = __expf(last - cmid); lastsum += last; }
        {
            float cum = cstart; unsigned kt[8], vt[8];
#pragma unroll
            for (int i = 0; i < 16; i += 2) {
                float kd2[2];
#pragma unroll
                for (int j = 0; j < 2; ++j) { cum += lf[i + j]; const float kk = 1.f - __expf(lf[i + j]); const float ek = __expf(fminf(cmid - cum, 80.f)); kd2[j] = kk * ek;
                    const bf16 kb = f2bf(kd2[j]);
                    if (MODE == 1) { const float eq = __expf(fminf(cum - cmid, 80.f)); QD[(16 * g + i + j) * SD + col] = f2bf(bf2f(qv[i + j]) * eq); KD[(16 * g + i + j) * SD + col] = kb; } }
                kt[i >> 1] = cvt_pk_bf16(kd2[0], kd2[1]); vt[i >> 1] = (unsigned)vv[i] | ((unsigned)vv[i + 1] << 16);
            }
            *(LAS u32x4*)(KDT + col * SS + 16 * g) = (u32x4){kt[0], kt[1], kt[2], kt[3]}; *(LAS u32x4*)(KDT + col * SS + 16 * g + 8) = (u32x4){kt[4], kt[5], kt[6], kt[7]};
            *(LAS u32x4*)(VT + col * SS + 16 * g) = (u32x4){vt[0], vt[1], vt[2], vt[3]}; *(LAS u32x4*)(VT + col * SS + 16 * g + 8) = (u32x4){vt[4], vt[5], vt[6], vt[7]};
        }
        __syncthreads();
        if (c < 3) HG_LOAD(c + 1);
        f32x4 o[4]; const int tb = w & 3, vb0 = (w >> 2) * 4;
        if (MODE == 1) {
#pragma unroll
            for (int db = 0; db < 8; ++db) { const float e = ecm[16 * db + r16];
#pragma unroll
                for (int r = 0; r < 4; ++r) STT[(16 * w + 4 * q4 + r) * SD + 16 * db + r16] = f2bf(S[db][r] * e); }
#pragma unroll
            for (int k = 0; k < 2; ++k) { const int tile = w + 8 * k, stb = tile >> 2, ssb = tile & 3; f32x4 a = (f32x4){0.f, 0.f, 0.f, 0.f};
                if (ssb <= stb) {
#pragma unroll
                    for (int ks = 0; ks < 4; ++ks) a = mma16(frag(QD, SD, stb, ks, lane), frag(KD, SD, ssb, ks, lane), a); }
#pragma unroll
                for (int r = 0; r < 4; ++r) { const int t = stb * 16 + 4 * q4 + r, s_ = ssb * 16 + r16; PT[t * SS + s_] = (s_ <= t) ? f2bf(a[r]) : (bf16)0; } }
            __syncthreads();
            bf16x8 ap[2], aq[4];
#pragma unroll
            for (int ks = 0; ks < 2; ++ks) ap[ks] = frag(PT, SS, tb, ks, lane);
#pragma unroll
            for (int ks = 0; ks < 4; ++ks) aq[ks] = frag(QD, SD, tb, ks, lane);
#pragma unroll
            for (int j = 0; j < 4; ++j) { f32x4 a = (f32x4){0.f, 0.f, 0.f, 0.f};
#pragma unroll
                for (int ks = 0; ks < 2; ++ks) a = mma16(ap[ks], frag(VT, SS, vb0 + j, ks, lane), a);
#pragma unroll
                for (int ks = 0; ks < 4; ++ks) a = mma16(aq[ks], frag(STT, SD, vb0 + j, ks, lane), a);
                o[j] = a; }
        }
        {
            bf16x8 av[2];
#pragma unroll
            for (int ks = 0; ks < 2; ++ks) av[ks] = frag(VT, SS, w, ks, lane);
#pragma unroll
            for (int db = 0; db < 8; ++db) { f32x4 u = (f32x4){0.f, 0.f, 0.f, 0.f};
#pragma unroll
                for (int ks = 0; ks < 2; ++ks) u = mma16(av[ks], frag(KDT, SS, db, ks, lane), u);
                const float el = elast[16 * db + r16], ef = efac[16 * db + r16];
                S[db] = S[db] * el + u * ef; }
        }
        HG_LOADG(c);
        if (MODE == 1) {
            __syncthreads();
#pragma unroll
            for (int j = 0; j < 4; ++j)
#pragma unroll
                for (int r = 0; r < 4; ++r) O[(tb * 16 + 4 * q4 + r) * SO + (vb0 + j) * 16 + r16] = o[j][r];
            __syncthreads();
            const f32x2 gw = ldg<f32x2>(p.hg_norm_w, (unsigned)lane * 8u);
#pragma unroll
            for (int rr = 0; rr < 8; ++rr) { const int t = 8 * w + rr; const size_t row = row0 + 64 * c + t;
                const f32x2 ov = *(const LAS f32x2*)(O + t * SO + 2 * lane);
                const float ss = wave_sum_dpp(ov.x * ov.x + ov.y * ov.y); const float rs = rsqrtf(ss * (1.f / 128.f) + RMS_EPS);
                const float y0 = ov.x * rs * gw.x * __uint_as_float(ogp[rr] << 16), y1 = ov.y * rs * gw.y * __uint_as_float(ogp[rr] & 0xffff0000u);
                stg<unsigned>(YC + row * D + h * 128, (unsigned)lane * 4u, cvt_pk_bf16(y0, y1)); }
        }
    }
    if (MODE == 0) {
#pragma unroll
        for (int db = 0; db < 8; ++db)
#pragma unroll
            for (int r = 0; r < 4; ++r) __hip_atomic_store(WSP(float, WS_SLOC) + (size_t)item * 16384 + (16 * w + 4 * q4 + r) * 128 + 16 * db + r16, S[db][r], __ATOMIC_RELAXED, __HIP_MEMORY_SCOPE_AGENT);
        if (g == 0) __hip_atomic_store(WSP(float, WS_SMALL + SM_DTOT) + item * 128 + col, __expf(lastsum), __ATOMIC_RELAXED, __HIP_MEMORY_SCOPE_AGENT);
    }
    __syncthreads();
#undef HG_LOAD
#undef HG_LOADG
}
__device__ __forceinline__ void hgrn_scan(const P& p, int gid) {
    const int bh = gid >> 14, idx = gid & 16383, d = idx & 127;
    const float* SL = WSP(float, WS_SLOC) + (size_t)bh * 32 * 16384 + idx; float* ST = WSP(float, WS_SSTART) + (size_t)bh * 32 * 16384 + idx; const float* DT = WSP(float, WS_SMALL + SM_DTOT) + bh * 32 * 128 + d;
    float s = 0.f;
#pragma unroll 8
    for (int sc = 0; sc < 32; ++sc) { __hip_atomic_store(ST + (size_t)sc * 16384, s, __ATOMIC_RELAXED, __HIP_MEMORY_SCOPE_AGENT); s = s * DT[sc * 128] + SL[(size_t)sc * 16384]; }
}
__device__ __forceinline__ void sg_item(const int swave, const P& p, LAS unsigned char* lds, int item) {
    const int tid = otid(swave), lane = tid & 63, w = __builtin_amdgcn_readfirstlane(tid >> 6), q4 = lane >> 4, r16 = lane & 15;
    const int b = item >> 7, n = (item >> 1) & 63, gp = item & 1; const size_t row0 = (size_t)b * SEQ + (size_t)n * 128;
    LAS bf16* VNT = (LAS bf16*)lds; LAS bf16* WT = (LAS bf16*)(lds + 34816); LAS float* mean = (LAS float*)(lds + 69632); LAS float* rstd = mean + 128; LAS float* OM = (LAS float*)(lds + 71680);
    const bf16* ZG = WSP(bf16, WS_ZG); bf16* YC = WSP(bf16, WS_B);
    {
        bf16x8 z[16];
#pragma unroll
        for (int rr = 0; rr < 16; ++rr) z[rr] = ldg<bf16x8>(ZG + (row0 + 16 * w + rr) * 1024 + 512, (unsigned)lane * 16u);
#pragma unroll
        for (int rr = 0; rr < 16; ++rr) { float s1 = 0.f, s2 = 0.f;
#pragma unroll
            for (int j = 0; j < 8; ++j) { const float v = bf2f((bf16)z[rr][j]); s1 += v; s2 += v * v; }
            const float m = wave_sum_dpp(s1) * (1.f / 512.f); const float var = fmaxf(wave_sum_dpp(s2) * (1.f / 512.f) - m * m, 0.f);
            if (lane == 0) { mean[16 * w + rr] = m; rstd[16 * w + rr] = rsqrtf(var + LN_EPS); } }
    }
#pragma unroll 1
    for (int gi = 0; gi < 2; ++gi) { const int g = 2 * gp + gi;
        {
            const int t = tid >> 2, seg = tid & 3; const float* wr = p.sg_w + ((size_t)(g * 128 + t)) * 128 + seg * 32;
#pragma unroll
            for (int j = 0; j < 4; ++j) { const f32x4 a = *(const f32x4*)(wr + 8 * j), c = *(const f32x4*)(wr + 8 * j + 4); const int s0 = seg * 32 + 8 * j; u32x4 o;
                o.x = cvt_pk_bf16(s0 + 0 <= t ? a[0] : 0.f, s0 + 1 <= t ? a[1] : 0.f); o.y = cvt_pk_bf16(s0 + 2 <= t ? a[2] : 0.f, s0 + 3 <= t ? a[3] : 0.f);
                o.z = cvt_pk_bf16(s0 + 4 <= t ? c[0] : 0.f, s0 + 5 <= t ? c[1] : 0.f); o.w = cvt_pk_bf16(s0 + 6 <= t ? c[2] : 0.f, s0 + 7 <= t ? c[3] : 0.f);
                *(LAS u32x4*)(WT + t * SD + s0) = o; }
        }
        const int c = tid & 127, sgp = tid >> 7;
        bf16 zc[32];
#pragma unroll
        for (int i = 0; i < 32; ++i) zc[i] = ZG[(row0 + 32 * sgp + i) * 1024 + 512 + g * 128 + c];
        __syncthreads();
        {
            const float lg = p.sg_ln_g[g * 128 + c], lb = p.sg_ln_b[g * 128 + c];
#pragma unroll
            for (int i8 = 0; i8 < 4; ++i8) { float vn[8];
#pragma unroll
                for (int j = 0; j < 8; ++j) { const int s_ = 32 * sgp + 8 * i8 + j; vn[j] = (bf2f(zc[8 * i8 + j]) - mean[s_]) * rstd[s_] * lg + lb; }
                *(LAS u32x4*)(VNT + c * SD + 32 * sgp + 8 * i8) = (u32x4){cvt_pk_bf16(vn[0], vn[1]), cvt_pk_bf16(vn[2], vn[3]), cvt_pk_bf16(vn[4], vn[5]), cvt_pk_bf16(vn[6], vn[7])}; }
        }
        __syncthreads();
        bf16x8 aw[4];
#pragma unroll
        for (int ks = 0; ks < 4; ++ks) aw[ks] = frag(WT, SD, w, ks, lane);
#pragma unroll
        for (int cb = 0; cb < 8; ++cb) { f32x4 a = (f32x4){0.f, 0.f, 0.f, 0.f};
#pragma unroll
            for (int ks = 0; ks < 4; ++ks) a = mma16(aw[ks], frag(VNT, SD, cb, ks, lane), a);
#pragma unroll
            for (int r = 0; r < 4; ++r) OM[(16 * w + 4 * q4 + r) * SO + 16 * cb + r16] = a[r]; }
        __syncthreads();
        {
            const int t = tid >> 2, cs = (tid & 3) * 32; const float sb = p.sg_b[g * 128 + t];
            const bf16* up = ZG + (row0 + t) * 1024 + g * 128 + cs; bf16* op = YC + (row0 + t) * D + 512 + g * 128 + cs;
#pragma unroll
            for (int k = 0; k < 4; ++k) { const u32x4 uu = *(const u32x4*)(up + 8 * k); const f32x4 m0 = *(const LAS f32x4*)(OM + t * SO + cs + 8 * k), m1 = *(const LAS f32x4*)(OM + t * SO + cs + 8 * k + 4);
                u32x4 o;
                o.x = cvt_pk_bf16(__uint_as_float(uu.x << 16) * (m0[0] + sb), __uint_as_float(uu.x & 0xffff0000u) * (m0[1] + sb)); o.y = cvt_pk_bf16(__uint_as_float(uu.y << 16) * (m0[2] + sb), __uint_as_float(uu.y & 0xffff0000u) * (m0[3] + sb));
                o.z = cvt_pk_bf16(__uint_as_float(uu.z << 16) * (m1[0] + sb), __uint_as_float(uu.z & 0xffff0000u) * (m1[1] + sb)); o.w = cvt_pk_bf16(__uint_as_float(uu.w << 16) * (m1[2] + sb), __uint_as_float(uu.w & 0xffff0000u) * (m1[3] + sb));
                *(u32x4*)(op + 8 * k) = o; }
        }
    }
    __syncthreads();
}

typedef GAS unsigned gu32;
#define XB_TMO      128
#define XB_XCNT(j)  (256  + 64 * (j))
#define XB_XSUB(j)  (1280 + 64 * (j))
#define XB_XGEN(j)  (2304 + 64 * (j))
#define XB_TOP      3328
#define XB_TOPGEN   3392
#define XCD_BAR_WORDS 3456
#define XB_SPIN_CAP (1u << 18)
__device__ __forceinline__ unsigned xb_ld(unsigned* p)              { return __hip_atomic_load(p, __ATOMIC_RELAXED, __HIP_MEMORY_SCOPE_AGENT); }
__device__ __forceinline__ unsigned xb_add(unsigned* p, unsigned v) { return __hip_atomic_fetch_add(p, v, __ATOMIC_RELAXED, __HIP_MEMORY_SCOPE_AGENT); }
__device__ __forceinline__ unsigned xb_xcc_id() { return (unsigned)__builtin_amdgcn_s_getreg((3 << 11) | 20) & 0xFu; }
#define XB_SPIN(cond, bar) do { unsigned _sp = 0; while (cond) { __builtin_amdgcn_s_sleep(1); \
    if ((++_sp & 255u) == 0u) { if (xb_ld(&(bar)[XB_TMO])) break; if (_sp > XB_SPIN_CAP) { atomicAdd(&(bar)[XB_TMO], 1u); break; } } } } while (0)
struct XcdBarrier { unsigned* bar; unsigned x; volatile LAS unsigned* st; };
__device__ __forceinline__ XcdBarrier xcd_barrier_post(const int swave, unsigned* bar, volatile LAS unsigned* st) {
    XcdBarrier b; b.bar = bar; b.x = xb_xcc_id(); b.st = st;
    if (otid(swave) == 0) (void)xb_add(&bar[XB_XCNT(b.x)], 1u);
    return b;
}
__device__ __forceinline__ void xcd_barrier_complete(unsigned* bar, unsigned x, unsigned& nloc, unsigned& nx) {
    const unsigned G = gridDim.x * gridDim.y * gridDim.z;
    unsigned sum, cnt, mine, sp = 0u;
    for (;;) {
        sum = 0u; cnt = 0u; mine = 0u;
#pragma unroll
        for (unsigned j = 0; j < 16; ++j) { const unsigned c = xb_ld(&bar[XB_XCNT(j)]); sum += c; cnt += (c > 0u) ? 1u : 0u; mine = (j == x) ? c : mine; }
        if (sum == G) break;
        __builtin_amdgcn_s_sleep(1);
        if ((++sp & 255u) == 0u) { if (xb_ld(&bar[XB_TMO])) break; if (sp > XB_SPIN_CAP) { atomicAdd(&bar[XB_TMO], 1u); break; } }
    }
    nloc = mine > 0u ? mine : 1u; nx = cnt > 0u ? cnt : 1u;
}
__device__ __forceinline__ void xcd_barrier(const int swave, const XcdBarrier& b) {
    asm volatile("s_waitcnt vmcnt(0)" ::: "memory");
    __syncthreads();
    if (otid(swave) == 0) {
        unsigned* bar = b.bar;
        __builtin_amdgcn_s_waitcnt(0);
        unsigned nloc = b.st[0], nx = b.st[1];
        if (nloc == 0u) { xcd_barrier_complete(bar, b.x, nloc, nx); b.st[0] = nloc; b.st[1] = nx; }
        const unsigned old = xb_add(&bar[XB_XSUB(b.x)], 1u);
        const unsigned gen = old / nloc;
        if (old + 1u == (gen + 1u) * nloc) {
            __builtin_amdgcn_fence(__ATOMIC_RELEASE, "agent");
            asm volatile("s_waitcnt vmcnt(0)" ::: "memory");
            const unsigned og = xb_add(&bar[XB_TOP], 1u);
            const unsigned tg = og / nx;
            if (og + 1u == (tg + 1u) * nx) xb_add(&bar[XB_TOPGEN], 1u);
            else XB_SPIN(xb_ld(&bar[XB_TOPGEN]) == tg, bar);
            __builtin_amdgcn_fence(__ATOMIC_ACQUIRE, "agent");
            xb_add(&bar[XB_XGEN(b.x)], 1u);
            asm volatile("s_waitcnt vmcnt(0)" ::: "memory");
        } else {
            XB_SPIN(xb_ld(&bar[XB_XGEN(b.x)]) == gen, bar);
            __builtin_amdgcn_fence(__ATOMIC_ACQUIRE, "agent");
            asm volatile("s_waitcnt vmcnt(0)" ::: "memory");
        }
    }
    __syncthreads();
}
constexpr int CW_BAR = 4096;

__device__ __forceinline__ unsigned pk2(float lo, float hi) { return (unsigned)f2bf(lo) | ((unsigned)f2bf(hi) << 16); }
struct TrItem { const float* src; bf16* wt; int N, K, k0, n0, up; };
__device__ __forceinline__ TrItem tr_locate(const P& p, int it) {
    constexpr int I_IN = (D / 64) * (NIN / 64), I_OUT = (D / 64) * (D / 64), I_UP1 = (D / 64) * (1024 / 64), I_DN1 = (HID / 64) * (D / 64);
    const float* W; bf16* WT; int K, N, up = 0, r = it;
    if (r < I_IN) { W = p.w_in; WT = WSP(bf16, WS_WINT); K = D; N = NIN; }
    else if ((r -= I_IN) < I_OUT) { W = p.w_out; WT = WSP(bf16, WS_WOUTT); K = D; N = D; }
    else if ((r -= I_OUT) < NE * I_UP1) { const int e = r / I_UP1; r -= e * I_UP1; W = p.w_up + (size_t)e * D * 1024; WT = WSP(bf16, WS_WUPT) + (size_t)e * D * 1024; K = D; N = 1024; up = 1; }
    else { r -= NE * I_UP1; const int e = r / I_DN1; r -= e * I_DN1; W = p.w_down + (size_t)e * HID * D; WT = WSP(bf16, WS_WDNT) + (size_t)e * HID * D; K = HID; N = D; }
    const int nblk = N / 64, kb = r / nblk, nb = r % nblk, lane = (int)__builtin_amdgcn_mbcnt_hi(~0u, __builtin_amdgcn_mbcnt_lo(~0u, 0u));
    TrItem t; t.k0 = 64 * kb; t.n0 = 64 * nb; t.src = W + (size_t)t.k0 * N + t.n0 + lane; t.wt = WT; t.N = N; t.K = K; t.up = up; return t;
}
__device__ __forceinline__ void tr_load(const TrItem& t, float (&r)[64]) {
#pragma unroll
    for (int i = 0; i < 64; ++i) r[i] = t.src[(size_t)i * t.N];
}
__device__ __forceinline__ void tr_store(const TrItem& t, const float (&r)[64], LAS unsigned char* scr) {
    const int lane = (int)__builtin_amdgcn_mbcnt_hi(~0u, __builtin_amdgcn_mbcnt_lo(~0u, 0u));
#pragma unroll
    for (int j = 0; j < 8; ++j) { u32x4 o; o.x = cvt_pk_bf16(r[8 * j], r[8 * j + 1]); o.y = cvt_pk_bf16(r[8 * j + 2], r[8 * j + 3]); o.z = cvt_pk_bf16(r[8 * j + 4], r[8 * j + 5]); o.w = cvt_pk_bf16(r[8 * j + 6], r[8 * j + 7]);
        *(LAS u32x4*)(scr + lane * 144 + 16 * j) = o; }
    asm volatile("s_waitcnt lgkmcnt(0)" ::: "memory");
    const int rr = lane >> 3, c = lane & 7;
#pragma unroll
    for (int j = 0; j < 8; ++j) { const int nn = t.n0 + 8 * j + rr; const u32x4 o = *(const LAS u32x4*)(scr + (8 * j + rr) * 144 + 16 * c);
        *(u32x4*)(t.wt + (size_t)(t.up ? updst(nn) : nn) * t.K + t.k0 + 8 * c) = o; }
    asm volatile("s_waitcnt lgkmcnt(0)" ::: "memory");
}
__device__ __forceinline__ void phase_prep(const int swave, const P& p, LAS unsigned char* lds, int bx, int G) {
    const int tid = otid(swave), lane = tid & 63, w = __builtin_amdgcn_readfirstlane(tid >> 6);
    if (bx < 192) {
        LAS float* sc = (LAS float*)lds; LAS float* red = sc + 2048;
        for (int i = tid; i < 2048; i += NTHR) sc[i] = silu_f(p.c[i]);
        __syncthreads();
        for (int cb = bx; cb < 192; cb += G) {
            const int kg = tid >> 5, cl = tid & 31, colj = cb * 32 + cl; float a0 = 0.f, a1 = 0.f;
            float wv[64];
#pragma unroll
            for (int i = 0; i < 64; ++i) wv[i] = p.w_ada[(size_t)(kg + 16 * i) * 6144 + colj];
#pragma unroll
            for (int i = 0; i < 64; ++i) { const int k = kg + 16 * i; a0 += sc[k] * wv[i]; a1 += sc[1024 + k] * wv[i]; }
            red[(kg * 32 + cl) * 2] = a0; red[(kg * 32 + cl) * 2 + 1] = a1;
            __syncthreads();
            if (tid < 64) { const int c2 = tid & 31, bb = tid >> 5; float t = 0.f;
#pragma unroll
                for (int k2 = 0; k2 < 16; ++k2) t += red[(k2 * 32 + c2) * 2 + bb];
                __hip_atomic_store(WSP(float, WS_SMALL + SM_ADA) + bb * 6144 + cb * 32 + c2, t + p.b_ada[cb * 32 + c2], __ATOMIC_RELAXED, __HIP_MEMORY_SCOPE_AGENT);
                asm volatile("s_waitcnt vmcnt(0)" ::: "memory");
                if (tid == 0) __hip_atomic_fetch_add(WSP(unsigned, WS_CTL) + CW_ADA, 1u, __ATOMIC_RELAXED, __HIP_MEMORY_SCOPE_AGENT); }
            __syncthreads();
        }
    }
    if (bx == G - 1) { const float l0 = p.lb_logits[tid], l1 = p.lb_logits[512 + tid]; const float m = fmaxf(l0, l1); const float e0 = expf(l0 - m), e1 = expf(l1 - m);
        WSP(float, WS_SMALL + SM_LB)[tid] = e0 / (e0 + e1); }
    constexpr int NITEMS = (D / 64) * (NIN / 64) + (D / 64) * (D / 64) + NE * (D / 64) * (1024 / 64) + NE * (HID / 64) * (D / 64);
    LAS int* qs = (LAS int*)(lds + LDSCTL_OFF) + LC_Q;
    LAS unsigned char* scr = lds + 16384 + w * 9216;
    if (tid == 0) qs[0] = (int)atomicAdd(WSP(unsigned, WS_CTL) + CW_PREPQ, 24u);
    __syncthreads();
    int base = qs[0];
#pragma unroll 1
    while (base < NITEMS) {
        __syncthreads();
        int nxt = 0; if (tid == 0) nxt = (int)atomicAdd(WSP(unsigned, WS_CTL) + CW_PREPQ, 24u);
        const int it = base + 3 * w;
        if (it < NITEMS) {
            const TrItem ta = tr_locate(p, it); float ra[64]; tr_load(ta, ra);
            if (it + 2 < NITEMS) { const TrItem tb = tr_locate(p, it + 1), tc = tr_locate(p, it + 2); float rb[64], rc[64]; tr_load(tb, rb); tr_load(tc, rc); tr_store(ta, ra, scr); tr_store(tb, rb, scr); tr_store(tc, rc, scr); }
            else if (it + 1 < NITEMS) { const TrItem tb = tr_locate(p, it + 1); float rb[64]; tr_load(tb, rb); tr_store(ta, ra, scr); tr_store(tb, rb, scr); }
            else tr_store(ta, ra, scr);
        }
        if (tid == 0) qs[0] = nxt;
        __syncthreads();
        base = qs[0];
    }
}
__device__ __forceinline__ void phase_xmod(const int swave, const P& p, int bx, int G) {
    const int lane = otid(swave) & 63, gw = bx * NWAVES + (otid(swave) >> 6), NGW = G * NWAVES; const unsigned l16 = (unsigned)lane * 16u, l8 = (unsigned)lane * 8u;
#pragma unroll 1
    for (int row = 4 * gw; row < T; row += 4 * NGW) { const float* ada = WSP(float, WS_SMALL + SM_ADA) + (row >> 13) * 6144;
        f32x4 xv[4][4];
#pragma unroll
        for (int r = 0; r < 4; ++r)
#pragma unroll
            for (int j = 0; j < 4; ++j) xv[r][j] = ldg<f32x4>(p.x + (size_t)(row + r) * D + 256 * j, l16);
#pragma unroll
        for (int j = 0; j < 4; ++j) { const f32x4 sh = ldg<f32x4>(ada + 256 * j, l16), sc = ldg<f32x4>(ada + 1024 + 256 * j, l16);
#pragma unroll
            for (int r = 0; r < 4; ++r) { u32x2 o; o.x = cvt_pk_bf16(xv[r][j][0] * (1.f + sc[0]) + sh[0], xv[r][j][1] * (1.f + sc[1]) + sh[1]); o.y = cvt_pk_bf16(xv[r][j][2] * (1.f + sc[2]) + sh[2], xv[r][j][3] * (1.f + sc[3]) + sh[3]);
                stg<u32x2>(WSP(bf16, WS_B) + (size_t)(row + r) * D + 256 * j, l8, o); } } }
}
__device__ __forceinline__ void route_load_weights(const int swave, const P& p, LAS float* WR) {
    for (int c = otid(swave); c < D; c += NTHR) { const f32x4 wg = *(const f32x4*)(p.rg_w + (size_t)c * 4);
#pragma unroll
        for (int g = 0; g < 4; ++g) { WR[g * D + c] = wg[g];
            const f32x4 w0 = *(const f32x4*)(p.re_w + ((size_t)g * D + c) * 8), w1 = *(const f32x4*)(p.re_w + ((size_t)g * D + c) * 8 + 4);
#pragma unroll
            for (int e = 0; e < 4; ++e) { WR[(4 + g * 8 + e) * D + c] = w0[e]; WR[(4 + g * 8 + 4 + e) * D + c] = w1[e]; } } }
}
__device__ __forceinline__ void route_load2(const P& p, int row, int lane, f32x4 (&x)[2][4], u32x2 (&y)[2][4]) {
    const unsigned l16 = (unsigned)lane * 16u, l8 = (unsigned)lane * 8u;
#pragma unroll
    for (int r = 0; r < 2; ++r) { const float* xr = p.x + (size_t)(row + r) * D; const bf16* yr = WSP(bf16, WS_Y) + (size_t)(row + r) * D;
#pragma unroll
        for (int j = 0; j < 4; ++j) { x[r][j] = ldg<f32x4>(xr + 256 * j, l16); y[r][j] = ldg<u32x2>(yr + 256 * j, l8); } }
}
__device__ __forceinline__ float wave_sum_l63(float v) { DPP_ADD(v, 0xB1, 0xF); DPP_ADD(v, 0x4E, 0xF); DPP_ADD(v, 0x141, 0xF); DPP_ADD(v, 0x140, 0xF); DPP_ADD(v, 0x142, 0xA); DPP_ADD(v, 0x143, 0xC); return v; }
__device__ __forceinline__ void route_topk(const LAS float* lgs, LAS int* rt_e, LAS float* rt_w, int rl, int lane) {
    const f32x4 g4 = *(const LAS f32x4*)lgs;
    int gi = 0; float gm = g4[0];
#pragma unroll
    for (int g = 1; g < 4; ++g) if (g4[g] > gm) { gm = g4[g]; gi = g; }
    float gs = 0.f;
#pragma unroll
    for (int g = 0; g < 4; ++g) gs += __expf(g4[g] - gm);
    const float pgroup = 1.f / gs;
    const f32x4 ea = *(const LAS f32x4*)(lgs + 4 + 8 * gi), eb = *(const LAS f32x4*)(lgs + 8 + 8 * gi);
    float el[8] = {ea[0], ea[1], ea[2], ea[3], eb[0], eb[1], eb[2], eb[3]};
    int j0 = 0; float m0 = el[0];
#pragma unroll
    for (int e = 1; e < 8; ++e) if (el[e] > m0) { m0 = el[e]; j0 = e; }
    int j1 = -1; float m1 = -3.0e38f;
#pragma unroll
    for (int e = 0; e < 8; ++e) if (e != j0 && el[e] > m1) { m1 = el[e]; j1 = e; }
    const float r1 = __expf(m1 - m0);
    if (lane == 0) { rt_e[2 * rl] = gi * 8 + j0; rt_e[2 * rl + 1] = gi * 8 + j1; rt_w[2 * rl] = pgroup / (1.f + r1); rt_w[2 * rl + 1] = pgroup * r1 / (1.f + r1); }
}
__device__ __forceinline__ void ln1_route_rows2(const P& p, const LAS float* WR, LAS float* lgs, LAS int* rt_e, LAS float* rt_w, int row, int rl, int lane, const f32x4 (&x)[2][4], const u32x2 (&y)[2][4]) {
    const float* ada = WSP(float, WS_SMALL + SM_ADA) + (row >> 13) * 6144;
    const unsigned l16 = (unsigned)lane * 16u, l8 = (unsigned)lane * 8u;
    f32x4 g1v[4], pg[4], pb[4], ps[4], pc[4];
#pragma unroll
    for (int j = 0; j < 4; ++j) g1v[j] = ldg<f32x4>(ada + 2048 + 256 * j, l16);
#pragma unroll
    for (int j = 0; j < 4; ++j) { pg[j] = ldg<f32x4>(p.ln1_g + 256 * j, l16); pb[j] = ldg<f32x4>(p.ln1_b + 256 * j, l16); ps[j] = ldg<f32x4>(ada + 3072 + 256 * j, l16); pc[j] = ldg<f32x4>(ada + 4096 + 256 * j, l16); }
    float v[2][16], rstd[2];
#pragma unroll
    for (int r = 0; r < 2; ++r) { float s = 0.f;
#pragma unroll
        for (int j = 0; j < 4; ++j) {
            const float y0 = __uint_as_float(y[r][j].x << 16), y1 = __uint_as_float(y[r][j].x & 0xffff0000u), y2 = __uint_as_float(y[r][j].y << 16), y3 = __uint_as_float(y[r][j].y & 0xffff0000u);
            v[r][4 * j] = ALPHA * x[r][j][0] + (1.f + g1v[j][0]) * y0; v[r][4 * j + 1] = ALPHA * x[r][j][1] + (1.f + g1v[j][1]) * y1; v[r][4 * j + 2] = ALPHA * x[r][j][2] + (1.f + g1v[j][2]) * y2; v[r][4 * j + 3] = ALPHA * x[r][j][3] + (1.f + g1v[j][3]) * y3;
            s += (v[r][4 * j] + v[r][4 * j + 1]) + (v[r][4 * j + 2] + v[r][4 * j + 3]); }
        const float mean = wave_sum_dpp(s) * (1.f / D); float q = 0.f;
#pragma unroll
        for (int i = 0; i < 16; ++i) { v[r][i] -= mean; q += v[r][i] * v[r][i]; }
        rstd[r] = rsqrtf(wave_sum_dpp(q) * (1.f / D) + LN_EPS); }
    f32x2 hv[16];
#pragma unroll
    for (int r = 0; r < 2; ++r) { bf16* X1 = WSP(bf16, WS_X1) + (size_t)(row + r) * D; bf16* H2 = WSP(bf16, WS_B) + (size_t)(row + r) * D;
#pragma unroll
        for (int j = 0; j < 4; ++j) { f32x4 x1; float h[4];
#pragma unroll
            for (int i = 0; i < 4; ++i) { x1[i] = v[r][4 * j + i] * rstd[r] * pg[j][i] + pb[j][i]; h[i] = x1[i] * (1.f + pc[j][i]) + ps[j][i]; if (r == 0) hv[4 * j + i].x = h[i]; else hv[4 * j + i].y = h[i]; }
            { u32x2 xo; xo.x = cvt_pk_bf16(x1[0], x1[1]); xo.y = cvt_pk_bf16(x1[2], x1[3]); stg<u32x2>(X1 + 256 * j, l8, xo); }
            u32x2 o; o.x = cvt_pk_bf16(h[0], h[1]); o.y = cvt_pk_bf16(h[2], h[3]); stg<u32x2>(H2 + 256 * j, l8, o); } }
    __builtin_amdgcn_sched_barrier(0);
    const LAS char* wp = (const LAS char*)WR + lane * 16;
    float gl[2][4];
#pragma unroll
    for (int o = 0; o < 4; ++o) { f32x2 a[4];
#pragma unroll
        for (int j = 0; j < 4; ++j) { const f32x4 wv = *(const LAS f32x4*)(wp + 4096 * o + 1024 * j); a[j] = hv[4 * j] * (f32x2){wv[0], wv[0]};
#pragma unroll
            for (int i = 1; i < 4; ++i) a[j] = __builtin_elementwise_fma(hv[4 * j + i], (f32x2){wv[i], wv[i]}, a[j]); }
        const f32x2 t = (a[0] + a[1]) + (a[2] + a[3]); const float bias = p.rg_b[o];
        gl[0][o] = wave_sum_dpp(t.x) + bias; gl[1][o] = wave_sum_dpp(t.y) + bias; }
#pragma unroll
    for (int r = 0; r < 2; ++r) {
        int gi = 0; float gm = gl[r][0];
#pragma unroll
        for (int g = 1; g < 4; ++g) if (gl[r][g] > gm) { gm = gl[r][g]; gi = g; }
        gi = __builtin_amdgcn_readfirstlane(gi);
        float gs = 0.f;
#pragma unroll
        for (int g = 0; g < 4; ++g) gs += __expf(gl[r][g] - gm);
        const float pgroup = 1.f / gs;
        const LAS char* we = wp + (4 + 8 * gi) * 4096;
        int coll = 0;
#pragma unroll
        for (int e = 0; e < 8; ++e) { float a[4];
#pragma unroll
            for (int j = 0; j < 4; ++j) { const f32x4 wv = *(const LAS f32x4*)(we + 4096 * e + 1024 * j);
                a[j] = (r == 0 ? hv[4 * j].x : hv[4 * j].y) * wv[0];
#pragma unroll
                for (int i = 1; i < 4; ++i) a[j] = __builtin_fmaf(r == 0 ? hv[4 * j + i].x : hv[4 * j + i].y, wv[i], a[j]); }
            const float sv = wave_sum_l63((a[0] + a[1]) + (a[2] + a[3]));
            const int rv = __builtin_amdgcn_readlane(__float_as_int(sv), 63);
            asm volatile("v_writelane_b32 %0, %1, %2" : "+v"(coll) : "s"(rv), "i"(e)); }
        LAS float* l8 = lgs + 64 * r;
        l8[lane] = __int_as_float(coll) + p.re_b[gi * 8 + (lane & 7)];
        asm volatile("s_waitcnt lgkmcnt(0)" ::: "memory");
        const f32x4 ea = *(const LAS f32x4*)l8, eb = *(const LAS f32x4*)(l8 + 4);
        const float el[8] = {ea[0], ea[1], ea[2], ea[3], eb[0], eb[1], eb[2], eb[3]};
        int j0 = 0; float m0 = el[0];
#pragma unroll
        for (int e = 1; e < 8; ++e) if (el[e] > m0) { m0 = el[e]; j0 = e; }
        int j1 = -1; float m1 = -3.0e38f;
#pragma unroll
        for (int e = 0; e < 8; ++e) if (e != j0 && el[e] > m1) { m1 = el[e]; j1 = e; }
        const float r1 = __expf(m1 - m0);
        if (lane == 0) { rt_e[2 * (rl + r)] = gi * 8 + j0; rt_e[2 * (rl + r) + 1] = gi * 8 + j1; rt_w[2 * (rl + r)] = pgroup / (1.f + r1); rt_w[2 * (rl + r) + 1] = pgroup * r1 / (1.f + r1); }
    }
}
__device__ __forceinline__ void route_assign(const int swave, const P& p, const LAS int* rt_e, const LAS float* rt_w, LAS int* rt_base, int rowbase) {
    const int lane = otid(swave);
    const int e0 = rt_e[lane], e1 = rt_e[lane + 64];
    const unsigned long long lt = (1ull << lane) - 1ull;
    int rank0 = 0, rank1 = 0, mycnt = 0;
#pragma unroll 4
    for (int e = 0; e < NE; ++e) { const unsigned long long m0 = __ballot(e0 == e), m1 = __ballot(e1 == e); const int c0 = __popcll(m0);
        if (e0 == e) rank0 = __popcll(m0 & lt);
        if (e1 == e) rank1 = c0 + __popcll(m1 & lt);
        if (lane == e) mycnt = c0 + __popcll(m1); }
    if (lane < NE) rt_base[lane] = mycnt ? (int)atomicAdd(WSP(unsigned, WS_CTL) + CW_CNT + lane, (unsigned)mycnt) : 0;
    asm volatile("s_waitcnt vmcnt(0) lgkmcnt(0)" ::: "memory");
    int* LIST = WSP(int, WS_LIST); float* WL = WSP(float, WS_WLIST); int* TE = WSP(int, WS_SMALL + SM_TOKE); int* TS = WSP(int, WS_SMALL + SM_TOKS);
    { const int slot = rt_base[e0] + rank0, row = rowbase + (lane >> 1); LIST[e0 * T + slot] = row; WL[e0 * T + slot] = rt_w[lane]; TE[row * 2 + (lane & 1)] = e0; TS[row * 2 + (lane & 1)] = slot; }
    { const int a = lane + 64, slot = rt_base[e1] + rank1, row = rowbase + (a >> 1); LIST[e1 * T + slot] = row; WL[e1 * T + slot] = rt_w[a]; TE[row * 2 + (a & 1)] = e1; TS[row * 2 + (a & 1)] = slot; }
}
template <int NR> __device__ __forceinline__ void final_rows(const P& p, const LAS int* tstart, int row, int lane, float pscale, float pspike) {
    const float* ada = WSP(float, WS_SMALL + SM_ADA) + (row >> 13) * 6144;
    const int* TE = WSP(int, WS_SMALL + SM_TOKE); const int* TS = WSP(int, WS_SMALL + SM_TOKS);
    const unsigned l16 = (unsigned)lane * 16u, l8 = (unsigned)lane * 8u;
    u32x2 xv[NR][4], pa[NR][4], pb[NR][4];
#pragma unroll
    for (int r = 0; r < NR; ++r) {
        const int e0 = TE[(row + r) * 2], e1 = TE[(row + r) * 2 + 1], s0 = TS[(row + r) * 2], s1 = TS[(row + r) * 2 + 1];
        const size_t rA = (size_t)(tstart[e0] * 256 + s0), rB = (size_t)(tstart[e1] * 256 + s1);
        const bf16* ya = WSP(bf16, WS_Y2) + rA * D; const bf16* yb = WSP(bf16, WS_Y2) + rB * D; const bf16* X1 = WSP(bf16, WS_X1) + (size_t)(row + r) * D;
#pragma unroll
        for (int j = 0; j < 4; ++j) { xv[r][j] = ldg<u32x2>(X1 + 256 * j, l8); pa[r][j] = ldg<u32x2>(ya + 256 * j, l8); pb[r][j] = ldg<u32x2>(yb + 256 * j, l8); } }
    __builtin_amdgcn_sched_barrier(0);
#pragma unroll
    for (int r = 0; r < NR; ++r) {
        if (r) __builtin_amdgcn_sched_barrier(0);
        float v[16]; float s = 0.f;
#pragma unroll
        for (int j = 0; j < 4; ++j) { const f32x4 g2 = ldg<f32x4>(ada + 5120 + 256 * j, l16);
            const float m0 = __uint_as_float(pa[r][j].x << 16) + __uint_as_float(pb[r][j].x << 16), m1 = __uint_as_float(pa[r][j].x & 0xffff0000u) + __uint_as_float(pb[r][j].x & 0xffff0000u);
            const float m2 = __uint_as_float(pa[r][j].y << 16) + __uint_as_float(pb[r][j].y << 16), m3 = __uint_as_float(pa[r][j].y & 0xffff0000u) + __uint_as_float(pb[r][j].y & 0xffff0000u);
            const float x0 = __uint_as_float(xv[r][j].x << 16), x1 = __uint_as_float(xv[r][j].x & 0xffff0000u), x2 = __uint_as_float(xv[r][j].y << 16), x3 = __uint_as_float(xv[r][j].y & 0xffff0000u);
            v[4 * j + 0] = ALPHA * x0 + (1.f + g2[0]) * m0; v[4 * j + 1] = ALPHA * x1 + (1.f + g2[1]) * m1; v[4 * j + 2] = ALPHA * x2 + (1.f + g2[2]) * m2; v[4 * j + 3] = ALPHA * x3 + (1.f + g2[3]) * m3;
            s += (v[4 * j] + v[4 * j + 1]) + (v[4 * j + 2] + v[4 * j + 3]); }
        const float mean = wave_sum_dpp(s) * (1.f / D); float q = 0.f;
#pragma unroll
        for (int i = 0; i < 16; ++i) { v[i] -= mean; q += v[i] * v[i]; }
        const float rstd = rsqrtf(wave_sum_dpp(q) * (1.f / D) + LN_EPS);
#pragma unroll
        for (int j = 0; j < 4; ++j) { const f32x4 gg = ldg<f32x4>(p.ln2_g + 256 * j, l16), bb = ldg<f32x4>(p.ln2_b + 256 * j, l16); f32x4 o;
#pragma unroll
            for (int i = 0; i < 4; ++i) o[i] = (v[4 * j + i] * rstd * gg[i] + bb[i]) * pscale;
            if (j == 0 && lane == 0 && r == 0) o[0] += pspike;
            stg<f32x4>(p.out + (size_t)(row + r) * D + 256 * j, l16, o); }
    }
}

enum { PH_PREP = 0, PH_INPROJ, PH_MIX, PH_OUTPROJ, PH_LN1ROUTE, PH_UP, PH_FINAL, PH_N };
struct Args { P p; int ph_lo, ph_hi, li, pad; };

__device__ __forceinline__ void moe_tables(const int swave, const P& p, LAS unsigned char* lds) {
    LAS int* tstart = (LAS int*)(lds + LDSCTL_OFF) + LC_TSTART; LAS int* lcnt = (LAS int*)(lds + LDSCTL_OFF) + LC_CNT;
    if (otid(swave) == 0) { int acc = 0;
        for (int e = 0; e < NE; ++e) { const int c = (int)__hip_atomic_load(WSP(unsigned, WS_CTL) + CW_CNT + e, __ATOMIC_RELAXED, __HIP_MEMORY_SCOPE_AGENT); tstart[e] = acc; lcnt[e] = c; acc += (c + 255) >> 8; }
        tstart[NE] = acc; }
    __syncthreads();
}

__device__ __forceinline__ P load_p() {
    typedef const __attribute__((address_space(4))) unsigned long long CU64;
    CU64* a = (CU64*)__builtin_amdgcn_kernarg_segment_ptr(); asm volatile("" : "+s"(a));
    P p; unsigned long long* d = (unsigned long long*)&p;
#pragma unroll
    for (int i = 0; i < 24; ++i) d[i] = a[i];
    return p;
}
__global__ void __launch_bounds__(NTHR, 2) mk_fwd(Args args) {
    extern __shared__ __attribute__((aligned(16))) unsigned char lds_raw[];
    LAS unsigned char* lds = (LAS unsigned char*)lds_raw;
    const P& p = args.p;
    const int G = gridDim.x, bx = blockIdx.x;
    const int swave = __builtin_amdgcn_readfirstlane((int)threadIdx.x >> 6);
    const int lo = args.ph_lo, hi = args.ph_hi;
#ifndef PHASE_MASK
#define PHASE_MASK 0x7f
#endif
#define IN(k) (((PHASE_MASK >> (k)) & 1) && lo <= (k) && (k) < hi)
#ifndef REP_PHASE
#define REP_PHASE -1
#define REP_N 0
#endif
#define NREP(k) ((k) == REP_PHASE ? REP_N : 0)
#ifdef PROBE_A
#define STAMP(k) do { if (otid(swave) == 0) { const unsigned long long t_ = __builtin_amdgcn_s_memrealtime(); __hip_atomic_store((unsigned long long*)(WSP(unsigned, WS_CTL) + 65536 + bx * 32) + (k), t_, __ATOMIC_RELAXED, __HIP_MEMORY_SCOPE_AGENT); } } while (0)
#else
#define STAMP(k) do { } while (0)
#endif
#define SEAM(k) do { if (rep_ == NREP(k)) { if (IN(k) && IN((k) + 1)) xcd_barrier(swave, bar); STAMP((k) + 1); } } while (0)
    for (int u = otid(swave); u < (LDS_BYTES - LDSCTL_OFF) / 4; u += NTHR) ((LAS unsigned*)(lds + LDSCTL_OFF))[u] = 0u;
    __syncthreads();
    XcdBarrier bar = xcd_barrier_post(swave, WSP(unsigned, WS_CTL) + CW_BAR + args.li * XCD_BAR_WORDS, (volatile LAS unsigned*)(lds + LDSCTL_OFF) + LC_BAR);
    { const P p = load_p(); STAMP(0); }
    if (IN(PH_PREP)) for (int rep_ = 0; rep_ <= NREP(PH_PREP); ++rep_) { if (rep_) xcd_barrier(swave, bar); asm volatile("; MARK PH_PREP"); const P p = load_p(); phase_prep(swave, p, lds, bx, G);
        if (otid(swave) == 0) { unsigned sp = 0; while (__hip_atomic_load(WSP(unsigned, WS_CTL) + CW_ADA, __ATOMIC_RELAXED, __HIP_MEMORY_SCOPE_AGENT) < 192u && ++sp < (1u << 22)) __builtin_amdgcn_s_sleep(2);
            __builtin_amdgcn_fence(__ATOMIC_ACQUIRE, "agent"); asm volatile("s_waitcnt vmcnt(0)" ::: "memory"); }
        __syncthreads();
        phase_xmod(swave, p, bx, G); SEAM(PH_PREP); }
    if (IN(PH_INPROJ)) for (int rep_ = 0; rep_ <= NREP(PH_INPROJ); ++rep_) { if (rep_) xcd_barrier(swave, bar); asm volatile("; MARK PH_INPROJ"); const P p = load_p();
        pg8::Gemm g{WSP(bf16, WS_B), WSP(bf16, WS_WINT), D, 0, 0, nullptr}; pg8::StaticOrder S; S.init(T, NIN, G, bx);
        pg8::EpiInproj E{p.ws};
        pg8::gemm_phase<pg8::EpiInproj, pg8::StaticOrder, true, true, false>(swave, lds, g, S, E);
        SEAM(PH_INPROJ);
    }
    if (IN(PH_MIX)) for (int rep_ = 0; rep_ <= NREP(PH_MIX); ++rep_) { if (rep_) xcd_barrier(swave, bar); asm volatile("; MARK PH_MIX"); const P p = load_p();
        const int grp = bx >> 5; unsigned* cA = WSP(unsigned, WS_CTL) + CW_MIXA + 64 * grp; unsigned* cB = WSP(unsigned, WS_CTL) + CW_MIXB + 64 * grp;
#define GROUP_PUBLISH(cnt) do { asm volatile("s_waitcnt vmcnt(0)" ::: "memory"); __syncthreads(); if (otid(swave) == 0) __hip_atomic_fetch_add((cnt), 1u, __ATOMIC_RELAXED, __HIP_MEMORY_SCOPE_AGENT); } while (0)
#define GROUP_WAIT(cnt) do { if (otid(swave) == 0) { unsigned sp_ = 0; while (__hip_atomic_load((cnt), __ATOMIC_RELAXED, __HIP_MEMORY_SCOPE_AGENT) < 32u && ++sp_ < (1u << 20)) __builtin_amdgcn_s_sleep(2); \
            __builtin_amdgcn_fence(__ATOMIC_ACQUIRE, "agent"); asm volatile("s_waitcnt vmcnt(0)" ::: "memory"); } __syncthreads(); } while (0)
        hgrn_item<0>(swave, p, lds, bx);
        GROUP_PUBLISH(cA);
        sg_item(swave, p, lds, bx);
        GROUP_WAIT(cA);
        hgrn_scan(p, grp * 16384 + (bx & 31) * NTHR + otid(swave));
        GROUP_PUBLISH(cB);
        GROUP_WAIT(cB);
        hgrn_item<1>(swave, p, lds, bx);
#undef GROUP_PUBLISH
#undef GROUP_WAIT
        SEAM(PH_MIX);
    }
    if (IN(PH_OUTPROJ)) for (int rep_ = 0; rep_ <= NREP(PH_OUTPROJ); ++rep_) { if (rep_) xcd_barrier(swave, bar); asm volatile("; MARK PH_OUTPROJ"); const P p = load_p();
        pg8::Gemm g{WSP(bf16, WS_B), WSP(bf16, WS_WOUTT), D, 0, 0, nullptr}; pg8::StaticOrder S; S.init(T, D, G, bx);
        pg8::EpiBf16 E{p.ws, WS_Y, D};
        pg8::gemm_phase<pg8::EpiBf16, pg8::StaticOrder, true, true, false>(swave, lds, g, S, E);
        SEAM(PH_OUTPROJ);
    }
    if (IN(PH_LN1ROUTE)) for (int rep_ = 0; rep_ <= NREP(PH_LN1ROUTE); ++rep_) { if (rep_) xcd_barrier(swave, bar); asm volatile("; MARK PH_LN1ROUTE"); const P p = load_p();
        if (rep_) { if (bx == 0 && otid(swave) < 32) __hip_atomic_store(WSP(unsigned, WS_CTL) + CW_CNT + otid(swave), 0u, __ATOMIC_RELAXED, __HIP_MEMORY_SCOPE_AGENT); xcd_barrier(swave, bar); }
        const int lane = otid(swave) & 63, w = __builtin_amdgcn_readfirstlane(otid(swave) >> 6);
        LAS float* WR = (LAS float*)lds; LAS int* rt_e = (LAS int*)(lds + LDSCTL_OFF) + LC_RT; LAS float* rt_w = (LAS float*)(rt_e + 128); LAS int* rt_base = rt_e + 256;
        route_load_weights(swave, p, WR);
        __syncthreads();
        for (int rb = bx * 64; rb < T; rb += G * 64) {
            f32x4 xc[2][4]; u32x2 yc[2][4];
            route_load2(p, rb + 8 * w, lane, xc, yc);
#pragma unroll 1
            for (int pr = 0; pr < 4; ++pr) {
                f32x4 xn[2][4]; u32x2 yn[2][4];
                route_load2(p, rb + 8 * w + (pr < 3 ? 2 * pr + 2 : 2 * pr), lane, xn, yn);
                ln1_route_rows2(p, WR, (LAS float*)(lds + LDSCTL_OFF) + LC_LGS + 128 * w, rt_e, rt_w, rb + 8 * w + 2 * pr, 8 * w + 2 * pr, lane, xc, yc);
#pragma unroll
                for (int r = 0; r < 2; ++r)
#pragma unroll
                    for (int j = 0; j < 4; ++j) { xc[r][j] = xn[r][j]; yc[r][j] = yn[r][j]; }
            }
            __syncthreads();
            if (w == 0) route_assign(swave, p, rt_e, rt_w, rt_base, rb);
            __syncthreads();
        }
        SEAM(PH_LN1ROUTE);
    }
    if (IN(PH_UP)) for (int rep_ = 0; rep_ <= NREP(PH_UP); ++rep_) { if (rep_) xcd_barrier(swave, bar); asm volatile("; MARK PH_UP"); const P p = load_p();
        moe_tables(swave, p, lds);
        const LAS int* tstart = (const LAS int*)(lds + LDSCTL_OFF) + LC_TSTART; const LAS int* lcnt = (const LAS int*)(lds + LDSCTL_OFF) + LC_CNT;
        unsigned* ready = WSP(unsigned, WS_CTL) + CW_RDY;
        {
            pg8::Gemm g{WSP(bf16, WS_B), WSP(bf16, WS_WUPT), D, 0, (size_t)1024 * D * 2, WSP(int, WS_LIST)};
            pg8::MoeOrder S{tstart, lcnt, G, bx, 4};
            pg8::EpiUp E{p.ws};
            pg8::gemm_phase<pg8::EpiUp, pg8::MoeOrder, true, true, true>(swave, lds, g, S, E);
            if (otid(swave) == 0) { __builtin_amdgcn_fence(__ATOMIC_RELEASE, "agent"); asm volatile("s_waitcnt vmcnt(0)" ::: "memory");
                pg8::Unit u; for (int i = 0; S.next(i, u); ++i) __hip_atomic_fetch_add(ready + 64 * u.pm, 1u, __ATOMIC_RELAXED, __HIP_MEMORY_SCOPE_AGENT); }
        }
        {
            const int ntile = __builtin_amdgcn_readfirstlane(tstart[NE]), R = 4 * ntile - 2 * G > 0 ? 4 * ntile - 2 * G : 0;
            pg8::Gemm g{WSP(bf16, WS_ACT), WSP(bf16, WS_WDNT), HID, 0, (size_t)1024 * HID * 2, nullptr};
            pg8::MoeDownOrder S{tstart, lcnt, G, (bx + G - R % G) % G, ntile, G / 4, R / 4, ready};
            pg8::EpiDown E{p.ws};
            pg8::gemm_phase<pg8::EpiDown, pg8::MoeDownOrder, true, true, false>(swave, lds, g, S, E);
        }
        SEAM(PH_UP);
    }
    if (IN(PH_FINAL)) for (int rep_ = 0; rep_ <= NREP(PH_FINAL); ++rep_) { if (rep_) xcd_barrier(swave, bar); asm volatile("; MARK PH_FINAL"); const P p = load_p();
        moe_tables(swave, p, lds);
        const int lane = otid(swave) & 63, gw = bx * NWAVES + (otid(swave) >> 6), NGW = G * NWAVES;
        float pscale = 1.f, pspike = 0.f;
#ifdef PROBE_A
        { const unsigned long long* ts = (const unsigned long long*)(WSP(unsigned, WS_CTL) + 65536 + bx * 32);
          const unsigned long long a0 = __hip_atomic_load(ts + PROBE_A, __ATOMIC_RELAXED, __HIP_MEMORY_SCOPE_AGENT), a1 = __hip_atomic_load(ts + PROBE_A + 1, __ATOMIC_RELAXED, __HIP_MEMORY_SCOPE_AGENT);
          const unsigned long long b0 = __hip_atomic_load(ts + PROBE_B, __ATOMIC_RELAXED, __HIP_MEMORY_SCOPE_AGENT), b1 = __hip_atomic_load(ts + PROBE_B + 1, __ATOMIC_RELAXED, __HIP_MEMORY_SCOPE_AGENT);
          pscale = 1.f + sqrtf((float)(a1 - a0) * 1e-5f); pspike = (float)(b1 - b0) * 0.1f; }
#endif
#pragma unroll 1
        for (int row = 4 * gw; row < T; row += 4 * NGW) { asm volatile("" ::: "memory"); final_rows<4>(p, (const LAS int*)(lds + LDSCTL_OFF) + LC_TSTART, row, lane, pscale, row == 0 ? pspike : 0.f); }
    }
#undef SEAM
#undef IN
}

#ifndef NAIVE_MASK
#define NAIVE_MASK 0
#endif
#ifndef MK_SPLIT
#define MK_SPLIT 0
#endif
static void launch_mk(const P& p, int lo, int hi, int li, hipStream_t s) {
    Args a{}; a.p = p; a.ph_lo = lo; a.ph_hi = hi; a.li = li; a.pad = 0;
    void* kargs[] = {&a};
    const hipError_t e = hipLaunchCooperativeKernel((const void*)mk_fwd, dim3(256), dim3(NTHR), kargs, LDS_BYTES, s);
    if (e != hipSuccess) fprintf(stderr, "kernel_launch: cooperative launch failed: %s\n", hipGetErrorString(e));
}
extern "C" void kernel_launch(void* const* d_in, const int* in_sizes, int n_in, void* d_out, int out_size, void* d_ws, size_t ws_size, hipStream_t stream) {
    if (n_in != 22 || ws_size < WS_END) { fprintf(stderr, "kernel_launch: unexpected n_in %d / ws %zu\n", n_in, ws_size); return; }
    static int inited = 0;
    if (!inited) { inited = 1;
        if (hipFuncSetAttribute((const void*)mk_fwd, hipFuncAttributeMaxDynamicSharedMemorySize, LDS_BYTES) != hipSuccess) fprintf(stderr, "kernel_launch: hipFuncSetAttribute failed\n"); }
    P p{};
    const float** f = (const float**)&p;
    for (int i = 0; i < 22; ++i) f[i] = (const float*)d_in[i];
    p.out = (float*)d_out; p.ws = (unsigned char*)d_ws;
    (void)hipMemsetAsync((char*)d_ws + WS_CTL, 0, 1 * MiB, stream);
    int li = 0;
    for (int k = 0; k < PH_N;) {
        int e = k + 1;
        if (!MK_SPLIT) while (e < PH_N && !((NAIVE_MASK >> e) & 1)) ++e;
        launch_mk(p, k, e, li++, stream);
        k = e;
    }
}
```

```cpp
#include <hip/hip_runtime.h>
#include <cstdio>
#include <cstdint>

typedef unsigned short bf16;
typedef float f32x4 __attribute__((ext_vector_type(4)));

constexpr int NB = 2, SEQ = 8192, D = 1024, T = NB * SEQ;
constexpr int NIN = 3072;
constexpr int NE = 32, HID = 512;
constexpr float ALPHA = 1.189207115002721f;
constexpr float LN_EPS = 1e-5f, RMS_EPS = 1e-6f;
constexpr int ROWS_PAD = 40960;

constexpr size_t MiB = 1u << 20;
constexpr size_t WS_CTL = 0;
constexpr size_t WS_SMALL = 1 * MiB;
constexpr size_t WS_LIST = 2 * MiB, WS_WLIST = 4 * MiB;
constexpr size_t WS_WINT = 6 * MiB, WS_WOUTT = 12 * MiB, WS_WUPT = 14 * MiB, WS_WDNT = 78 * MiB;
constexpr size_t WS_B = 110 * MiB;
constexpr size_t WS_QS = 142 * MiB, WS_V = 158 * MiB, WS_OG = 174 * MiB, WS_LOGF = 190 * MiB, WS_ZG = 222 * MiB;
constexpr size_t WS_Y = 142 * MiB, WS_ACT = 206 * MiB;
constexpr size_t WS_SLOC = 254 * MiB, WS_SSTART = 270 * MiB;
constexpr size_t WS_X1 = 286 * MiB, WS_Y2 = 350 * MiB, WS_END = 430 * MiB;
constexpr size_t SM_ADA = 0, SM_LB = 64 * 1024, SM_ROWBASE = 128 * 1024, SM_SGSTAT = 256 * 1024, SM_TOKE = 512 * 1024, SM_TOKS = 640 * 1024, SM_DTOT = 768 * 1024;
constexpr int CW_CNT = 1024;
constexpr int CW_ADA = 1088;
constexpr int CW_RDY = 131072;
constexpr int CW_MIXA = 2048, CW_MIXB = 2560;
constexpr int CW_PREPQ = 1152;

struct P {
    const float *x, *c, *w_ada, *b_ada, *w_in, *lb_logits, *hg_norm_w, *sg_ln_g, *sg_ln_b, *sg_w, *sg_b, *w_out, *ln1_g, *ln1_b,
        *rg_w, *rg_b, *re_w, *re_b, *w_up, *w_down, *ln2_g, *ln2_b;
    float* out; unsigned char* ws;
};

__device__ __forceinline__ float bf2f(bf16 b) { return __uint_as_float(((unsigned)b) << 16); }
__device__ __forceinline__ bf16 f2bf(float f) { unsigned u = __float_as_uint(f); return (bf16)((u + 0x7fffu + ((u >> 16) & 1u)) >> 16); }
__device__ __forceinline__ float silu_f(float x) { return x / (1.f + __expf(-x)); }
__device__ __forceinline__ float gelu_f(float x) { return 0.5f * x * (1.f + erff(x * 0.70710678118654752f)); }
__device__ __forceinline__ float wave_sum(float v) {
#pragma unroll
    for (int o = 1; o < 64; o <<= 1) v += __shfl_xor(v, o);
    return v;
}
#define WSP(type, off) ((type*)(p.ws + (off)))

__device__ __forceinline__ int updst(int n) { const int part = n >> 9, q = n & 511; return 256 * (q >> 7) + 128 * part + (q & 127); }

#define LAS __attribute__((address_space(3)))
#define GAS __attribute__((address_space(1)))
typedef short bf16x8 __attribute__((ext_vector_type(8)));
typedef unsigned u32x4 __attribute__((ext_vector_type(4)));
typedef unsigned u32x2 __attribute__((ext_vector_type(2)));
typedef float f32x2 __attribute__((ext_vector_type(2)));
constexpr int NWAVES = 8, NTHR = 512;
template <class Tv> __device__ __forceinline__ Tv ldg(const void* base, unsigned off) { return *(const Tv*)((const char*)base + off); }
template <class Tv> __device__ __forceinline__ void stg(void* base, unsigned off, Tv v) { *(Tv*)((char*)base + off) = v; }
#define DPP_ADD(v, ctrl, rmask) v += __int_as_float(__builtin_amdgcn_update_dpp(0, __float_as_int(v), ctrl, rmask, 0xF, false))
__device__ __forceinline__ float wave_sum_dpp(float v) {
    DPP_ADD(v, 0xB1, 0xF);
    DPP_ADD(v, 0x4E, 0xF);
    DPP_ADD(v, 0x141, 0xF);
    DPP_ADD(v, 0x140, 0xF);
    DPP_ADD(v, 0x142, 0xA);
    DPP_ADD(v, 0x143, 0xC);
    return __int_as_float(__builtin_amdgcn_readlane(__float_as_int(v), 63));
}
__device__ __forceinline__ int otid(int swave) { int l; asm volatile("v_mbcnt_lo_u32_b32 %0, -1, 0\n\tv_mbcnt_hi_u32_b32 %0, -1, %0" : "=v"(l)); return (swave << 6) | l; }
constexpr int RING_BYTES = 131072, LDSCTL_OFF = 147456, LDS_BYTES = 155648;
constexpr int LC_BAR = 0, LC_TSTART = 64  , LC_CNT = 128  , LC_RT = 256  , LC_LGS = 576  , LC_Q = 32  ;

__device__ __forceinline__ unsigned cvt_pk_bf16(float lo, float hi) { unsigned r; asm volatile("v_cvt_pk_bf16_f32 %0, %1, %2" : "=v"(r) : "v"(lo), "v"(hi)); return r; }
__device__ __forceinline__ float fast_sigmoid(float x) { return __builtin_amdgcn_rcpf(1.f + __expf(-x)); }
__device__ __forceinline__ f32x2 gelu_pk(f32x2 v) {
    const f32x2 av = __builtin_elementwise_abs(v), d = av * 0.2316418882f + 1.0f;
    f32x2 t; t.x = __builtin_amdgcn_rcpf(d.x); t.y = __builtin_amdgcn_rcpf(d.y);
    f32x2 q = t * 0.5307027145f + (-0.7265760135f); q = q * t + 0.7107068705f; q = q * t + (-0.142248368f); q = q * t + 0.127414796f; q = q * t;
    const f32x2 s = (v * v) * (-0.72134752044f);
    f32x2 e; e.x = __builtin_amdgcn_exp2f(s.x); e.y = __builtin_amdgcn_exp2f(s.y);
    const f32x2 m = v * (q * e), r = v - m;
    f32x2 o; o.x = v.x < 0.f ? m.x : r.x; o.y = v.y < 0.f ? m.y : r.y; return o;
}

namespace pg8 {
constexpr int BM = 256, BK = 64, HALF = 128, HTB = HALF * BK * 2, STAGE_BYTES = 8 * HTB, NXCD = 8, WGM = 8;
__host__ __device__ __forceinline__ int lds_byte(int r, int c) { const int st = (r >> 4) * 2 + (c >> 5), rr = r & 15, cc = c & 31, ob = rr * 64 + cc * 2; return st * 1024 + (ob ^ (((ob >> 9) & 1) << 5)); }
__host__ __device__ __forceinline__ void stage_rc(int b, int& R, int& C) { const int st = b / 1024, sb = b % 1024, swz = sb ^ (((sb >> 9) & 1) << 5); R = (st >> 1) * 16 + swz / 64; C = (st & 1) * 32 + (swz % 64) / 2; }
__host__ __device__ __forceinline__ int perm32(int rho) { const int n = rho >> 4, i = rho & 15; return 8 * (i >> 2) + 4 * n + (i & 3); }

struct Unit { int pm, pn, e, nvalid, r0, pad; };
struct Gemm { const bf16* A; const bf16* Bt; int K, pad; size_t bstride; const int* list; };

struct StaticOrder {
    int nM, nN, nwg, G, c;
    __device__ void init(int M, int N, int G_, int c_) { nM = M / BM; nN = N / BM; nwg = nM * nN; G = G_; c = c_; }
    __device__ bool next(int i, Unit& u) const {
        const long L = (long)i * G + c; if (L >= nwg) return false;
        int wgid = (int)L; { const int q = nwg / NXCD, r = nwg % NXCD, xcd = wgid % NXCD, off = wgid / NXCD; wgid = (xcd < r ? xcd * (q + 1) : r * (q + 1) + (xcd - r) * q) + off; }
        const int nig = WGM * nN, gid = wgid / nig, fm = gid * WGM, gsz = (nM - fm) < WGM ? (nM - fm) : WGM;
        u.pm = fm + ((wgid % nig) % gsz); u.pn = (wgid % nig) / gsz; u.e = 0; u.nvalid = 256; u.r0 = 0; u.pad = 0; return true;
    }
    __device__ __forceinline__ void a_ready(int, const Unit&) const {}
};
struct MoeOrder {
    const LAS int* tstart; const LAS int* cnt; int G, c, nN;
    __device__ bool next(int i, Unit& u) const {
        const int L = i * G + c, ntile = __builtin_amdgcn_readfirstlane(tstart[NE]); if (L >= ntile * nN) return false;
        const int tile = L / nN; u.pn = L % nN; u.pm = tile;
        int e = 0;
#pragma unroll 1
        for (int k = 1; k < NE; ++k) e = (tile >= tstart[k]) ? k : e;
        e = __builtin_amdgcn_readfirstlane(e); u.e = e; u.pm = __builtin_amdgcn_readfirstlane(u.pm); u.pn = __builtin_amdgcn_readfirstlane(u.pn);
        u.r0 = __builtin_amdgcn_readfirstlane((tile - tstart[e]) * 256); const int left = __builtin_amdgcn_readfirstlane(cnt[e]) - u.r0; u.nvalid = left < 256 ? left : 256; u.pad = 0; return true;
    }
    __device__ __forceinline__ void a_ready(int, const Unit&) const {}
};
struct MoeDownOrder {
    const LAS int* tstart; const LAS int* cnt; int G, cr, ntile, P, r; unsigned* ready;
    __device__ int tile_of(int idx) const {
        const int ne = 2 * (P - r);
        if (idx < ne) { const int q = idx / (P - r), m = idx - q * (P - r); return q * P + r + m; }
        const int k = idx - ne; if (k < 2 * r) { const int q = k / r, m = k - q * r; return q * P + m; }
        return 2 * P + (k - 2 * r);
    }
    __device__ bool next(int i, Unit& u) const {
        const int d = i * G + cr; if (d >= ntile * 4) return false;
        const int tile = tile_of(d >> 2); u.pn = d & 3; u.pm = tile;
        int e = 0;
#pragma unroll 1
        for (int k = 1; k < NE; ++k) e = (tile >= tstart[k]) ? k : e;
        e = __builtin_amdgcn_readfirstlane(e); u.e = e; u.pm = __builtin_amdgcn_readfirstlane(u.pm); u.pn = __builtin_amdgcn_readfirstlane(u.pn);
        u.r0 = __builtin_amdgcn_readfirstlane((tile - tstart[e]) * 256); const int left = __builtin_amdgcn_readfirstlane(cnt[e]) - u.r0; u.nvalid = left < 256 ? left : 256; u.pad = 0; return true;
    }
    __device__ __forceinline__ void a_ready(int swave, const Unit& u) const {
        if (swave == 0) { unsigned sp = 0;
            while ((unsigned)__builtin_amdgcn_readfirstlane(__hip_atomic_load(ready + 64 * u.pm, __ATOMIC_RELAXED, __HIP_MEMORY_SCOPE_AGENT)) < 4u && ++sp < (1u << 20)) __builtin_amdgcn_s_sleep(2);
            __builtin_amdgcn_fence(__ATOMIC_ACQUIRE, "agent");
            asm volatile("s_waitcnt vmcnt(0)" ::: "memory"); }
        asm volatile("" ::: "memory"); __builtin_amdgcn_s_barrier(); asm volatile("" ::: "memory");
    }
};

#define PG8_LAS LAS
template <class Epi, class Sched, bool ALIGN_EPI, bool SP2, bool GATHER>
__device__ __forceinline__ void gemm_phase(const int swave, PG8_LAS unsigned char* lds, const Gemm g, const Sched& S, const Epi& E) {
    const int tid = otid(swave), wid = __builtin_amdgcn_readfirstlane(tid >> 6), lane = tid & 63, wr = wid >> 2, wc = wid & 3, fr = lane & 15, fq = lane >> 4;
    const int K = g.K, nt = K / BK;
    unsigned voffB[2], vA[2][2], vAn[2][2]; int RA[2], CA[2];
#pragma unroll
    for (int i = 0; i < 2; ++i) { int R, C; stage_rc(tid * 16 + i * 8192, R, C); const int Rb = Epi::PERM ? ((R & ~31) + perm32(R & 31)) : R; RA[i] = R; CA[i] = C;
        voffB[i] = (unsigned)(Rb * K + C) * 2u;
#pragma unroll
        for (int h = 0; h < 2; ++h) { vA[h][i] = (unsigned)((h * HALF + R) * K + C) * 2u; vAn[h][i] = vA[h][i]; } }
    const size_t kstep = (size_t)(BK * 2);
    const size_t hstep = (size_t)HALF * K * 2;
    const size_t tstep = 2 * hstep;
    const unsigned ldsw = (unsigned)wid * 1024u;
    const int aoff = lds_byte(wr * 64 + fr, fq * 8), boff = lds_byte(wc * 32 + fr, fq * 8);
#define PG8_SA(b, h) (((b) * 2 + (h)) * HTB)
#define PG8_SB(b, h) ((4 + (b) * 2 + (h)) * HTB)
#define PG8_STAGE(bufoff, gbase, voff) do { _Pragma("unroll") for (int _i = 0; _i < 2; ++_i) \
        __builtin_amdgcn_global_load_lds((const unsigned*)((const char*)(gbase) + (voff)[_i]), (PG8_LAS unsigned*)(lds + (bufoff) + ldsw + _i * 8192), 16, 0, 0); } while (0)
#define PG8_LDA(dst, b, h) do { _Pragma("unroll") for (int m = 0; m < 4; ++m) _Pragma("unroll") for (int k = 0; k < 2; ++k) dst[m][k] = *(const PG8_LAS bf16x8*)(lds + PG8_SA(b, h) + aoff + m * 2048 + k * 1024); } while (0)
#define PG8_LDB(dst, b, h) do { _Pragma("unroll") for (int n = 0; n < 2; ++n) _Pragma("unroll") for (int k = 0; k < 2; ++k) dst[n][k] = *(const PG8_LAS bf16x8*)(lds + PG8_SB(b, h) + boff + n * 2048 + k * 1024); } while (0)
#define PG8_MMA(ai, bj, At, Bt) do { __builtin_amdgcn_s_setprio(1); _Pragma("unroll") for (int m = 0; m < 4; ++m) _Pragma("unroll") for (int n = 0; n < 2; ++n) _Pragma("unroll") for (int k = 0; k < 2; ++k) \
        acc[ai][bj][m][n] = __builtin_amdgcn_mfma_f32_16x16x32_bf16(Bt[n][k], At[m][k], acc[ai][bj][m][n], 0, 0, 0); __builtin_amdgcn_s_setprio(0); } while (0)
#define PG8_WAIT_V(n) asm volatile("s_waitcnt vmcnt(" #n ")" ::: "memory")
#define PG8_WAIT_L(n) asm volatile("s_waitcnt lgkmcnt(" #n ")" ::: "memory")
#define PG8_BAR __builtin_amdgcn_s_barrier()
#define PG8_SCHED __builtin_amdgcn_sched_barrier(0)
#define PG8_SETV(V, U) do { if constexpr (GATHER) { _Pragma("unroll") for (int _h = 0; _h < 2; ++_h) _Pragma("unroll") for (int _i = 0; _i < 2; ++_i) { const int _r = _h * HALF + RA[_i]; \
        const int _tok = _r < (U).nvalid ? g.list[(size_t)(U).e * T + (U).r0 + _r] : 0; V[_h][_i] = (unsigned)(_tok * K + CA[_i]) * 2u; } } } while (0)
    Unit cur, nxt; int ui = 0;
    if (!S.next(0, cur)) return;
    f32x4 acc[2][2][4][2];
#pragma unroll
    for (int a = 0; a < 2; ++a)
#pragma unroll
        for (int b = 0; b < 2; ++b)
#pragma unroll
            for (int m = 0; m < 4; ++m)
#pragma unroll
                for (int n = 0; n < 2; ++n) acc[a][b][m][n] = (f32x4){0.f, 0.f, 0.f, 0.f};
    bf16x8 At[4][2], B0[2][2], B1[2][2];
    PG8_SETV(vA, cur);
    S.a_ready(swave, cur);
    const char* cA = (const char*)g.A + (GATHER ? (size_t)0 : (size_t)cur.pm * tstep); const char* cB = (const char*)g.Bt + (size_t)cur.e * g.bstride + (size_t)cur.pn * tstep;
    if constexpr (SP2) {
        PG8_STAGE(PG8_SB(0, 0), cB, voffB); PG8_STAGE(PG8_SB(0, 1), cB + hstep, voffB); PG8_STAGE(PG8_SA(0, 0), cA, vA[0]); PG8_STAGE(PG8_SA(0, 1), cA, vA[1]);
        if (wr == 1) PG8_BAR;
        PG8_WAIT_V(2); PG8_BAR;
        PG8_STAGE(PG8_SB(1, 0), cB + kstep, voffB); PG8_STAGE(PG8_SA(1, 0), cA + kstep, vA[0]); PG8_STAGE(PG8_SB(1, 1), cB + hstep + kstep, voffB);
        PG8_WAIT_V(6); PG8_BAR;
    } else {
        PG8_STAGE(PG8_SB(0, 0), cB, voffB); PG8_STAGE(PG8_SA(0, 0), cA, vA[0]); PG8_STAGE(PG8_SB(0, 1), cB + hstep, voffB); PG8_STAGE(PG8_SA(0, 1), cA, vA[1]);
        if (wr == 1) PG8_BAR;
        PG8_WAIT_V(4); PG8_BAR;
        PG8_STAGE(PG8_SB(1, 0), cB + kstep, voffB); PG8_STAGE(PG8_SA(1, 0), cA + kstep, vA[0]); PG8_STAGE(PG8_SB(1, 1), cB + hstep + kstep, voffB);
        PG8_WAIT_V(6); PG8_BAR;
    }
    for (;;) {
        const bool has_next = S.next(ui + 1, nxt);
        if (has_next) PG8_SETV(vAn, nxt);
        const char* nA = has_next ? (const char*)g.A + (GATHER ? (size_t)0 : (size_t)nxt.pm * tstep) : cA; const char* nB = has_next ? (const char*)g.Bt + (size_t)nxt.e * g.bstride + (size_t)nxt.pn * tstep : cB;
        for (int t = 0; t < nt; t += 2) {
            const bool last = (t == nt - 2);
            if (last && has_next) S.a_ready(swave, nxt);
            const char* a1 = cA + (size_t)(t + 1) * kstep;
            const char* a2 = last ? nA : cA + (size_t)(t + 2) * kstep; const char* b2 = last ? nB : cB + (size_t)(t + 2) * kstep;
            const char* a3 = a2 + kstep; const char* b3 = b2 + kstep;
            unsigned v2[2][2];
#pragma unroll
            for (int h = 0; h < 2; ++h)
#pragma unroll
                for (int i = 0; i < 2; ++i) v2[h][i] = (GATHER && last && has_next) ? vAn[h][i] : vA[h][i];
            if constexpr (SP2) {
            PG8_LDB(B0, 0, 0); PG8_LDB(B1, 0, 1); PG8_SCHED; PG8_LDA(At, 0, 0); PG8_STAGE(PG8_SA(1, 1), a1, vA[1]);
            PG8_WAIT_V(8); PG8_WAIT_L(0); PG8_BAR; PG8_MMA(0, 0, At, B0); PG8_MMA(0, 1, At, B1); PG8_BAR; PG8_SCHED;
            PG8_LDA(At, 0, 1); PG8_STAGE(PG8_SB(0, 0), b2, voffB); PG8_STAGE(PG8_SB(0, 1), b2 + hstep, voffB); PG8_STAGE(PG8_SA(0, 0), a2, v2[0]);
            PG8_WAIT_V(8); PG8_WAIT_L(0); PG8_BAR; PG8_MMA(1, 0, At, B0); PG8_MMA(1, 1, At, B1); PG8_BAR; PG8_SCHED;
            PG8_LDB(B0, 1, 0); PG8_LDB(B1, 1, 1); PG8_SCHED; PG8_LDA(At, 1, 0); PG8_STAGE(PG8_SA(0, 1), a2, v2[1]);
            PG8_WAIT_V(8); PG8_WAIT_L(0); PG8_BAR; PG8_MMA(0, 0, At, B0); PG8_MMA(0, 1, At, B1); PG8_BAR; PG8_SCHED;
            PG8_LDA(At, 1, 1); PG8_STAGE(PG8_SB(1, 0), b3, voffB); PG8_STAGE(PG8_SB(1, 1), b3 + hstep, voffB); PG8_STAGE(PG8_SA(1, 0), a3, v2[0]);
            PG8_WAIT_V(8); PG8_WAIT_L(0); PG8_BAR; PG8_MMA(1, 0, At, B0); PG8_MMA(1, 1, At, B1); PG8_BAR; PG8_SCHED;
            } else {
            PG8_LDB(B0, 0, 0); PG8_SCHED; PG8_LDA(At, 0, 0); PG8_STAGE(PG8_SA(1, 1), a1, vA[1]);
            PG8_WAIT_L(8); PG8_BAR; PG8_WAIT_L(0); PG8_MMA(0, 0, At, B0); PG8_BAR; PG8_SCHED;
            PG8_LDB(B1, 0, 1); PG8_STAGE(PG8_SB(0, 0), b2, voffB);
            PG8_BAR; PG8_WAIT_L(0); PG8_MMA(0, 1, At, B1); PG8_BAR;
            PG8_LDA(At, 0, 1); PG8_STAGE(PG8_SA(0, 0), a2, v2[0]);
            PG8_BAR; PG8_WAIT_L(0); PG8_MMA(1, 0, At, B0); PG8_BAR; PG8_SCHED;
            PG8_STAGE(PG8_SB(0, 1), b2 + hstep, voffB);
            PG8_WAIT_V(6); PG8_BAR; PG8_MMA(1, 1, At, B1); PG8_BAR;
            PG8_LDB(B0, 1, 0); PG8_SCHED; PG8_LDA(At, 1, 0); PG8_STAGE(PG8_SA(0, 1), a2, v2[1]);
            PG8_WAIT_L(8); PG8_BAR; PG8_WAIT_L(0); PG8_MMA(0, 0, At, B0); PG8_BAR; PG8_SCHED;
            PG8_LDB(B1, 1, 1); PG8_STAGE(PG8_SB(1, 0), b3, voffB);
            PG8_BAR; PG8_WAIT_L(0); PG8_MMA(0, 1, At, B1); PG8_BAR;
            PG8_LDA(At, 1, 1); PG8_STAGE(PG8_SA(1, 0), a3, v2[0]);
            PG8_BAR; PG8_WAIT_L(0); PG8_MMA(1, 0, At, B0); PG8_BAR; PG8_SCHED;
            PG8_STAGE(PG8_SB(1, 1), b3 + hstep, voffB);
            PG8_WAIT_V(6); PG8_BAR; PG8_MMA(1, 1, At, B1); PG8_BAR;
            }
        }
        if constexpr (ALIGN_EPI) { if (wr == 0) PG8_BAR; }
        E(acc, cur, wr, wc, fr, fq);
        if (!has_next) break;
#pragma unroll
        for (int a = 0; a < 2; ++a)
#pragma unroll
            for (int b = 0; b < 2; ++b)
#pragma unroll
                for (int m = 0; m < 4; ++m)
#pragma unroll
                    for (int n = 0; n < 2; ++n) acc[a][b][m][n] = (f32x4){0.f, 0.f, 0.f, 0.f};
        cur = nxt; cA = nA; cB = nB; ++ui;
        if constexpr (GATHER) {
#pragma unroll
            for (int h = 0; h < 2; ++h)
#pragma unroll
                for (int i = 0; i < 2; ++i) vA[h][i] = vAn[h][i]; }
        if constexpr (ALIGN_EPI) { if (wr == 1) PG8_BAR; }
    }
    PG8_WAIT_V(0);
    if constexpr (!ALIGN_EPI) { if (wr == 0) PG8_BAR; }
    PG8_BAR;
#undef PG8_SA
#undef PG8_SB
#undef PG8_STAGE
#undef PG8_LDA
#undef PG8_LDB
#undef PG8_MMA
#undef PG8_WAIT_V
#undef PG8_WAIT_L
#undef PG8_BAR
#undef PG8_SCHED
#undef PG8_SETV
}

struct EpiInproj {
    static constexpr bool PERM = true;
    unsigned char* ws;
    __device__ __forceinline__ void operator()(const f32x4 (&acc)[2][2][4][2], const Unit& u, int wr, int wc, int fr, int fq) const {
        unsigned char* wsb_ = ws; asm volatile("" : "+v"(wsb_)); GAS unsigned char* wsb = (GAS unsigned char*)wsb_;
        GAS bf16* QVO = (GAS bf16*)(wsb + WS_QS); GAS bf16* ZG = (GAS bf16*)(wsb + WS_ZG); GAS float* LOGF = (GAS float*)(wsb + WS_LOGF); const GAS float* LB = (const GAS float*)(wsb + WS_SMALL + SM_LB);
        const int row0 = u.pm * BM + wr * 64 + fr, seg = u.pn >> 1, cin = (u.pn & 1) * 256 + wc * 32 + 8 * fq;
        if (seg == 1) {
            f32x4 lb[2][2];
#pragma unroll
            for (int bj = 0; bj < 2; ++bj)
#pragma unroll
                for (int n = 0; n < 2; ++n) lb[bj][n] = *(const GAS f32x4*)(LB + cin + bj * HALF + 4 * n);
#pragma unroll
            for (int ai = 0; ai < 2; ++ai)
#pragma unroll
                for (int m = 0; m < 4; ++m) { GAS _Float16* rowp = (GAS _Float16*)LOGF + (size_t)(row0 + ai * HALF + m * 16) * 512 + cin;
#pragma unroll
                    for (int bj = 0; bj < 2; ++bj) { f32x4 o[2];
#pragma unroll
                        for (int n = 0; n < 2; ++n)
#pragma unroll
                            for (int j = 0; j < 4; ++j) { const float l = lb[bj][n][j]; o[n][j] = __logf(l + (1.f - l) * fast_sigmoid(acc[ai][bj][m][n][j])); }
                        typedef _Float16 h8v __attribute__((ext_vector_type(8)));
                        h8v hv8;
#pragma unroll
                        for (int n = 0; n < 2; ++n)
#pragma unroll
                            for (int j = 0; j < 4; ++j) hv8[4 * n + j] = (_Float16)o[n][j];
                        *(GAS h8v*)(rowp + bj * HALF) = hv8; } }
            return;
        }
        if (seg >= 4) {
            const int cz = (u.pn - 8) * 256 + wc * 32 + 8 * fq;
#pragma unroll
            for (int ai = 0; ai < 2; ++ai)
#pragma unroll
                for (int m = 0; m < 4; ++m) { GAS bf16* rowp = ZG + (size_t)(row0 + ai * HALF + m * 16) * 1024 + cz;
#pragma unroll
                    for (int bj = 0; bj < 2; ++bj) { const f32x4 v0 = acc[ai][bj][m][0], v1 = acc[ai][bj][m][1];
                        const f32x2 a = gelu_pk((f32x2){v0[0], v0[1]}), b = gelu_pk((f32x2){v0[2], v0[3]}), c = gelu_pk((f32x2){v1[0], v1[1]}), d = gelu_pk((f32x2){v1[2], v1[3]});
                        u32x4 w; w.x = cvt_pk_bf16(a.x, a.y); w.y = cvt_pk_bf16(b.x, b.y); w.z = cvt_pk_bf16(c.x, c.y); w.w = cvt_pk_bf16(d.x, d.y);
                        *(GAS u32x4*)(rowp + bj * HALF) = w; } }
            return;
        }
        GAS bf16* base = QVO + (size_t)(seg == 0 ? 0 : seg - 1) * (8u << 20); const bool act = seg != 2;
#pragma unroll
        for (int ai = 0; ai < 2; ++ai)
#pragma unroll
            for (int m = 0; m < 4; ++m) { GAS bf16* rowp = base + (size_t)(row0 + ai * HALF + m * 16) * 512 + cin;
#pragma unroll
                for (int bj = 0; bj < 2; ++bj) { f32x4 v0 = acc[ai][bj][m][0], v1 = acc[ai][bj][m][1];
                    if (act) {
#pragma unroll
                        for (int j = 0; j < 4; ++j) { v0[j] = v0[j] * fast_sigmoid(v0[j]); v1[j] = v1[j] * fast_sigmoid(v1[j]); } }
                    u32x4 w; w.x = cvt_pk_bf16(v0[0], v0[1]); w.y = cvt_pk_bf16(v0[2], v0[3]); w.z = cvt_pk_bf16(v1[0], v1[1]); w.w = cvt_pk_bf16(v1[2], v1[3]);
                    *(GAS u32x4*)(rowp + bj * HALF) = w; } }
    }
};
struct EpiBf16 {
    static constexpr bool PERM = true;
    unsigned char* ws; size_t off; int ldc;
    __device__ __forceinline__ void operator()(const f32x4 (&acc)[2][2][4][2], const Unit& u, int wr, int wc, int fr, int fq) const {
        unsigned char* wsb_ = ws; asm volatile("" : "+v"(wsb_)); GAS unsigned char* wsb = (GAS unsigned char*)wsb_; GAS bf16* O = (GAS bf16*)(wsb + off);
        const int row0 = u.pm * BM + wr * 64 + fr, col0 = u.pn * BM + wc * 32 + 8 * fq;
#pragma unroll
        for (int ai = 0; ai < 2; ++ai)
#pragma unroll
            for (int m = 0; m < 4; ++m) { GAS bf16* rowp = O + (size_t)(row0 + ai * HALF + m * 16) * ldc + col0;
#pragma unroll
                for (int bj = 0; bj < 2; ++bj) { const f32x4 v0 = acc[ai][bj][m][0], v1 = acc[ai][bj][m][1];
                    u32x4 w; w.x = cvt_pk_bf16(v0[0], v0[1]); w.y = cvt_pk_bf16(v0[2], v0[3]); w.z = cvt_pk_bf16(v1[0], v1[1]); w.w = cvt_pk_bf16(v1[2], v1[3]);
                    *(GAS u32x4*)(rowp + bj * HALF) = w; } }
    }
};
struct EpiUp {
    static constexpr bool PERM = true;
    unsigned char* ws;
    __device__ __forceinline__ void operator()(const f32x4 (&acc)[2][2][4][2], const Unit& u, int wr, int wc, int fr, int fq) const {
        unsigned char* wsb_ = ws; asm volatile("" : "+v"(wsb_)); GAS unsigned char* wsb = (GAS unsigned char*)wsb_; GAS bf16* ACT = (GAS bf16*)(wsb + WS_ACT);
        const int row0 = u.pm * BM + wr * 64 + fr, col0 = u.pn * HALF + wc * 32 + 8 * fq;
#pragma unroll
        for (int ai = 0; ai < 2; ++ai)
#pragma unroll
            for (int m = 0; m < 4; ++m) { GAS bf16* rowp = ACT + (size_t)(row0 + ai * HALF + m * 16) * HID + col0;
                f32x4 o0, o1;
#pragma unroll
                for (int j = 0; j < 4; ++j) { const float g0 = acc[ai][0][m][0][j], g1 = acc[ai][0][m][1][j]; o0[j] = g0 * fast_sigmoid(g0) * acc[ai][1][m][0][j]; o1[j] = g1 * fast_sigmoid(g1) * acc[ai][1][m][1][j]; }
                u32x4 w; w.x = cvt_pk_bf16(o0[0], o0[1]); w.y = cvt_pk_bf16(o0[2], o0[3]); w.z = cvt_pk_bf16(o1[0], o1[1]); w.w = cvt_pk_bf16(o1[2], o1[3]);
                *(GAS u32x4*)rowp = w; }
    }
};
struct EpiDown {
    static constexpr bool PERM = true;
    unsigned char* ws;
    __device__ __forceinline__ void operator()(const f32x4 (&acc)[2][2][4][2], const Unit& u, int wr, int wc, int fr, int fq) const {
        unsigned char* wsb_ = ws; asm volatile("" : "+v"(wsb_)); GAS unsigned char* wsb = (GAS unsigned char*)wsb_; GAS bf16* Y2 = (GAS bf16*)(wsb + WS_Y2); const GAS float* WL = (const GAS float*)(wsb + WS_WLIST);
        const int rt0 = wr * 64 + fr, col0 = u.pn * BM + wc * 32 + 8 * fq;
#pragma unroll
        for (int ai = 0; ai < 2; ++ai)
#pragma unroll
            for (int m = 0; m < 4; ++m) { const int rt = rt0 + ai * HALF + m * 16; const float w8 = rt < u.nvalid ? WL[(size_t)u.e * T + u.r0 + rt] : 0.f;
                GAS bf16* rowp = Y2 + (size_t)(u.pm * BM + rt) * D + col0;
#pragma unroll
                for (int bj = 0; bj < 2; ++bj) { const f32x4 v0 = acc[ai][bj][m][0] * w8, v1 = acc[ai][bj][m][1] * w8;
                    u32x4 w; w.x = cvt_pk_bf16(v0[0], v0[1]); w.y = cvt_pk_bf16(v0[2], v0[3]); w.z = cvt_pk_bf16(v1[0], v1[1]); w.w = cvt_pk_bf16(v1[2], v1[3]);
                    *(GAS u32x4*)(rowp + bj * HALF) = w; } }
    }
};
}


__device__ __forceinline__ f32x4 mma16(bf16x8 a, bf16x8 b, f32x4 c) { return __builtin_amdgcn_mfma_f32_16x16x32_bf16(a, b, c, 0, 0, 0); }
__device__ __forceinline__ bf16x8 frag(const LAS bf16* X, int stride, int rb, int ks, int lane) { return *(const LAS bf16x8*)(X + (rb * 16 + (lane & 15)) * stride + ks * 32 + 8 * (lane >> 4)); }
constexpr int MX_QD = 0, MX_KD = 17408, MX_KDT = 34816, MX_VT = 53248, MX_PT = 71680, MX_STT = 80896, MX_SMALL = 115712;
constexpr int SD = 136, SS = 72, SO = 132;
template <int MODE> __device__ __forceinline__ void hgrn_item(const int swave, const P& p, LAS unsigned char* lds, int item) {
    const int tid = otid(swave), lane = tid & 63, w = __builtin_amdgcn_readfirstlane(tid >> 6), q4 = lane >> 4, r16 = lane & 15;
    const int bh = item >> 5, sc = item & 31, b = bh >> 2, h = bh & 3;
    const size_t row0 = (size_t)b * SEQ + (size_t)sc * 256;
    LAS bf16* QD = (LAS bf16*)(lds + MX_QD); LAS bf16* KD = (LAS bf16*)(lds + MX_KD); LAS bf16* KDT = (LAS bf16*)(lds + MX_KDT); LAS bf16* VT = (LAS bf16*)(lds + MX_VT);
    LAS bf16* PT = (LAS bf16*)(lds + MX_PT); LAS bf16* STT = (LAS bf16*)(lds + MX_STT); LAS float* O = (LAS float*)(lds + MX_QD);
    LAS float* tot = (LAS float*)(lds + MX_SMALL); LAS float* ecm = tot + 1024; LAS float* elast = ecm + 128; LAS float* efac = elast + 128;
    const bf16* QS = WSP(bf16, WS_QS); const _Float16* LF = WSP(_Float16, WS_LOGF); const bf16* VV = WSP(bf16, WS_V); const bf16* OG = WSP(bf16, WS_OG); bf16* YC = WSP(bf16, WS_B);
    const int cp = tid & 63, g = tid >> 6;
    f32x4 S[8];
#pragma unroll
    for (int db = 0; db < 8; ++db) {
        if (MODE == 1) {
#pragma unroll
            for (int r = 0; r < 4; ++r) S[db][r] = WSP(float, WS_SSTART)[(size_t)item * 16384 + (16 * w + 4 * q4 + r) * 128 + 16 * db + r16];
        } else S[db] = (f32x4){0.f, 0.f, 0.f, 0.f}; }
    f32x2 lastsum = (f32x2){0.f, 0.f};
    unsigned lf2[8], q2[8], v2[8];
    unsigned ogp[8];
#define HG_LOAD(c_) do { const size_t ob_ = (row0 + 64 * (c_)) * 512 + h * 128; const unsigned lo_ = (unsigned)(8 * g * 512 + 2 * cp);   \
        _Pragma("unroll") for (int i = 0; i < 8; ++i) { lf2[i] = ldg<unsigned>(LF + ob_, (lo_ + i * 512) * 2u); v2[i] = ldg<unsigned>(VV + ob_, (lo_ + i * 512) * 2u); q2[i] = MODE == 1 ? ldg<unsigned>(QS + ob_, (lo_ + i * 512) * 2u) : 0u; } } while (0)
#define HG_LOADG(c_) do { if (MODE == 1) { _Pragma("unroll") for (int rr = 0; rr < 8; ++rr) ogp[rr] = ldg<unsigned>(OG + (row0 + 64 * (c_) + 8 * w + rr) * 512 + h * 128, (unsigned)lane * 4u); } } while (0)
#define F16LO(u) ((float)__builtin_bit_cast(_Float16, (unsigned short)((u) & 0xffffu)))
#define F16HI(u) ((float)__builtin_bit_cast(_Float16, (unsigned short)((u) >> 16)))
    HG_LOAD(0);
#pragma unroll 1
    for (int c = 0; c < 4; ++c) {
        f32x2 lfv[8]; f32x2 run = (f32x2){0.f, 0.f};
#pragma unroll
        for (int i = 0; i < 8; ++i) { lfv[i] = (f32x2){F16LO(lf2[i]), F16HI(lf2[i])}; run += lfv[i]; }
        *(LAS f32x2*)(tot + g * 128 + 2 * cp) = run;
        __syncthreads();
        f32x2 cstart = (f32x2){0.f, 0.f}, cmid = (f32x2){0.f, 0.f}, last = (f32x2){0.f, 0.f};
#pragma unroll
        for (int gg = 0; gg < 8; ++gg) { const f32x2 t = *(const LAS f32x2*)(tot + gg * 128 + 2 * cp); if (gg < g) cstart += t; if (gg < 4) cmid += t; last += t; }
        if (g == 0) { *(LAS f32x2*)(ecm + 2 * cp) = (f32x2){__expf(cmid.x), __expf(cmid.y)}; *(LAS f32x2*)(elast + 2 * cp) = (f32x2){__expf(last.x), __expf(last.y)};
                      *(LAS f32x2*)(efac + 2 * cp) = (f32x2){__expf(last.x - cmid.x), __expf(last.y - cmid.y)}; lastsum += last; }
        {
            f32x2 cum = cstart; float kda[8], kdb[8];
#pragma unroll
            for (int i = 0; i < 8; ++i) { cum += lfv[i];
                kda[i] = (1.f - __expf(lfv[i].x)) * __expf(fminf(cmid.x - cum.x, 80.f)); kdb[i] = (1.f - __expf(lfv[i].y)) * __expf(fminf(cmid.y - cum.y, 80.f));
                if (MODE == 1) { const float qa = __uint_as_float(q2[i] << 16) * __expf(fminf(cum.x - cmid.x, 80.f)), qb = __uint_as_float(q2[i] & 0xffff0000u) * __expf(fminf(cum.y - cmid.y, 80.f));
                    *(LAS unsigned*)(QD + (8 * g + i) * SD + 2 * cp) = cvt_pk_bf16(qa, qb); *(LAS unsigned*)(KD + (8 * g + i) * SD + 2 * cp) = cvt_pk_bf16(kda[i], kdb[i]); } }
            *(LAS u32x4*)(KDT + (2 * cp) * SS + 8 * g) = (u32x4){cvt_pk_bf16(kda[0], kda[1]), cvt_pk_bf16(kda[2], kda[3]), cvt_pk_bf16(kda[4], kda[5]), cvt_pk_bf16(kda[6], kda[7])};
            *(LAS u32x4*)(KDT + (2 * cp + 1) * SS + 8 * g) = (u32x4){cvt_pk_bf16(kdb[0], kdb[1]), cvt_pk_bf16(kdb[2], kdb[3]), cvt_pk_bf16(kdb[4], kdb[5]), cvt_pk_bf16(kdb[6], kdb[7])};
            *(LAS u32x4*)(VT + (2 * cp) * SS + 8 * g) = (u32x4){(v2[0] & 0xffffu) | (v2[1] << 16), (v2[2] & 0xffffu) | (v2[3] << 16), (v2[4] & 0xffffu) | (v2[5] << 16), (v2[6] & 0xffffu) | (v2[7] << 16)};
            *(LAS u32x4*)(VT + (2 * cp + 1) * SS + 8 * g) = (u32x4){(v2[0] >> 16) | (v2[1] & 0xffff0000u), (v2[2] >> 16) | (v2[3] & 0xffff0000u), (v2[4] >> 16) | (v2[5] & 0xffff0000u), (v2[6] >> 16) | (v2[7] & 0xffff0000u)};
        }
        __syncthreads();
        if (c < 3) HG_LOAD(c + 1);
        f32x4 o[4]; const int tb = w & 3, vb0 = (w >> 2) * 4;
        if (MODE == 1) {
#pragma unroll
            for (int db = 0; db < 8; ++db) { const float e = ecm[16 * db + r16];
#pragma unroll
                for (int r = 0; r < 4; ++r) STT[(16 * w + 4 * q4 + r) * SD + 16 * db + r16] = f2bf(S[db][r] * e); }
#pragma unroll
            for (int k = 0; k < 2; ++k) { const int tile = w + 8 * k, stb = tile >> 2, ssb = tile & 3; f32x4 a = (f32x4){0.f, 0.f, 0.f, 0.f};
                if (ssb <= stb) {
#pragma unroll
                    for (int ks = 0; ks < 4; ++ks) a = mma16(frag(QD, SD, stb, ks, lane), frag(KD, SD, ssb, ks, lane), a); }
#pragma unroll
                for (int r = 0; r < 4; ++r) { const int t = stb * 16 + 4 * q4 + r, s_ = ssb * 16 + r16; PT[t * SS + s_] = (s_ <= t) ? f2bf(a[r]) : (bf16)0; } }
            __syncthreads();
            bf16x8 ap[2], aq[4];
#pragma unroll
            for (int ks = 0; ks < 2; ++ks) ap[ks] = frag(PT, SS, tb, ks, lane);
#pragma unroll
            for (int ks = 0; ks < 4; ++ks) aq[ks] = frag(QD, SD, tb, ks, lane);
#pragma unroll
            for (int j = 0; j < 4; ++j) { f32x4 a = (f32x4){0.f, 0.f, 0.f, 0.f};
#pragma unroll
                for (int ks = 0; ks < 2; ++ks) a = mma16(ap[ks], frag(VT, SS, vb0 + j, ks, lane), a);
#pragma unroll
                for (int ks = 0; ks < 4; ++ks) a = mma16(aq[ks], frag(STT, SD, vb0 + j, ks, lane), a);
                o[j] = a; }
        }
        {
            bf16x8 av[2];
#pragma unroll
            for (int ks = 0; ks < 2; ++ks) av[ks] = frag(VT, SS, w, ks, lane);
#pragma unroll
            for (int db = 0; db < 8; ++db) { f32x4 u = (f32x4){0.f, 0.f, 0.f, 0.f};
#pragma unroll
                for (int ks = 0; ks < 2; ++ks) u = mma16(av[ks], frag(KDT, SS, db, ks, lane), u);
                const float el = elast[16 * db + r16], ef = efac[16 * db + r16];
                S[db] = S[db] * el + u * ef; }
        }
        HG_LOADG(c);
        if (MODE == 1) {
            __syncthreads();
#pragma unroll
            for (int j = 0; j < 4; ++j)
#pragma unroll
                for (int r = 0; r < 4; ++r) O[(tb * 16 + 4 * q4 + r) * SO + (vb0 + j) * 16 + r16] = o[j][r];
            __syncthreads();
            const f32x2 gw = ldg<f32x2>(p.hg_norm_w, (unsigned)lane * 8u);
#pragma unroll
            for (int rr = 0; rr < 8; ++rr) { const int t = 8 * w + rr; const size_t row = row0 + 64 * c + t;
                const f32x2 ov = *(const LAS f32x2*)(O + t * SO + 2 * lane);
                const float ss = wave_sum_dpp(ov.x * ov.x + ov.y * ov.y); const float rs = rsqrtf(ss * (1.f / 128.f) + RMS_EPS);
                const float y0 = ov.x * rs * gw.x * __uint_as_float(ogp[rr] << 16), y1 = ov.y * rs * gw.y * __uint_as_float(ogp[rr] & 0xffff0000u);
                stg<unsigned>(YC + row * D + h * 128, (unsigned)lane * 4u, cvt_pk_bf16(y0, y1)); }
        }
    }
    if (MODE == 0) {
#pragma unroll
        for (int db = 0; db < 8; ++db)
#pragma unroll
            for (int r = 0; r < 4; ++r) __hip_atomic_store(WSP(float, WS_SLOC) + (size_t)item * 16384 + (16 * w + 4 * q4 + r) * 128 + 16 * db + r16, S[db][r], __ATOMIC_RELAXED, __HIP_MEMORY_SCOPE_AGENT);
        if (g == 0) { __hip_atomic_store(WSP(float, WS_SMALL + SM_DTOT) + item * 128 + 2 * cp, __expf(lastsum.x), __ATOMIC_RELAXED, __HIP_MEMORY_SCOPE_AGENT); __hip_atomic_store(WSP(float, WS_SMALL + SM_DTOT) + item * 128 + 2 * cp + 1, __expf(lastsum.y), __ATOMIC_RELAXED, __HIP_MEMORY_SCOPE_AGENT); }
    }
    __syncthreads();
#undef HG_LOAD
#undef HG_LOADG
#undef F16LO
#undef F16HI
}
__device__ __forceinline__ void hgrn_scan(const P& p, int gid) {
    const int bh = gid >> 14, idx = gid & 16383, d = idx & 127;
    const float* SL = WSP(float, WS_SLOC) + (size_t)bh * 32 * 16384 + idx; float* ST = WSP(float, WS_SSTART) + (size_t)bh * 32 * 16384 + idx; const float* DT = WSP(float, WS_SMALL + SM_DTOT) + bh * 32 * 128 + d;
    float s = 0.f;
#pragma unroll 8
    for (int sc = 0; sc < 32; ++sc) { __hip_atomic_store(ST + (size_t)sc * 16384, s, __ATOMIC_RELAXED, __HIP_MEMORY_SCOPE_AGENT); s = s * DT[sc * 128] + SL[(size_t)sc * 16384]; }
}
__device__ __forceinline__ void sg_item(const int swave, const P& p, LAS unsigned char* lds, int item) {
    const int tid = otid(swave), lane = tid & 63, w = __builtin_amdgcn_readfirstlane(tid >> 6), q4 = lane >> 4, r16 = lane & 15;
    const int b = item >> 7, n = (item >> 1) & 63, gp = item & 1; const size_t row0 = (size_t)b * SEQ + (size_t)n * 128;
    LAS bf16* VNT = (LAS bf16*)lds; LAS bf16* WT = (LAS bf16*)(lds + 34816); LAS float* mean = (LAS float*)(lds + 69632); LAS float* rstd = mean + 128; LAS float* OM = (LAS float*)(lds + 71680);
    const bf16* ZG = WSP(bf16, WS_ZG); bf16* YC = WSP(bf16, WS_B);
    {
        bf16x8 z[16];
#pragma unroll
        for (int rr = 0; rr < 16; ++rr) z[rr] = ldg<bf16x8>(ZG + (row0 + 16 * w + rr) * 1024 + 512, (unsigned)lane * 16u);
#pragma unroll
        for (int rr = 0; rr < 16; ++rr) { float s1 = 0.f, s2 = 0.f;
#pragma unroll
            for (int j = 0; j < 8; ++j) { const float v = bf2f((bf16)z[rr][j]); s1 += v; s2 += v * v; }
            const float m = wave_sum_dpp(s1) * (1.f / 512.f); const float var = fmaxf(wave_sum_dpp(s2) * (1.f / 512.f) - m * m, 0.f);
            if (lane == 0) { mean[16 * w + rr] = m; rstd[16 * w + rr] = rsqrtf(var + LN_EPS); } }
    }
#pragma unroll 1
    for (int gi = 0; gi < 2; ++gi) { const int g = 2 * gp + gi;
        {
            const int t = tid >> 2, seg = tid & 3; const float* wr = p.sg_w + ((size_t)(g * 128 + t)) * 128 + seg * 32;
#pragma unroll
            for (int j = 0; j < 4; ++j) { const f32x4 a = *(const f32x4*)(wr + 8 * j), c = *(const f32x4*)(wr + 8 * j + 4); const int s0 = seg * 32 + 8 * j; u32x4 o;
                o.x = cvt_pk_bf16(s0 + 0 <= t ? a[0] : 0.f, s0 + 1 <= t ? a[1] : 0.f); o.y = cvt_pk_bf16(s0 + 2 <= t ? a[2] : 0.f, s0 + 3 <= t ? a[3] : 0.f);
                o.z = cvt_pk_bf16(s0 + 4 <= t ? c[0] : 0.f, s0 + 5 <= t ? c[1] : 0.f); o.w = cvt_pk_bf16(s0 + 6 <= t ? c[2] : 0.f, s0 + 7 <= t ? c[3] : 0.f);
                *(LAS u32x4*)(WT + t * SD + s0) = o; }
        }
        const int cp = tid & 63, sgp = tid >> 6;
        unsigned zc[16];
#pragma unroll
        for (int i = 0; i < 16; ++i) zc[i] = ldg<unsigned>(ZG + (row0 + 16 * sgp) * 1024 + 512 + g * 128, (unsigned)(i * 1024 + 2 * cp) * 2u);
        __syncthreads();
        {
            const f32x2 lg = ldg<f32x2>(p.sg_ln_g + g * 128, (unsigned)cp * 8u), lb = ldg<f32x2>(p.sg_ln_b + g * 128, (unsigned)cp * 8u);
#pragma unroll
            for (int i8 = 0; i8 < 2; ++i8) { float va[8], vb[8];
#pragma unroll
                for (int j = 0; j < 8; ++j) { const int s_ = 16 * sgp + 8 * i8 + j; const float m = mean[s_], rs = rstd[s_];
                    va[j] = (__uint_as_float(zc[8 * i8 + j] << 16) - m) * rs * lg.x + lb.x; vb[j] = (__uint_as_float(zc[8 * i8 + j] & 0xffff0000u) - m) * rs * lg.y + lb.y; }
                *(LAS u32x4*)(VNT + (2 * cp) * SD + 16 * sgp + 8 * i8) = (u32x4){cvt_pk_bf16(va[0], va[1]), cvt_pk_bf16(va[2], va[3]), cvt_pk_bf16(va[4], va[5]), cvt_pk_bf16(va[6], va[7])};
                *(LAS u32x4*)(VNT + (2 * cp + 1) * SD + 16 * sgp + 8 * i8) = (u32x4){cvt_pk_bf16(vb[0], vb[1]), cvt_pk_bf16(vb[2], vb[3]), cvt_pk_bf16(vb[4], vb[5]), cvt_pk_bf16(vb[6], vb[7])}; }
        }
        __syncthreads();
        bf16x8 aw[4];
#pragma unroll
        for (int ks = 0; ks < 4; ++ks) aw[ks] = frag(WT, SD, w, ks, lane);
#pragma unroll
        for (int cb = 0; cb < 8; ++cb) { f32x4 a = (f32x4){0.f, 0.f, 0.f, 0.f};
#pragma unroll
            for (int ks = 0; ks < 4; ++ks) a = mma16(aw[ks], frag(VNT, SD, cb, ks, lane), a);
#pragma unroll
            for (int r = 0; r < 4; ++r) OM[(16 * w + 4 * q4 + r) * SO + 16 * cb + r16] = a[r]; }
        __syncthreads();
        {
            const int t = tid >> 2, cs = (tid & 3) * 32; const float sb = p.sg_b[g * 128 + t];
            const bf16* up = ZG + (row0 + t) * 1024 + g * 128 + cs; bf16* op = YC + (row0 + t) * D + 512 + g * 128 + cs;
#pragma unroll
            for (int k = 0; k < 4; ++k) { const u32x4 uu = *(const u32x4*)(up + 8 * k); const f32x4 m0 = *(const LAS f32x4*)(OM + t * SO + cs + 8 * k), m1 = *(const LAS f32x4*)(OM + t * SO + cs + 8 * k + 4);
                u32x4 o;
                o.x = cvt_pk_bf16(__uint_as_float(uu.x << 16) * (m0[0] + sb), __uint_as_float(uu.x & 0xffff0000u) * (m0[1] + sb)); o.y = cvt_pk_bf16(__uint_as_float(uu.y << 16) * (m0[2] + sb), __uint_as_float(uu.y & 0xffff0000u) * (m0[3] + sb));
                o.z = cvt_pk_bf16(__uint_as_float(uu.z << 16) * (m1[0] + sb), __uint_as_float(uu.z & 0xffff0000u) * (m1[1] + sb)); o.w = cvt_pk_bf16(__uint_as_float(uu.w << 16) * (m1[2] + sb), __uint_as_float(uu.w & 0xffff0000u) * (m1[3] + sb));
                *(u32x4*)(op + 8 * k) = o; }
        }
    }
    __syncthreads();
}

typedef GAS unsigned gu32;
#define XB_TMO      128
#define XB_XCNT(j)  (256  + 64 * (j))
#define XB_XSUB(j)  (1280 + 64 * (j))
#define XB_XGEN(j)  (2304 + 64 * (j))
#define XB_TOP      3328
#define XB_TOPGEN   3392
#define XCD_BAR_WORDS 3456
#define XB_SPIN_CAP (1u << 18)
__device__ __forceinline__ unsigned xb_ld(unsigned* p)              { return __hip_atomic_load(p, __ATOMIC_RELAXED, __HIP_MEMORY_SCOPE_AGENT); }
__device__ __forceinline__ unsigned xb_add(unsigned* p, unsigned v) { return __hip_atomic_fetch_add(p, v, __ATOMIC_RELAXED, __HIP_MEMORY_SCOPE_AGENT); }
__device__ __forceinline__ unsigned xb_xcc_id() { return (unsigned)__builtin_amdgcn_s_getreg((3 << 11) | 20) & 0xFu; }
#define XB_SPIN(cond, bar) do { unsigned _sp = 0; while (cond) { __builtin_amdgcn_s_sleep(1); \
    if ((++_sp & 255u) == 0u) { if (xb_ld(&(bar)[XB_TMO])) break; if (_sp > XB_SPIN_CAP) { atomicAdd(&(bar)[XB_TMO], 1u); break; } } } } while (0)
struct XcdBarrier { unsigned* bar; unsigned x; volatile LAS unsigned* st; };
__device__ __forceinline__ XcdBarrier xcd_barrier_post(const int swave, unsigned* bar, volatile LAS unsigned* st) {
    XcdBarrier b; b.bar = bar; b.x = xb_xcc_id(); b.st = st;
    if (otid(swave) == 0) (void)xb_add(&bar[XB_XCNT(b.x)], 1u);
    return b;
}
__device__ __forceinline__ void xcd_barrier_complete(unsigned* bar, unsigned x, unsigned& nloc, unsigned& nx) {
    const unsigned G = gridDim.x * gridDim.y * gridDim.z;
    unsigned sum, cnt, mine, sp = 0u;
    for (;;) {
        sum = 0u; cnt = 0u; mine = 0u;
#pragma unroll
        for (unsigned j = 0; j < 16; ++j) { const unsigned c = xb_ld(&bar[XB_XCNT(j)]); sum += c; cnt += (c > 0u) ? 1u : 0u; mine = (j == x) ? c : mine; }
        if (sum == G) break;
        __builtin_amdgcn_s_sleep(1);
        if ((++sp & 255u) == 0u) { if (xb_ld(&bar[XB_TMO])) break; if (sp > XB_SPIN_CAP) { atomicAdd(&bar[XB_TMO], 1u); break; } }
    }
    nloc = mine > 0u ? mine : 1u; nx = cnt > 0u ? cnt : 1u;
}
__device__ __forceinline__ void xcd_barrier(const int swave, const XcdBarrier& b) {
    asm volatile("s_waitcnt vmcnt(0)" ::: "memory");
    __syncthreads();
    if (otid(swave) == 0) {
        unsigned* bar = b.bar;
        __builtin_amdgcn_s_waitcnt(0);
        unsigned nloc = b.st[0], nx = b.st[1];
        if (nloc == 0u) { xcd_barrier_complete(bar, b.x, nloc, nx); b.st[0] = nloc; b.st[1] = nx; }
        const unsigned old = xb_add(&bar[XB_XSUB(b.x)], 1u);
        const unsigned gen = old / nloc;
        if (old + 1u == (gen + 1u) * nloc) {
            __builtin_amdgcn_fence(__ATOMIC_RELEASE, "agent");
            asm volatile("s_waitcnt vmcnt(0)" ::: "memory");
            const unsigned og = xb_add(&bar[XB_TOP], 1u);
            const unsigned tg = og / nx;
            if (og + 1u == (tg + 1u) * nx) xb_add(&bar[XB_TOPGEN], 1u);
            else XB_SPIN(xb_ld(&bar[XB_TOPGEN]) == tg, bar);
            __builtin_amdgcn_fence(__ATOMIC_ACQUIRE, "agent");
            xb_add(&bar[XB_XGEN(b.x)], 1u);
            asm volatile("s_waitcnt vmcnt(0)" ::: "memory");
        } else {
            XB_SPIN(xb_ld(&bar[XB_XGEN(b.x)]) == gen, bar);
            __builtin_amdgcn_fence(__ATOMIC_ACQUIRE, "agent");
            asm volatile("s_waitcnt vmcnt(0)" ::: "memory");
        }
    }
    __syncthreads();
}
constexpr int CW_BAR = 4096;

__device__ __forceinline__ unsigned pk2(float lo, float hi) { return (unsigned)f2bf(lo) | ((unsigned)f2bf(hi) << 16); }
struct TrItem { const float* src; bf16* wt; int N, K, k0, n0, up; };
__device__ __forceinline__ TrItem tr_locate(const P& p, int it) {
    constexpr int I_IN = (D / 64) * (NIN / 64), I_OUT = (D / 64) * (D / 64), I_UP1 = (D / 64) * (1024 / 64), I_DN1 = (HID / 64) * (D / 64);
    const float* W; bf16* WT; int K, N, up = 0, r = it;
    if (r < I_IN) { W = p.w_in; WT = WSP(bf16, WS_WINT); K = D; N = NIN; }
    else if ((r -= I_IN) < I_OUT) { W = p.w_out; WT = WSP(bf16, WS_WOUTT); K = D; N = D; }
    else if ((r -= I_OUT) < NE * I_UP1) { const int e = r / I_UP1; r -= e * I_UP1; W = p.w_up + (size_t)e * D * 1024; WT = WSP(bf16, WS_WUPT) + (size_t)e * D * 1024; K = D; N = 1024; up = 1; }
    else { r -= NE * I_UP1; const int e = r / I_DN1; r -= e * I_DN1; W = p.w_down + (size_t)e * HID * D; WT = WSP(bf16, WS_WDNT) + (size_t)e * HID * D; K = HID; N = D; }
    const int nblk = N / 64, kb = r / nblk, nb = r % nblk, lane = (int)__builtin_amdgcn_mbcnt_hi(~0u, __builtin_amdgcn_mbcnt_lo(~0u, 0u));
    TrItem t; t.k0 = 64 * kb; t.n0 = 64 * nb; t.src = W + (size_t)t.k0 * N + t.n0 + lane; t.wt = WT; t.N = N; t.K = K; t.up = up; return t;
}
__device__ __forceinline__ void tr_load(const TrItem& t, float (&r)[64]) {
#pragma unroll
    for (int i = 0; i < 64; ++i) r[i] = t.src[(size_t)i * t.N];
}
__device__ __forceinline__ void tr_store(const TrItem& t, const float (&r)[64], LAS unsigned char* scr) {
    const int lane = (int)__builtin_amdgcn_mbcnt_hi(~0u, __builtin_amdgcn_mbcnt_lo(~0u, 0u));
#pragma unroll
    for (int j = 0; j < 8; ++j) { u32x4 o; o.x = cvt_pk_bf16(r[8 * j], r[8 * j + 1]); o.y = cvt_pk_bf16(r[8 * j + 2], r[8 * j + 3]); o.z = cvt_pk_bf16(r[8 * j + 4], r[8 * j + 5]); o.w = cvt_pk_bf16(r[8 * j + 6], r[8 * j + 7]);
        *(LAS u32x4*)(scr + lane * 144 + 16 * j) = o; }
    asm volatile("s_waitcnt lgkmcnt(0)" ::: "memory");
    const int rr = lane >> 3, c = lane & 7;
#pragma unroll
    for (int j = 0; j < 8; ++j) { const int nn = t.n0 + 8 * j + rr; const u32x4 o = *(const LAS u32x4*)(scr + (8 * j + rr) * 144 + 16 * c);
        *(u32x4*)(t.wt + (size_t)(t.up ? updst(nn) : nn) * t.K + t.k0 + 8 * c) = o; }
    asm volatile("s_waitcnt lgkmcnt(0)" ::: "memory");
}
__device__ __forceinline__ void phase_prep(const int swave, const P& p, LAS unsigned char* lds, int bx, int G) {
    const int tid = otid(swave), lane = tid & 63, w = __builtin_amdgcn_readfirstlane(tid >> 6);
    if (bx < 192) {
        LAS float* sc = (LAS float*)lds; LAS float* red = sc + 2048;
        for (int i = tid; i < 2048; i += NTHR) sc[i] = silu_f(p.c[i]);
        __syncthreads();
        for (int cb = bx; cb < 192; cb += G) {
            const int kg = tid >> 5, cl = tid & 31, colj = cb * 32 + cl; float a0 = 0.f, a1 = 0.f;
            float wv[64];
#pragma unroll
            for (int i = 0; i < 64; ++i) wv[i] = p.w_ada[(size_t)(kg + 16 * i) * 6144 + colj];
#pragma unroll
            for (int i = 0; i < 64; ++i) { const int k = kg + 16 * i; a0 += sc[k] * wv[i]; a1 += sc[1024 + k] * wv[i]; }
            red[(kg * 32 + cl) * 2] = a0; red[(kg * 32 + cl) * 2 + 1] = a1;
            __syncthreads();
            if (tid < 64) { const int c2 = tid & 31, bb = tid >> 5; float t = 0.f;
#pragma unroll
                for (int k2 = 0; k2 < 16; ++k2) t += red[(k2 * 32 + c2) * 2 + bb];
                __hip_atomic_store(WSP(float, WS_SMALL + SM_ADA) + bb * 6144 + cb * 32 + c2, t + p.b_ada[cb * 32 + c2], __ATOMIC_RELAXED, __HIP_MEMORY_SCOPE_AGENT);
                asm volatile("s_waitcnt vmcnt(0)" ::: "memory");
                if (tid == 0) __hip_atomic_fetch_add(WSP(unsigned, WS_CTL) + CW_ADA, 1u, __ATOMIC_RELAXED, __HIP_MEMORY_SCOPE_AGENT); }
            __syncthreads();
        }
    }
    if (bx == G - 1) { const float l0 = p.lb_logits[tid], l1 = p.lb_logits[512 + tid]; const float m = fmaxf(l0, l1); const float e0 = expf(l0 - m), e1 = expf(l1 - m);
        WSP(float, WS_SMALL + SM_LB)[tid] = e0 / (e0 + e1); }
    constexpr int NITEMS = (D / 64) * (NIN / 64) + (D / 64) * (D / 64) + NE * (D / 64) * (1024 / 64) + NE * (HID / 64) * (D / 64);
    LAS int* qs = (LAS int*)(lds + LDSCTL_OFF) + LC_Q;
    LAS unsigned char* scr = lds + 16384 + w * 9216;
    if (tid == 0) qs[0] = (int)atomicAdd(WSP(unsigned, WS_CTL) + CW_PREPQ, 24u);
    __syncthreads();
    int base = qs[0];
#pragma unroll 1
    while (base < NITEMS) {
        __syncthreads();
        int nxt = 0; if (tid == 0) nxt = (int)atomicAdd(WSP(unsigned, WS_CTL) + CW_PREPQ, 24u);
        const int it = base + 3 * w;
        if (it < NITEMS) {
            const TrItem ta = tr_locate(p, it); float ra[64]; tr_load(ta, ra);
            if (it + 2 < NITEMS) { const TrItem tb = tr_locate(p, it + 1), tc = tr_locate(p, it + 2); float rb[64], rc[64]; tr_load(tb, rb); tr_load(tc, rc); tr_store(ta, ra, scr); tr_store(tb, rb, scr); tr_store(tc, rc, scr); }
            else if (it + 1 < NITEMS) { const TrItem tb = tr_locate(p, it + 1); float rb[64]; tr_load(tb, rb); tr_store(ta, ra, scr); tr_store(tb, rb, scr); }
            else tr_store(ta, ra, scr);
        }
        if (tid == 0) qs[0] = nxt;
        __syncthreads();
        base = qs[0];
    }
}
__device__ __forceinline__ void phase_xmod(const int swave, const P& p, int bx, int G) {
    const int lane = otid(swave) & 63, gw = bx * NWAVES + (otid(swave) >> 6), NGW = G * NWAVES; const unsigned l16 = (unsigned)lane * 16u, l8 = (unsigned)lane * 8u;
#pragma unroll 1
    for (int row = 4 * gw; row < T; row += 4 * NGW) { const float* ada = WSP(float, WS_SMALL + SM_ADA) + (row >> 13) * 6144;
        f32x4 xv[4][4];
#pragma unroll
        for (int r = 0; r < 4; ++r)
#pragma unroll
            for (int j = 0; j < 4; ++j) xv[r][j] = ldg<f32x4>(p.x + (size_t)(row + r) * D + 256 * j, l16);
#pragma unroll
        for (int j = 0; j < 4; ++j) { const f32x4 sh = ldg<f32x4>(ada + 256 * j, l16), sc = ldg<f32x4>(ada + 1024 + 256 * j, l16);
#pragma unroll
            for (int r = 0; r < 4; ++r) { u32x2 o; o.x = cvt_pk_bf16(xv[r][j][0] * (1.f + sc[0]) + sh[0], xv[r][j][1] * (1.f + sc[1]) + sh[1]); o.y = cvt_pk_bf16(xv[r][j][2] * (1.f + sc[2]) + sh[2], xv[r][j][3] * (1.f + sc[3]) + sh[3]);
                stg<u32x2>(WSP(bf16, WS_B) + (size_t)(row + r) * D + 256 * j, l8, o); } } }
}
__device__ __forceinline__ void route_load_weights(const int swave, const P& p, LAS float* WR) {
    for (int c = otid(swave); c < D; c += NTHR) { const f32x4 wg = *(const f32x4*)(p.rg_w + (size_t)c * 4);
#pragma unroll
        for (int g = 0; g < 4; ++g) { WR[g * D + c] = wg[g];
            const f32x4 w0 = *(const f32x4*)(p.re_w + ((size_t)g * D + c) * 8), w1 = *(const f32x4*)(p.re_w + ((size_t)g * D + c) * 8 + 4);
#pragma unroll
            for (int e = 0; e < 4; ++e) { WR[(4 + g * 8 + e) * D + c] = w0[e]; WR[(4 + g * 8 + 4 + e) * D + c] = w1[e]; } } }
}
__device__ __forceinline__ void route_load2(const P& p, int row, int lane, f32x4 (&x)[2][4], u32x2 (&y)[2][4]) {
    const unsigned l16 = (unsigned)lane * 16u, l8 = (unsigned)lane * 8u;
#pragma unroll
    for (int r = 0; r < 2; ++r) { const float* xr = p.x + (size_t)(row + r) * D; const bf16* yr = WSP(bf16, WS_Y) + (size_t)(row + r) * D;
#pragma unroll
        for (int j = 0; j < 4; ++j) { x[r][j] = ldg<f32x4>(xr + 256 * j, l16); y[r][j] = ldg<u32x2>(yr + 256 * j, l8); } }
}
__device__ __forceinline__ float wave_sum_l63(float v) { DPP_ADD(v, 0xB1, 0xF); DPP_ADD(v, 0x4E, 0xF); DPP_ADD(v, 0x141, 0xF); DPP_ADD(v, 0x140, 0xF); DPP_ADD(v, 0x142, 0xA); DPP_ADD(v, 0x143, 0xC); return v; }
__device__ __forceinline__ void route_topk(const LAS float* lgs, LAS int* rt_e, LAS float* rt_w, int rl, int lane) {
    const f32x4 g4 = *(const LAS f32x4*)lgs;
    int gi = 0; float gm = g4[0];
#pragma unroll
    for (int g = 1; g < 4; ++g) if (g4[g] > gm) { gm = g4[g]; gi = g; }
    float gs = 0.f;
#pragma unroll
    for (int g = 0; g < 4; ++g) gs += __expf(g4[g] - gm);
    const float pgroup = 1.f / gs;
    const f32x4 ea = *(const LAS f32x4*)(lgs + 4 + 8 * gi), eb = *(const LAS f32x4*)(lgs + 8 + 8 * gi);
    float el[8] = {ea[0], ea[1], ea[2], ea[3], eb[0], eb[1], eb[2], eb[3]};
    int j0 = 0; float m0 = el[0];
#pragma unroll
    for (int e = 1; e < 8; ++e) if (el[e] > m0) { m0 = el[e]; j0 = e; }
    int j1 = -1; float m1 = -3.0e38f;
#pragma unroll
    for (int e = 0; e < 8; ++e) if (e != j0 && el[e] > m1) { m1 = el[e]; j1 = e; }
    const float r1 = __expf(m1 - m0);
    if (lane == 0) { rt_e[2 * rl] = gi * 8 + j0; rt_e[2 * rl + 1] = gi * 8 + j1; rt_w[2 * rl] = pgroup / (1.f + r1); rt_w[2 * rl + 1] = pgroup * r1 / (1.f + r1); }
}
__device__ __forceinline__ void ln1_route_rows2(const P& p, const LAS float* WR, LAS float* lgs, LAS int* rt_e, LAS float* rt_w, int row, int rl, int lane, const f32x4 (&x)[2][4], const u32x2 (&y)[2][4]) {
    const float* ada = WSP(float, WS_SMALL + SM_ADA) + (row >> 13) * 6144;
    const unsigned l16 = (unsigned)lane * 16u, l8 = (unsigned)lane * 8u;
    f32x4 g1v[4], pg[4], pb[4], ps[4], pc[4];
#pragma unroll
    for (int j = 0; j < 4; ++j) g1v[j] = ldg<f32x4>(ada + 2048 + 256 * j, l16);
#pragma unroll
    for (int j = 0; j < 4; ++j) { pg[j] = ldg<f32x4>(p.ln1_g + 256 * j, l16); pb[j] = ldg<f32x4>(p.ln1_b + 256 * j, l16); ps[j] = ldg<f32x4>(ada + 3072 + 256 * j, l16); pc[j] = ldg<f32x4>(ada + 4096 + 256 * j, l16); }
    float v[2][16], rstd[2];
#pragma unroll
    for (int r = 0; r < 2; ++r) { float s = 0.f;
#pragma unroll
        for (int j = 0; j < 4; ++j) {
            const float y0 = __uint_as_float(y[r][j].x << 16), y1 = __uint_as_float(y[r][j].x & 0xffff0000u), y2 = __uint_as_float(y[r][j].y << 16), y3 = __uint_as_float(y[r][j].y & 0xffff0000u);
            v[r][4 * j] = ALPHA * x[r][j][0] + (1.f + g1v[j][0]) * y0; v[r][4 * j + 1] = ALPHA * x[r][j][1] + (1.f + g1v[j][1]) * y1; v[r][4 * j + 2] = ALPHA * x[r][j][2] + (1.f + g1v[j][2]) * y2; v[r][4 * j + 3] = ALPHA * x[r][j][3] + (1.f + g1v[j][3]) * y3;
            s += (v[r][4 * j] + v[r][4 * j + 1]) + (v[r][4 * j + 2] + v[r][4 * j + 3]); }
        const float mean = wave_sum_dpp(s) * (1.f / D); float q = 0.f;
#pragma unroll
        for (int i = 0; i < 16; ++i) { v[r][i] -= mean; q += v[r][i] * v[r][i]; }
        rstd[r] = rsqrtf(wave_sum_dpp(q) * (1.f / D) + LN_EPS); }
    f32x2 hv[16];
#pragma unroll
    for (int r = 0; r < 2; ++r) { bf16* X1 = WSP(bf16, WS_X1) + (size_t)(row + r) * D; bf16* H2 = WSP(bf16, WS_B) + (size_t)(row + r) * D;
#pragma unroll
        for (int j = 0; j < 4; ++j) { f32x4 x1; float h[4];
#pragma unroll
            for (int i = 0; i < 4; ++i) { x1[i] = v[r][4 * j + i] * rstd[r] * pg[j][i] + pb[j][i]; h[i] = x1[i] * (1.f + pc[j][i]) + ps[j][i]; if (r == 0) hv[4 * j + i].x = h[i]; else hv[4 * j + i].y = h[i]; }
            { u32x2 xo; xo.x = cvt_pk_bf16(x1[0], x1[1]); xo.y = cvt_pk_bf16(x1[2], x1[3]); stg<u32x2>(X1 + 256 * j, l8, xo); }
            u32x2 o; o.x = cvt_pk_bf16(h[0], h[1]); o.y = cvt_pk_bf16(h[2], h[3]); stg<u32x2>(H2 + 256 * j, l8, o); } }
    __builtin_amdgcn_sched_barrier(0);
    const LAS char* wp = (const LAS char*)WR + lane * 16;
    float gl[2][4];
#pragma unroll
    for (int o = 0; o < 4; ++o) { f32x2 a[4];
#pragma unroll
        for (int j = 0; j < 4; ++j) { const f32x4 wv = *(const LAS f32x4*)(wp + 4096 * o + 1024 * j); a[j] = hv[4 * j] * (f32x2){wv[0], wv[0]};
#pragma unroll
            for (int i = 1; i < 4; ++i) a[j] = __builtin_elementwise_fma(hv[4 * j + i], (f32x2){wv[i], wv[i]}, a[j]); }
        const f32x2 t = (a[0] + a[1]) + (a[2] + a[3]); const float bias = p.rg_b[o];
        gl[0][o] = wave_sum_dpp(t.x) + bias; gl[1][o] = wave_sum_dpp(t.y) + bias; }
#pragma unroll
    for (int r = 0; r < 2; ++r) {
        int gi = 0; float gm = gl[r][0];
#pragma unroll
        for (int g = 1; g < 4; ++g) if (gl[r][g] > gm) { gm = gl[r][g]; gi = g; }
        gi = __builtin_amdgcn_readfirstlane(gi);
        float gs = 0.f;
#pragma unroll
        for (int g = 0; g < 4; ++g) gs += __expf(gl[r][g] - gm);
        const float pgroup = 1.f / gs;
        const LAS char* we = wp + (4 + 8 * gi) * 4096;
        int coll = 0;
#pragma unroll
        for (int e = 0; e < 8; ++e) { float a[4];
#pragma unroll
            for (int j = 0; j < 4; ++j) { const f32x4 wv = *(const LAS f32x4*)(we + 4096 * e + 1024 * j);
                a[j] = (r == 0 ? hv[4 * j].x : hv[4 * j].y) * wv[0];
#pragma unroll
                for (int i = 1; i < 4; ++i) a[j] = __builtin_fmaf(r == 0 ? hv[4 * j + i].x : hv[4 * j + i].y, wv[i], a[j]); }
            const float sv = wave_sum_l63((a[0] + a[1]) + (a[2] + a[3]));
            const int rv = __builtin_amdgcn_readlane(__float_as_int(sv), 63);
            asm volatile("v_writelane_b32 %0, %1, %2" : "+v"(coll) : "s"(rv), "i"(e)); }
        LAS float* l8 = lgs + 64 * r;
        l8[lane] = __int_as_float(coll) + p.re_b[gi * 8 + (lane & 7)];
        asm volatile("s_waitcnt lgkmcnt(0)" ::: "memory");
        const f32x4 ea = *(const LAS f32x4*)l8, eb = *(const LAS f32x4*)(l8 + 4);
        const float el[8] = {ea[0], ea[1], ea[2], ea[3], eb[0], eb[1], eb[2], eb[3]};
        int j0 = 0; float m0 = el[0];
#pragma unroll
        for (int e = 1; e < 8; ++e) if (el[e] > m0) { m0 = el[e]; j0 = e; }
        int j1 = -1; float m1 = -3.0e38f;
#pragma unroll
        for (int e = 0; e < 8; ++e) if (e != j0 && el[e] > m1) { m1 = el[e]; j1 = e; }
        const float r1 = __expf(m1 - m0);
        if (lane == 0) { rt_e[2 * (rl + r)] = gi * 8 + j0; rt_e[2 * (rl + r) + 1] = gi * 8 + j1; rt_w[2 * (rl + r)] = pgroup / (1.f + r1); rt_w[2 * (rl + r) + 1] = pgroup * r1 / (1.f + r1); }
    }
}
__device__ __forceinline__ void route_assign(const int swave, const P& p, const LAS int* rt_e, const LAS float* rt_w, LAS int* rt_base, int rowbase) {
    const int lane = otid(swave);
    const int e0 = rt_e[lane], e1 = rt_e[lane + 64];
    const unsigned long long lt = (1ull << lane) - 1ull;
    int rank0 = 0, rank1 = 0, mycnt = 0;
#pragma unroll 4
    for (int e = 0; e < NE; ++e) { const unsigned long long m0 = __ballot(e0 == e), m1 = __ballot(e1 == e); const int c0 = __popcll(m0);
        if (e0 == e) rank0 = __popcll(m0 & lt);
        if (e1 == e) rank1 = c0 + __popcll(m1 & lt);
        if (lane == e) mycnt = c0 + __popcll(m1); }
    if (lane < NE) rt_base[lane] = mycnt ? (int)atomicAdd(WSP(unsigned, WS_CTL) + CW_CNT + lane, (unsigned)mycnt) : 0;
    asm volatile("s_waitcnt vmcnt(0) lgkmcnt(0)" ::: "memory");
    int* LIST = WSP(int, WS_LIST); float* WL = WSP(float, WS_WLIST); int* TE = WSP(int, WS_SMALL + SM_TOKE); int* TS = WSP(int, WS_SMALL + SM_TOKS);
    { const int slot = rt_base[e0] + rank0, row = rowbase + (lane >> 1); LIST[e0 * T + slot] = row; WL[e0 * T + slot] = rt_w[lane]; TE[row * 2 + (lane & 1)] = e0; TS[row * 2 + (lane & 1)] = slot; }
    { const int a = lane + 64, slot = rt_base[e1] + rank1, row = rowbase + (a >> 1); LIST[e1 * T + slot] = row; WL[e1 * T + slot] = rt_w[a]; TE[row * 2 + (a & 1)] = e1; TS[row * 2 + (a & 1)] = slot; }
}
template <int NR> __device__ __forceinline__ void final_rows(const P& p, const LAS int* tstart, int row, int lane, float pscale, float pspike) {
    const float* ada = WSP(float, WS_SMALL + SM_ADA) + (row >> 13) * 6144;
    const int* TE = WSP(int, WS_SMALL + SM_TOKE); const int* TS = WSP(int, WS_SMALL + SM_TOKS);
    const unsigned l16 = (unsigned)lane * 16u, l8 = (unsigned)lane * 8u;
    u32x2 xv[NR][4], pa[NR][4], pb[NR][4];
#pragma unroll
    for (int r = 0; r < NR; ++r) {
        const int e0 = TE[(row + r) * 2], e1 = TE[(row + r) * 2 + 1], s0 = TS[(row + r) * 2], s1 = TS[(row + r) * 2 + 1];
        const size_t rA = (size_t)(tstart[e0] * 256 + s0), rB = (size_t)(tstart[e1] * 256 + s1);
        const bf16* ya = WSP(bf16, WS_Y2) + rA * D; const bf16* yb = WSP(bf16, WS_Y2) + rB * D; const bf16* X1 = WSP(bf16, WS_X1) + (size_t)(row + r) * D;
#pragma unroll
        for (int j = 0; j < 4; ++j) { xv[r][j] = ldg<u32x2>(X1 + 256 * j, l8); pa[r][j] = ldg<u32x2>(ya + 256 * j, l8); pb[r][j] = ldg<u32x2>(yb + 256 * j, l8); } }
    __builtin_amdgcn_sched_barrier(0);
#pragma unroll
    for (int r = 0; r < NR; ++r) {
        if (r) __builtin_amdgcn_sched_barrier(0);
        float v[16]; float s = 0.f;
#pragma unroll
        for (int j = 0; j < 4; ++j) { const f32x4 g2 = ldg<f32x4>(ada + 5120 + 256 * j, l16);
            const float m0 = __uint_as_float(pa[r][j].x << 16) + __uint_as_float(pb[r][j].x << 16), m1 = __uint_as_float(pa[r][j].x & 0xffff0000u) + __uint_as_float(pb[r][j].x & 0xffff0000u);
            const float m2 = __uint_as_float(pa[r][j].y << 16) + __uint_as_float(pb[r][j].y << 16), m3 = __uint_as_float(pa[r][j].y & 0xffff0000u) + __uint_as_float(pb[r][j].y & 0xffff0000u);
            const float x0 = __uint_as_float(xv[r][j].x << 16), x1 = __uint_as_float(xv[r][j].x & 0xffff0000u), x2 = __uint_as_float(xv[r][j].y << 16), x3 = __uint_as_float(xv[r][j].y & 0xffff0000u);
            v[4 * j + 0] = ALPHA * x0 + (1.f + g2[0]) * m0; v[4 * j + 1] = ALPHA * x1 + (1.f + g2[1]) * m1; v[4 * j + 2] = ALPHA * x2 + (1.f + g2[2]) * m2; v[4 * j + 3] = ALPHA * x3 + (1.f + g2[3]) * m3;
            s += (v[4 * j] + v[4 * j + 1]) + (v[4 * j + 2] + v[4 * j + 3]); }
        const float mean = wave_sum_dpp(s) * (1.f / D); float q = 0.f;
#pragma unroll
        for (int i = 0; i < 16; ++i) { v[i] -= mean; q += v[i] * v[i]; }
        const float rstd = rsqrtf(wave_sum_dpp(q) * (1.f / D) + LN_EPS);
#pragma unroll
        for (int j = 0; j < 4; ++j) { const f32x4 gg = ldg<f32x4>(p.ln2_g + 256 * j, l16), bb = ldg<f32x4>(p.ln2_b + 256 * j, l16); f32x4 o;
#pragma unroll
            for (int i = 0; i < 4; ++i) o[i] = (v[4 * j + i] * rstd * gg[i] + bb[i]) * pscale;
            if (j == 0 && lane == 0 && r == 0) o[0] += pspike;
            stg<f32x4>(p.out + (size_t)(row + r) * D + 256 * j, l16, o); }
    }
}

enum { PH_PREP = 0, PH_INPROJ, PH_MIX, PH_OUTPROJ, PH_LN1ROUTE, PH_UP, PH_FINAL, PH_N };
struct Args { P p; int ph_lo, ph_hi, li, pad; };

__device__ __forceinline__ void moe_tables(const int swave, const P& p, LAS unsigned char* lds) {
    LAS int* tstart = (LAS int*)(lds + LDSCTL_OFF) + LC_TSTART; LAS int* lcnt = (LAS int*)(lds + LDSCTL_OFF) + LC_CNT;
    if (otid(swave) == 0) { int acc = 0;
        for (int e = 0; e < NE; ++e) { const int c = (int)__hip_atomic_load(WSP(unsigned, WS_CTL) + CW_CNT + e, __ATOMIC_RELAXED, __HIP_MEMORY_SCOPE_AGENT); tstart[e] = acc; lcnt[e] = c; acc += (c + 255) >> 8; }
        tstart[NE] = acc; }
    __syncthreads();
}

__device__ __forceinline__ P load_p() {
    typedef const __attribute__((address_space(4))) unsigned long long CU64;
    CU64* a = (CU64*)__builtin_amdgcn_kernarg_segment_ptr(); asm volatile("" : "+s"(a));
#define LP_F(i) ((const float*)(const GAS float*)(a[i]))
    P p;
    p.x = LP_F(0); p.c = LP_F(1); p.w_ada = LP_F(2); p.b_ada = LP_F(3); p.w_in = LP_F(4); p.lb_logits = LP_F(5); p.hg_norm_w = LP_F(6); p.sg_ln_g = LP_F(7); p.sg_ln_b = LP_F(8); p.sg_w = LP_F(9); p.sg_b = LP_F(10);
    p.w_out = LP_F(11); p.ln1_g = LP_F(12); p.ln1_b = LP_F(13); p.rg_w = LP_F(14); p.rg_b = LP_F(15); p.re_w = LP_F(16); p.re_b = LP_F(17); p.w_up = LP_F(18); p.w_down = LP_F(19); p.ln2_g = LP_F(20); p.ln2_b = LP_F(21);
    p.out = (float*)(GAS float*)(a[22]); p.ws = (unsigned char*)(GAS unsigned char*)(a[23]);
#undef LP_F
    return p;
}
__global__ void __launch_bounds__(NTHR, 2) mk_fwd(Args args) {
    extern __shared__ __attribute__((aligned(16))) unsigned char lds_raw[];
    LAS unsigned char* lds = (LAS unsigned char*)lds_raw;
    const P& p = args.p;
    const int G = gridDim.x, bx = blockIdx.x;
    const int swave = __builtin_amdgcn_readfirstlane((int)threadIdx.x >> 6);
    const int lo = args.ph_lo, hi = args.ph_hi;
#ifndef PHASE_MASK
#define PHASE_MASK 0x7f
#endif
#define IN(k) (((PHASE_MASK >> (k)) & 1) && lo <= (k) && (k) < hi)
#ifndef REP_PHASE
#define REP_PHASE -1
#define REP_N 0
#endif
#define NREP(k) ((k) == REP_PHASE ? REP_N : 0)
#ifdef PROBE_A
#define STAMP(k) do { if (otid(swave) == 0) { const unsigned long long t_ = __builtin_amdgcn_s_memrealtime(); __hip_atomic_store((unsigned long long*)(WSP(unsigned, WS_CTL) + 65536 + bx * 32) + (k), t_, __ATOMIC_RELAXED, __HIP_MEMORY_SCOPE_AGENT); } } while (0)
#else
#define STAMP(k) do { } while (0)
#endif
#define SEAM(k) do { if (rep_ == NREP(k)) { if (IN(k) && IN((k) + 1)) xcd_barrier(swave, bar); STAMP((k) + 1); } } while (0)
    for (int u = otid(swave); u < (LDS_BYTES - LDSCTL_OFF) / 4; u += NTHR) ((LAS unsigned*)(lds + LDSCTL_OFF))[u] = 0u;
    __syncthreads();
    XcdBarrier bar = xcd_barrier_post(swave, WSP(unsigned, WS_CTL) + CW_BAR + args.li * XCD_BAR_WORDS, (volatile LAS unsigned*)(lds + LDSCTL_OFF) + LC_BAR);
    { const P p = load_p(); STAMP(0); }
    if (IN(PH_PREP)) for (int rep_ = 0; rep_ <= NREP(PH_PREP); ++rep_) { if (rep_) xcd_barrier(swave, bar); asm volatile("; MARK PH_PREP"); const P p = load_p(); phase_prep(swave, p, lds, bx, G);
        if (otid(swave) == 0) { unsigned sp = 0; while (__hip_atomic_load(WSP(unsigned, WS_CTL) + CW_ADA, __ATOMIC_RELAXED, __HIP_MEMORY_SCOPE_AGENT) < 192u && ++sp < (1u << 22)) __builtin_amdgcn_s_sleep(2);
            __builtin_amdgcn_fence(__ATOMIC_ACQUIRE, "agent"); asm volatile("s_waitcnt vmcnt(0)" ::: "memory"); }
        __syncthreads();
        phase_xmod(swave, p, bx, G); SEAM(PH_PREP); }
    if (IN(PH_INPROJ)) for (int rep_ = 0; rep_ <= NREP(PH_INPROJ); ++rep_) { if (rep_) xcd_barrier(swave, bar); asm volatile("; MARK PH_INPROJ"); const P p = load_p();
        pg8::Gemm g{WSP(bf16, WS_B), WSP(bf16, WS_WINT), D, 0, 0, nullptr}; pg8::StaticOrder S; S.init(T, NIN, G, bx);
        pg8::EpiInproj E{p.ws};
        pg8::gemm_phase<pg8::EpiInproj, pg8::StaticOrder, true, true, false>(swave, lds, g, S, E);
        SEAM(PH_INPROJ);
    }
    if (IN(PH_MIX)) for (int rep_ = 0; rep_ <= NREP(PH_MIX); ++rep_) { if (rep_) xcd_barrier(swave, bar); asm volatile("; MARK PH_MIX"); const P p = load_p();
        const int grp = bx >> 5; unsigned* cA = WSP(unsigned, WS_CTL) + CW_MIXA + 64 * grp; unsigned* cB = WSP(unsigned, WS_CTL) + CW_MIXB + 64 * grp;
#define GROUP_PUBLISH(cnt) do { asm volatile("s_waitcnt vmcnt(0)" ::: "memory"); __syncthreads(); if (otid(swave) == 0) __hip_atomic_fetch_add((cnt), 1u, __ATOMIC_RELAXED, __HIP_MEMORY_SCOPE_AGENT); } while (0)
#define GROUP_WAIT(cnt) do { if (otid(swave) == 0) { unsigned sp_ = 0; while (__hip_atomic_load((cnt), __ATOMIC_RELAXED, __HIP_MEMORY_SCOPE_AGENT) < 32u && ++sp_ < (1u << 20)) __builtin_amdgcn_s_sleep(2); \
            __builtin_amdgcn_fence(__ATOMIC_ACQUIRE, "agent"); asm volatile("s_waitcnt vmcnt(0)" ::: "memory"); } __syncthreads(); } while (0)
        hgrn_item<0>(swave, p, lds, bx);
        GROUP_PUBLISH(cA);
        sg_item(swave, p, lds, bx);
        GROUP_WAIT(cA);
        hgrn_scan(p, grp * 16384 + (bx & 31) * NTHR + otid(swave));
        GROUP_PUBLISH(cB);
        GROUP_WAIT(cB);
        hgrn_item<1>(swave, p, lds, bx);
#undef GROUP_PUBLISH
#undef GROUP_WAIT
        SEAM(PH_MIX);
    }
    if (IN(PH_OUTPROJ)) for (int rep_ = 0; rep_ <= NREP(PH_OUTPROJ); ++rep_) { if (rep_) xcd_barrier(swave, bar); asm volatile("; MARK PH_OUTPROJ"); const P p = load_p();
        pg8::Gemm g{WSP(bf16, WS_B), WSP(bf16, WS_WOUTT), D, 0, 0, nullptr}; pg8::StaticOrder S; S.init(T, D, G, bx);
        pg8::EpiBf16 E{p.ws, WS_Y, D};
        pg8::gemm_phase<pg8::EpiBf16, pg8::StaticOrder, true, true, false>(swave, lds, g, S, E);
        SEAM(PH_OUTPROJ);
    }
    if (IN(PH_LN1ROUTE)) for (int rep_ = 0; rep_ <= NREP(PH_LN1ROUTE); ++rep_) { if (rep_) xcd_barrier(swave, bar); asm volatile("; MARK PH_LN1ROUTE"); const P p = load_p();
        if (rep_) { if (bx == 0 && otid(swave) < 32) __hip_atomic_store(WSP(unsigned, WS_CTL) + CW_CNT + otid(swave), 0u, __ATOMIC_RELAXED, __HIP_MEMORY_SCOPE_AGENT); xcd_barrier(swave, bar); }
        const int lane = otid(swave) & 63, w = __builtin_amdgcn_readfirstlane(otid(swave) >> 6);
        LAS float* WR = (LAS float*)lds; LAS int* rt_e = (LAS int*)(lds + LDSCTL_OFF) + LC_RT; LAS float* rt_w = (LAS float*)(rt_e + 128); LAS int* rt_base = rt_e + 256;
        f32x4 xc[2][4]; u32x2 yc[2][4];
        route_load2(p, bx * 64 + 8 * w, lane, xc, yc);
        route_load_weights(swave, p, WR);
        __syncthreads();
        for (int rb = bx * 64; rb < T; rb += G * 64) {
            if (rb != bx * 64) route_load2(p, rb + 8 * w, lane, xc, yc);
#pragma unroll 1
            for (int pr = 0; pr < 4; ++pr) {
                f32x4 xn[2][4]; u32x2 yn[2][4];
                route_load2(p, rb + 8 * w + (pr < 3 ? 2 * pr + 2 : 2 * pr), lane, xn, yn);
                ln1_route_rows2(p, WR, (LAS float*)(lds + LDSCTL_OFF) + LC_LGS + 128 * w, rt_e, rt_w, rb + 8 * w + 2 * pr, 8 * w + 2 * pr, lane, xc, yc);
#pragma unroll
                for (int r = 0; r < 2; ++r)
#pragma unroll
                    for (int j = 0; j < 4; ++j) { xc[r][j] = xn[r][j]; yc[r][j] = yn[r][j]; }
            }
            __syncthreads();
            if (w == 0) route_assign(swave, p, rt_e, rt_w, rt_base, rb);
            __syncthreads();
        }
        SEAM(PH_LN1ROUTE);
    }
    if (IN(PH_UP)) for (int rep_ = 0; rep_ <= NREP(PH_UP); ++rep_) { if (rep_) xcd_barrier(swave, bar); asm volatile("; MARK PH_UP"); const P p = load_p();
        moe_tables(swave, p, lds);
        const LAS int* tstart = (const LAS int*)(lds + LDSCTL_OFF) + LC_TSTART; const LAS int* lcnt = (const LAS int*)(lds + LDSCTL_OFF) + LC_CNT;
        unsigned* ready = WSP(unsigned, WS_CTL) + CW_RDY;
        {
            pg8::Gemm g{WSP(bf16, WS_B), WSP(bf16, WS_WUPT), D, 0, (size_t)1024 * D * 2, WSP(int, WS_LIST)};
            pg8::MoeOrder S{tstart, lcnt, G, bx, 4};
            pg8::EpiUp E{p.ws};
            pg8::gemm_phase<pg8::EpiUp, pg8::MoeOrder, true, true, true>(swave, lds, g, S, E);
            if (otid(swave) == 0) { __builtin_amdgcn_fence(__ATOMIC_RELEASE, "agent"); asm volatile("s_waitcnt vmcnt(0)" ::: "memory");
                pg8::Unit u; for (int i = 0; S.next(i, u); ++i) __hip_atomic_fetch_add(ready + 64 * u.pm, 1u, __ATOMIC_RELAXED, __HIP_MEMORY_SCOPE_AGENT); }
        }
        {
            const int ntile = __builtin_amdgcn_readfirstlane(tstart[NE]), R = 4 * ntile - 2 * G > 0 ? 4 * ntile - 2 * G : 0;
            pg8::Gemm g{WSP(bf16, WS_ACT), WSP(bf16, WS_WDNT), HID, 0, (size_t)1024 * HID * 2, nullptr};
            pg8::MoeDownOrder S{tstart, lcnt, G, (bx + G - R % G) % G, ntile, G / 4, R / 4, ready};
            pg8::EpiDown E{p.ws};
            pg8::gemm_phase<pg8::EpiDown, pg8::MoeDownOrder, true, true, false>(swave, lds, g, S, E);
        }
        SEAM(PH_UP);
    }
    if (IN(PH_FINAL)) for (int rep_ = 0; rep_ <= NREP(PH_FINAL); ++rep_) { if (rep_) xcd_barrier(swave, bar); asm volatile("; MARK PH_FINAL"); const P p = load_p();
        moe_tables(swave, p, lds);
        const int lane = otid(swave) & 63, gw = bx * NWAVES + (otid(swave) >> 6), NGW = G * NWAVES;
        float pscale = 1.f, pspike = 0.f;
#ifdef PROBE_A
        { const unsigned long long* ts = (const unsigned long long*)(WSP(unsigned, WS_CTL) + 65536 + bx * 32);
          const unsigned long long a0 = __hip_atomic_load(ts + PROBE_A, __ATOMIC_RELAXED, __HIP_MEMORY_SCOPE_AGENT), a1 = __hip_atomic_load(ts + PROBE_A + 1, __ATOMIC_RELAXED, __HIP_MEMORY_SCOPE_AGENT);
          const unsigned long long b0 = __hip_atomic_load(ts + PROBE_B, __ATOMIC_RELAXED, __HIP_MEMORY_SCOPE_AGENT), b1 = __hip_atomic_load(ts + PROBE_B + 1, __ATOMIC_RELAXED, __HIP_MEMORY_SCOPE_AGENT);
          pscale = 1.f + sqrtf((float)(a1 - a0) * 1e-5f); pspike = (float)(b1 - b0) * 0.1f; }
#endif
#pragma unroll 1
        for (int row = 4 * gw; row < T; row += 4 * NGW) { asm volatile("" ::: "memory"); final_rows<4>(p, (const LAS int*)(lds + LDSCTL_OFF) + LC_TSTART, row, lane, pscale, row == 0 ? pspike : 0.f); }
    }
#undef SEAM
#undef IN
}

#ifndef NAIVE_MASK
#define NAIVE_MASK 0
#endif
#ifndef MK_SPLIT
#define MK_SPLIT 0
#endif
static void launch_mk(const P& p, int lo, int hi, int li, hipStream_t s) {
    Args a{}; a.p = p; a.ph_lo = lo; a.ph_hi = hi; a.li = li; a.pad = 0;
    void* kargs[] = {&a};
    const hipError_t e = hipLaunchCooperativeKernel((const void*)mk_fwd, dim3(256), dim3(NTHR), kargs, LDS_BYTES, s);
    if (e != hipSuccess) fprintf(stderr, "kernel_launch: cooperative launch failed: %s\n", hipGetErrorString(e));
}
extern "C" void kernel_launch(void* const* d_in, const int* in_sizes, int n_in, void* d_out, int out_size, void* d_ws, size_t ws_size, hipStream_t stream) {
    if (n_in != 22 || ws_size < WS_END) { fprintf(stderr, "kernel_launch: unexpected n_in %d / ws %zu\n", n_in, ws_size); return; }
    static int inited = 0;
    if (!inited) { inited = 1;
        if (hipFuncSetAttribute((const void*)mk_fwd, hipFuncAttributeMaxDynamicSharedMemorySize, LDS_BYTES) != hipSuccess) fprintf(stderr, "kernel_launch: hipFuncSetAttribute failed\n"); }
    P p{};
    const float** f = (const float**)&p;
    for (int i = 0; i < 22; ++i) f[i] = (const float*)d_in[i];
    p.out = (float*)d_out; p.ws = (unsigned char*)d_ws;
    (void)hipMemsetAsync((char*)d_ws + WS_CTL, 0, 1 * MiB, stream);
    int li = 0;
    for (int k = 0; k < PH_N;) {
        int e = k + 1;
        if (!MK_SPLIT) while (e < PH_N && !((NAIVE_MASK >> e) & 1)) ++e;
        launch_mk(p, k, e, li++, stream);
        k = e;
    }
}
```

```cpp
#include <hip/hip_runtime.h>
#include <cstdio>
#include <cstdint>

typedef unsigned short bf16;
typedef float f32x4 __attribute__((ext_vector_type(4)));

constexpr int NB = 2, SEQ = 8192, D = 1024, T = NB * SEQ;
constexpr int NIN = 3072;
constexpr int NE = 32, HID = 512;
constexpr float ALPHA = 1.189207115002721f;
constexpr float LN_EPS = 1e-5f, RMS_EPS = 1e-6f;
constexpr int ROWS_PAD = 40960;

constexpr size_t MiB = 1u << 20;
constexpr size_t WS_CTL = 0;
constexpr size_t WS_SMALL = 1 * MiB;
constexpr size_t WS_LIST = 2 * MiB, WS_WLIST = 4 * MiB;
constexpr size_t WS_WINT = 6 * MiB, WS_WOUTT = 12 * MiB, WS_WUPT = 14 * MiB, WS_WDNT = 78 * MiB;
constexpr size_t WS_B = 110 * MiB;
constexpr size_t WS_QS = 142 * MiB, WS_V = 158 * MiB, WS_OG = 174 * MiB, WS_LOGF = 190 * MiB, WS_ZG = 222 * MiB;
constexpr size_t WS_Y = 142 * MiB, WS_ACT = 206 * MiB;
constexpr size_t WS_SLOC = 254 * MiB, WS_SSTART = 270 * MiB;
constexpr size_t WS_X1 = 286 * MiB, WS_Y2 = 350 * MiB, WS_END = 430 * MiB;
constexpr size_t SM_ADA = 0, SM_LB = 64 * 1024, SM_ROWBASE = 128 * 1024, SM_SGSTAT = 256 * 1024, SM_TOKE = 512 * 1024, SM_TOKS = 640 * 1024, SM_DTOT = 768 * 1024;
constexpr int CW_CNT = 1024;
constexpr int CW_ADA = 1088;
constexpr int CW_RDY = 131072;
constexpr int CW_MIXA = 2048, CW_MIXB = 2560;
constexpr int CW_PREPQ = 1152;

struct P {
    const float *x, *c, *w_ada, *b_ada, *w_in, *lb_logits, *hg_norm_w, *sg_ln_g, *sg_ln_b, *sg_w, *sg_b, *w_out, *ln1_g, *ln1_b,
        *rg_w, *rg_b, *re_w, *re_b, *w_up, *w_down, *ln2_g, *ln2_b;
    float* out; unsigned char* ws;
};

__device__ __forceinline__ float bf2f(bf16 b) { return __uint_as_float(((unsigned)b) << 16); }
__device__ __forceinline__ bf16 f2bf(float f) { unsigned u = __float_as_uint(f); return (bf16)((u + 0x7fffu + ((u >> 16) & 1u)) >> 16); }
__device__ __forceinline__ float silu_f(float x) { return x / (1.f + __expf(-x)); }
__device__ __forceinline__ float gelu_f(float x) { return 0.5f * x * (1.f + erff(x * 0.70710678118654752f)); }
__device__ __forceinline__ float wave_sum(float v) {
#pragma unroll
    for (int o = 1; o < 64; o <<= 1) v += __shfl_xor(v, o);
    return v;
}
#define WSP(type, off) ((type*)(p.ws + (off)))

__device__ __forceinline__ int updst(int n) { const int part = n >> 9, q = n & 511; return 256 * (q >> 7) + 128 * part + (q & 127); }

#define LAS __attribute__((address_space(3)))
#define GAS __attribute__((address_space(1)))
typedef short bf16x8 __attribute__((ext_vector_type(8)));
typedef unsigned u32x4 __attribute__((ext_vector_type(4)));
typedef unsigned u32x2 __attribute__((ext_vector_type(2)));
typedef float f32x2 __attribute__((ext_vector_type(2)));
constexpr int NWAVES = 8, NTHR = 512;
template <class Tv> __device__ __forceinline__ Tv ldg(const void* base, unsigned off) { return *(const Tv*)((const char*)base + off); }
template <class Tv> __device__ __forceinline__ void stg(void* base, unsigned off, Tv v) { *(Tv*)((char*)base + off) = v; }
template <class Tv> __device__ __forceinline__ Tv ldg_nt(const void* base, unsigned off) { return __builtin_nontemporal_load((const Tv*)((const char*)base + off)); }
template <class Tv> __device__ __forceinline__ void stg_nt(void* base, unsigned off, Tv v) { __builtin_nontemporal_store(v, (Tv*)((char*)base + off)); }
#define DPP_ADD(v, ctrl, rmask) v += __int_as_float(__builtin_amdgcn_update_dpp(0, __float_as_int(v), ctrl, rmask, 0xF, false))
__device__ __forceinline__ float wave_sum_dpp(float v) {
    DPP_ADD(v, 0xB1, 0xF);
    DPP_ADD(v, 0x4E, 0xF);
    DPP_ADD(v, 0x141, 0xF);
    DPP_ADD(v, 0x140, 0xF);
    DPP_ADD(v, 0x142, 0xA);
    DPP_ADD(v, 0x143, 0xC);
    return __int_as_float(__builtin_amdgcn_readlane(__float_as_int(v), 63));
}
__device__ __forceinline__ int otid(int swave) { int l; asm volatile("v_mbcnt_lo_u32_b32 %0, -1, 0\n\tv_mbcnt_hi_u32_b32 %0, -1, %0" : "=v"(l)); return (swave << 6) | l; }
constexpr int RING_BYTES = 131072, LDSCTL_OFF = 147456, LDS_BYTES = 155648;
constexpr int LC_BAR = 0, LC_TSTART = 64  , LC_CNT = 128  , LC_RT = 256  , LC_LGS = 576  , LC_Q = 32  ;

__device__ __forceinline__ unsigned cvt_pk_bf16(float lo, float hi) { unsigned r; asm volatile("v_cvt_pk_bf16_f32 %0, %1, %2" : "=v"(r) : "v"(lo), "v"(hi)); return r; }
__device__ __forceinline__ float fast_sigmoid(float x) { return __builtin_amdgcn_rcpf(1.f + __expf(-x)); }
__device__ __forceinline__ f32x2 gelu_pk(f32x2 v) {
    const f32x2 av = __builtin_elementwise_abs(v), d = av * 0.2316418882f + 1.0f;
    f32x2 t; t.x = __builtin_amdgcn_rcpf(d.x); t.y = __builtin_amdgcn_rcpf(d.y);
    f32x2 q = t * 0.5307027145f + (-0.7265760135f); q = q * t + 0.7107068705f; q = q * t + (-0.142248368f); q = q * t + 0.127414796f; q = q * t;
    const f32x2 s = (v * v) * (-0.72134752044f);
    f32x2 e; e.x = __builtin_amdgcn_exp2f(s.x); e.y = __builtin_amdgcn_exp2f(s.y);
    const f32x2 m = v * (q * e), r = v - m;
    f32x2 o; o.x = v.x < 0.f ? m.x : r.x; o.y = v.y < 0.f ? m.y : r.y; return o;
}

namespace pg8 {
constexpr int BM = 256, BK = 64, HALF = 128, HTB = HALF * BK * 2, STAGE_BYTES = 8 * HTB, NXCD = 8, WGM = 8;
__host__ __device__ __forceinline__ int lds_byte(int r, int c) { const int st = (r >> 4) * 2 + (c >> 5), rr = r & 15, cc = c & 31, ob = rr * 64 + cc * 2; return st * 1024 + (ob ^ (((ob >> 9) & 1) << 5)); }
__host__ __device__ __forceinline__ void stage_rc(int b, int& R, int& C) { const int st = b / 1024, sb = b % 1024, swz = sb ^ (((sb >> 9) & 1) << 5); R = (st >> 1) * 16 + swz / 64; C = (st & 1) * 32 + (swz % 64) / 2; }
__host__ __device__ __forceinline__ int perm32(int rho) { const int n = rho >> 4, i = rho & 15; return 8 * (i >> 2) + 4 * n + (i & 3); }

struct Unit { int pm, pn, e, nvalid, r0, pad; };
struct Gemm { const bf16* A; const bf16* Bt; int K, pad; size_t bstride; const int* list; };

struct StaticOrder {
    int nM, nN, nwg, G, c;
    __device__ void init(int M, int N, int G_, int c_) { nM = M / BM; nN = N / BM; nwg = nM * nN; G = G_; c = c_; }
    __device__ bool next(int i, Unit& u) const {
        const long L = (long)i * G + c; if (L >= nwg) return false;
        int wgid = (int)L; { const int q = nwg / NXCD, r = nwg % NXCD, xcd = wgid % NXCD, off = wgid / NXCD; wgid = (xcd < r ? xcd * (q + 1) : r * (q + 1) + (xcd - r) * q) + off; }
        const int nig = WGM * nN, gid = wgid / nig, fm = gid * WGM, gsz = (nM - fm) < WGM ? (nM - fm) : WGM;
        u.pm = fm + ((wgid % nig) % gsz); u.pn = (wgid % nig) / gsz; u.e = 0; u.nvalid = 256; u.r0 = 0; u.pad = 0; return true;
    }
    __device__ __forceinline__ void a_ready(int, const Unit&) const {}
};
struct MoeOrder {
    const LAS int* tstart; const LAS int* cnt; int G, c, nN;
    __device__ bool next(int i, Unit& u) const {
        const int ntile = __builtin_amdgcn_readfirstlane(tstart[NE]);
        int tile;
        if (G == 256 && nN == 4) {
            tile = 64 * i + (c & 7) + 8 * (c >> 5); u.pn = (c >> 3) & 3; if (tile >= ntile) return false;
        } else { const int L = i * G + c; if (L >= ntile * nN) return false; tile = L / nN; u.pn = L % nN; }
        u.pm = tile;
        int e = 0;
#pragma unroll 1
        for (int k = 1; k < NE; ++k) e = (tile >= tstart[k]) ? k : e;
        e = __builtin_amdgcn_readfirstlane(e); u.e = e; u.pm = __builtin_amdgcn_readfirstlane(u.pm); u.pn = __builtin_amdgcn_readfirstlane(u.pn);
        u.r0 = __builtin_amdgcn_readfirstlane((tile - tstart[e]) * 256); const int left = __builtin_amdgcn_readfirstlane(cnt[e]) - u.r0; u.nvalid = left < 256 ? left : 256; u.pad = 0; return true;
    }
    __device__ __forceinline__ void a_ready(int, const Unit&) const {}
};
struct MoeDownOrder {
    const LAS int* tstart; const LAS int* cnt; int G, cr, ntile, P, r; unsigned* ready;
    __device__ int tile_of(int idx) const {
        const int ne = 2 * (P - r);
        if (idx < ne) { const int q = idx / (P - r), m = idx - q * (P - r); return q * P + r + m; }
        const int k = idx - ne; if (k < 2 * r) { const int q = k / r, m = k - q * r; return q * P + m; }
        return 2 * P + (k - 2 * r);
    }
    __device__ bool next(int i, Unit& u) const {
        const int d = i * G + cr; if (d >= ntile * 4) return false;
        const int tile = tile_of(d >> 2); u.pn = d & 3; u.pm = tile;
        int e = 0;
#pragma unroll 1
        for (int k = 1; k < NE; ++k) e = (tile >= tstart[k]) ? k : e;
        e = __builtin_amdgcn_readfirstlane(e); u.e = e; u.pm = __builtin_amdgcn_readfirstlane(u.pm); u.pn = __builtin_amdgcn_readfirstlane(u.pn);
        u.r0 = __builtin_amdgcn_readfirstlane((tile - tstart[e]) * 256); const int left = __builtin_amdgcn_readfirstlane(cnt[e]) - u.r0; u.nvalid = left < 256 ? left : 256; u.pad = 0; return true;
    }
    __device__ __forceinline__ void a_ready(int swave, const Unit& u) const {
        if (swave == 0) { unsigned sp = 0;
            while ((unsigned)__builtin_amdgcn_readfirstlane(__hip_atomic_load(ready + 64 * u.pm, __ATOMIC_RELAXED, __HIP_MEMORY_SCOPE_AGENT)) < 4u && ++sp < (1u << 20)) __builtin_amdgcn_s_sleep(2);
            __builtin_amdgcn_fence(__ATOMIC_ACQUIRE, "agent");
            asm volatile("s_waitcnt vmcnt(0)" ::: "memory"); }
        asm volatile("" ::: "memory"); __builtin_amdgcn_s_barrier(); asm volatile("" ::: "memory");
    }
};

#define PG8_LAS LAS
template <class Epi, class Sched, bool ALIGN_EPI, bool SP2, bool GATHER>
__device__ __forceinline__ void gemm_phase(const int swave, PG8_LAS unsigned char* lds, const Gemm g, const Sched& S, const Epi& E) {
    const int tid = otid(swave), wid = __builtin_amdgcn_readfirstlane(tid >> 6), lane = tid & 63, wr = wid >> 2, wc = wid & 3, fr = lane & 15, fq = lane >> 4;
    const int K = g.K, nt = K / BK;
    unsigned voffB[2], vA[2][2], vAn[2][2]; int RA[2], CA[2];
#pragma unroll
    for (int i = 0; i < 2; ++i) { int R, C; stage_rc(tid * 16 + i * 8192, R, C); const int Rb = Epi::PERM ? ((R & ~31) + perm32(R & 31)) : R; RA[i] = R; CA[i] = C;
        voffB[i] = (unsigned)(Rb * K + C) * 2u;
#pragma unroll
        for (int h = 0; h < 2; ++h) { vA[h][i] = (unsigned)((h * HALF + R) * K + C) * 2u; vAn[h][i] = vA[h][i]; } }
    const size_t kstep = (size_t)(BK * 2);
    const size_t hstep = (size_t)HALF * K * 2;
    const size_t tstep = 2 * hstep;
    const unsigned ldsw = (unsigned)wid * 1024u;
    const int aoff = lds_byte(wr * 64 + fr, fq * 8), boff = lds_byte(wc * 32 + fr, fq * 8);
#define PG8_SA(b, h) (((b) * 2 + (h)) * HTB)
#define PG8_SB(b, h) ((4 + (b) * 2 + (h)) * HTB)
#define PG8_STAGE(bufoff, gbase, voff) do { _Pragma("unroll") for (int _i = 0; _i < 2; ++_i) \
        __builtin_amdgcn_global_load_lds((const unsigned*)((const char*)(gbase) + (voff)[_i]), (PG8_LAS unsigned*)(lds + (bufoff) + ldsw + _i * 8192), 16, 0, 0); } while (0)
#define PG8_LDA(dst, b, h) do { _Pragma("unroll") for (int m = 0; m < 4; ++m) _Pragma("unroll") for (int k = 0; k < 2; ++k) dst[m][k] = *(const PG8_LAS bf16x8*)(lds + PG8_SA(b, h) + aoff + m * 2048 + k * 1024); } while (0)
#define PG8_LDB(dst, b, h) do { _Pragma("unroll") for (int n = 0; n < 2; ++n) _Pragma("unroll") for (int k = 0; k < 2; ++k) dst[n][k] = *(const PG8_LAS bf16x8*)(lds + PG8_SB(b, h) + boff + n * 2048 + k * 1024); } while (0)
#define PG8_MMA(ai, bj, At, Bt) do { __builtin_amdgcn_s_setprio(1); _Pragma("unroll") for (int m = 0; m < 4; ++m) _Pragma("unroll") for (int n = 0; n < 2; ++n) _Pragma("unroll") for (int k = 0; k < 2; ++k) \
        acc[ai][bj][m][n] = __builtin_amdgcn_mfma_f32_16x16x32_bf16(Bt[n][k], At[m][k], acc[ai][bj][m][n], 0, 0, 0); __builtin_amdgcn_s_setprio(0); } while (0)
#define PG8_WAIT_V(n) asm volatile("s_waitcnt vmcnt(" #n ")" ::: "memory")
#define PG8_WAIT_L(n) asm volatile("s_waitcnt lgkmcnt(" #n ")" ::: "memory")
#define PG8_BAR __builtin_amdgcn_s_barrier()
#define PG8_SCHED __builtin_amdgcn_sched_barrier(0)
#define PG8_SETV(V, U) do { if constexpr (GATHER) { _Pragma("unroll") for (int _h = 0; _h < 2; ++_h) _Pragma("unroll") for (int _i = 0; _i < 2; ++_i) { const int _r = _h * HALF + RA[_i]; \
        const int _tok = _r < (U).nvalid ? g.list[(size_t)(U).e * T + (U).r0 + _r] : 0; V[_h][_i] = (unsigned)(_tok * K + CA[_i]) * 2u; } } } while (0)
    Unit cur, nxt; int ui = 0;
    if (!S.next(0, cur)) return;
    f32x4 acc[2][2][4][2];
#pragma unroll
    for (int a = 0; a < 2; ++a)
#pragma unroll
        for (int b = 0; b < 2; ++b)
#pragma unroll
            for (int m = 0; m < 4; ++m)
#pragma unroll
                for (int n = 0; n < 2; ++n) acc[a][b][m][n] = (f32x4){0.f, 0.f, 0.f, 0.f};
    bf16x8 At[4][2], B0[2][2], B1[2][2];
    PG8_SETV(vA, cur);
    S.a_ready(swave, cur);
    const char* cA = (const char*)g.A + (GATHER ? (size_t)0 : (size_t)cur.pm * tstep); const char* cB = (const char*)g.Bt + (size_t)cur.e * g.bstride + (size_t)cur.pn * tstep;
    if constexpr (SP2) {
        PG8_STAGE(PG8_SB(0, 0), cB, voffB); PG8_STAGE(PG8_SB(0, 1), cB + hstep, voffB); PG8_STAGE(PG8_SA(0, 0), cA, vA[0]); PG8_STAGE(PG8_SA(0, 1), cA, vA[1]);
        if (wr == 1) PG8_BAR;
        PG8_WAIT_V(2); PG8_BAR;
        PG8_STAGE(PG8_SB(1, 0), cB + kstep, voffB); PG8_STAGE(PG8_SA(1, 0), cA + kstep, vA[0]); PG8_STAGE(PG8_SB(1, 1), cB + hstep + kstep, voffB);
        PG8_WAIT_V(6); PG8_BAR;
    } else {
        PG8_STAGE(PG8_SB(0, 0), cB, voffB); PG8_STAGE(PG8_SA(0, 0), cA, vA[0]); PG8_STAGE(PG8_SB(0, 1), cB + hstep, voffB); PG8_STAGE(PG8_SA(0, 1), cA, vA[1]);
        if (wr == 1) PG8_BAR;
        PG8_WAIT_V(4); PG8_BAR;
        PG8_STAGE(PG8_SB(1, 0), cB + kstep, voffB); PG8_STAGE(PG8_SA(1, 0), cA + kstep, vA[0]); PG8_STAGE(PG8_SB(1, 1), cB + hstep + kstep, voffB);
        PG8_WAIT_V(6); PG8_BAR;
    }
    for (;;) {
        const bool has_next = S.next(ui + 1, nxt);
        if (has_next) PG8_SETV(vAn, nxt);
        const char* nA = has_next ? (const char*)g.A + (GATHER ? (size_t)0 : (size_t)nxt.pm * tstep) : cA; const char* nB = has_next ? (const char*)g.Bt + (size_t)nxt.e * g.bstride + (size_t)nxt.pn * tstep : cB;
        for (int t = 0; t < nt; t += 2) {
            const bool last = (t == nt - 2);
            if (last && has_next) S.a_ready(swave, nxt);
            const char* a1 = cA + (size_t)(t + 1) * kstep;
            const char* a2 = last ? nA : cA + (size_t)(t + 2) * kstep; const char* b2 = last ? nB : cB + (size_t)(t + 2) * kstep;
            const char* a3 = a2 + kstep; const char* b3 = b2 + kstep;
            unsigned v2[2][2];
#pragma unroll
            for (int h = 0; h < 2; ++h)
#pragma unroll
                for (int i = 0; i < 2; ++i) v2[h][i] = (GATHER && last && has_next) ? vAn[h][i] : vA[h][i];
            if constexpr (SP2) {
            PG8_LDB(B0, 0, 0); PG8_LDB(B1, 0, 1); PG8_SCHED; PG8_LDA(At, 0, 0); PG8_STAGE(PG8_SA(1, 1), a1, vA[1]);
            PG8_WAIT_V(8); PG8_WAIT_L(0); PG8_BAR; PG8_MMA(0, 0, At, B0); PG8_MMA(0, 1, At, B1); PG8_BAR; PG8_SCHED;
            PG8_LDA(At, 0, 1); PG8_STAGE(PG8_SB(0, 0), b2, voffB); PG8_STAGE(PG8_SB(0, 1), b2 + hstep, voffB); PG8_STAGE(PG8_SA(0, 0), a2, v2[0]);
            PG8_WAIT_V(8); PG8_WAIT_L(0); PG8_BAR; PG8_MMA(1, 0, At, B0); PG8_MMA(1, 1, At, B1); PG8_BAR; PG8_SCHED;
            PG8_LDB(B0, 1, 0); PG8_LDB(B1, 1, 1); PG8_SCHED; PG8_LDA(At, 1, 0); PG8_STAGE(PG8_SA(0, 1), a2, v2[1]);
            PG8_WAIT_V(8); PG8_WAIT_L(0); PG8_BAR; PG8_MMA(0, 0, At, B0); PG8_MMA(0, 1, At, B1); PG8_BAR; PG8_SCHED;
            PG8_LDA(At, 1, 1); PG8_STAGE(PG8_SB(1, 0), b3, voffB); PG8_STAGE(PG8_SB(1, 1), b3 + hstep, voffB); PG8_STAGE(PG8_SA(1, 0), a3, v2[0]);
            PG8_WAIT_V(8); PG8_WAIT_L(0); PG8_BAR; PG8_MMA(1, 0, At, B0); PG8_MMA(1, 1, At, B1); PG8_BAR; PG8_SCHED;
            } else {
            PG8_LDB(B0, 0, 0); PG8_SCHED; PG8_LDA(At, 0, 0); PG8_STAGE(PG8_SA(1, 1), a1, vA[1]);
            PG8_WAIT_L(8); PG8_BAR; PG8_WAIT_L(0); PG8_MMA(0, 0, At, B0); PG8_BAR; PG8_SCHED;
            PG8_LDB(B1, 0, 1); PG8_STAGE(PG8_SB(0, 0), b2, voffB);
            PG8_BAR; PG8_WAIT_L(0); PG8_MMA(0, 1, At, B1); PG8_BAR;
            PG8_LDA(At, 0, 1); PG8_STAGE(PG8_SA(0, 0), a2, v2[0]);
            PG8_BAR; PG8_WAIT_L(0); PG8_MMA(1, 0, At, B0); PG8_BAR; PG8_SCHED;
            PG8_STAGE(PG8_SB(0, 1), b2 + hstep, voffB);
            PG8_WAIT_V(6); PG8_BAR; PG8_MMA(1, 1, At, B1); PG8_BAR;
            PG8_LDB(B0, 1, 0); PG8_SCHED; PG8_LDA(At, 1, 0); PG8_STAGE(PG8_SA(0, 1), a2, v2[1]);
            PG8_WAIT_L(8); PG8_BAR; PG8_WAIT_L(0); PG8_MMA(0, 0, At, B0); PG8_BAR; PG8_SCHED;
            PG8_LDB(B1, 1, 1); PG8_STAGE(PG8_SB(1, 0), b3, voffB);
            PG8_BAR; PG8_WAIT_L(0); PG8_MMA(0, 1, At, B1); PG8_BAR;
            PG8_LDA(At, 1, 1); PG8_STAGE(PG8_SA(1, 0), a3, v2[0]);
            PG8_BAR; PG8_WAIT_L(0); PG8_MMA(1, 0, At, B0); PG8_BAR; PG8_SCHED;
            PG8_STAGE(PG8_SB(1, 1), b3 + hstep, voffB);
            PG8_WAIT_V(6); PG8_BAR; PG8_MMA(1, 1, At, B1); PG8_BAR;
            }
        }
        if constexpr (ALIGN_EPI) { if (wr == 0) PG8_BAR; }
        E(acc, cur, wr, wc, fr, fq);
        if (!has_next) break;
#pragma unroll
        for (int a = 0; a < 2; ++a)
#pragma unroll
            for (int b = 0; b < 2; ++b)
#pragma unroll
                for (int m = 0; m < 4; ++m)
#pragma unroll
                    for (int n = 0; n < 2; ++n) acc[a][b][m][n] = (f32x4){0.f, 0.f, 0.f, 0.f};
        cur = nxt; cA = nA; cB = nB; ++ui;
        if constexpr (GATHER) {
#pragma unroll
            for (int h = 0; h < 2; ++h)
#pragma unroll
                for (int i = 0; i < 2; ++i) vA[h][i] = vAn[h][i]; }
        if constexpr (ALIGN_EPI) { if (wr == 1) PG8_BAR; }
    }
    PG8_WAIT_V(0);
    if constexpr (!ALIGN_EPI) { if (wr == 0) PG8_BAR; }
    PG8_BAR;
#undef PG8_SA
#undef PG8_SB
#undef PG8_STAGE
#undef PG8_LDA
#undef PG8_LDB
#undef PG8_MMA
#undef PG8_WAIT_V
#undef PG8_WAIT_L
#undef PG8_BAR
#undef PG8_SCHED
#undef PG8_SETV
}

struct EpiInproj {
    static constexpr bool PERM = true;
    unsigned char* ws;
    __device__ __forceinline__ void operator()(const f32x4 (&acc)[2][2][4][2], const Unit& u, int wr, int wc, int fr, int fq) const {
        unsigned char* wsb_ = ws; asm volatile("" : "+v"(wsb_)); GAS unsigned char* wsb = (GAS unsigned char*)wsb_;
        GAS bf16* QVO = (GAS bf16*)(wsb + WS_QS); GAS bf16* ZG = (GAS bf16*)(wsb + WS_ZG); GAS float* LOGF = (GAS float*)(wsb + WS_LOGF); const GAS float* LB = (const GAS float*)(wsb + WS_SMALL + SM_LB);
        const int row0 = u.pm * BM + wr * 64 + fr, seg = u.pn >> 1, cin = (u.pn & 1) * 256 + wc * 32 + 8 * fq;
        if (seg == 1) {
            f32x4 lb[2][2];
#pragma unroll
            for (int bj = 0; bj < 2; ++bj)
#pragma unroll
                for (int n = 0; n < 2; ++n) lb[bj][n] = *(const GAS f32x4*)(LB + cin + bj * HALF + 4 * n);
#pragma unroll
            for (int ai = 0; ai < 2; ++ai)
#pragma unroll
                for (int m = 0; m < 4; ++m) { GAS _Float16* rowp = (GAS _Float16*)LOGF + (size_t)(row0 + ai * HALF + m * 16) * 512 + cin;
#pragma unroll
                    for (int bj = 0; bj < 2; ++bj) { f32x4 o[2];
#pragma unroll
                        for (int n = 0; n < 2; ++n)
#pragma unroll
                            for (int j = 0; j < 4; ++j) { const float l = lb[bj][n][j]; o[n][j] = __logf(l + (1.f - l) * fast_sigmoid(acc[ai][bj][m][n][j])); }
                        typedef _Float16 h8v __attribute__((ext_vector_type(8)));
                        h8v hv8;
#pragma unroll
                        for (int n = 0; n < 2; ++n)
#pragma unroll
                            for (int j = 0; j < 4; ++j) hv8[4 * n + j] = (_Float16)o[n][j];
                        *(GAS h8v*)(rowp + bj * HALF) = hv8; } }
            return;
        }
        if (seg >= 4) {
            const int cz = (u.pn - 8) * 256 + wc * 32 + 8 * fq;
#pragma unroll
            for (int ai = 0; ai < 2; ++ai)
#pragma unroll
                for (int m = 0; m < 4; ++m) { GAS bf16* rowp = ZG + (size_t)(row0 + ai * HALF + m * 16) * 1024 + cz;
#pragma unroll
                    for (int bj = 0; bj < 2; ++bj) { const f32x4 v0 = acc[ai][bj][m][0], v1 = acc[ai][bj][m][1];
                        const f32x2 a = gelu_pk((f32x2){v0[0], v0[1]}), b = gelu_pk((f32x2){v0[2], v0[3]}), c = gelu_pk((f32x2){v1[0], v1[1]}), d = gelu_pk((f32x2){v1[2], v1[3]});
                        u32x4 w; w.x = cvt_pk_bf16(a.x, a.y); w.y = cvt_pk_bf16(b.x, b.y); w.z = cvt_pk_bf16(c.x, c.y); w.w = cvt_pk_bf16(d.x, d.y);
                        *(GAS u32x4*)(rowp + bj * HALF) = w; } }
            return;
        }
        GAS bf16* base = QVO + (size_t)(seg == 0 ? 0 : seg - 1) * (8u << 20); const bool act = seg != 2;
#pragma unroll
        for (int ai = 0; ai < 2; ++ai)
#pragma unroll
            for (int m = 0; m < 4; ++m) { GAS bf16* rowp = base + (size_t)(row0 + ai * HALF + m * 16) * 512 + cin;
#pragma unroll
                for (int bj = 0; bj < 2; ++bj) { f32x4 v0 = acc[ai][bj][m][0], v1 = acc[ai][bj][m][1];
                    if (act) {
#pragma unroll
                        for (int j = 0; j < 4; ++j) { v0[j] = v0[j] * fast_sigmoid(v0[j]); v1[j] = v1[j] * fast_sigmoid(v1[j]); } }
                    u32x4 w; w.x = cvt_pk_bf16(v0[0], v0[1]); w.y = cvt_pk_bf16(v0[2], v0[3]); w.z = cvt_pk_bf16(v1[0], v1[1]); w.w = cvt_pk_bf16(v1[2], v1[3]);
                    *(GAS u32x4*)(rowp + bj * HALF) = w; } }
    }
};
struct EpiBf16 {
    static constexpr bool PERM = true;
    unsigned char* ws; size_t off; int ldc;
    __device__ __forceinline__ void operator()(const f32x4 (&acc)[2][2][4][2], const Unit& u, int wr, int wc, int fr, int fq) const {
        unsigned char* wsb_ = ws; asm volatile("" : "+v"(wsb_)); GAS unsigned char* wsb = (GAS unsigned char*)wsb_; GAS bf16* O = (GAS bf16*)(wsb + off);
        const int row0 = u.pm * BM + wr * 64 + fr, col0 = u.pn * BM + wc * 32 + 8 * fq;
#pragma unroll
        for (int ai = 0; ai < 2; ++ai)
#pragma unroll
            for (int m = 0; m < 4; ++m) { GAS bf16* rowp = O + (size_t)(row0 + ai * HALF + m * 16) * ldc + col0;
#pragma unroll
                for (int bj = 0; bj < 2; ++bj) { const f32x4 v0 = acc[ai][bj][m][0], v1 = acc[ai][bj][m][1];
                    u32x4 w; w.x = cvt_pk_bf16(v0[0], v0[1]); w.y = cvt_pk_bf16(v0[2], v0[3]); w.z = cvt_pk_bf16(v1[0], v1[1]); w.w = cvt_pk_bf16(v1[2], v1[3]);
                    *(GAS u32x4*)(rowp + bj * HALF) = w; } }
    }
};
struct EpiUp {
    static constexpr bool PERM = true;
    unsigned char* ws;
    __device__ __forceinline__ void operator()(const f32x4 (&acc)[2][2][4][2], const Unit& u, int wr, int wc, int fr, int fq) const {
        unsigned char* wsb_ = ws; asm volatile("" : "+v"(wsb_)); GAS unsigned char* wsb = (GAS unsigned char*)wsb_; GAS bf16* ACT = (GAS bf16*)(wsb + WS_ACT);
        const int row0 = u.pm * BM + wr * 64 + fr, col0 = u.pn * HALF + wc * 32 + 8 * fq;
#pragma unroll
        for (int ai = 0; ai < 2; ++ai)
#pragma unroll
            for (int m = 0; m < 4; ++m) { GAS bf16* rowp = ACT + (size_t)(row0 + ai * HALF + m * 16) * HID + col0;
                f32x4 o0, o1;
#pragma unroll
                for (int j = 0; j < 4; ++j) { const float g0 = acc[ai][0][m][0][j], g1 = acc[ai][0][m][1][j]; o0[j] = g0 * fast_sigmoid(g0) * acc[ai][1][m][0][j]; o1[j] = g1 * fast_sigmoid(g1) * acc[ai][1][m][1][j]; }
                u32x4 w; w.x = cvt_pk_bf16(o0[0], o0[1]); w.y = cvt_pk_bf16(o0[2], o0[3]); w.z = cvt_pk_bf16(o1[0], o1[1]); w.w = cvt_pk_bf16(o1[2], o1[3]);
                *(GAS u32x4*)rowp = w; }
    }
};
struct EpiDown {
    static constexpr bool PERM = true;
    unsigned char* ws;
    __device__ __forceinline__ void operator()(const f32x4 (&acc)[2][2][4][2], const Unit& u, int wr, int wc, int fr, int fq) const {
        unsigned char* wsb_ = ws; asm volatile("" : "+v"(wsb_)); GAS unsigned char* wsb = (GAS unsigned char*)wsb_; GAS bf16* Y2 = (GAS bf16*)(wsb + WS_Y2); const GAS float* WL = (const GAS float*)(wsb + WS_WLIST);
        const int rt0 = wr * 64 + fr, col0 = u.pn * BM + wc * 32 + 8 * fq;
#pragma unroll
        for (int ai = 0; ai < 2; ++ai)
#pragma unroll
            for (int m = 0; m < 4; ++m) { const int rt = rt0 + ai * HALF + m * 16; const float w8 = rt < u.nvalid ? WL[(size_t)u.e * T + u.r0 + rt] : 0.f;
                GAS bf16* rowp = Y2 + (size_t)(u.pm * BM + rt) * D + col0;
#pragma unroll
                for (int bj = 0; bj < 2; ++bj) { const f32x4 v0 = acc[ai][bj][m][0] * w8, v1 = acc[ai][bj][m][1] * w8;
                    u32x4 w; w.x = cvt_pk_bf16(v0[0], v0[1]); w.y = cvt_pk_bf16(v0[2], v0[3]); w.z = cvt_pk_bf16(v1[0], v1[1]); w.w = cvt_pk_bf16(v1[2], v1[3]);
                    *(GAS u32x4*)(rowp + bj * HALF) = w; } }
    }
};
}


__device__ __forceinline__ f32x4 mma16(bf16x8 a, bf16x8 b, f32x4 c) { return __builtin_amdgcn_mfma_f32_16x16x32_bf16(a, b, c, 0, 0, 0); }
__device__ __forceinline__ bf16x8 frag(const LAS bf16* X, int stride, int rb, int ks, int lane) { return *(const LAS bf16x8*)(X + (rb * 16 + (lane & 15)) * stride + ks * 32 + 8 * (lane >> 4)); }
constexpr int MX_QD = 0, MX_KD = 17408, MX_KDT = 34816, MX_VT = 53248, MX_PT = 71680, MX_STT = 80896, MX_SMALL = 115712;
constexpr int SD = 136, SS = 72, SO = 132;
template <int MODE> __device__ __forceinline__ void hgrn_item(const int swave, const P& p, LAS unsigned char* lds, int item) {
    const int tid = otid(swave), lane = tid & 63, w = __builtin_amdgcn_readfirstlane(tid >> 6), q4 = lane >> 4, r16 = lane & 15;
    const int bh = item >> 5, sc = item & 31, b = bh >> 2, h = bh & 3;
    const size_t row0 = (size_t)b * SEQ + (size_t)sc * 256;
    LAS bf16* QD = (LAS bf16*)(lds + MX_QD); LAS bf16* KD = (LAS bf16*)(lds + MX_KD); LAS bf16* KDT = (LAS bf16*)(lds + MX_KDT); LAS bf16* VT = (LAS bf16*)(lds + MX_VT);
    LAS bf16* PT = (LAS bf16*)(lds + MX_PT); LAS bf16* STT = (LAS bf16*)(lds + MX_STT); LAS float* O = (LAS float*)(lds + MX_QD);
    LAS float* tot = (LAS float*)(lds + MX_SMALL); LAS float* ecm = tot + 1024; LAS float* elast = ecm + 128; LAS float* efac = elast + 128;
    const bf16* QS = WSP(bf16, WS_QS); const _Float16* LF = WSP(_Float16, WS_LOGF); const bf16* VV = WSP(bf16, WS_V); const bf16* OG = WSP(bf16, WS_OG); bf16* YC = WSP(bf16, WS_B);
    const int cp = tid & 63, g = tid >> 6;
    f32x4 S[8];
#pragma unroll
    for (int db = 0; db < 8; ++db) {
        if (MODE == 1) {
#pragma unroll
            for (int r = 0; r < 4; ++r) S[db][r] = WSP(float, WS_SSTART)[(size_t)item * 16384 + (16 * w + 4 * q4 + r) * 128 + 16 * db + r16];
        } else S[db] = (f32x4){0.f, 0.f, 0.f, 0.f}; }
    f32x2 lastsum = (f32x2){0.f, 0.f};
    unsigned lf2[8], q2[8], v2[8];
    unsigned ogp[8];
#define HG_LOAD(c_) do { const size_t ob_ = (row0 + 64 * (c_)) * 512 + h * 128; const unsigned lo_ = (unsigned)(8 * g * 512 + 2 * cp);   \
        _Pragma("unroll") for (int i = 0; i < 8; ++i) { lf2[i] = ldg<unsigned>(LF + ob_, (lo_ + i * 512) * 2u); v2[i] = ldg<unsigned>(VV + ob_, (lo_ + i * 512) * 2u); q2[i] = MODE == 1 ? ldg<unsigned>(QS + ob_, (lo_ + i * 512) * 2u) : 0u; } } while (0)
#define HG_LOADG(c_) do { if (MODE == 1) { _Pragma("unroll") for (int rr = 0; rr < 8; ++rr) ogp[rr] = ldg<unsigned>(OG + (row0 + 64 * (c_) + 8 * w + rr) * 512 + h * 128, (unsigned)lane * 4u); } } while (0)
#define F16LO(u) ((float)__builtin_bit_cast(_Float16, (unsigned short)((u) & 0xffffu)))
#define F16HI(u) ((float)__builtin_bit_cast(_Float16, (unsigned short)((u) >> 16)))
    HG_LOAD(0);
#pragma unroll 1
    for (int c = 0; c < 4; ++c) {
        f32x2 lfv[8]; f32x2 run = (f32x2){0.f, 0.f};
#pragma unroll
        for (int i = 0; i < 8; ++i) { lfv[i] = (f32x2){F16LO(lf2[i]), F16HI(lf2[i])}; run += lfv[i]; }
        *(LAS f32x2*)(tot + g * 128 + 2 * cp) = run;
        __syncthreads();
        f32x2 cstart = (f32x2){0.f, 0.f}, cmid = (f32x2){0.f, 0.f}, last = (f32x2){0.f, 0.f};
#pragma unroll
        for (int gg = 0; gg < 8; ++gg) { const f32x2 t = *(const LAS f32x2*)(tot + gg * 128 + 2 * cp); if (gg < g) cstart += t; if (gg < 4) cmid += t; last += t; }
        if (g == 0) { *(LAS f32x2*)(ecm + 2 * cp) = (f32x2){__expf(cmid.x), __expf(cmid.y)}; *(LAS f32x2*)(elast + 2 * cp) = (f32x2){__expf(last.x), __expf(last.y)};
                      *(LAS f32x2*)(efac + 2 * cp) = (f32x2){__expf(last.x - cmid.x), __expf(last.y - cmid.y)}; lastsum += last; }
        {
            f32x2 cum = cstart; float kda[8], kdb[8];
#pragma unroll
            for (int i = 0; i < 8; ++i) { cum += lfv[i];
                kda[i] = (1.f - __expf(lfv[i].x)) * __expf(fminf(cmid.x - cum.x, 80.f)); kdb[i] = (1.f - __expf(lfv[i].y)) * __expf(fminf(cmid.y - cum.y, 80.f));
                if (MODE == 1) { const float qa = __uint_as_float(q2[i] << 16) * __expf(fminf(cum.x - cmid.x, 80.f)), qb = __uint_as_float(q2[i] & 0xffff0000u) * __expf(fminf(cum.y - cmid.y, 80.f));
                    *(LAS unsigned*)(QD + (8 * g + i) * SD + 2 * cp) = cvt_pk_bf16(qa, qb); *(LAS unsigned*)(KD + (8 * g + i) * SD + 2 * cp) = cvt_pk_bf16(kda[i], kdb[i]); } }
            *(LAS u32x4*)(KDT + (2 * cp) * SS + 8 * g) = (u32x4){cvt_pk_bf16(kda[0], kda[1]), cvt_pk_bf16(kda[2], kda[3]), cvt_pk_bf16(kda[4], kda[5]), cvt_pk_bf16(kda[6], kda[7])};
            *(LAS u32x4*)(KDT + (2 * cp + 1) * SS + 8 * g) = (u32x4){cvt_pk_bf16(kdb[0], kdb[1]), cvt_pk_bf16(kdb[2], kdb[3]), cvt_pk_bf16(kdb[4], kdb[5]), cvt_pk_bf16(kdb[6], kdb[7])};
            *(LAS u32x4*)(VT + (2 * cp) * SS + 8 * g) = (u32x4){(v2[0] & 0xffffu) | (v2[1] << 16), (v2[2] & 0xffffu) | (v2[3] << 16), (v2[4] & 0xffffu) | (v2[5] << 16), (v2[6] & 0xffffu) | (v2[7] << 16)};
            *(LAS u32x4*)(VT + (2 * cp + 1) * SS + 8 * g) = (u32x4){(v2[0] >> 16) | (v2[1] & 0xffff0000u), (v2[2] >> 16) | (v2[3] & 0xffff0000u), (v2[4] >> 16) | (v2[5] & 0xffff0000u), (v2[6] >> 16) | (v2[7] & 0xffff0000u)};
        }
        __syncthreads();
        if (c < 3) HG_LOAD(c + 1);
        f32x4 o[4]; const int tb = w & 3, vb0 = (w >> 2) * 4;
        if (MODE == 1) {
#pragma unroll
            for (int db = 0; db < 8; ++db) { const float e = ecm[16 * db + r16];
#pragma unroll
                for (int r = 0; r < 4; ++r) STT[(16 * w + 4 * q4 + r) * SD + 16 * db + r16] = f2bf(S[db][r] * e); }
#pragma unroll
            for (int k = 0; k < 2; ++k) { const int tile = w + 8 * k, stb = tile >> 2, ssb = tile & 3; f32x4 a = (f32x4){0.f, 0.f, 0.f, 0.f};
                if (ssb <= stb) {
#pragma unroll
                    for (int ks = 0; ks < 4; ++ks) a = mma16(frag(QD, SD, stb, ks, lane), frag(KD, SD, ssb, ks, lane), a); }
#pragma unroll
                for (int r = 0; r < 4; ++r) { const int t = stb * 16 + 4 * q4 + r, s_ = ssb * 16 + r16; PT[t * SS + s_] = (s_ <= t) ? f2bf(a[r]) : (bf16)0; } }
            __syncthreads();
            bf16x8 ap[2], aq[4];
#pragma unroll
            for (int ks = 0; ks < 2; ++ks) ap[ks] = frag(PT, SS, tb, ks, lane);
#pragma unroll
            for (int ks = 0; ks < 4; ++ks) aq[ks] = frag(QD, SD, tb, ks, lane);
#pragma unroll
            for (int j = 0; j < 4; ++j) { f32x4 a = (f32x4){0.f, 0.f, 0.f, 0.f};
#pragma unroll
                for (int ks = 0; ks < 2; ++ks) a = mma16(ap[ks], frag(VT, SS, vb0 + j, ks, lane), a);
#pragma unroll
                for (int ks = 0; ks < 4; ++ks) a = mma16(aq[ks], frag(STT, SD, vb0 + j, ks, lane), a);
                o[j] = a; }
        }
        {
            bf16x8 av[2];
#pragma unroll
            for (int ks = 0; ks < 2; ++ks) av[ks] = frag(VT, SS, w, ks, lane);
#pragma unroll
            for (int db = 0; db < 8; ++db) { f32x4 u = (f32x4){0.f, 0.f, 0.f, 0.f};
#pragma unroll
                for (int ks = 0; ks < 2; ++ks) u = mma16(av[ks], frag(KDT, SS, db, ks, lane), u);
                const float el = elast[16 * db + r16], ef = efac[16 * db + r16];
                S[db] = S[db] * el + u * ef; }
        }
        HG_LOADG(c);
        if (MODE == 1) {
            __syncthreads();
#pragma unroll
            for (int j = 0; j < 4; ++j)
#pragma unroll
                for (int r = 0; r < 4; ++r) O[(tb * 16 + 4 * q4 + r) * SO + (vb0 + j) * 16 + r16] = o[j][r];
            __syncthreads();
            const f32x2 gw = ldg<f32x2>(p.hg_norm_w, (unsigned)lane * 8u);
#pragma unroll
            for (int rr = 0; rr < 8; ++rr) { const int t = 8 * w + rr; const size_t row = row0 + 64 * c + t;
                const f32x2 ov = *(const LAS f32x2*)(O + t * SO + 2 * lane);
                const float ss = wave_sum_dpp(ov.x * ov.x + ov.y * ov.y); const float rs = rsqrtf(ss * (1.f / 128.f) + RMS_EPS);
                const float y0 = ov.x * rs * gw.x * __uint_as_float(ogp[rr] << 16), y1 = ov.y * rs * gw.y * __uint_as_float(ogp[rr] & 0xffff0000u);
                stg<unsigned>(YC + row * D + h * 128, (unsigned)lane * 4u, cvt_pk_bf16(y0, y1)); }
        }
    }
    if (MODE == 0) {
#pragma unroll
        for (int db = 0; db < 8; ++db)
#pragma unroll
            for (int r = 0; r < 4; ++r) __hip_atomic_store(WSP(float, WS_SLOC) + (size_t)item * 16384 + (16 * w + 4 * q4 + r) * 128 + 16 * db + r16, S[db][r], __ATOMIC_RELAXED, __HIP_MEMORY_SCOPE_AGENT);
        if (g == 0) { __hip_atomic_store(WSP(float, WS_SMALL + SM_DTOT) + item * 128 + 2 * cp, __expf(lastsum.x), __ATOMIC_RELAXED, __HIP_MEMORY_SCOPE_AGENT); __hip_atomic_store(WSP(float, WS_SMALL + SM_DTOT) + item * 128 + 2 * cp + 1, __expf(lastsum.y), __ATOMIC_RELAXED, __HIP_MEMORY_SCOPE_AGENT); }
    }
    __syncthreads();
#undef HG_LOAD
#undef HG_LOADG
#undef F16LO
#undef F16HI
}
__device__ __forceinline__ void hgrn_scan(const P& p, int gid) {
    const int bh = gid >> 14, idx = gid & 16383, d = idx & 127;
    const float* SL = WSP(float, WS_SLOC) + (size_t)bh * 32 * 16384 + idx; float* ST = WSP(float, WS_SSTART) + (size_t)bh * 32 * 16384 + idx; const float* DT = WSP(float, WS_SMALL + SM_DTOT) + bh * 32 * 128 + d;
    float s = 0.f;
#pragma unroll 8
    for (int sc = 0; sc < 32; ++sc) { __hip_atomic_store(ST + (size_t)sc * 16384, s, __ATOMIC_RELAXED, __HIP_MEMORY_SCOPE_AGENT); s = s * DT[sc * 128] + SL[(size_t)sc * 16384]; }
}
__device__ __forceinline__ void sg_item(const int swave, const P& p, LAS unsigned char* lds, int item) {
    const int tid = otid(swave), lane = tid & 63, w = __builtin_amdgcn_readfirstlane(tid >> 6), q4 = lane >> 4, r16 = lane & 15;
    const int b = item >> 7, n = (item >> 1) & 63, gp = item & 1; const size_t row0 = (size_t)b * SEQ + (size_t)n * 128;
    LAS bf16* VNT = (LAS bf16*)lds; LAS bf16* WT = (LAS bf16*)(lds + 34816); LAS float* mean = (LAS float*)(lds + 69632); LAS float* rstd = mean + 128; LAS float* OM = (LAS float*)(lds + 71680);
    const bf16* ZG = WSP(bf16, WS_ZG); bf16* YC = WSP(bf16, WS_B);
    {
        bf16x8 z[16];
#pragma unroll
        for (int rr = 0; rr < 16; ++rr) z[rr] = ldg<bf16x8>(ZG + (row0 + 16 * w + rr) * 1024 + 512, (unsigned)lane * 16u);
#pragma unroll
        for (int rr = 0; rr < 16; ++rr) { float s1 = 0.f, s2 = 0.f;
#pragma unroll
            for (int j = 0; j < 8; ++j) { const float v = bf2f((bf16)z[rr][j]); s1 += v; s2 += v * v; }
            const float m = wave_sum_dpp(s1) * (1.f / 512.f); const float var = fmaxf(wave_sum_dpp(s2) * (1.f / 512.f) - m * m, 0.f);
            if (lane == 0) { mean[16 * w + rr] = m; rstd[16 * w + rr] = rsqrtf(var + LN_EPS); } }
    }
#pragma unroll 1
    for (int gi = 0; gi < 2; ++gi) { const int g = 2 * gp + gi;
        {
            const int t = tid >> 2, seg = tid & 3; const float* wr = p.sg_w + ((size_t)(g * 128 + t)) * 128 + seg * 32;
#pragma unroll
            for (int j = 0; j < 4; ++j) { const f32x4 a = *(const f32x4*)(wr + 8 * j), c = *(const f32x4*)(wr + 8 * j + 4); const int s0 = seg * 32 + 8 * j; u32x4 o;
                o.x = cvt_pk_bf16(s0 + 0 <= t ? a[0] : 0.f, s0 + 1 <= t ? a[1] : 0.f); o.y = cvt_pk_bf16(s0 + 2 <= t ? a[2] : 0.f, s0 + 3 <= t ? a[3] : 0.f);
                o.z = cvt_pk_bf16(s0 + 4 <= t ? c[0] : 0.f, s0 + 5 <= t ? c[1] : 0.f); o.w = cvt_pk_bf16(s0 + 6 <= t ? c[2] : 0.f, s0 + 7 <= t ? c[3] : 0.f);
                *(LAS u32x4*)(WT + t * SD + s0) = o; }
        }
        const int cp = tid & 63, sgp = tid >> 6;
        unsigned zc[16];
#pragma unroll
        for (int i = 0; i < 16; ++i) zc[i] = ldg<unsigned>(ZG + (row0 + 16 * sgp) * 1024 + 512 + g * 128, (unsigned)(i * 1024 + 2 * cp) * 2u);
        __syncthreads();
        {
            const f32x2 lg = ldg<f32x2>(p.sg_ln_g + g * 128, (unsigned)cp * 8u), lb = ldg<f32x2>(p.sg_ln_b + g * 128, (unsigned)cp * 8u);
#pragma unroll
            for (int i8 = 0; i8 < 2; ++i8) { float va[8], vb[8];
#pragma unroll
                for (int j = 0; j < 8; ++j) { const int s_ = 16 * sgp + 8 * i8 + j; const float m = mean[s_], rs = rstd[s_];
                    va[j] = (__uint_as_float(zc[8 * i8 + j] << 16) - m) * rs * lg.x + lb.x; vb[j] = (__uint_as_float(zc[8 * i8 + j] & 0xffff0000u) - m) * rs * lg.y + lb.y; }
                *(LAS u32x4*)(VNT + (2 * cp) * SD + 16 * sgp + 8 * i8) = (u32x4){cvt_pk_bf16(va[0], va[1]), cvt_pk_bf16(va[2], va[3]), cvt_pk_bf16(va[4], va[5]), cvt_pk_bf16(va[6], va[7])};
                *(LAS u32x4*)(VNT + (2 * cp + 1) * SD + 16 * sgp + 8 * i8) = (u32x4){cvt_pk_bf16(vb[0], vb[1]), cvt_pk_bf16(vb[2], vb[3]), cvt_pk_bf16(vb[4], vb[5]), cvt_pk_bf16(vb[6], vb[7])}; }
        }
        __syncthreads();
        bf16x8 aw[4];
#pragma unroll
        for (int ks = 0; ks < 4; ++ks) aw[ks] = frag(WT, SD, w, ks, lane);
#pragma unroll
        for (int cb = 0; cb < 8; ++cb) { f32x4 a = (f32x4){0.f, 0.f, 0.f, 0.f};
#pragma unroll
            for (int ks = 0; ks < 4; ++ks) a = mma16(aw[ks], frag(VNT, SD, cb, ks, lane), a);
#pragma unroll
            for (int r = 0; r < 4; ++r) OM[(16 * w + 4 * q4 + r) * SO + 16 * cb + r16] = a[r]; }
        __syncthreads();
        {
            const int t = tid >> 2, cs = (tid & 3) * 32; const float sb = p.sg_b[g * 128 + t];
            const bf16* up = ZG + (row0 + t) * 1024 + g * 128 + cs; bf16* op = YC + (row0 + t) * D + 512 + g * 128 + cs;
#pragma unroll
            for (int k = 0; k < 4; ++k) { const u32x4 uu = *(const u32x4*)(up + 8 * k); const f32x4 m0 = *(const LAS f32x4*)(OM + t * SO + cs + 8 * k), m1 = *(const LAS f32x4*)(OM + t * SO + cs + 8 * k + 4);
                u32x4 o;
                o.x = cvt_pk_bf16(__uint_as_float(uu.x << 16) * (m0[0] + sb), __uint_as_float(uu.x & 0xffff0000u) * (m0[1] + sb)); o.y = cvt_pk_bf16(__uint_as_float(uu.y << 16) * (m0[2] + sb), __uint_as_float(uu.y & 0xffff0000u) * (m0[3] + sb));
                o.z = cvt_pk_bf16(__uint_as_float(uu.z << 16) * (m1[0] + sb), __uint_as_float(uu.z & 0xffff0000u) * (m1[1] + sb)); o.w = cvt_pk_bf16(__uint_as_float(uu.w << 16) * (m1[2] + sb), __uint_as_float(uu.w & 0xffff0000u) * (m1[3] + sb));
                *(u32x4*)(op + 8 * k) = o; }
        }
    }
    __syncthreads();
}

typedef GAS unsigned gu32;
#define XB_TMO      128
#define XB_XCNT(j)  (256  + 64 * (j))
#define XB_XSUB(j)  (1280 + 64 * (j))
#define XB_XGEN(j)  (2304 + 64 * (j))
#define XB_TOP      3328
#define XB_TOPGEN   3392
#define XCD_BAR_WORDS 3456
#define XB_SPIN_CAP (1u << 18)
__device__ __forceinline__ unsigned xb_ld(unsigned* p)              { return __hip_atomic_load(p, __ATOMIC_RELAXED, __HIP_MEMORY_SCOPE_AGENT); }
__device__ __forceinline__ unsigned xb_add(unsigned* p, unsigned v) { return __hip_atomic_fetch_add(p, v, __ATOMIC_RELAXED, __HIP_MEMORY_SCOPE_AGENT); }
__device__ __forceinline__ unsigned xb_xcc_id() { return (unsigned)__builtin_amdgcn_s_getreg((3 << 11) | 20) & 0xFu; }
#define XB_SPIN(cond, bar) do { unsigned _sp = 0; while (cond) { __builtin_amdgcn_s_sleep(1); \
    if ((++_sp & 255u) == 0u) { if (xb_ld(&(bar)[XB_TMO])) break; if (_sp > XB_SPIN_CAP) { atomicAdd(&(bar)[XB_TMO], 1u); break; } } } } while (0)
struct XcdBarrier { unsigned* bar; unsigned x; volatile LAS unsigned* st; };
__device__ __forceinline__ XcdBarrier xcd_barrier_post(const int swave, unsigned* bar, volatile LAS unsigned* st) {
    XcdBarrier b; b.bar = bar; b.x = xb_xcc_id(); b.st = st;
    if (otid(swave) == 0) (void)xb_add(&bar[XB_XCNT(b.x)], 1u);
    return b;
}
__device__ __forceinline__ void xcd_barrier_complete(unsigned* bar, unsigned x, unsigned& nloc, unsigned& nx) {
    const unsigned G = gridDim.x * gridDim.y * gridDim.z;
    unsigned sum, cnt, mine, sp = 0u;
    for (;;) {
        sum = 0u; cnt = 0u; mine = 0u;
#pragma unroll
        for (unsigned j = 0; j < 16; ++j) { const unsigned c = xb_ld(&bar[XB_XCNT(j)]); sum += c; cnt += (c > 0u) ? 1u : 0u; mine = (j == x) ? c : mine; }
        if (sum == G) break;
        __builtin_amdgcn_s_sleep(1);
        if ((++sp & 255u) == 0u) { if (xb_ld(&bar[XB_TMO])) break; if (sp > XB_SPIN_CAP) { atomicAdd(&bar[XB_TMO], 1u); break; } }
    }
    nloc = mine > 0u ? mine : 1u; nx = cnt > 0u ? cnt : 1u;
}
__device__ __forceinline__ void xcd_barrier(const int swave, const XcdBarrier& b) {
    asm volatile("s_waitcnt vmcnt(0)" ::: "memory");
    __syncthreads();
    if (otid(swave) == 0) {
        unsigned* bar = b.bar;
        __builtin_amdgcn_s_waitcnt(0);
        unsigned nloc = b.st[0], nx = b.st[1];
        if (nloc == 0u) { xcd_barrier_complete(bar, b.x, nloc, nx); b.st[0] = nloc; b.st[1] = nx; }
        const unsigned old = xb_add(&bar[XB_XSUB(b.x)], 1u);
        const unsigned gen = old / nloc;
        if (old + 1u == (gen + 1u) * nloc) {
            __builtin_amdgcn_fence(__ATOMIC_RELEASE, "agent");
            asm volatile("s_waitcnt vmcnt(0)" ::: "memory");
            const unsigned og = xb_add(&bar[XB_TOP], 1u);
            const unsigned tg = og / nx;
            if (og + 1u == (tg + 1u) * nx) xb_add(&bar[XB_TOPGEN], 1u);
            else XB_SPIN(xb_ld(&bar[XB_TOPGEN]) == tg, bar);
            __builtin_amdgcn_fence(__ATOMIC_ACQUIRE, "agent");
            xb_add(&bar[XB_XGEN(b.x)], 1u);
            asm volatile("s_waitcnt vmcnt(0)" ::: "memory");
        } else {
            XB_SPIN(xb_ld(&bar[XB_XGEN(b.x)]) == gen, bar);
            __builtin_amdgcn_fence(__ATOMIC_ACQUIRE, "agent");
            asm volatile("s_waitcnt vmcnt(0)" ::: "memory");
        }
    }
    __syncthreads();
}
constexpr int CW_BAR = 4096;

__device__ __forceinline__ unsigned pk2(float lo, float hi) { return (unsigned)f2bf(lo) | ((unsigned)f2bf(hi) << 16); }
struct TrItem { const float* src; bf16* wt; int N, K, k0, n0, up; };
__device__ __forceinline__ TrItem tr_locate(const P& p, int it) {
    constexpr int I_IN = (D / 64) * (NIN / 64), I_OUT = (D / 64) * (D / 64), I_UP1 = (D / 64) * (1024 / 64), I_DN1 = (HID / 64) * (D / 64);
    const float* W; bf16* WT; int K, N, up = 0, r = it;
    if (r < I_IN) { W = p.w_in; WT = WSP(bf16, WS_WINT); K = D; N = NIN; }
    else if ((r -= I_IN) < I_OUT) { W = p.w_out; WT = WSP(bf16, WS_WOUTT); K = D; N = D; }
    else if ((r -= I_OUT) < NE * I_UP1) { const int e = r / I_UP1; r -= e * I_UP1; W = p.w_up + (size_t)e * D * 1024; WT = WSP(bf16, WS_WUPT) + (size_t)e * D * 1024; K = D; N = 1024; up = 1; }
    else { r -= NE * I_UP1; const int e = r / I_DN1; r -= e * I_DN1; W = p.w_down + (size_t)e * HID * D; WT = WSP(bf16, WS_WDNT) + (size_t)e * HID * D; K = HID; N = D; }
    const int nblk = N / 64, kb = r / nblk, nb = r % nblk, lane = (int)__builtin_amdgcn_mbcnt_hi(~0u, __builtin_amdgcn_mbcnt_lo(~0u, 0u));
    TrItem t; t.k0 = 64 * kb; t.n0 = 64 * nb; t.src = W + (size_t)t.k0 * N + t.n0 + lane; t.wt = WT; t.N = N; t.K = K; t.up = up; return t;
}
__device__ __forceinline__ void tr_load(const TrItem& t, float (&r)[64]) {
#pragma unroll
    for (int i = 0; i < 64; ++i) r[i] = __builtin_nontemporal_load(t.src + (size_t)i * t.N);
}
__device__ __forceinline__ void tr_store(const TrItem& t, const float (&r)[64], LAS unsigned char* scr) {
    const int lane = (int)__builtin_amdgcn_mbcnt_hi(~0u, __builtin_amdgcn_mbcnt_lo(~0u, 0u));
#pragma unroll
    for (int j = 0; j < 8; ++j) { u32x4 o; o.x = cvt_pk_bf16(r[8 * j], r[8 * j + 1]); o.y = cvt_pk_bf16(r[8 * j + 2], r[8 * j + 3]); o.z = cvt_pk_bf16(r[8 * j + 4], r[8 * j + 5]); o.w = cvt_pk_bf16(r[8 * j + 6], r[8 * j + 7]);
        *(LAS u32x4*)(scr + lane * 144 + 16 * j) = o; }
    asm volatile("s_waitcnt lgkmcnt(0)" ::: "memory");
    const int rr = lane >> 3, c = lane & 7;
#pragma unroll
    for (int j = 0; j < 8; ++j) { const int nn = t.n0 + 8 * j + rr; const u32x4 o = *(const LAS u32x4*)(scr + (8 * j + rr) * 144 + 16 * c);
        __builtin_nontemporal_store(o, (u32x4*)(t.wt + (size_t)(t.up ? updst(nn) : nn) * t.K + t.k0 + 8 * c)); }
    asm volatile("s_waitcnt lgkmcnt(0)" ::: "memory");
}
__device__ __forceinline__ void phase_prep(const int swave, const P& p, LAS unsigned char* lds, int bx, int G) {
    const int tid = otid(swave), lane = tid & 63, w = __builtin_amdgcn_readfirstlane(tid >> 6);
    if (bx < 192) {
        LAS float* sc = (LAS float*)lds; LAS float* red = sc + 2048;
        for (int i = tid; i < 2048; i += NTHR) sc[i] = silu_f(p.c[i]);
        __syncthreads();
        for (int cb = bx; cb < 192; cb += G) {
            const int kg = tid >> 5, cl = tid & 31, colj = cb * 32 + cl; float a0 = 0.f, a1 = 0.f;
            float wv[64];
#pragma unroll
            for (int i = 0; i < 64; ++i) wv[i] = __builtin_nontemporal_load(p.w_ada + (size_t)(kg + 16 * i) * 6144 + colj);
#pragma unroll
            for (int i = 0; i < 64; ++i) { const int k = kg + 16 * i; a0 += sc[k] * wv[i]; a1 += sc[1024 + k] * wv[i]; }
            red[(kg * 32 + cl) * 2] = a0; red[(kg * 32 + cl) * 2 + 1] = a1;
            __syncthreads();
            if (tid < 64) { const int c2 = tid & 31, bb = tid >> 5; float t = 0.f;
#pragma unroll
                for (int k2 = 0; k2 < 16; ++k2) t += red[(k2 * 32 + c2) * 2 + bb];
                __hip_atomic_store(WSP(float, WS_SMALL + SM_ADA) + bb * 6144 + cb * 32 + c2, t + p.b_ada[cb * 32 + c2], __ATOMIC_RELAXED, __HIP_MEMORY_SCOPE_AGENT);
                asm volatile("s_waitcnt vmcnt(0)" ::: "memory");
                if (tid == 0) __hip_atomic_fetch_add(WSP(unsigned, WS_CTL) + CW_ADA, 1u, __ATOMIC_RELAXED, __HIP_MEMORY_SCOPE_AGENT); }
            __syncthreads();
        }
    }
    if (bx == G - 1) { const float l0 = p.lb_logits[tid], l1 = p.lb_logits[512 + tid]; const float m = fmaxf(l0, l1); const float e0 = expf(l0 - m), e1 = expf(l1 - m);
        WSP(float, WS_SMALL + SM_LB)[tid] = e0 / (e0 + e1); }
    constexpr int NITEMS = (D / 64) * (NIN / 64) + (D / 64) * (D / 64) + NE * (D / 64) * (1024 / 64) + NE * (HID / 64) * (D / 64);
    LAS int* qs = (LAS int*)(lds + LDSCTL_OFF) + LC_Q;
    LAS unsigned char* scr = lds + 16384 + w * 9216;
    if (tid == 0) qs[0] = (int)atomicAdd(WSP(unsigned, WS_CTL) + CW_PREPQ, 24u);
    __syncthreads();
    int base = qs[0];
#pragma unroll 1
    while (base < NITEMS) {
        __syncthreads();
        int nxt = 0; if (tid == 0) nxt = (int)atomicAdd(WSP(unsigned, WS_CTL) + CW_PREPQ, 24u);
        const int it = base + 3 * w;
        if (it < NITEMS) {
            const TrItem ta = tr_locate(p, it); float ra[64]; tr_load(ta, ra);
            if (it + 2 < NITEMS) { const TrItem tb = tr_locate(p, it + 1), tc = tr_locate(p, it + 2); float rb[64], rc[64]; tr_load(tb, rb); tr_load(tc, rc); tr_store(ta, ra, scr); tr_store(tb, rb, scr); tr_store(tc, rc, scr); }
            else if (it + 1 < NITEMS) { const TrItem tb = tr_locate(p, it + 1); float rb[64]; tr_load(tb, rb); tr_store(ta, ra, scr); tr_store(tb, rb, scr); }
            else tr_store(ta, ra, scr);
        }
        if (tid == 0) qs[0] = nxt;
        __syncthreads();
        base = qs[0];
    }
}
__device__ __forceinline__ void phase_xmod(const int swave, const P& p, int bx, int G) {
    const int lane = otid(swave) & 63, gw = bx * NWAVES + (otid(swave) >> 6), NGW = G * NWAVES; const unsigned l16 = (unsigned)lane * 16u, l8 = (unsigned)lane * 8u;
#pragma unroll 1
    for (int row = 4 * gw; row < T; row += 4 * NGW) { const float* ada = WSP(float, WS_SMALL + SM_ADA) + (row >> 13) * 6144;
        f32x4 xv[4][4];
#pragma unroll
        for (int r = 0; r < 4; ++r)
#pragma unroll
            for (int j = 0; j < 4; ++j) xv[r][j] = ldg_nt<f32x4>(p.x + (size_t)(row + r) * D + 256 * j, l16);
#pragma unroll
        for (int j = 0; j < 4; ++j) { const f32x4 sh = ldg<f32x4>(ada + 256 * j, l16), sc = ldg<f32x4>(ada + 1024 + 256 * j, l16);
#pragma unroll
            for (int r = 0; r < 4; ++r) { u32x2 o; o.x = cvt_pk_bf16(xv[r][j][0] * (1.f + sc[0]) + sh[0], xv[r][j][1] * (1.f + sc[1]) + sh[1]); o.y = cvt_pk_bf16(xv[r][j][2] * (1.f + sc[2]) + sh[2], xv[r][j][3] * (1.f + sc[3]) + sh[3]);
                stg<u32x2>(WSP(bf16, WS_B) + (size_t)(row + r) * D + 256 * j, l8, o); } } }
}
__device__ __forceinline__ void route_load_weights(const int swave, const P& p, LAS float* WR) {
    for (int c = otid(swave); c < D; c += NTHR) { const f32x4 wg = *(const f32x4*)(p.rg_w + (size_t)c * 4);
#pragma unroll
        for (int g = 0; g < 4; ++g) { WR[g * D + c] = wg[g];
            const f32x4 w0 = *(const f32x4*)(p.re_w + ((size_t)g * D + c) * 8), w1 = *(const f32x4*)(p.re_w + ((size_t)g * D + c) * 8 + 4);
#pragma unroll
            for (int e = 0; e < 4; ++e) { WR[(4 + g * 8 + e) * D + c] = w0[e]; WR[(4 + g * 8 + 4 + e) * D + c] = w1[e]; } } }
}
__device__ __forceinline__ void route_load2(const P& p, int row, int lane, f32x4 (&x)[2][4], u32x2 (&y)[2][4]) {
    const unsigned l16 = (unsigned)lane * 16u, l8 = (unsigned)lane * 8u;
#pragma unroll
    for (int r = 0; r < 2; ++r) { const float* xr = p.x + (size_t)(row + r) * D; const bf16* yr = WSP(bf16, WS_Y) + (size_t)(row + r) * D;
#pragma unroll
        for (int j = 0; j < 4; ++j) { x[r][j] = ldg_nt<f32x4>(xr + 256 * j, l16); y[r][j] = ldg_nt<u32x2>(yr + 256 * j, l8); } }
}
__device__ __forceinline__ float wave_sum_l63(float v) { DPP_ADD(v, 0xB1, 0xF); DPP_ADD(v, 0x4E, 0xF); DPP_ADD(v, 0x141, 0xF); DPP_ADD(v, 0x140, 0xF); DPP_ADD(v, 0x142, 0xA); DPP_ADD(v, 0x143, 0xC); return v; }
__device__ __forceinline__ void route_topk(const LAS float* lgs, LAS int* rt_e, LAS float* rt_w, int rl, int lane) {
    const f32x4 g4 = *(const LAS f32x4*)lgs;
    int gi = 0; float gm = g4[0];
#pragma unroll
    for (int g = 1; g < 4; ++g) if (g4[g] > gm) { gm = g4[g]; gi = g; }
    float gs = 0.f;
#pragma unroll
    for (int g = 0; g < 4; ++g) gs += __expf(g4[g] - gm);
    const float pgroup = 1.f / gs;
    const f32x4 ea = *(const LAS f32x4*)(lgs + 4 + 8 * gi), eb = *(const LAS f32x4*)(lgs + 8 + 8 * gi);
    float el[8] = {ea[0], ea[1], ea[2], ea[3], eb[0], eb[1], eb[2], eb[3]};
    int j0 = 0; float m0 = el[0];
#pragma unroll
    for (int e = 1; e < 8; ++e) if (el[e] > m0) { m0 = el[e]; j0 = e; }
    int j1 = -1; float m1 = -3.0e38f;
#pragma unroll
    for (int e = 0; e < 8; ++e) if (e != j0 && el[e] > m1) { m1 = el[e]; j1 = e; }
    const float r1 = __expf(m1 - m0);
    if (lane == 0) { rt_e[2 * rl] = gi * 8 + j0; rt_e[2 * rl + 1] = gi * 8 + j1; rt_w[2 * rl] = pgroup / (1.f + r1); rt_w[2 * rl + 1] = pgroup * r1 / (1.f + r1); }
}
__device__ __forceinline__ void ln1_route_rows2(const P& p, const LAS float* WR, LAS float* lgs, LAS int* rt_e, LAS float* rt_w, int row, int rl, int lane, const f32x4 (&x)[2][4], const u32x2 (&y)[2][4]) {
    const float* ada = WSP(float, WS_SMALL + SM_ADA) + (row >> 13) * 6144;
    const unsigned l16 = (unsigned)lane * 16u, l8 = (unsigned)lane * 8u;
    f32x4 g1v[4], pg[4], pb[4], ps[4], pc[4];
#pragma unroll
    for (int j = 0; j < 4; ++j) g1v[j] = ldg<f32x4>(ada + 2048 + 256 * j, l16);
#pragma unroll
    for (int j = 0; j < 4; ++j) { pg[j] = ldg<f32x4>(p.ln1_g + 256 * j, l16); pb[j] = ldg<f32x4>(p.ln1_b + 256 * j, l16); ps[j] = ldg<f32x4>(ada + 3072 + 256 * j, l16); pc[j] = ldg<f32x4>(ada + 4096 + 256 * j, l16); }
    float v[2][16], rstd[2];
#pragma unroll
    for (int r = 0; r < 2; ++r) { float s = 0.f;
#pragma unroll
        for (int j = 0; j < 4; ++j) {
            const float y0 = __uint_as_float(y[r][j].x << 16), y1 = __uint_as_float(y[r][j].x & 0xffff0000u), y2 = __uint_as_float(y[r][j].y << 16), y3 = __uint_as_float(y[r][j].y & 0xffff0000u);
            v[r][4 * j] = ALPHA * x[r][j][0] + (1.f + g1v[j][0]) * y0; v[r][4 * j + 1] = ALPHA * x[r][j][1] + (1.f + g1v[j][1]) * y1; v[r][4 * j + 2] = ALPHA * x[r][j][2] + (1.f + g1v[j][2]) * y2; v[r][4 * j + 3] = ALPHA * x[r][j][3] + (1.f + g1v[j][3]) * y3;
            s += (v[r][4 * j] + v[r][4 * j + 1]) + (v[r][4 * j + 2] + v[r][4 * j + 3]); }
        const float mean = wave_sum_dpp(s) * (1.f / D); float q = 0.f;
#pragma unroll
        for (int i = 0; i < 16; ++i) { v[r][i] -= mean; q += v[r][i] * v[r][i]; }
        rstd[r] = rsqrtf(wave_sum_dpp(q) * (1.f / D) + LN_EPS); }
    f32x2 hv[16];
#pragma unroll
    for (int r = 0; r < 2; ++r) { bf16* X1 = WSP(bf16, WS_X1) + (size_t)(row + r) * D; bf16* H2 = WSP(bf16, WS_B) + (size_t)(row + r) * D;
#pragma unroll
        for (int j = 0; j < 4; ++j) { f32x4 x1; float h[4];
#pragma unroll
            for (int i = 0; i < 4; ++i) { x1[i] = v[r][4 * j + i] * rstd[r] * pg[j][i] + pb[j][i]; h[i] = x1[i] * (1.f + pc[j][i]) + ps[j][i]; if (r == 0) hv[4 * j + i].x = h[i]; else hv[4 * j + i].y = h[i]; }
            { u32x2 xo; xo.x = cvt_pk_bf16(x1[0], x1[1]); xo.y = cvt_pk_bf16(x1[2], x1[3]); stg<u32x2>(X1 + 256 * j, l8, xo); }
            u32x2 o; o.x = cvt_pk_bf16(h[0], h[1]); o.y = cvt_pk_bf16(h[2], h[3]); stg<u32x2>(H2 + 256 * j, l8, o); } }
    __builtin_amdgcn_sched_barrier(0);
    const LAS char* wp = (const LAS char*)WR + lane * 16;
    float gl[2][4];
#pragma unroll
    for (int o = 0; o < 4; ++o) { f32x2 a[4];
#pragma unroll
        for (int j = 0; j < 4; ++j) { const f32x4 wv = *(const LAS f32x4*)(wp + 4096 * o + 1024 * j); a[j] = hv[4 * j] * (f32x2){wv[0], wv[0]};
#pragma unroll
            for (int i = 1; i < 4; ++i) a[j] = __builtin_elementwise_fma(hv[4 * j + i], (f32x2){wv[i], wv[i]}, a[j]); }
        const f32x2 t = (a[0] + a[1]) + (a[2] + a[3]); const float bias = p.rg_b[o];
        gl[0][o] = wave_sum_dpp(t.x) + bias; gl[1][o] = wave_sum_dpp(t.y) + bias; }
#pragma unroll
    for (int r = 0; r < 2; ++r) {
        int gi = 0; float gm = gl[r][0];
#pragma unroll
        for (int g = 1; g < 4; ++g) if (gl[r][g] > gm) { gm = gl[r][g]; gi = g; }
        gi = __builtin_amdgcn_readfirstlane(gi);
        float gs = 0.f;
#pragma unroll
        for (int g = 0; g < 4; ++g) gs += __expf(gl[r][g] - gm);
        const float pgroup = 1.f / gs;
        const LAS char* we = wp + (4 + 8 * gi) * 4096;
        int coll = 0;
#pragma unroll
        for (int e = 0; e < 8; ++e) { float a[4];
#pragma unroll
            for (int j = 0; j < 4; ++j) { const f32x4 wv = *(const LAS f32x4*)(we + 4096 * e + 1024 * j);
                a[j] = (r == 0 ? hv[4 * j].x : hv[4 * j].y) * wv[0];
#pragma unroll
                for (int i = 1; i < 4; ++i) a[j] = __builtin_fmaf(r == 0 ? hv[4 * j + i].x : hv[4 * j + i].y, wv[i], a[j]); }
            const float sv = wave_sum_l63((a[0] + a[1]) + (a[2] + a[3]));
            const int rv = __builtin_amdgcn_readlane(__float_as_int(sv), 63);
            asm volatile("v_writelane_b32 %0, %1, %2" : "+v"(coll) : "s"(rv), "i"(e)); }
        LAS float* l8 = lgs + 64 * r;
        l8[lane] = __int_as_float(coll) + p.re_b[gi * 8 + (lane & 7)];
        asm volatile("s_waitcnt lgkmcnt(0)" ::: "memory");
        const f32x4 ea = *(const LAS f32x4*)l8, eb = *(const LAS f32x4*)(l8 + 4);
        const float el[8] = {ea[0], ea[1], ea[2], ea[3], eb[0], eb[1], eb[2], eb[3]};
        int j0 = 0; float m0 = el[0];
#pragma unroll
        for (int e = 1; e < 8; ++e) if (el[e] > m0) { m0 = el[e]; j0 = e; }
        int j1 = -1; float m1 = -3.0e38f;
#pragma unroll
        for (int e = 0; e < 8; ++e) if (e != j0 && el[e] > m1) { m1 = el[e]; j1 = e; }
        const float r1 = __expf(m1 - m0);
        if (lane == 0) { rt_e[2 * (rl + r)] = gi * 8 + j0; rt_e[2 * (rl + r) + 1] = gi * 8 + j1; rt_w[2 * (rl + r)] = pgroup / (1.f + r1); rt_w[2 * (rl + r) + 1] = pgroup * r1 / (1.f + r1); }
    }
}
__device__ __forceinline__ void route_assign(const int swave, const P& p, const LAS int* rt_e, const LAS float* rt_w, LAS int* rt_base, int rowbase) {
    const int lane = otid(swave);
    const int e0 = rt_e[lane], e1 = rt_e[lane + 64];
    const unsigned long long lt = (1ull << lane) - 1ull;
    int rank0 = 0, rank1 = 0, mycnt = 0;
#pragma unroll 4
    for (int e = 0; e < NE; ++e) { const unsigned long long m0 = __ballot(e0 == e), m1 = __ballot(e1 == e); const int c0 = __popcll(m0);
        if (e0 == e) rank0 = __popcll(m0 & lt);
        if (e1 == e) rank1 = c0 + __popcll(m1 & lt);
        if (lane == e) mycnt = c0 + __popcll(m1); }
    if (lane < NE) rt_base[lane] = mycnt ? (int)atomicAdd(WSP(unsigned, WS_CTL) + CW_CNT + lane, (unsigned)mycnt) : 0;
    asm volatile("s_waitcnt vmcnt(0) lgkmcnt(0)" ::: "memory");
    int* LIST = WSP(int, WS_LIST); float* WL = WSP(float, WS_WLIST); int* TE = WSP(int, WS_SMALL + SM_TOKE); int* TS = WSP(int, WS_SMALL + SM_TOKS);
    { const int slot = rt_base[e0] + rank0, row = rowbase + (lane >> 1); LIST[e0 * T + slot] = row; WL[e0 * T + slot] = rt_w[lane]; TE[row * 2 + (lane & 1)] = e0; TS[row * 2 + (lane & 1)] = slot; }
    { const int a = lane + 64, slot = rt_base[e1] + rank1, row = rowbase + (a >> 1); LIST[e1 * T + slot] = row; WL[e1 * T + slot] = rt_w[a]; TE[row * 2 + (a & 1)] = e1; TS[row * 2 + (a & 1)] = slot; }
}
template <int NR> __device__ __forceinline__ void final_rows(const P& p, const LAS int* tstart, int row, int lane, float pscale, float pspike) {
    const float* ada = WSP(float, WS_SMALL + SM_ADA) + (row >> 13) * 6144;
    const int* TE = WSP(int, WS_SMALL + SM_TOKE); const int* TS = WSP(int, WS_SMALL + SM_TOKS);
    const unsigned l16 = (unsigned)lane * 16u, l8 = (unsigned)lane * 8u;
    u32x2 xv[NR][4], pa[NR][4], pb[NR][4];
#pragma unroll
    for (int r = 0; r < NR; ++r) {
        const int e0 = TE[(row + r) * 2], e1 = TE[(row + r) * 2 + 1], s0 = TS[(row + r) * 2], s1 = TS[(row + r) * 2 + 1];
        const size_t rA = (size_t)(tstart[e0] * 256 + s0), rB = (size_t)(tstart[e1] * 256 + s1);
        const bf16* ya = WSP(bf16, WS_Y2) + rA * D; const bf16* yb = WSP(bf16, WS_Y2) + rB * D; const bf16* X1 = WSP(bf16, WS_X1) + (size_t)(row + r) * D;
#pragma unroll
        for (int j = 0; j < 4; ++j) { xv[r][j] = ldg_nt<u32x2>(X1 + 256 * j, l8); pa[r][j] = ldg_nt<u32x2>(ya + 256 * j, l8); pb[r][j] = ldg_nt<u32x2>(yb + 256 * j, l8); } }
    __builtin_amdgcn_sched_barrier(0);
#pragma unroll
    for (int r = 0; r < NR; ++r) {
        if (r) __builtin_amdgcn_sched_barrier(0);
        float v[16]; float s = 0.f;
#pragma unroll
        for (int j = 0; j < 4; ++j) { const f32x4 g2 = ldg<f32x4>(ada + 5120 + 256 * j, l16);
            const float m0 = __uint_as_float(pa[r][j].x << 16) + __uint_as_float(pb[r][j].x << 16), m1 = __uint_as_float(pa[r][j].x & 0xffff0000u) + __uint_as_float(pb[r][j].x & 0xffff0000u);
            const float m2 = __uint_as_float(pa[r][j].y << 16) + __uint_as_float(pb[r][j].y << 16), m3 = __uint_as_float(pa[r][j].y & 0xffff0000u) + __uint_as_float(pb[r][j].y & 0xffff0000u);
            const float x0 = __uint_as_float(xv[r][j].x << 16), x1 = __uint_as_float(xv[r][j].x & 0xffff0000u), x2 = __uint_as_float(xv[r][j].y << 16), x3 = __uint_as_float(xv[r][j].y & 0xffff0000u);
            v[4 * j + 0] = ALPHA * x0 + (1.f + g2[0]) * m0; v[4 * j + 1] = ALPHA * x1 + (1.f + g2[1]) * m1; v[4 * j + 2] = ALPHA * x2 + (1.f + g2[2]) * m2; v[4 * j + 3] = ALPHA * x3 + (1.f + g2[3]) * m3;
            s += (v[4 * j] + v[4 * j + 1]) + (v[4 * j + 2] + v[4 * j + 3]); }
        const float mean = wave_sum_dpp(s) * (1.f / D); float q = 0.f;
#pragma unroll
        for (int i = 0; i < 16; ++i) { v[i] -= mean; q += v[i] * v[i]; }
        const float rstd = rsqrtf(wave_sum_dpp(q) * (1.f / D) + LN_EPS);
#pragma unroll
        for (int j = 0; j < 4; ++j) { const f32x4 gg = ldg<f32x4>(p.ln2_g + 256 * j, l16), bb = ldg<f32x4>(p.ln2_b + 256 * j, l16); f32x4 o;
#pragma unroll
            for (int i = 0; i < 4; ++i) o[i] = (v[4 * j + i] * rstd * gg[i] + bb[i]) * pscale;
            if (j == 0 && lane == 0 && r == 0) o[0] += pspike;
            stg_nt<f32x4>(p.out + (size_t)(row + r) * D + 256 * j, l16, o); }
    }
}

enum { PH_PREP = 0, PH_INPROJ, PH_MIX, PH_OUTPROJ, PH_LN1ROUTE, PH_UP, PH_FINAL, PH_N };
struct Args { P p; int ph_lo, ph_hi, li, pad; };

__device__ __forceinline__ void moe_tables(const int swave, const P& p, LAS unsigned char* lds) {
    LAS int* tstart = (LAS int*)(lds + LDSCTL_OFF) + LC_TSTART; LAS int* lcnt = (LAS int*)(lds + LDSCTL_OFF) + LC_CNT;
    if (otid(swave) == 0) { int acc = 0;
        for (int e = 0; e < NE; ++e) { const int c = (int)__hip_atomic_load(WSP(unsigned, WS_CTL) + CW_CNT + e, __ATOMIC_RELAXED, __HIP_MEMORY_SCOPE_AGENT); tstart[e] = acc; lcnt[e] = c; acc += (c + 255) >> 8; }
        tstart[NE] = acc; }
    __syncthreads();
}

__device__ __forceinline__ P load_p() {
    typedef const __attribute__((address_space(4))) unsigned long long CU64;
    CU64* a = (CU64*)__builtin_amdgcn_kernarg_segment_ptr(); asm volatile("" : "+s"(a));
#define LP_F(i) ((const float*)(const GAS float*)(a[i]))
    P p;
    p.x = LP_F(0); p.c = LP_F(1); p.w_ada = LP_F(2); p.b_ada = LP_F(3); p.w_in = LP_F(4); p.lb_logits = LP_F(5); p.hg_norm_w = LP_F(6); p.sg_ln_g = LP_F(7); p.sg_ln_b = LP_F(8); p.sg_w = LP_F(9); p.sg_b = LP_F(10);
    p.w_out = LP_F(11); p.ln1_g = LP_F(12); p.ln1_b = LP_F(13); p.rg_w = LP_F(14); p.rg_b = LP_F(15); p.re_w = LP_F(16); p.re_b = LP_F(17); p.w_up = LP_F(18); p.w_down = LP_F(19); p.ln2_g = LP_F(20); p.ln2_b = LP_F(21);
    p.out = (float*)(GAS float*)(a[22]); p.ws = (unsigned char*)(GAS unsigned char*)(a[23]);
#undef LP_F
    return p;
}
__global__ void __launch_bounds__(NTHR, 2) mk_fwd(Args args) {
    extern __shared__ __attribute__((aligned(16))) unsigned char lds_raw[];
    LAS unsigned char* lds = (LAS unsigned char*)lds_raw;
    const P& p = args.p;
    const int G = gridDim.x, bx = blockIdx.x;
    const int swave = __builtin_amdgcn_readfirstlane((int)threadIdx.x >> 6);
    const int lo = args.ph_lo, hi = args.ph_hi;
#ifndef PHASE_MASK
#define PHASE_MASK 0x7f
#endif
#define IN(k) (((PHASE_MASK >> (k)) & 1) && lo <= (k) && (k) < hi)
#ifndef REP_PHASE
#define REP_PHASE -1
#define REP_N 0
#endif
#define NREP(k) ((k) == REP_PHASE ? REP_N : 0)
#ifdef PROBE_A
#define STAMP(k) do { if (otid(swave) == 0) { const unsigned long long t_ = __builtin_amdgcn_s_memrealtime(); __hip_atomic_store((unsigned long long*)(WSP(unsigned, WS_CTL) + 65536 + bx * 32) + (k), t_, __ATOMIC_RELAXED, __HIP_MEMORY_SCOPE_AGENT); } } while (0)
#else
#define STAMP(k) do { } while (0)
#endif
#define SEAM(k) do { if (rep_ == NREP(k)) { if (IN(k) && IN((k) + 1)) xcd_barrier(swave, bar); STAMP((k) + 1); } } while (0)
    for (int u = otid(swave); u < (LDS_BYTES - LDSCTL_OFF) / 4; u += NTHR) ((LAS unsigned*)(lds + LDSCTL_OFF))[u] = 0u;
    __syncthreads();
    XcdBarrier bar = xcd_barrier_post(swave, WSP(unsigned, WS_CTL) + CW_BAR + args.li * XCD_BAR_WORDS, (volatile LAS unsigned*)(lds + LDSCTL_OFF) + LC_BAR);
    { const P p = load_p(); STAMP(0); }
    if (IN(PH_PREP)) for (int rep_ = 0; rep_ <= NREP(PH_PREP); ++rep_) { if (rep_) xcd_barrier(swave, bar); asm volatile("; MARK PH_PREP"); const P p = load_p(); phase_prep(swave, p, lds, bx, G);
        if (otid(swave) == 0) { unsigned sp = 0; while (__hip_atomic_load(WSP(unsigned, WS_CTL) + CW_ADA, __ATOMIC_RELAXED, __HIP_MEMORY_SCOPE_AGENT) < 192u && ++sp < (1u << 22)) __builtin_amdgcn_s_sleep(2);
            __builtin_amdgcn_fence(__ATOMIC_ACQUIRE, "agent"); asm volatile("s_waitcnt vmcnt(0)" ::: "memory"); }
        __syncthreads();
        phase_xmod(swave, p, bx, G); SEAM(PH_PREP); }
    if (IN(PH_INPROJ)) for (int rep_ = 0; rep_ <= NREP(PH_INPROJ); ++rep_) { if (rep_) xcd_barrier(swave, bar); asm volatile("; MARK PH_INPROJ"); const P p = load_p();
        pg8::Gemm g{WSP(bf16, WS_B), WSP(bf16, WS_WINT), D, 0, 0, nullptr}; pg8::StaticOrder S; S.init(T, NIN, G, bx);
        pg8::EpiInproj E{p.ws};
        pg8::gemm_phase<pg8::EpiInproj, pg8::StaticOrder, true, true, false>(swave, lds, g, S, E);
        SEAM(PH_INPROJ);
    }
    if (IN(PH_MIX)) for (int rep_ = 0; rep_ <= NREP(PH_MIX); ++rep_) { if (rep_) xcd_barrier(swave, bar); asm volatile("; MARK PH_MIX"); const P p = load_p();
        const int grp = bx >> 5; unsigned* cA = WSP(unsigned, WS_CTL) + CW_MIXA + 64 * grp; unsigned* cB = WSP(unsigned, WS_CTL) + CW_MIXB + 64 * grp;
#define GROUP_PUBLISH(cnt) do { asm volatile("s_waitcnt vmcnt(0)" ::: "memory"); __syncthreads(); if (otid(swave) == 0) __hip_atomic_fetch_add((cnt), 1u, __ATOMIC_RELAXED, __HIP_MEMORY_SCOPE_AGENT); } while (0)
#define GROUP_WAIT(cnt) do { if (otid(swave) == 0) { unsigned sp_ = 0; while (__hip_atomic_load((cnt), __ATOMIC_RELAXED, __HIP_MEMORY_SCOPE_AGENT) < 32u && ++sp_ < (1u << 20)) __builtin_amdgcn_s_sleep(2); \
            __builtin_amdgcn_fence(__ATOMIC_ACQUIRE, "agent"); asm volatile("s_waitcnt vmcnt(0)" ::: "memory"); } __syncthreads(); } while (0)
        hgrn_item<0>(swave, p, lds, bx);
        GROUP_PUBLISH(cA);
        sg_item(swave, p, lds, bx);
        GROUP_WAIT(cA);
        hgrn_scan(p, grp * 16384 + (bx & 31) * NTHR + otid(swave));
        GROUP_PUBLISH(cB);
        GROUP_WAIT(cB);
        hgrn_item<1>(swave, p, lds, bx);
#undef GROUP_PUBLISH
#undef GROUP_WAIT
        SEAM(PH_MIX);
    }
    if (IN(PH_OUTPROJ)) for (int rep_ = 0; rep_ <= NREP(PH_OUTPROJ); ++rep_) { if (rep_) xcd_barrier(swave, bar); asm volatile("; MARK PH_OUTPROJ"); const P p = load_p();
        pg8::Gemm g{WSP(bf16, WS_B), WSP(bf16, WS_WOUTT), D, 0, 0, nullptr}; pg8::StaticOrder S; S.init(T, D, G, bx);
        pg8::EpiBf16 E{p.ws, WS_Y, D};
        pg8::gemm_phase<pg8::EpiBf16, pg8::StaticOrder, true, true, false>(swave, lds, g, S, E);
        SEAM(PH_OUTPROJ);
    }
    if (IN(PH_LN1ROUTE)) for (int rep_ = 0; rep_ <= NREP(PH_LN1ROUTE); ++rep_) { if (rep_) xcd_barrier(swave, bar); asm volatile("; MARK PH_LN1ROUTE"); const P p = load_p();
        if (rep_) { if (bx == 0 && otid(swave) < 32) __hip_atomic_store(WSP(unsigned, WS_CTL) + CW_CNT + otid(swave), 0u, __ATOMIC_RELAXED, __HIP_MEMORY_SCOPE_AGENT); xcd_barrier(swave, bar); }
        const int lane = otid(swave) & 63, w = __builtin_amdgcn_readfirstlane(otid(swave) >> 6);
        LAS float* WR = (LAS float*)lds; LAS int* rt_e = (LAS int*)(lds + LDSCTL_OFF) + LC_RT; LAS float* rt_w = (LAS float*)(rt_e + 128); LAS int* rt_base = rt_e + 256;
        f32x4 xc[2][4]; u32x2 yc[2][4];
        route_load2(p, bx * 64 + 8 * w, lane, xc, yc);
        route_load_weights(swave, p, WR);
        __syncthreads();
        for (int rb = bx * 64; rb < T; rb += G * 64) {
            if (rb != bx * 64) route_load2(p, rb + 8 * w, lane, xc, yc);
#pragma unroll 1
            for (int pr = 0; pr < 4; ++pr) {
                f32x4 xn[2][4]; u32x2 yn[2][4];
                route_load2(p, rb + 8 * w + (pr < 3 ? 2 * pr + 2 : 2 * pr), lane, xn, yn);
                ln1_route_rows2(p, WR, (LAS float*)(lds + LDSCTL_OFF) + LC_LGS + 128 * w, rt_e, rt_w, rb + 8 * w + 2 * pr, 8 * w + 2 * pr, lane, xc, yc);
#pragma unroll
                for (int r = 0; r < 2; ++r)
#pragma unroll
                    for (int j = 0; j < 4; ++j) { xc[r][j] = xn[r][j]; yc[r][j] = yn[r][j]; }
            }
            __syncthreads();
            if (w == 0) route_assign(swave, p, rt_e, rt_w, rt_base, rb);
            __syncthreads();
        }
        SEAM(PH_LN1ROUTE);
    }
    if (IN(PH_UP)) for (int rep_ = 0; rep_ <= NREP(PH_UP); ++rep_) { if (rep_) xcd_barrier(swave, bar); asm volatile("; MARK PH_UP"); const P p = load_p();
        moe_tables(swave, p, lds);
        const LAS int* tstart = (const LAS int*)(lds + LDSCTL_OFF) + LC_TSTART; const LAS int* lcnt = (const LAS int*)(lds + LDSCTL_OFF) + LC_CNT;
        unsigned* ready = WSP(unsigned, WS_CTL) + CW_RDY;
        {
            pg8::Gemm g{WSP(bf16, WS_B), WSP(bf16, WS_WUPT), D, 0, (size_t)1024 * D * 2, WSP(int, WS_LIST)};
            pg8::MoeOrder S{tstart, lcnt, G, bx, 4};
            pg8::EpiUp E{p.ws};
            pg8::gemm_phase<pg8::EpiUp, pg8::MoeOrder, true, true, true>(swave, lds, g, S, E);
            if (otid(swave) == 0) { __builtin_amdgcn_fence(__ATOMIC_RELEASE, "agent"); asm volatile("s_waitcnt vmcnt(0)" ::: "memory");
                pg8::Unit u; for (int i = 0; S.next(i, u); ++i) __hip_atomic_fetch_add(ready + 64 * u.pm, 1u, __ATOMIC_RELAXED, __HIP_MEMORY_SCOPE_AGENT); }
        }
        {
            const int ntile = __builtin_amdgcn_readfirstlane(tstart[NE]), R = 4 * ntile - 2 * G > 0 ? 4 * ntile - 2 * G : 0;
            pg8::Gemm g{WSP(bf16, WS_ACT), WSP(bf16, WS_WDNT), HID, 0, (size_t)1024 * HID * 2, nullptr};
            int cr = (bx + G - R % G) % G;
            if (G == 256) { const int m = (bx & 7) + 8 * (bx >> 5), q = (bx >> 3) & 3, r = R / 4; cr = m < r ? (G - R + 4 * m + q) : (4 * (m - r) + q); }
            pg8::MoeDownOrder S{tstart, lcnt, G, cr, ntile, G / 4, R / 4, ready};
            pg8::EpiDown E{p.ws};
            pg8::gemm_phase<pg8::EpiDown, pg8::MoeDownOrder, true, true, false>(swave, lds, g, S, E);
        }
        SEAM(PH_UP);
    }
    if (IN(PH_FINAL)) for (int rep_ = 0; rep_ <= NREP(PH_FINAL); ++rep_) { if (rep_) xcd_barrier(swave, bar); asm volatile("; MARK PH_FINAL"); const P p = load_p();
        moe_tables(swave, p, lds);
        const int lane = otid(swave) & 63, gw = bx * NWAVES + (otid(swave) >> 6), NGW = G * NWAVES;
        float pscale = 1.f, pspike = 0.f;
#ifdef PROBE_A
        { const unsigned long long* ts = (const unsigned long long*)(WSP(unsigned, WS_CTL) + 65536 + bx * 32);
          const unsigned long long a0 = __hip_atomic_load(ts + PROBE_A, __ATOMIC_RELAXED, __HIP_MEMORY_SCOPE_AGENT), a1 = __hip_atomic_load(ts + PROBE_A + 1, __ATOMIC_RELAXED, __HIP_MEMORY_SCOPE_AGENT);
          const unsigned long long b0 = __hip_atomic_load(ts + PROBE_B, __ATOMIC_RELAXED, __HIP_MEMORY_SCOPE_AGENT), b1 = __hip_atomic_load(ts + PROBE_B + 1, __ATOMIC_RELAXED, __HIP_MEMORY_SCOPE_AGENT);
          pscale = 1.f + sqrtf((float)(a1 - a0) * 1e-5f); pspike = (float)(b1 - b0) * 0.1f; }
#endif
#pragma unroll 1
        for (int row = 4 * gw; row < T; row += 4 * NGW) { asm volatile("" ::: "memory"); final_rows<4>(p, (const LAS int*)(lds + LDSCTL_OFF) + LC_TSTART, row, lane, pscale, row == 0 ? pspike : 0.f); }
    }
#undef SEAM
#undef IN
}

#ifndef NAIVE_MASK
#define NAIVE_MASK 0
#endif
#ifndef MK_SPLIT
#define MK_SPLIT 0
#endif
static void launch_mk(const P& p, int lo, int hi, int li, hipStream_t s) {
    Args a{}; a.p = p; a.ph_lo = lo; a.ph_hi = hi; a.li = li; a.pad = 0;
    void* kargs[] = {&a};
    const hipError_t e = hipLaunchCooperativeKernel((const void*)mk_fwd, dim3(256), dim3(NTHR), kargs, LDS_BYTES, s);
    if (e != hipSuccess) fprintf(stderr, "kernel_launch: cooperative launch failed: %s\n", hipGetErrorString(e));
}
extern "C" void kernel_launch(void* const* d_in, const int* in_sizes, int n_in, void* d_out, int out_size, void* d_ws, size_t ws_size, hipStream_t stream) {
    if (n_in != 22 || ws_size < WS_END) { fprintf(stderr, "kernel_launch: unexpected n_in %d / ws %zu\n", n_in, ws_size); return; }
    static int inited = 0;
    if (!inited) { inited = 1;
        if (hipFuncSetAttribute((const void*)mk_fwd, hipFuncAttributeMaxDynamicSharedMemorySize, LDS_BYTES) != hipSuccess) fprintf(stderr, "kernel_launch: hipFuncSetAttribute failed\n"); }
    P p{};
    const float** f = (const float**)&p;
    for (int i = 0; i < 22; ++i) f[i] = (const float*)d_in[i];
    p.out = (float*)d_out; p.ws = (unsigned char*)d_ws;
    (void)hipMemsetAsync((char*)d_ws + WS_CTL, 0, 1 * MiB, stream);
    int li = 0;
    for (int k = 0; k < PH_N;) {
        int e = k + 1;
        if (!MK_SPLIT) while (e < PH_N && !((NAIVE_MASK >> e) & 1)) ++e;
        launch_mk(p, k, e, li++, stream);
        k = e;
    }
}
```
